# Optimizing an MI355X kernel written in HIP

```python
import math
import jax, jax.numpy as jnp
from jax import lax
import numpy as np

D_MODEL = 2048
BATCH = 4
SEQ = 4096
DEPTH = 4

N_A = DEPTH // 2
N_B = DEPTH - N_A

CHUNK = 128
A_WIDTH = D_MODEL
A_GROUPS = 16
A_GROUP_DIM = A_WIDTH // A_GROUPS

N_HEADS = 16
HEAD_DIM = 128
ATT_WIDTH = N_HEADS * HEAD_DIM
Q_BLOCK = 128

FFN_DIM = 5632
CONV_W = 3

EPS = 1e-6

kernel_name = "hybrid_gmlp_fox_yoco_convffn"


def rmsnorm(x, g):
    xf = x.astype(jnp.float32)
    r = lax.rsqrt(jnp.mean(xf * xf, axis=-1, keepdims=True) + EPS)
    return (xf * r).astype(x.dtype) * g


def chunked_gmlp(xn, w_in, v_norm, w_s, b_s, w_out):
    B, S, _ = xn.shape
    z = jax.nn.gelu(xn @ w_in, approximate=False)
    u, v = jnp.split(z, 2, axis=-1)
    v = rmsnorm(v, v_norm)
    v = v.reshape(B, S // CHUNK, CHUNK, A_GROUPS, A_GROUP_DIM)
    causal = jnp.tril(jnp.ones((CHUNK, CHUNK), dtype=bool))
    w = jnp.where(causal[None], w_s, jnp.zeros_like(w_s))
    mixed = jnp.einsum('gts,bnsgc->bntgc', w, v) + b_s.T[:, :, None]
    gated = u * mixed.reshape(B, S, A_WIDTH)
    return gated @ w_out


def conv_ffn(xn, w_up, conv_w, conv_b, w_down):
    S = xn.shape[1]
    h = xn @ w_up
    hp = jnp.pad(h, ((0, 0), (CONV_W - 1, 0), (0, 0)))
    h = sum(hp[:, k:k + S] * conv_w[k] for k in range(CONV_W)) + conv_b
    gate, val = jnp.split(h, 2, axis=-1)
    return (jax.nn.silu(gate) * val) @ w_down


def fox_shared_kv(h, kv_norm, w_kvf, b_f, k_norm):
    B, S, _ = h.shape
    xn = rmsnorm(h, kv_norm)
    kvf = xn @ w_kvf
    k = kvf[..., :ATT_WIDTH].reshape(B, S, N_HEADS, HEAD_DIM)
    v = kvf[..., ATT_WIDTH:2 * ATT_WIDTH].reshape(B, S, N_HEADS, HEAD_DIM)
    f = kvf[..., 2 * ATT_WIDTH:] + b_f
    k = rmsnorm(k, k_norm).transpose(0, 2, 1, 3)
    v = v.transpose(0, 2, 1, 3)
    log_f = jax.nn.log_sigmoid(f.astype(jnp.float32))
    c = jnp.cumsum(log_f, axis=1).transpose(0, 2, 1)
    return k, v, c


def forgetting_attention(xn, w_qg, q_norm, w_out, k, v, c):
    B, S, _ = xn.shape
    qg = xn @ w_qg
    q, g = jnp.split(qg, 2, axis=-1)
    q = rmsnorm(q.reshape(B, S, N_HEADS, HEAD_DIM), q_norm).transpose(0, 2, 1, 3)
    scale = HEAD_DIM ** -0.5
    outs = []
    for i in range(S // Q_BLOCK):
        lo, hi = i * Q_BLOCK, (i + 1) * Q_BLOCK
        qb = q[:, :, lo:hi]
        kb = k[:, :, :hi]
        vb = v[:, :, :hi]
        s = (jnp.einsum('bhqd,bhkd->bhqk', qb, kb).astype(jnp.float32) * scale
             + c[:, :, lo:hi, None] - c[:, :, None, :hi])
        mask = (lo + jnp.arange(Q_BLOCK))[:, None] >= jnp.arange(hi)[None, :]
        s = jnp.where(mask, s, -jnp.inf)
        p = jax.nn.softmax(s, axis=-1).astype(vb.dtype)
        outs.append(jnp.einsum('bhqk,bhkd->bhqd', p, vb))
    o = jnp.concatenate(outs, axis=2).transpose(0, 2, 1, 3).reshape(B, S, ATT_WIDTH)
    o = o * jax.nn.sigmoid(g)
    return o @ w_out


def setup_inputs(seed: int = 0) -> dict:
    key = jax.random.key(seed)
    ks = jax.random.split(key, 24)
    f32 = jnp.float32

    def nrm(k, shape, scale):
        return jax.random.normal(k, shape, f32) * scale

    def gain(k, shape):
        return 1.0 + 0.02 * jax.random.normal(k, shape, f32)

    return {
        "x": jax.random.normal(ks[0], (BATCH, SEQ, D_MODEL), f32),
        "a_norm": gain(ks[1], (N_A, D_MODEL)),
        "a_w_in": nrm(ks[2], (N_A, D_MODEL, 2 * A_WIDTH), D_MODEL ** -0.5),
        "a_v_norm": gain(ks[3], (N_A, A_WIDTH)),
        "a_w_s": nrm(ks[4], (N_A, A_GROUPS, CHUNK, CHUNK), 0.5 * CHUNK ** -0.5),
        "a_b_s": 1.0 + 0.1 * jax.random.normal(ks[5], (N_A, A_GROUPS, CHUNK), f32),
        "a_w_out": nrm(ks[6], (N_A, A_WIDTH, D_MODEL), A_WIDTH ** -0.5),
        "kv_norm": gain(ks[7], (D_MODEL,)),
        "w_kvf": nrm(ks[8], (D_MODEL, 2 * ATT_WIDTH + N_HEADS), D_MODEL ** -0.5),
        "b_f": jax.random.uniform(ks[9], (N_HEADS,), f32, 2.0, 5.0),
        "k_norm": gain(ks[10], (HEAD_DIM,)),
        "b_norm": gain(ks[11], (N_B, D_MODEL)),
        "b_w_qg": nrm(ks[12], (N_B, D_MODEL, 2 * ATT_WIDTH), D_MODEL ** -0.5),
        "q_norm": gain(ks[13], (N_B, HEAD_DIM)),
        "b_w_out": nrm(ks[14], (N_B, ATT_WIDTH, D_MODEL), ATT_WIDTH ** -0.5),
        "f_norm": gain(ks[15], (DEPTH, D_MODEL)),
        "f_w_up": nrm(ks[16], (DEPTH, D_MODEL, 2 * FFN_DIM), D_MODEL ** -0.5),
        "f_conv_w": jnp.zeros((DEPTH, CONV_W, 2 * FFN_DIM), f32).at[:, CONV_W - 1].set(1.0)
                    + nrm(ks[17], (DEPTH, CONV_W, 2 * FFN_DIM), 0.3),
        "f_conv_b": nrm(ks[18], (DEPTH, 2 * FFN_DIM), 0.01),
        "f_w_down": nrm(ks[19], (DEPTH, FFN_DIM, D_MODEL), FFN_DIM ** -0.5),
        "final_norm": gain(ks[20], (D_MODEL,)),
    }


def reference(x, a_norm, a_w_in, a_v_norm, a_w_s, a_b_s, a_w_out,
              kv_norm, w_kvf, b_f, k_norm,
              b_norm, b_w_qg, q_norm, b_w_out,
              f_norm, f_w_up, f_conv_w, f_conv_b, f_w_down, final_norm):
    h = x
    k_sh = v_sh = c_sh = None
    for l in range(DEPTH):
        if l < N_A:
            h = h + chunked_gmlp(rmsnorm(h, a_norm[l]), a_w_in[l], a_v_norm[l],
                                 a_w_s[l], a_b_s[l], a_w_out[l])
        else:
            j = l - N_A
            h = h + forgetting_attention(rmsnorm(h, b_norm[j]), b_w_qg[j], q_norm[j],
                                         b_w_out[j], k_sh, v_sh, c_sh)
        h = h + conv_ffn(rmsnorm(h, f_norm[l]), f_w_up[l], f_conv_w[l],
                         f_conv_b[l], f_w_down[l])
        if l == N_A - 1:
            k_sh, v_sh, c_sh = fox_shared_kv(h, kv_norm, w_kvf, b_f, k_norm)
    return rmsnorm(h, final_norm)
```

```cpp
#include <hip/hip_runtime.h>
#include <hip/hip_cooperative_groups.h>
#include <hip/hip_bf16.h>
#include <cstdio>
#include <cstdint>
namespace cg = cooperative_groups;
__device__ __forceinline__ int opaque_tid() { int t = threadIdx.x; asm volatile("" : "+v"(t)); return t; }
namespace pg8 {
#define PG8_LAS __attribute__((address_space(3)))
typedef unsigned short bf16_t;
typedef short bf16x8 __attribute__((ext_vector_type(8)));
typedef float f32x4 __attribute__((ext_vector_type(4)));
typedef unsigned u32x4 __attribute__((ext_vector_type(4)));
constexpr int BM = 256, BK = 64, HALF = 128, HTB = HALF * BK * 2  , STAGE_BYTES = 8 * HTB, NXCD = 8, WGM = 8;

__host__ __device__ __forceinline__ int lds_byte(int r, int c) { const int st = (r >> 4) * 2 + (c >> 5), rr = r & 15, cc = c & 31, ob = rr * 64 + cc * 2; return st * 1024 + (ob ^ (((ob >> 9) & 1) << 5)); }
__host__ __device__ __forceinline__ void stage_rc(int b, int& R, int& C) { const int st = b / 1024, sb = b % 1024, swz = sb ^ (((sb >> 9) & 1) << 5); R = (st >> 1) * 16 + swz / 64; C = (st & 1) * 32 + (swz % 64) / 2; }
__host__ __device__ __forceinline__ int perm32(int rho) { const int n = rho >> 4, i = rho & 15; return 8 * (i >> 2) + 4 * n + (i & 3); }

struct Unit { int pm, pn; };
struct Gemm { const bf16_t* A; const bf16_t* Bt; int M, N, K; };

struct StaticOrder {
    int nM, nN, nwg, G, c;
    __host__ __device__ void init(int M, int N, int G_, int c_) { nM = M / BM; nN = N / BM; nwg = nM * nN; G = G_; c = c_; }
    __host__ __device__ bool next(int i, Unit& u) const {
        const long L = (long)i * G + c; if (L >= nwg) return false;
        int wgid = (int)L; { const int q = nwg / NXCD, r = nwg % NXCD, xcd = wgid % NXCD, off = wgid / NXCD; wgid = (xcd < r ? xcd * (q + 1) : r * (q + 1) + (xcd - r) * q) + off; }
        const int nig = WGM * nN, gid = wgid / nig, fm = gid * WGM, gsz = (nM - fm) < WGM ? (nM - fm) : WGM;
        u.pm = fm + ((wgid % nig) % gsz); u.pn = (wgid % nig) / gsz; return true;
    }
    __device__ __forceinline__ void a_ready(const Unit&) const {}
    __device__ __forceinline__ void done(const Unit&) const {}
};

__device__ __forceinline__ unsigned cvt_pk_bf16(float lo, float hi) { unsigned r; asm volatile("v_cvt_pk_bf16_f32 %0, %1, %2" : "=v"(r) : "v"(lo), "v"(hi)); return r; }
typedef float f32x2 __attribute__((ext_vector_type(2)));
__device__ __forceinline__ f32x2 gelu_pk(f32x2 v) {
    const f32x2 av = __builtin_elementwise_abs(v), d = av * 0.2316418882f + 1.0f;
    f32x2 t; t.x = __builtin_amdgcn_rcpf(d.x); t.y = __builtin_amdgcn_rcpf(d.y);
    f32x2 q = t * 0.5307027145f + (-0.7265760135f); q = q * t + 0.7107068705f; q = q * t + (-0.142248368f); q = q * t + 0.127414796f; q = q * t;
    const f32x2 s = (v * v) * (-0.72134752044f);
    f32x2 e; e.x = __builtin_amdgcn_exp2f(s.x); e.y = __builtin_amdgcn_exp2f(s.y);
    const f32x2 m = v * (q * e), r = v - m;
    f32x2 o; o.x = v.x < 0.f ? m.x : r.x; o.y = v.y < 0.f ? m.y : r.y; return o;
}
template <int MODE> struct EpiBf {
    static constexpr bool PERM = true, AFTER_DRAIN = false;
    bf16_t* O; int ldc; int split_pn; float* ss;
    __device__ __forceinline__ void operator()(const f32x4 (&acc)[2][2][4][2], const Unit& u, int wr, int wc, int fr, int fq) const {
        const int row0 = u.pm * BM + wr * 64 + fr, col0 = u.pn * BM + wc * 32 + 8 * fq;
        const bool up = u.pn >= split_pn;
#pragma unroll
        for (int ai = 0; ai < 2; ++ai)
#pragma unroll
            for (int m = 0; m < 4; ++m) { const int row = row0 + ai * HALF + m * 16; bf16_t* rowp = O + (size_t)row * ldc + col0; float s = 0.f;
#pragma unroll
                for (int bj = 0; bj < 2; ++bj) { f32x4 v0 = acc[ai][bj][m][0], v1 = acc[ai][bj][m][1];
                    if (MODE == 1) { f32x2 a = gelu_pk((f32x2){v0[0], v0[1]}), b = gelu_pk((f32x2){v0[2], v0[3]}), c = gelu_pk((f32x2){v1[0], v1[1]}), d = gelu_pk((f32x2){v1[2], v1[3]});
                        v0 = (f32x4){a.x, a.y, b.x, b.y}; v1 = (f32x4){c.x, c.y, d.x, d.y};
                        s += (v0[0] * v0[0] + v0[1] * v0[1]) + (v0[2] * v0[2] + v0[3] * v0[3]) + (v1[0] * v1[0] + v1[1] * v1[1]) + (v1[2] * v1[2] + v1[3] * v1[3]); }
                    if (MODE == 2) { if (up) {
#pragma unroll
                        for (int e = 0; e < 4; ++e) { v0[e] = __builtin_amdgcn_rcpf(1.0f + __builtin_amdgcn_exp2f(-1.4426950408889634f * v0[e])); v1[e] = __builtin_amdgcn_rcpf(1.0f + __builtin_amdgcn_exp2f(-1.4426950408889634f * v1[e])); } } }
                    u32x4 w; w.x = cvt_pk_bf16(v0[0], v0[1]); w.y = cvt_pk_bf16(v0[2], v0[3]); w.z = cvt_pk_bf16(v1[0], v1[1]); w.w = cvt_pk_bf16(v1[2], v1[3]);
                    *(u32x4*)(rowp + bj * HALF) = w; }
                if (MODE == 1) { if (up) { s += __shfl_xor(s, 16); s += __shfl_xor(s, 32); if (fq == 0) ss[(size_t)row * 32 + (u.pn - split_pn) * 4 + wc] = s; } } }
    }
};
struct EpiRes {
    static constexpr bool PERM = false, AFTER_DRAIN = false;
    const float* base; float* out; int ldc;
    __device__ __forceinline__ void operator()(const f32x4 (&acc)[2][2][4][2], const Unit& u, int wr, int wc, int fr, int fq) const {
        const int col0 = u.pn * BM + wc * 32 + 4 * fq;
#pragma unroll
        for (int ai = 0; ai < 2; ++ai)
#pragma unroll
            for (int m = 0; m < 4; ++m) { const size_t off = (size_t)(u.pm * BM + ai * HALF + wr * 64 + m * 16 + fr) * ldc + col0; f32x4 b[2][2];
#pragma unroll
                for (int bj = 0; bj < 2; ++bj)
#pragma unroll
                    for (int n = 0; n < 2; ++n) b[bj][n] = *(const f32x4*)(base + off + bj * HALF + n * 16);
#pragma unroll
                for (int bj = 0; bj < 2; ++bj)
#pragma unroll
                    for (int n = 0; n < 2; ++n) *(f32x4*)(out + off + bj * HALF + n * 16) = b[bj][n] + acc[ai][bj][m][n];
                if (m & 1) asm volatile("" ::: "memory"); }
    }
};
template <class Epi, class Sched, bool ALIGN_EPI = false, bool SP2 = false>
__device__ __forceinline__ void gemm_phase(PG8_LAS unsigned char* lds, const Gemm g, const Sched& S, const Epi& E) {
    const int tid = opaque_tid(), wid = __builtin_amdgcn_readfirstlane(tid >> 6), lane = tid & 63, wr = wid >> 2, wc = wid & 3, fr = lane & 15, fq = lane >> 4;
    const int K = g.K, nt = K / BK;
    unsigned voffA[2], voffB[2];
#pragma unroll
    for (int i = 0; i < 2; ++i) { int R, C; stage_rc(tid * 16 + i * 8192, R, C); const int Rb = Epi::PERM ? ((R & ~31) + perm32(R & 31)) : R;
        voffA[i] = (unsigned)(R * K + C) * 2u; voffB[i] = (unsigned)(Rb * K + C) * 2u; }
    const size_t kstep = (size_t)(BK * 2);
    const size_t hstep = (size_t)HALF * K * 2;
    const size_t tstep = 2 * hstep;
    const unsigned ldsw = (unsigned)wid * 1024u;
    const int aoff = lds_byte(wr * 64 + fr, fq * 8), boff = lds_byte(wc * 32 + fr, fq * 8);
#define PG8_SA(b, h) (((b) * 2 + (h)) * HTB)
#define PG8_SB(b, h) ((4 + (b) * 2 + (h)) * HTB)
#define PG8_STAGE(bufoff, gbase, voff) do { _Pragma("unroll") for (int _i = 0; _i < 2; ++_i) \
        __builtin_amdgcn_global_load_lds((const unsigned*)((const char*)(gbase) + (voff)[_i]), (PG8_LAS unsigned*)(lds + (bufoff) + ldsw + _i * 8192), 16, 0, 0); } while (0)
#define PG8_LDA(dst, b, h) do { _Pragma("unroll") for (int m = 0; m < 4; ++m) _Pragma("unroll") for (int k = 0; k < 2; ++k) dst[m][k] = *(const PG8_LAS bf16x8*)(lds + PG8_SA(b, h) + aoff + m * 2048 + k * 1024); } while (0)
#define PG8_LDB(dst, b, h) do { _Pragma("unroll") for (int n = 0; n < 2; ++n) _Pragma("unroll") for (int k = 0; k < 2; ++k) dst[n][k] = *(const PG8_LAS bf16x8*)(lds + PG8_SB(b, h) + boff + n * 2048 + k * 1024); } while (0)
#define PG8_MMA(ai, bj, At, Bt) do { __builtin_amdgcn_s_setprio(1); _Pragma("unroll") for (int m = 0; m < 4; ++m) _Pragma("unroll") for (int n = 0; n < 2; ++n) _Pragma("unroll") for (int k = 0; k < 2; ++k) \
        acc[ai][bj][m][n] = __builtin_amdgcn_mfma_f32_16x16x32_bf16(Bt[n][k], At[m][k], acc[ai][bj][m][n], 0, 0, 0); __builtin_amdgcn_s_setprio(0); } while (0)
#define PG8_WAIT_V(n) asm volatile("s_waitcnt vmcnt(" #n ")" ::: "memory")
#define PG8_WAIT_L(n) asm volatile("s_waitcnt lgkmcnt(" #n ")" ::: "memory")
#define PG8_BAR __builtin_amdgcn_s_barrier()
#define PG8_SCHED __builtin_amdgcn_sched_barrier(0)
    Unit cur, nxt; int ui = 0;
    if (!S.next(0, cur)) return;
    f32x4 acc[2][2][4][2];
#pragma unroll
    for (int a = 0; a < 2; ++a)
#pragma unroll
        for (int b = 0; b < 2; ++b)
#pragma unroll
            for (int m = 0; m < 4; ++m)
#pragma unroll
                for (int n = 0; n < 2; ++n) acc[a][b][m][n] = (f32x4){0.f, 0.f, 0.f, 0.f};
    bf16x8 At[4][2], B0[2][2], B1[2][2];
    const char* cA = (const char*)g.A + (size_t)cur.pm * tstep; const char* cB = (const char*)g.Bt + (size_t)cur.pn * tstep;
    S.a_ready(cur);
    if constexpr (SP2) {
        PG8_STAGE(PG8_SB(0, 0), cB, voffB); PG8_STAGE(PG8_SB(0, 1), cB + hstep, voffB); PG8_STAGE(PG8_SA(0, 0), cA, voffA); PG8_STAGE(PG8_SA(0, 1), cA + hstep, voffA);
        if (wr == 1) PG8_BAR;
        PG8_WAIT_V(2); PG8_BAR;
        PG8_STAGE(PG8_SB(1, 0), cB + kstep, voffB); PG8_STAGE(PG8_SA(1, 0), cA + kstep, voffA); PG8_STAGE(PG8_SB(1, 1), cB + hstep + kstep, voffB);
        PG8_WAIT_V(6); PG8_BAR;
    } else {
        PG8_STAGE(PG8_SB(0, 0), cB, voffB); PG8_STAGE(PG8_SA(0, 0), cA, voffA); PG8_STAGE(PG8_SB(0, 1), cB + hstep, voffB); PG8_STAGE(PG8_SA(0, 1), cA + hstep, voffA);
        if (wr == 1) PG8_BAR;
        PG8_WAIT_V(4); PG8_BAR;
        PG8_STAGE(PG8_SB(1, 0), cB + kstep, voffB); PG8_STAGE(PG8_SA(1, 0), cA + kstep, voffA); PG8_STAGE(PG8_SB(1, 1), cB + hstep + kstep, voffB);
        PG8_WAIT_V(6); PG8_BAR;
    }
    for (;;) {
        const bool has_next = S.next(ui + 1, nxt);
        const char* nA = has_next ? (const char*)g.A + (size_t)nxt.pm * tstep : cA; const char* nB = has_next ? (const char*)g.Bt + (size_t)nxt.pn * tstep : cB;
        for (int t = 0; t < nt; t += 2) {
            const bool last = (t == nt - 2);
            const char* a1 = cA + (size_t)(t + 1) * kstep;
            const char* a2 = last ? nA : cA + (size_t)(t + 2) * kstep; const char* b2 = last ? nB : cB + (size_t)(t + 2) * kstep;
            const char* a3 = a2 + kstep; const char* b3 = b2 + kstep;
            if (last && has_next) S.a_ready(nxt);
            if constexpr (SP2) {
            PG8_LDB(B0, 0, 0); PG8_LDB(B1, 0, 1); PG8_SCHED; PG8_LDA(At, 0, 0); PG8_STAGE(PG8_SA(1, 1), a1 + hstep, voffA);
            PG8_WAIT_V(8); PG8_WAIT_L(0); PG8_BAR; PG8_MMA(0, 0, At, B0); PG8_MMA(0, 1, At, B1); PG8_BAR; PG8_SCHED;
            PG8_LDA(At, 0, 1); PG8_STAGE(PG8_SB(0, 0), b2, voffB); PG8_STAGE(PG8_SB(0, 1), b2 + hstep, voffB); PG8_STAGE(PG8_SA(0, 0), a2, voffA);
            PG8_WAIT_V(8); PG8_WAIT_L(0); PG8_BAR; PG8_MMA(1, 0, At, B0); PG8_MMA(1, 1, At, B1); PG8_BAR; PG8_SCHED;
            PG8_LDB(B0, 1, 0); PG8_LDB(B1, 1, 1); PG8_SCHED; PG8_LDA(At, 1, 0); PG8_STAGE(PG8_SA(0, 1), a2 + hstep, voffA);
            PG8_WAIT_V(8); PG8_WAIT_L(0); PG8_BAR; PG8_MMA(0, 0, At, B0); PG8_MMA(0, 1, At, B1); PG8_BAR; PG8_SCHED;
            PG8_LDA(At, 1, 1); PG8_STAGE(PG8_SB(1, 0), b3, voffB); PG8_STAGE(PG8_SB(1, 1), b3 + hstep, voffB); PG8_STAGE(PG8_SA(1, 0), a3, voffA);
            PG8_WAIT_V(8); PG8_WAIT_L(0); PG8_BAR; PG8_MMA(1, 0, At, B0); PG8_MMA(1, 1, At, B1); PG8_BAR; PG8_SCHED;
            } else {
            PG8_LDB(B0, 0, 0); PG8_SCHED; PG8_LDA(At, 0, 0); PG8_STAGE(PG8_SA(1, 1), a1 + hstep, voffA);
            PG8_WAIT_L(8); PG8_BAR; PG8_WAIT_L(0); PG8_MMA(0, 0, At, B0); PG8_BAR; PG8_SCHED;
            PG8_LDB(B1, 0, 1); PG8_STAGE(PG8_SB(0, 0), b2, voffB);
            PG8_BAR; PG8_WAIT_L(0); PG8_MMA(0, 1, At, B1); PG8_BAR;
            PG8_LDA(At, 0, 1); PG8_STAGE(PG8_SA(0, 0), a2, voffA);
            PG8_BAR; PG8_WAIT_L(0); PG8_MMA(1, 0, At, B0); PG8_BAR; PG8_SCHED;
            PG8_STAGE(PG8_SB(0, 1), b2 + hstep, voffB);
            PG8_WAIT_V(6); PG8_BAR; PG8_MMA(1, 1, At, B1); PG8_BAR;
            PG8_LDB(B0, 1, 0); PG8_SCHED; PG8_LDA(At, 1, 0); PG8_STAGE(PG8_SA(0, 1), a2 + hstep, voffA);
            PG8_WAIT_L(8); PG8_BAR; PG8_WAIT_L(0); PG8_MMA(0, 0, At, B0); PG8_BAR; PG8_SCHED;
            PG8_LDB(B1, 1, 1); PG8_STAGE(PG8_SB(1, 0), b3, voffB);
            PG8_BAR; PG8_WAIT_L(0); PG8_MMA(0, 1, At, B1); PG8_BAR;
            PG8_LDA(At, 1, 1); PG8_STAGE(PG8_SA(1, 0), a3, voffA);
            PG8_BAR; PG8_WAIT_L(0); PG8_MMA(1, 0, At, B0); PG8_BAR; PG8_SCHED;
            PG8_STAGE(PG8_SB(1, 1), b3 + hstep, voffB);
            PG8_WAIT_V(6); PG8_BAR; PG8_MMA(1, 1, At, B1); PG8_BAR;
            }
        }
        if constexpr (ALIGN_EPI) { if (wr == 0) PG8_BAR; }
        if constexpr (!Epi::AFTER_DRAIN) { E(acc, cur, wr, wc, fr, fq); S.done(cur); }
        if (!has_next) break;
#pragma unroll
        for (int a = 0; a < 2; ++a)
#pragma unroll
            for (int b = 0; b < 2; ++b)
#pragma unroll
                for (int m = 0; m < 4; ++m)
#pragma unroll
                    for (int n = 0; n < 2; ++n) acc[a][b][m][n] = (f32x4){0.f, 0.f, 0.f, 0.f};
        cur = nxt; cA = nA; cB = nB; ++ui;
        if constexpr (ALIGN_EPI) { if (wr == 1) PG8_BAR; }
    }
    PG8_WAIT_V(0);
    if constexpr (!ALIGN_EPI) { if (wr == 0) PG8_BAR; }
    PG8_BAR;
    if constexpr (Epi::AFTER_DRAIN) { E.fused(acc, cur, wr, wc, fr, fq, lds, wid, lane); S.done(cur); }
#undef PG8_SA
#undef PG8_SB
#undef PG8_STAGE
#undef PG8_LDA
#undef PG8_LDB
#undef PG8_MMA
#undef PG8_WAIT_V
#undef PG8_WAIT_L
#undef PG8_BAR
#undef PG8_SCHED
}
}
namespace att {
constexpr int D = 128, LDQ = 4096, LDK = 4096, LDO = 2048, LDG = 4096;
constexpr float THR = 8.f; constexpr bool WSKIP = false;
typedef unsigned u32x4_t __attribute__((ext_vector_type(4)));
typedef short bf16x8_t __attribute__((ext_vector_type(8)));
__device__ __forceinline__ bf16x8_t ka_frag(unsigned lo, unsigned up, int hi) {
    u32x4_t w;
    w.x = 0x3f803f80u; w.y = 0x3f80u | (((lo & 0xffffu) ^ 0x8000u) << 16); w.z = ((lo >> 16) ^ 0x8000u) | (((up & 0xffffu) ^ 0x8000u) << 16); w.w = 0u;
    if (hi) { w.x = 0u; w.y = 0u; w.z = 0u; }
    return __builtin_bit_cast(bf16x8_t, w);
}
__device__ __forceinline__ bf16x8_t qa_frag(unsigned lo, unsigned up, int hi) {
    u32x4_t w;
    w.x = lo; w.y = (up & 0xffffu) | 0x3f800000u; w.z = 0x3f803f80u; w.w = 0u;
    if (hi) { w.x = 0u; w.y = 0u; w.z = 0u; }
    return __builtin_bit_cast(bf16x8_t, w);
}
constexpr float SCALE = 0.08838834764831845f;
constexpr int NW = 8, QBLK = 32, KVBLK = 64, QB = NW * QBLK;
constexpr int SHM_V = KVBLK * D * 2, SHM_K = KVBLK * D * 2;
constexpr int ATT_LDS_BYTES = 2 * SHM_V + 2 * SHM_K + NW * 64 * 4;

using bf16 = __hip_bfloat16;
typedef short bf16x8 __attribute__((ext_vector_type(8)));
typedef short s16x4 __attribute__((ext_vector_type(4)));
typedef float f32x16 __attribute__((ext_vector_type(16)));
typedef float f32x4 __attribute__((ext_vector_type(4)));
typedef unsigned u32x4 __attribute__((ext_vector_type(4)));
template <class A, class Bt> struct same_t { static constexpr bool v = false; };
template <class A> struct same_t<A, A> { static constexpr bool v = true; };

#define KSWZ(row, colB) ((row) * 256 + ((colB) ^ (((row) & 7) << 4)))
#define SBAR() __builtin_amdgcn_sched_barrier(0)
__device__ __forceinline__ int v_st(int k, int c) { const int kk = (k & ~0xC) | ((k & 4) << 1) | ((k & 8) >> 1); return ((kk >> 3) * 4 + (c >> 5)) * 512 + ((kk & 7) * 32 + (c & 31)) * 2; }
__device__ __forceinline__ int v_rd_base(int lane) { return ((lane & 3) << 3) | (((lane >> 2) & 3) << 6) | (((lane >> 4) & 1) << 5) | (((lane >> 5) & 1) << 8); }
constexpr int v_rd_off(int d0, int ks, int half) { return d0 * 512 + ks * 4096 + half * 2048; }
__device__ __forceinline__ int crow(int r, int hi) { return (r & 3) + 8 * (r >> 2) + 4 * hi; }
__device__ __forceinline__ unsigned cvtpk(float lo, float hi) {
    unsigned r; asm volatile("v_cvt_pk_bf16_f32 %0, %1, %2" : "=v"(r) : "v"(lo), "v"(hi)); return r;
}
__device__ __forceinline__ bf16x8 pack8(f32x4 a, f32x4 b) {
    u32x4 w = {cvtpk(a[0], a[1]), cvtpk(a[2], a[3]), cvtpk(b[0], b[1]), cvtpk(b[2], b[3])};
    return *reinterpret_cast<bf16x8*>(&w);
}
template <class T> __device__ __forceinline__ bf16x8 load8(const T* p) {
    if constexpr (same_t<T, float>::v) { return pack8(*(const f32x4*)p, *(const f32x4*)(p + 4)); }
    else { return *reinterpret_cast<const bf16x8*>(p); }
}
__device__ __forceinline__ void mask_tile(f32x16& p0, f32x16& p1, int dq, unsigned W) {
    const float NEG = -__builtin_inff();
#pragma unroll
    for (int r = 0; r < 16; ++r) {
        const int c = (r & 3) + 8 * (r >> 2);
        if ((unsigned)(dq - c) >= W) p0[r] = NEG;
        if ((unsigned)(dq - c - 32) >= W) p1[r] = NEG;
    }
}
__device__ __forceinline__ void partialSM(f32x16& p0, f32x16& p1, float& m_reg, float& mn, float& alpha) {
    float pmax = p0[0]; for (int r = 1; r < 16; ++r) pmax = fmaxf(pmax, p0[r]); for (int r = 0; r < 16; ++r) pmax = fmaxf(pmax, p1[r]);
    { auto rr = __builtin_amdgcn_permlane32_swap(__float_as_uint(pmax), __float_as_uint(pmax), false, false);
      pmax = fmaxf(__uint_as_float(rr[0]), __uint_as_float(rr[1])); }
    constexpr float C2 = 1.4426950408889634f * SCALE;
    if (__builtin_expect(__all((pmax - m_reg) * SCALE <= THR), 1)) { mn = m_reg; alpha = 1.f; }
    else { mn = fmaxf(m_reg, pmax); alpha = __builtin_amdgcn_exp2f((m_reg - mn) * C2); m_reg = mn; }
    const float mnL = -mn * C2;
    for (int r = 0; r < 16; ++r) p0[r] = fmaf(p0[r], C2, mnL); for (int r = 0; r < 16; ++r) p1[r] = fmaf(p1[r], C2, mnL);
    for (int r = 0; r < 16; ++r) p0[r] = __builtin_amdgcn_exp2f(p0[r]);
}
__device__ __forceinline__ void finishSM(f32x16& p0, f32x16& p1, float alpha, float& l_reg, bf16x8& pa0, bf16x8& pa1, bf16x8& pa2, bf16x8& pa3) {
    for (int r = 0; r < 16; ++r) p1[r] = __builtin_amdgcn_exp2f(p1[r]);
    float ps = 0; for (int r = 0; r < 16; ++r) ps += p0[r]; for (int r = 0; r < 16; ++r) ps += p1[r];
    { auto rr = __builtin_amdgcn_permlane32_swap(__float_as_uint(ps), __float_as_uint(ps), false, false);
      ps = __uint_as_float(rr[0]) + __uint_as_float(rr[1]); }
    l_reg = l_reg * alpha + ps;
#define PK4(P, B_, OUT) do { unsigned a0 = cvtpk(P[B_+0], P[B_+1]), a1 = cvtpk(P[B_+2], P[B_+3]);                          \
        unsigned b0 = cvtpk(P[B_+4], P[B_+5]), b1 = cvtpk(P[B_+6], P[B_+7]);                                             \
        auto r0 = __builtin_amdgcn_permlane32_swap(a0, b0, false, false); auto r1 = __builtin_amdgcn_permlane32_swap(a1, b1, false, false); \
        u32x4 w = {r0[0], r1[0], r0[1], r1[1]}; OUT = *reinterpret_cast<bf16x8*>(&w); } while (0)
    PK4(p0, 0, pa0); PK4(p0, 8, pa1); PK4(p1, 0, pa2); PK4(p1, 8, pa3);
#undef PK4
}
template <int KB, bool SK>
__device__ __forceinline__ void qkt(f32x16& p0, f32x16& p1, const char* K_lds, int r32, int hi, const bf16x8* qr, bool act, unsigned long long qa, unsigned long long c) {
    if (SK && !act) { const float NEG = -__builtin_inff();
#pragma unroll
        for (int r = 0; r < 16; ++r) { p0[r] = NEG; p1[r] = NEG; } return; }
    p0 = f32x16{}; p1 = f32x16{};
    const char* kb[4];
#pragma unroll
    for (int dd = 0; dd < 4; ++dd) kb[dd] = K_lds + KB * SHM_K + KSWZ(r32, (dd * 16 + hi * 8) * 2);
#pragma unroll
    for (int d0 = 0; d0 < 8; ++d0) { const char* a = kb[d0 & 3] + (d0 >> 2) * 128;
        bf16x8 b0 = *reinterpret_cast<const bf16x8*>(a);
        bf16x8 b1 = *reinterpret_cast<const bf16x8*>(a + 32 * 256);
        p0 = __builtin_amdgcn_mfma_f32_32x32x16_bf16(b0, qr[d0], p0, 0, 0, 0);
        p1 = __builtin_amdgcn_mfma_f32_32x32x16_bf16(b1, qr[d0], p1, 0, 0, 0); }
    { unsigned ql = (unsigned)qa, qu = (unsigned)(qa >> 32); asm volatile("" : "+v"(ql), "+v"(qu));
      const bf16x8 qaf = qa_frag(ql, qu, hi);
      const unsigned cl = (unsigned)c, cu = (unsigned)(c >> 32);
      auto r0 = __builtin_amdgcn_permlane32_swap(cl, cl, false, false); auto r1 = __builtin_amdgcn_permlane32_swap(cu, cu, false, false);
      p0 = __builtin_amdgcn_mfma_f32_32x32x16_bf16(ka_frag(r0[0], r1[0], hi), qaf, p0, 0, 0, 0);
      p1 = __builtin_amdgcn_mfma_f32_32x32x16_bf16(ka_frag(r0[1], r1[1], hi), qaf, p1, 0, 0, 0); }
}
template <int VB, bool SK>
__device__ __forceinline__ void pv_tile(f32x16* o, int vb0, bf16x8 pa0, bf16x8 pa1, bf16x8 pa2, bf16x8 pa3, bool act) {
    if (SK && !act) return;
#define TRRD(dst, off) asm volatile("ds_read_b64_tr_b16 %0, %1 offset:%2" : "=&v"(dst) : "v"(vb0), "i"(off) : "memory")
#define PV_D0(d0) do { s16x4 l0, l1, l2, l3, h0, h1, h2, h3; constexpr int b_ = VB * SHM_V + v_rd_off(d0, 0, 0);     \
        TRRD(l0, b_); TRRD(h0, b_ + 2048); TRRD(l1, b_ + 4096); TRRD(h1, b_ + 6144); TRRD(l2, b_ + 8192); TRRD(h2, b_ + 10240); TRRD(l3, b_ + 12288); TRRD(h3, b_ + 14336); \
        asm volatile("s_waitcnt lgkmcnt(0)" ::: "memory"); SBAR();                 \
        o[d0] = __builtin_amdgcn_mfma_f32_32x32x16_bf16(pa0, (bf16x8){l0[0], l0[1], l0[2], l0[3], h0[0], h0[1], h0[2], h0[3]}, o[d0], 0, 0, 0);   \
        o[d0] = __builtin_amdgcn_mfma_f32_32x32x16_bf16(pa1, (bf16x8){l1[0], l1[1], l1[2], l1[3], h1[0], h1[1], h1[2], h1[3]}, o[d0], 0, 0, 0);   \
        o[d0] = __builtin_amdgcn_mfma_f32_32x32x16_bf16(pa2, (bf16x8){l2[0], l2[1], l2[2], l2[3], h2[0], h2[1], h2[2], h2[3]}, o[d0], 0, 0, 0);   \
        o[d0] = __builtin_amdgcn_mfma_f32_32x32x16_bf16(pa3, (bf16x8){l3[0], l3[1], l3[2], l3[3], h3[0], h3[1], h3[2], h3[3]}, o[d0], 0, 0, 0); } while (0)
    PV_D0(0); PV_D0(1); PV_D0(2); PV_D0(3);
#undef PV_D0
#undef TRRD
}

template <class TIn, class TOut> struct BlockRef { const TIn* Q; const TIn* K; const TIn* V; TOut* O; const unsigned short* G; const unsigned long long* CA; int P0; };
template <class TIn> struct Seam {
    bf16x8 qr[8];
    bf16x8 st_v0, st_v1, st_k0, st_k1; f32x4 sf0, sf1, sf2, sf3;
    unsigned long long ca, qa;
    f32x4 tq[16];
};
__device__ __forceinline__ int swa_jlo(int P0, int W) { const int lowk = P0 - W + 1; return lowk > 0 ? lowk / KVBLK : 0; }
#define ROW(p, k0, rr) ((p) + (size_t)((k0) + (rr)) * LDK + sc)
#define VMW() asm volatile("s_waitcnt vmcnt(0)" ::: "memory")
#define VMWN(n) asm volatile("s_waitcnt vmcnt(%0)" :: "i"(n) : "memory")
#define SLOAD_H(Kp, Vp, CAp, k0) do { S.st_v0 = load8<TIn>(ROW(Vp, k0, sr)); S.st_v1 = load8<TIn>(ROW(Vp, k0, 32 + sr));              \
                         S.st_k0 = load8<TIn>(ROW(Kp, k0, sr)); S.st_k1 = load8<TIn>(ROW(Kp, k0, 32 + sr)); S.ca = (CAp)[(k0) + lane]; } while (0)
#define SWRITE_HK(bf) do { *(bf16x8*)(K_lds + (bf) * SHM_K + kws) = S.st_k0; *(bf16x8*)(K_lds + (bf) * SHM_K + kws + 32 * 256) = S.st_k1; } while (0)
#define SWRITE_HV(bf) do { *(bf16x8*)(V_lds + (bf) * SHM_V + vst0) = S.st_v0; *(bf16x8*)(V_lds + (bf) * SHM_V + vst1) = S.st_v1; } while (0)
#define SWRITE_H(bf) do { SWRITE_HV(bf); SWRITE_HK(bf); } while (0)
#define SLOAD_F(p, k0) do { S.sf0 = *(const f32x4*)ROW(p, k0, sr); S.sf1 = *(const f32x4*)(ROW(p, k0, sr) + 4);                \
                            S.sf2 = *(const f32x4*)ROW(p, k0, 32 + sr); S.sf3 = *(const f32x4*)(ROW(p, k0, 32 + sr) + 4); } while (0)
#define SWRITE_KF(bf) do { *(bf16x8*)(K_lds + (bf) * SHM_K + kws) = pack8(S.sf0, S.sf1); *(bf16x8*)(K_lds + (bf) * SHM_K + kws + 32 * 256) = pack8(S.sf2, S.sf3); } while (0)
#define SWRITE_VF(bf) do { *(bf16x8*)(V_lds + (bf) * SHM_V + vst0) = pack8(S.sf0, S.sf1); *(bf16x8*)(V_lds + (bf) * SHM_V + vst1) = pack8(S.sf2, S.sf3); } while (0)
template <class TIn, class TOut>
__device__ __forceinline__ void causal_swa_prime(const BlockRef<TIn, TOut>& cur, int W, char* lds, Seam<TIn>& S) {
    constexpr bool F32 = same_t<TIn, float>::v;
    const int tid = opaque_tid(), wid = __builtin_amdgcn_readfirstlane(tid >> 6), lane = tid & 63, r32 = lane & 31, hi = lane >> 5;
    const int sr = tid >> 4, sc = (tid & 15) * 8, kws = KSWZ(sr, sc * 2); char* K_lds = lds + 2 * SHM_V;
    const int kb0 = swa_jlo(cur.P0, W) * KVBLK;
    for (int d0 = 0; d0 < 8; ++d0) S.qr[d0] = load8<TIn>(cur.Q + (size_t)(wid * QBLK + r32) * LDQ + d0 * 16 + hi * 8);
    S.qa = cur.CA[cur.P0 + wid * QBLK + r32];
    if constexpr (F32) { SLOAD_F((const float*)cur.K, kb0); VMW(); SWRITE_KF(0); SBAR(); SLOAD_F((const float*)cur.V, kb0); }
    else { SLOAD_H(cur.K, cur.V, cur.CA, kb0); VMW(); SWRITE_HK(0); }
    __syncthreads();
}
template <class TIn, class TOut>
__device__ __forceinline__ void causal_swa_block(const BlockRef<TIn, TOut>& cur, const BlockRef<TIn, TOut>& nxt, int skv, int W, char* lds, Seam<TIn>& S) {
    constexpr bool F32 = same_t<TIn, float>::v;
    const int tid = opaque_tid(), wid = __builtin_amdgcn_readfirstlane(tid >> 6), lane = tid & 63, r32 = lane & 31, hi = lane >> 5;
    const int j_lo = swa_jlo(cur.P0, W);
    int j_hi = (cur.P0 + QB - 1) / KVBLK + 1; if (j_hi > skv / KVBLK) j_hi = skv / KVBLK;
    const int NT = j_hi - j_lo;
    const int kbn = swa_jlo(nxt.P0, W) * KVBLK;
    const int qlo = cur.P0 + wid * QBLK, qm = qlo + r32 - 4 * hi;
    char* V_lds = lds; char* K_lds = lds + 2 * SHM_V;
    float* ws = (float*)(lds + 2 * SHM_V + 2 * SHM_K) + wid * 64; float* li_l = ws, * al_l = ws + 32;
    float m_reg = -1e30f, l_reg = 0; f32x16 o[4] = {};
    const int sr = tid >> 4, sc = (tid & 15) * 8, vst0 = v_st(sr, sc), vst1 = v_st(32 + sr, sc), kws = KSWZ(sr, sc * 2);
    const int vb0 = (int)(uintptr_t)V_lds + v_rd_base(lane);
    const TIn* Kh = cur.K; const TIn* Vh = cur.V; const unsigned long long* CAh = cur.CA;
#define RESC(a) do { if (__any((a) < 1.f)) { if (hi == 0) al_l[r32] = (a); asm volatile("s_waitcnt lgkmcnt(0)" ::: "memory");              \
                     for (int d_ = 0; d_ < 4; ++d_) for (int r = 0; r < 16; ++r) o[d_][r] *= al_l[crow(r, hi)]; } } while (0)
#define KBASE(t) ((j_lo + (t)) * KVBLK)
#define ACT(t) (KBASE(t) <= qlo + QBLK - 1 && KBASE(t) + KVBLK - 1 >= qlo - W + 1)
#define MASKT(P0_, P1_, t) do { const int kb_ = KBASE(t); if ((!SK || ACT(t)) && (kb_ + KVBLK - 1 > qlo || kb_ <= qlo + QBLK - 1 - W)) mask_tile(P0_, P1_, qm - kb_, (unsigned)W); } while (0)
    constexpr int NQL = F32 ? 16 : 8;
    constexpr bool SK = WSKIP && !F32;
#define SEAM_K0() do { VMWN(NQL); if constexpr (F32) { SWRITE_KF(0); SBAR(); SLOAD_F((const float*)nxt.V, kbn); } else { SWRITE_HK(0); } SBAR(); } while (0)
    f32x16 pA0, pA1, pB0, pB1; float mnA, mnB, alA, alB; bf16x8 pa0, pa1, pa2, pa3;
    if constexpr (F32) { VMW(); SWRITE_VF(0); SBAR(); } else { SWRITE_HV(0); SBAR(); }
    const unsigned long long qa_ = S.qa, hc = S.ca;
    if (NT > 1) { if constexpr (F32) SLOAD_F((const float*)Kh, KBASE(1)); else SLOAD_H(Kh, Vh, CAh, KBASE(1)); }
    SBAR(); qkt<0, SK>(pA0, pA1, K_lds, r32, hi, S.qr, ACT(0), qa_, hc);
    if constexpr (F32) { if (NT > 1) { VMW(); SWRITE_KF(1); SBAR(); SLOAD_F((const float*)Vh, KBASE(1)); } }
    MASKT(pA0, pA1, 0); partialSM(pA0, pA1, m_reg, mnA, alA);
    if (NT > 1) { VMW(); if constexpr (F32) { SWRITE_VF(1); SBAR(); if (NT > 2) SLOAD_F((const float*)Kh, KBASE(2)); } else SWRITE_H(1); }
    __syncthreads();
#define HALF_STEP(PX0, PX1, mnX, alX, PY0, PY1, alY, t, KB, VB, SB) do {                                                      \
        { const unsigned long long c_ = S.ca; SBAR(); qkt<KB, SK>(PX0, PX1, K_lds, r32, hi, S.qr, ACT(t), qa_, c_); }                                             \
        finishSM(PY0, PY1, alY, l_reg, pa0, pa1, pa2, pa3); SBAR();                                                           \
        if ((t) + 1 < NT) { if constexpr (F32) { VMW(); SWRITE_KF(SB); SBAR(); SLOAD_F((const float*)Vh, KBASE((t) + 1)); }  \
                            else { SLOAD_H(Kh, Vh, CAh, KBASE((t) + 1)); } SBAR(); }                                               \
        pv_tile<VB, SK>(o, vb0, pa0, pa1, pa2, pa3, ACT((t) - 1)); MASKT(PX0, PX1, (t)); partialSM(PX0, PX1, m_reg, mnX, alX);                                        \
        __syncthreads();                                                                                                      \
        if ((t) + 1 < NT) { VMW(); if constexpr (F32) { SWRITE_VF(SB); SBAR(); if ((t) + 2 < NT) SLOAD_F((const float*)Kh, KBASE((t) + 2)); } \
                            else { SWRITE_H(SB); } }                                                                          \
        RESC(alX); __syncthreads(); } while (0)
    for (int t = 1; t + 1 < NT; t += 2) {
        HALF_STEP(pB0, pB1, mnB, alB, pA0, pA1, alA, t, 1, 0, 0);
        HALF_STEP(pA0, pA1, mnA, alA, pB0, pB1, alB, t + 1, 0, 1, 1);
    }
    const bool even = (NT & 1) == 0;
    if (even) { const unsigned long long c_ = S.ca; SBAR(); qkt<1, SK>(pB0, pB1, K_lds, r32, hi, S.qr, ACT(NT - 1), qa_, c_); SBAR(); }
#define QROW(e) (nxt.Q + (size_t)(wid * QBLK + r32) * D + ((e) >> 1) * 16 + hi * 8 + ((e) & 1) * 4)
    if constexpr (F32) { SLOAD_F((const float*)nxt.K, kbn); SBAR();
#pragma unroll
        for (int e = 0; e < 8; ++e) S.tq[e] = *(const f32x4*)QROW(e); }
    else { SLOAD_H(nxt.K, nxt.V, nxt.CA, kbn); SBAR();
#pragma unroll
        for (int d0 = 0; d0 < 8; ++d0) S.qr[d0] = load8<TIn>(nxt.Q + (size_t)(wid * QBLK + r32) * LDQ + d0 * 16 + hi * 8);
        S.qa = nxt.CA[nxt.P0 + wid * QBLK + r32]; }
    SBAR();
    finishSM(pA0, pA1, alA, l_reg, pa0, pa1, pa2, pa3); SBAR();
    if constexpr (F32) {
#pragma unroll
        for (int e = 8; e < 16; ++e) S.tq[e] = *(const f32x4*)QROW(e); SBAR(); }
#undef QROW
    pv_tile<0, SK>(o, vb0, pa0, pa1, pa2, pa3, ACT(even ? NT - 2 : NT - 1));
    if (even) { MASKT(pB0, pB1, NT - 1); partialSM(pB0, pB1, m_reg, mnB, alB); __syncthreads(); RESC(alB);
        finishSM(pB0, pB1, alB, l_reg, pa0, pa1, pa2, pa3); SBAR(); pv_tile<1, SK>(o, vb0, pa0, pa1, pa2, pa3, ACT(NT - 1)); }
    SBAR(); SEAM_K0();
    if (hi == 0) li_l[r32] = l_reg; asm volatile("s_waitcnt lgkmcnt(0)" ::: "memory");
    float rli[16];
#pragma unroll
    for (int r = 0; r < 16; ++r) rli[r] = __builtin_amdgcn_rcpf(li_l[crow(r, hi)]);
    TOut* Ow = cur.O + (size_t)(wid * QBLK) * LDO; const unsigned short* Gw = cur.G + (size_t)(wid * QBLK) * LDG;
#pragma unroll
    for (int r = 0; r < 16; ++r) { const int orow = crow(r, hi);
#pragma unroll
        for (int d0 = 0; d0 < 4; ++d0) { const float v = o[d0][r] * rli[r];
            if constexpr (same_t<TOut, float>::v) { Ow[(size_t)orow * LDO + d0 * 32 + r32] = v; }
            else { const float vn = __shfl_xor(v, 1);
                   if ((r32 & 1) == 0) { const unsigned g2 = *(const unsigned*)(Gw + (size_t)orow * LDG + d0 * 32 + r32);
                       *(unsigned*)(Ow + (size_t)orow * LDO + d0 * 32 + r32) = cvtpk(v * __uint_as_float(g2 << 16), vn * __uint_as_float(g2 & 0xffff0000u)); } } } }
    if constexpr (F32) {
#pragma unroll
        for (int d0 = 0; d0 < 8; ++d0) S.qr[d0] = pack8(S.tq[2 * d0], S.tq[2 * d0 + 1]); }
    __syncthreads();
#undef RESC
#undef KBASE
#undef ACT
#undef MASKT
#undef SEAM_K0
#undef HALF_STEP
}
#undef ROW
#undef VMW
#undef VMWN
#undef SLOAD_H
#undef SWRITE_HK
#undef SWRITE_HV
#undef SWRITE_H
#undef SLOAD_F
#undef SWRITE_KF
#undef SWRITE_VF

__host__ __device__ inline int swa_nx(int nqb, int nramp) { return (nramp + 1) / 2 + (nqb - nramp); }
struct SwaItem { int bh, qb0, qb1; };
__device__ __forceinline__ SwaItem swa_decode(int L, int nqb, int nx) {
    SwaItem it; const int xcd = L & 7, k = L >> 3, gi = k / nx, r = k - gi * nx;
    it.bh = gi * 8 + xcd; const int x = r;
    it.qb0 = x; it.qb1 = nqb - 1 - x;
    return it;
}
struct AttnT { const bf16* Q; const bf16* K; const bf16* V; bf16* O; const unsigned short* G; const unsigned long long* CA; };
__device__ __forceinline__ BlockRef<bf16, bf16> swa_ref(const SwaItem& it, int pass, const AttnT& T, int seq, int nh) {
    const int qb = pass ? it.qb1 : it.qb0, b = it.bh / nh, h = it.bh % nh; const size_t tok0 = (size_t)b * seq;
    BlockRef<bf16, bf16> r;
    r.Q = T.Q + (tok0 + (size_t)qb * QB) * LDQ + h * D; r.O = T.O + (tok0 + (size_t)qb * QB) * LDO + h * D; r.G = T.G + (tok0 + (size_t)qb * QB) * LDG + h * D;
    r.K = T.K + tok0 * LDK + h * D; r.V = T.V + tok0 * LDK + h * D; r.CA = T.CA + (size_t)it.bh * seq; r.P0 = qb * QB;
    return r;
}
__device__ __forceinline__ void attn_phase(char* lds, const AttnT& T, int nb, int nh, int seq) {
    const int W = 1 << 30, nqb = seq / QB, nx = nqb / 2, total = nx * nb * nh, stride = gridDim.x;
    int L = blockIdx.x; if (L >= total) return;
    SwaItem it = swa_decode(L, nqb, nx); int pass = 0;
    BlockRef<bf16, bf16> cur = swa_ref(it, 0, T, seq, nh);
    Seam<bf16> S;
    causal_swa_prime<bf16, bf16>(cur, W, lds, S);
    for (;;) {
        const bool more_pass = pass == 0 && it.qb1 != it.qb0, more_item = L + stride < total, last = !more_pass && !more_item;
        SwaItem itn = it; int passn = pass + 1, Ln = L;
        if (!more_pass) { passn = 0; Ln = more_item ? L + stride : L; itn = swa_decode(Ln, nqb, nx); }
        const BlockRef<bf16, bf16> nxt = last ? cur : swa_ref(itn, passn, T, seq, nh);
        causal_swa_block<bf16, bf16>(cur, nxt, seq, W, lds, S);
        if (last) break;
        cur = nxt; it = itn; pass = passn; L = Ln;
    }
}
#undef KSWZ
#undef SBAR
}
constexpr int DM = 2048, NB = 4, SEQ = 4096, MT = NB * SEQ, FF = 5632, FF2 = 2 * FF, NH = 16, HD = 128, CH = 128, NG = 16;
constexpr float EPS = 1e-6f;
constexpr int NWAVES = 8, NTHREADS = NWAVES * 64;
constexpr size_t MiB = 1u << 20;
constexpr size_t WS_VSS = 0;
constexpr size_t WS_LOGF = 1 * MiB;
constexpr size_t WS_CA = 2 * MiB;
constexpr size_t WS_WSB = 4 * MiB;
constexpr size_t WS_WF = 5 * MiB;
constexpr size_t WS_W_AIN = 6 * MiB;
constexpr size_t WS_W_AOUT = WS_W_AIN + 32 * MiB;
constexpr size_t WS_W_KV = WS_W_AOUT + 16 * MiB;
constexpr size_t WS_W_QG = WS_W_KV + 16 * MiB;
constexpr size_t WS_W_BOUT = WS_W_QG + 32 * MiB;
constexpr size_t WS_W_UP = WS_W_BOUT + 16 * MiB;
constexpr size_t WS_W_DN = WS_W_UP + 176 * MiB;
constexpr size_t WS_XN = WS_W_DN + 88 * MiB;
constexpr size_t WS_XN2 = WS_XN + 64 * MiB;
constexpr size_t WS_KV = WS_XN2 + 64 * MiB;
constexpr size_t WS_BIG = WS_KV + 128 * MiB;
constexpr size_t WS_ACT = WS_BIG + 352 * MiB;
constexpr size_t WS_SSP = WS_ACT + 176 * MiB;
constexpr size_t WS_END = WS_SSP + 2 * MiB;
constexpr int LDS_BYTES = 147456;

typedef unsigned short bf16_t;
typedef float f32x4 __attribute__((ext_vector_type(4)));
typedef unsigned u32x4 __attribute__((ext_vector_type(4)));
typedef unsigned u32x2 __attribute__((ext_vector_type(2)));
typedef short bf16x8 __attribute__((ext_vector_type(8)));
#define LAS __attribute__((address_space(3)))
__device__ __forceinline__ unsigned pk2(float lo, float hi) { return pg8::cvt_pk_bf16(lo, hi); }
__device__ __forceinline__ float bf_lo(unsigned w) { return __uint_as_float(w << 16); }
__device__ __forceinline__ float bf_hi(unsigned w) { return __uint_as_float(w & 0xffff0000u); }
__device__ __forceinline__ float wave_sum(float v) {
#pragma unroll
    for (int o = 1; o < 64; o <<= 1) v += __shfl_xor(v, o);
    return v;
}
struct Args { const float* in[21]; float* out; unsigned char* ws; };

__device__ __forceinline__ int up_row(int n) { return n < FF ? (n >> 7) * 256 + (n & 127) : ((n - FF) >> 7) * 256 + 128 + ((n - FF) & 127); }
__device__ __forceinline__ void transpose_item(const float* W, int K, int ld, int ncols, bf16_t* WT, int mode, LAS float* scr, int item, int lane) {
    const int nblk = ncols / 32, kb = item / nblk, nb = item % nblk, k0 = 64 * kb, n0 = 32 * nb;
#pragma unroll 8
    for (int i = 0; i < 32; ++i) { const int kk = 2 * i + (lane >> 5); scr[kk * 33 + (lane & 31)] = W[(size_t)(k0 + kk) * ld + n0 + (lane & 31)]; }
    asm volatile("s_waitcnt lgkmcnt(0)" ::: "memory");
    const int c = lane & 7; const int r0 = mode ? up_row(n0) : n0;
#pragma unroll
    for (int j = 0; j < 4; ++j) { const int n = (lane >> 3) + 8 * j; const LAS float* s = scr + (8 * c) * 33 + n;
        u32x4 o; o.x = pk2(s[0 * 33], s[1 * 33]); o.y = pk2(s[2 * 33], s[3 * 33]); o.z = pk2(s[4 * 33], s[5 * 33]); o.w = pk2(s[6 * 33], s[7 * 33]);
        *(u32x4*)(WT + (size_t)(r0 + n) * K + k0 + 8 * c) = o; }
    asm volatile("s_waitcnt lgkmcnt(0)" ::: "memory");
}
__device__ __forceinline__ void transpose_matrix(const float* W, int K, int ld, int ncols, bf16_t* WT, int mode, LAS float* scr, int gw, int NGW, int lane) {
    const int items = (K / 64) * (ncols / 32);
    for (int it = gw; it < items; it += NGW) transpose_item(W, K, ld, ncols, WT, mode, scr, it, lane);
}
template <bool F32OUT>
__device__ __forceinline__ void norm_rows(const float* src, const float* g, void* dst, int gw, int NGW, int lane) {
    for (int m = gw; m < MT; m += NGW) {
        const f32x4* xr = (const f32x4*)(src + (size_t)m * DM) + lane; f32x4 v[8]; float s = 0.f;
#pragma unroll
        for (int j = 0; j < 8; ++j) { v[j] = xr[64 * j]; s += (v[j].x * v[j].x + v[j].y * v[j].y) + (v[j].z * v[j].z + v[j].w * v[j].w); }
        const float r = 1.0f / sqrtf(wave_sum(s) * (1.0f / DM) + EPS);
        const f32x4* gr = (const f32x4*)g + lane;
        if constexpr (F32OUT) { f32x4* o = (f32x4*)((float*)dst + (size_t)m * DM) + lane;
#pragma unroll
            for (int j = 0; j < 8; ++j) o[64 * j] = (v[j] * r) * gr[64 * j]; }
        else { u32x2* o = (u32x2*)((bf16_t*)dst + (size_t)m * DM) + lane;
#pragma unroll
            for (int j = 0; j < 8; ++j) { const f32x4 y = (v[j] * r) * gr[64 * j]; u32x2 w; w.x = pk2(y.x, y.y); w.y = pk2(y.z, y.w); o[64 * j] = w; } }
    }
}
__device__ __forceinline__ void headnorm_rows(bf16_t* buf, int ld, const float* gain, int gw, int NGW, int lane) {
    const f32x4 g0 = *(const f32x4*)(gain + (lane & 15) * 8), g1 = *(const f32x4*)(gain + (lane & 15) * 8 + 4);
    for (int m = gw; m < MT; m += NGW) {
        u32x4* p = (u32x4*)(buf + (size_t)m * ld) + lane; u32x4 w[4];
#pragma unroll
        for (int j = 0; j < 4; ++j) w[j] = p[64 * j];
#pragma unroll
        for (int j = 0; j < 4; ++j) {
            float x[8] = {bf_lo(w[j].x), bf_hi(w[j].x), bf_lo(w[j].y), bf_hi(w[j].y), bf_lo(w[j].z), bf_hi(w[j].z), bf_lo(w[j].w), bf_hi(w[j].w)};
            float s = 0.f;
#pragma unroll
            for (int e = 0; e < 8; ++e) s += x[e] * x[e];
            s += __shfl_xor(s, 1); s += __shfl_xor(s, 2); s += __shfl_xor(s, 4); s += __shfl_xor(s, 8);
            const float r = 1.0f / sqrtf(s * (1.0f / HD) + EPS);
            u32x4 o; o.x = pk2(x[0] * r * g0.x, x[1] * r * g0.y); o.y = pk2(x[2] * r * g0.z, x[3] * r * g0.w); o.z = pk2(x[4] * r * g1.x, x[5] * r * g1.y); o.w = pk2(x[6] * r * g1.z, x[7] * r * g1.w);
            p[64 * j] = o; }
    }
}
__device__ __forceinline__ void fgate_rows(const float* h, const bf16_t* wfh, const bf16_t* wfl, const float* bf, float* logf, int gw, int NGW, int lane) {
    const int fr = lane & 15, fq = lane >> 4;
    for (int rg = gw; rg < MT / 16; rg += NGW) {
        const float* hrow = h + (size_t)(rg * 16 + fr) * DM + 8 * fq; const bf16_t* wh = wfh + fr * DM + 8 * fq; const bf16_t* wl = wfl + fr * DM + 8 * fq;
        f32x4 acc = {0.f, 0.f, 0.f, 0.f}; float ssq = 0.f;
#pragma unroll 4
        for (int ks = 0; ks < DM / 32; ++ks) {
            const f32x4 a0 = *(const f32x4*)(hrow + 32 * ks), a1 = *(const f32x4*)(hrow + 32 * ks + 4);
            ssq += (a0.x * a0.x + a0.y * a0.y) + (a0.z * a0.z + a0.w * a0.w) + (a1.x * a1.x + a1.y * a1.y) + (a1.z * a1.z + a1.w * a1.w);
            u32x4 hi; hi.x = pk2(a0.x, a0.y); hi.y = pk2(a0.z, a0.w); hi.z = pk2(a1.x, a1.y); hi.w = pk2(a1.z, a1.w);
            u32x4 lo; lo.x = pk2(a0.x - bf_lo(hi.x), a0.y - bf_hi(hi.x)); lo.y = pk2(a0.z - bf_lo(hi.y), a0.w - bf_hi(hi.y)); lo.z = pk2(a1.x - bf_lo(hi.z), a1.y - bf_hi(hi.z)); lo.w = pk2(a1.z - bf_lo(hi.w), a1.w - bf_hi(hi.w));
            const bf16x8 whv = *(const bf16x8*)(wh + 32 * ks), wlv = *(const bf16x8*)(wl + 32 * ks);
            const bf16x8 hv = __builtin_bit_cast(bf16x8, hi), lv = __builtin_bit_cast(bf16x8, lo);
            acc = __builtin_amdgcn_mfma_f32_16x16x32_bf16(whv, hv, acc, 0, 0, 0);
            acc = __builtin_amdgcn_mfma_f32_16x16x32_bf16(wlv, hv, acc, 0, 0, 0);
            acc = __builtin_amdgcn_mfma_f32_16x16x32_bf16(whv, lv, acc, 0, 0, 0);
        }
        ssq += __shfl_xor(ssq, 16); ssq += __shfl_xor(ssq, 32);
        const float r = 1.0f / sqrtf(ssq * (1.0f / DM) + EPS);
        const f32x4 b = *(const f32x4*)(bf + 4 * fq); f32x4 o;
#pragma unroll
        for (int e = 0; e < 4; ++e) { const float f = acc[e] * r + b[e]; o[e] = fminf(f, 0.f) - log1pf(expf(-fabsf(f))); }
        *(f32x4*)(logf + (size_t)(rg * 16 + fr) * 16 + 4 * fq) = o;
    }
}
__device__ __forceinline__ void scan_seq(const float* logf, unsigned long long* CA, int seq, int lane) {
    const int b = seq >> 4, hh = seq & 15;
    const float* lf = logf + ((size_t)b * SEQ + (size_t)lane * 64) * 16 + hh;
    float v[64];
#pragma unroll
    for (int i = 0; i < 64; ++i) v[i] = lf[i * 16];
#pragma unroll
    for (int i = 1; i < 64; ++i) v[i] += v[i - 1];
    const float tot = v[63]; float t = tot;
#pragma unroll
    for (int o = 1; o < 64; o <<= 1) { const float y = __shfl_up(t, o); if (lane >= o) t += y; }
    const float excl = t - tot;
    unsigned long long* out = CA + (size_t)seq * SEQ + lane * 64;
#pragma unroll
    for (int i = 0; i < 64; ++i) { const float c = (excl + v[i]) * 11.313708498984761f;
        const unsigned h1 = pk2(c, 0.f) & 0xffffu; const float r1 = c - bf_lo(h1);
        const unsigned h2 = pk2(r1, 0.f) & 0xffffu; const float r2 = r1 - bf_lo(h2);
        const unsigned h3 = pk2(r2, 0.f) & 0xffffu;
        out[i] = (unsigned long long)(h1 | (h2 << 16)) | ((unsigned long long)h3 << 32); }
}
__device__ __forceinline__ void spatial_phase(LAS unsigned char* ldsp, const bf16_t* Z, const float* ssp, const bf16_t* wsb, const float* vnorm, const float* bs, bf16_t* GATED, int wave, int lane) {
    const int fr = lane & 15, fq = lane >> 4;
    for (int item = blockIdx.x; item < (MT / CH) * NG; item += gridDim.x) {
        const int ch = item >> 4, g = item & 15, row0 = ch * CH, cw = g * 128 + wave * 16;
        LAS float* rvs = (LAS float*)ldsp;
        __syncthreads();
        { const int t_ = wave * 64 + lane; if (t_ < CH) { const f32x4* p = (const f32x4*)(ssp + (size_t)(row0 + t_) * 32); float sq = 0.f;
#pragma unroll
            for (int q = 0; q < 8; ++q) { const f32x4 v = p[q]; sq += (v.x + v.y) + (v.z + v.w); }
            rvs[t_] = 1.0f / sqrtf(sq * (1.0f / DM) + EPS); } }
        __syncthreads();
        bf16x8 vf[4];
#pragma unroll
        for (int ks = 0; ks < 4; ++ks) {
            const bf16_t* vp = Z + (size_t)(row0 + 32 * ks + 8 * fq) * 4096 + 2048 + cw + fr; float x[8];
#pragma unroll
            for (int i = 0; i < 8; ++i) x[i] = __uint_as_float((unsigned)vp[(size_t)i * 4096] << 16) * rvs[32 * ks + 8 * fq + i];
            u32x4 w; w.x = pk2(x[0], x[1]); w.y = pk2(x[2], x[3]); w.z = pk2(x[4], x[5]); w.w = pk2(x[6], x[7]); vf[ks] = __builtin_bit_cast(bf16x8, w);
        }
        f32x4 acc[8];
#pragma unroll
        for (int m = 0; m < 8; ++m) { acc[m] = (f32x4){0.f, 0.f, 0.f, 0.f};
#pragma unroll
            for (int ks = 0; ks < 4; ++ks) if (32 * ks <= 16 * m + 15) {
                const bf16x8 wf = *(const bf16x8*)(wsb + ((size_t)(g * 128 + 16 * m + fr) * 128 + 32 * ks + 8 * fq));
                acc[m] = __builtin_amdgcn_mfma_f32_16x16x32_bf16(vf[ks], wf, acc[m], 0, 0, 0); } }
        const f32x4 vn = *(const f32x4*)(vnorm + cw + 4 * fq);
#pragma unroll
        for (int m = 0; m < 8; ++m) { const int t = 16 * m + fr; const size_t row = (size_t)(row0 + t); const float bias = bs[g * 128 + t];
            const u32x2 uu = *(const u32x2*)(Z + row * 4096 + cw + 4 * fq);
            const float o0 = bf_lo(uu.x) * (acc[m][0] * vn[0] + bias), o1 = bf_hi(uu.x) * (acc[m][1] * vn[1] + bias), o2 = bf_lo(uu.y) * (acc[m][2] * vn[2] + bias), o3 = bf_hi(uu.y) * (acc[m][3] * vn[3] + bias);
            u32x2 w; w.x = pk2(o0, o1); w.y = pk2(o2, o3); *(u32x2*)(GATED + row * DM + cw + 4 * fq) = w; }
    }
}
__device__ __forceinline__ void conv_phase(const bf16_t* BIG, const float* cw, const float* cb, bf16_t* ACT) {
    constexpr int NQ = FF / 8, RS = 32, NTASK = NQ * (MT / RS);
    const int tid_ = opaque_tid();
    for (int T = blockIdx.x * NTHREADS + tid_; T < NTASK; T += gridDim.x * NTHREADS) {
        const int q = T % NQ, strip = T / NQ, j0 = 8 * q, pg = (q >> 4) * 256 + (q & 15) * 8, row0 = strip * RS;
        float wg[3][8], wv[3][8], bg[8], bv[8];
#pragma unroll
        for (int k = 0; k < 3; ++k)
#pragma unroll
            for (int e = 0; e < 8; ++e) { wg[k][e] = cw[(size_t)k * FF2 + j0 + e]; wv[k][e] = cw[(size_t)k * FF2 + FF + j0 + e]; }
#pragma unroll
        for (int e = 0; e < 8; ++e) { bg[e] = cb[j0 + e]; bv[e] = cb[FF + j0 + e]; }
        const bf16_t* src = BIG + (size_t)row0 * FF2 + pg; bf16_t* dst = ACT + (size_t)row0 * FF + j0;
        u32x4 g2 = {0u, 0u, 0u, 0u}, g1 = g2, v2 = g2, v1 = g2;
        if ((row0 & (SEQ - 1)) != 0) { g2 = *(const u32x4*)(src - 2 * (size_t)FF2); v2 = *(const u32x4*)(src - 2 * (size_t)FF2 + 128); g1 = *(const u32x4*)(src - (size_t)FF2); v1 = *(const u32x4*)(src - (size_t)FF2 + 128); }
        for (int i0 = 0; i0 < RS; i0 += 8) {
            u32x4 gc[8], vc[8];
#pragma unroll
            for (int i = 0; i < 8; ++i) { gc[i] = *(const u32x4*)(src + (size_t)(i0 + i) * FF2); vc[i] = *(const u32x4*)(src + (size_t)(i0 + i) * FF2 + 128); }
#pragma unroll
            for (int i = 0; i < 8; ++i) { u32x4 o;
#pragma unroll
                for (int p = 0; p < 4; ++p) {
                    const float ga = wg[0][2 * p] * bf_lo(g2[p]) + wg[1][2 * p] * bf_lo(g1[p]) + wg[2][2 * p] * bf_lo(gc[i][p]) + bg[2 * p];
                    const float gb = wg[0][2 * p + 1] * bf_hi(g2[p]) + wg[1][2 * p + 1] * bf_hi(g1[p]) + wg[2][2 * p + 1] * bf_hi(gc[i][p]) + bg[2 * p + 1];
                    const float va = wv[0][2 * p] * bf_lo(v2[p]) + wv[1][2 * p] * bf_lo(v1[p]) + wv[2][2 * p] * bf_lo(vc[i][p]) + bv[2 * p];
                    const float vb = wv[0][2 * p + 1] * bf_hi(v2[p]) + wv[1][2 * p + 1] * bf_hi(v1[p]) + wv[2][2 * p + 1] * bf_hi(vc[i][p]) + bv[2 * p + 1];
                    const float sa = ga * __builtin_amdgcn_rcpf(1.0f + __builtin_amdgcn_exp2f(-1.4426950408889634f * ga)), sb = gb * __builtin_amdgcn_rcpf(1.0f + __builtin_amdgcn_exp2f(-1.4426950408889634f * gb));
                    o[p] = pk2(sa * va, sb * vb); }
                *(u32x4*)(dst + (size_t)(i0 + i) * FF) = o; g2 = g1; g1 = gc[i]; v2 = v1; v1 = vc[i]; }
        }
    }
}

typedef const Args __attribute__((address_space(4))) CArgs;
__device__ __forceinline__ CArgs* kargs() { CArgs* p = (CArgs*)__builtin_amdgcn_kernarg_segment_ptr(); asm volatile("" : "+s"(p)); return p; }
#define PTRS \
    CArgs* ap_ = kargs(); unsigned char* ws = ap_->ws; float* h = ap_->out; (void)ws; (void)h; \
    const float* x = ap_->in[0]; const float* a_norm = ap_->in[1]; const float* a_w_in = ap_->in[2]; const float* a_v_norm = ap_->in[3]; const float* a_w_s = ap_->in[4]; const float* a_b_s = ap_->in[5]; \
    const float* a_w_out = ap_->in[6]; const float* kv_norm = ap_->in[7]; const float* w_kvf = ap_->in[8]; const float* b_f = ap_->in[9]; const float* k_norm = ap_->in[10]; const float* b_norm = ap_->in[11]; \
    const float* b_w_qg = ap_->in[12]; const float* q_norm = ap_->in[13]; const float* b_w_out = ap_->in[14]; const float* f_norm = ap_->in[15]; const float* f_w_up = ap_->in[16]; const float* f_conv_w = ap_->in[17]; \
    const float* f_conv_b = ap_->in[18]; const float* f_w_down = ap_->in[19]; const float* final_norm = ap_->in[20]; \
    (void)x; (void)a_norm; (void)a_w_in; (void)a_v_norm; (void)a_w_s; (void)a_b_s; (void)a_w_out; (void)kv_norm; (void)w_kvf; (void)b_f; (void)k_norm; (void)b_norm; (void)b_w_qg; (void)q_norm; (void)b_w_out; \
    (void)f_norm; (void)f_w_up; (void)f_conv_w; (void)f_conv_b; (void)f_w_down; (void)final_norm; \
    float* VSS = (float*)(ws + WS_SSP); float* LOGF = (float*)(ws + WS_LOGF); unsigned long long* CA = (unsigned long long*)(ws + WS_CA); \
    bf16_t* WSB = (bf16_t*)(ws + WS_WSB); bf16_t* WFH = (bf16_t*)(ws + WS_WF); bf16_t* WFL = WFH + 16 * DM; \
    bf16_t* W_AIN = (bf16_t*)(ws + WS_W_AIN); bf16_t* W_AOUT = (bf16_t*)(ws + WS_W_AOUT); bf16_t* W_KV = (bf16_t*)(ws + WS_W_KV); bf16_t* W_QG = (bf16_t*)(ws + WS_W_QG); \
    bf16_t* W_BOUT = (bf16_t*)(ws + WS_W_BOUT); bf16_t* W_UP = (bf16_t*)(ws + WS_W_UP); bf16_t* W_DN = (bf16_t*)(ws + WS_W_DN); \
    bf16_t* XN = (bf16_t*)(ws + WS_XN); bf16_t* XN2 = (bf16_t*)(ws + WS_XN2); bf16_t* KVB = (bf16_t*)(ws + WS_KV); bf16_t* BIG = (bf16_t*)(ws + WS_BIG); bf16_t* ACT = (bf16_t*)(ws + WS_ACT); \
    (void)VSS; (void)LOGF; (void)CA; (void)WSB; (void)WFH; (void)WFL; (void)W_AIN; (void)W_AOUT; (void)W_KV; (void)W_QG; (void)W_BOUT; (void)W_UP; (void)W_DN; (void)XN; (void)XN2; (void)KVB; (void)BIG; (void)ACT;
#define GEMM_PHASE(EPI, Aptr, Bptr, NN, KK, ...) do { pg8::Gemm g_{Aptr, Bptr, MT, NN, KK}; pg8::StaticOrder S_; S_.init(MT, NN, G, (int)blockIdx.x); EPI E_{__VA_ARGS__}; \
    pg8::gemm_phase<EPI, pg8::StaticOrder, true, true>(ldsp, g_, S_, E_); } while (0)

__global__ void __launch_bounds__(NTHREADS, 2) fwd_megakernel(Args a) {
    extern __shared__ __attribute__((aligned(16))) unsigned char lds[];
    cg::grid_group grid = cg::this_grid();
#define GSYNC() do { asm volatile("s_waitcnt vmcnt(0)" ::: "memory"); grid.sync(); } while (0)
    const int wave = __builtin_amdgcn_readfirstlane(threadIdx.x >> 6);
    const int G = gridDim.x, gw = blockIdx.x * NWAVES + wave, NGW = G * NWAVES;
    LAS unsigned char* ldsp = (LAS unsigned char*)lds;

    {
        PTRS
        const int tid = opaque_tid(), lane = tid & 63;
        const int gt = blockIdx.x * NTHREADS + tid, NGT = G * NTHREADS;
        for (int i = gt; i < 2 * NG * CH * CH / 8; i += NGT) {
            const int e0 = i * 8, s0 = e0 & 127, t = (e0 >> 7) & 127; const f32x4 w0 = *(const f32x4*)(a_w_s + e0), w1 = *(const f32x4*)(a_w_s + e0 + 4);
            float y[8] = {w0.x, w0.y, w0.z, w0.w, w1.x, w1.y, w1.z, w1.w};
#pragma unroll
            for (int e = 0; e < 8; ++e) if (s0 + e > t) y[e] = 0.f;
            u32x4 o; o.x = pk2(y[0], y[1]); o.y = pk2(y[2], y[3]); o.z = pk2(y[4], y[5]); o.w = pk2(y[6], y[7]); *(u32x4*)(WSB + e0) = o; }
        for (int i = gt; i < 16 * DM; i += NGT) { const int n = i / DM, k = i % DM; const float w = kv_norm[k] * w_kvf[(size_t)k * 4112 + 4096 + n];
            const unsigned hi = pk2(w, 0.f) & 0xffffu; WFH[i] = (bf16_t)hi; WFL[i] = (bf16_t)(pk2(w - bf_lo(hi), 0.f) & 0xffffu); }
        LAS float* scr = (LAS float*)(ldsp + wave * 16384);
        for (int l = 0; l < 2; ++l) {
            transpose_matrix(a_w_in + (size_t)l * DM * 4096, DM, 4096, 4096, W_AIN + (size_t)l * 4096 * DM, 0, scr, gw, NGW, lane);
            transpose_matrix(a_w_out + (size_t)l * DM * DM, DM, DM, DM, W_AOUT + (size_t)l * DM * DM, 0, scr, gw, NGW, lane);
            transpose_matrix(b_w_qg + (size_t)l * DM * 4096, DM, 4096, 4096, W_QG + (size_t)l * 4096 * DM, 0, scr, gw, NGW, lane);
            transpose_matrix(b_w_out + (size_t)l * DM * DM, DM, DM, DM, W_BOUT + (size_t)l * DM * DM, 0, scr, gw, NGW, lane);
        }
        transpose_matrix(w_kvf, DM, 4112, 4096, W_KV, 0, scr, gw, NGW, lane);
        for (int l = 0; l < 4; ++l) {
            transpose_matrix(f_w_up + (size_t)l * DM * FF2, DM, FF2, FF2, W_UP + (size_t)l * FF2 * DM, 1, scr, gw, NGW, lane);
            transpose_matrix(f_w_down + (size_t)l * FF * DM, FF, DM, DM, W_DN + (size_t)l * DM * FF, 0, scr, gw, NGW, lane);
        }
        norm_rows<false>(x, a_norm, XN, gw, NGW, lane);
    }
    GSYNC();

    for (int l = 0; l < 4; ++l) {
        if (l < 2) {
            { PTRS GEMM_PHASE(pg8::EpiBf<1>, XN, W_AIN + (size_t)l * 4096 * DM, 4096, DM, BIG, 4096, 8, VSS); }
            GSYNC();
            { PTRS const int lane = opaque_tid() & 63;
              spatial_phase(ldsp, BIG, VSS, WSB + (size_t)l * NG * CH * CH, a_v_norm + (size_t)l * DM, a_b_s + (size_t)l * NG * CH, ACT, wave, lane); }
            GSYNC();
        } else {
            const int j = l - 2;
            { PTRS GEMM_PHASE(pg8::EpiBf<2>, XN2, W_QG + (size_t)j * 4096 * DM, 4096, DM, BIG, 4096, 8, nullptr); }
            GSYNC();
            { PTRS const int lane = opaque_tid() & 63;
              headnorm_rows(BIG, 4096, q_norm + (size_t)j * HD, gw, NGW, lane);
              if (j == 0) headnorm_rows(KVB, 4096, k_norm, gw, NGW, lane); }
            GSYNC();
            { PTRS att::AttnT T{(const att::bf16*)BIG, (const att::bf16*)KVB, (const att::bf16*)(KVB + 2048), (att::bf16*)ACT, BIG + 2048, CA};
              att::attn_phase((char*)lds, T, NB, NH, SEQ); }
            GSYNC();
        }
        { PTRS const bf16_t* Wt = l < 2 ? W_AOUT + (size_t)l * DM * DM : W_BOUT + (size_t)(l - 2) * DM * DM;
          GEMM_PHASE(pg8::EpiRes, ACT, Wt, DM, DM, l == 0 ? x : (const float*)h, h, DM); }
        GSYNC();
        { PTRS const int lane = opaque_tid() & 63; norm_rows<false>(h, f_norm + (size_t)l * DM, XN, gw, NGW, lane); }
        GSYNC();
        { PTRS GEMM_PHASE(pg8::EpiBf<0>, XN, W_UP + (size_t)l * FF2 * DM, FF2, DM, BIG, FF2, 1 << 30, nullptr); }
        GSYNC();
        { PTRS conv_phase(BIG, f_conv_w + (size_t)l * 3 * FF2, f_conv_b + (size_t)l * FF2, ACT); }
        GSYNC();
        { PTRS GEMM_PHASE(pg8::EpiRes, ACT, W_DN + (size_t)l * DM * FF, DM, FF, h, h, DM); }
        GSYNC();
        if (l == 0) { PTRS const int lane = opaque_tid() & 63; norm_rows<false>(h, a_norm + DM, XN, gw, NGW, lane); }
        else if (l == 1) {
            { PTRS const int lane = opaque_tid() & 63;
              norm_rows<false>(h, kv_norm, XN, gw, NGW, lane);
              norm_rows<false>(h, b_norm, XN2, gw, NGW, lane);
              fgate_rows(h, WFH, WFL, b_f, LOGF, gw, NGW, lane); }
            GSYNC();
            { PTRS const int lane = opaque_tid() & 63;
              if (blockIdx.x < 8) scan_seq(LOGF, CA, blockIdx.x * 8 + wave, lane);
              GEMM_PHASE(pg8::EpiBf<0>, XN, W_KV, 4096, DM, KVB, 4096, 1 << 30, nullptr); }
        }
        else if (l == 2) { PTRS const int lane = opaque_tid() & 63; norm_rows<false>(h, b_norm + DM, XN2, gw, NGW, lane); }
        else { PTRS const int lane = opaque_tid() & 63; norm_rows<true>(h, final_norm, h, gw, NGW, lane); }
        if (l < 3) GSYNC();
    }
}

extern "C" void kernel_launch(void* const* d_in, const int* in_sizes, int n_in, void* d_out, int out_size, void* d_ws, size_t ws_size, hipStream_t stream) {
    static int grid = 0;
    if (grid == 0) {
        if (n_in != 21 || out_size != MT * DM || ws_size < WS_END) { fprintf(stderr, "kernel_launch: unexpected shapes (n_in %d out %d ws %zu, need ws >= %zu)\n", n_in, out_size, ws_size, (size_t)WS_END); grid = -1; return; }
        int dev = 0, cus = 0, per_cu = 0;
        (void)hipGetDevice(&dev); (void)hipDeviceGetAttribute(&cus, hipDeviceAttributeMultiprocessorCount, dev);
        (void)hipFuncSetAttribute((const void*)fwd_megakernel, hipFuncAttributeMaxDynamicSharedMemorySize, LDS_BYTES);
        (void)hipOccupancyMaxActiveBlocksPerMultiprocessor(&per_cu, (const void*)fwd_megakernel, NTHREADS, LDS_BYTES);
        if (per_cu < 1) { fprintf(stderr, "kernel_launch: occupancy query says %d blocks per CU\n", per_cu); per_cu = 1; }
        grid = cus * 1;
        (void)hipGetLastError();
    }
    if (grid < 0) return;
    Args a{};
    for (int i = 0; i < 21; ++i) a.in[i] = (const float*)d_in[i];
    a.out = (float*)d_out; a.ws = (unsigned char*)d_ws;
    void* args[] = {&a};
    hipError_t e = hipLaunchCooperativeKernel((const void*)fwd_megakernel, dim3(grid), dim3(NTHREADS), args, LDS_BYTES, stream);
    if (e != hipSuccess) fprintf(stderr, "cooperative launch failed: %s (grid %d)\n", hipGetErrorString(e), grid);
}
```

```cpp
#include <hip/hip_runtime.h>
#include <hip/hip_cooperative_groups.h>
#include <hip/hip_bf16.h>
#include <cstdio>
#include <cstdint>
namespace cg = cooperative_groups;
__device__ __forceinline__ int opaque_tid() { int t = threadIdx.x; asm volatile("" : "+v"(t)); return t; }
namespace pg8 {
#define PG8_LAS __attribute__((address_space(3)))
typedef unsigned short bf16_t;
typedef short bf16x8 __attribute__((ext_vector_type(8)));
typedef float f32x4 __attribute__((ext_vector_type(4)));
typedef unsigned u32x4 __attribute__((ext_vector_type(4)));
constexpr int BM = 256, BK = 64, HALF = 128, HTB = HALF * BK * 2  , STAGE_BYTES = 8 * HTB, NXCD = 8, WGM = 8;

__host__ __device__ __forceinline__ int lds_byte(int r, int c) { const int st = (r >> 4) * 2 + (c >> 5), rr = r & 15, cc = c & 31, ob = rr * 64 + cc * 2; return st * 1024 + (ob ^ (((ob >> 9) & 1) << 5)); }
__host__ __device__ __forceinline__ void stage_rc(int b, int& R, int& C) { const int st = b / 1024, sb = b % 1024, swz = sb ^ (((sb >> 9) & 1) << 5); R = (st >> 1) * 16 + swz / 64; C = (st & 1) * 32 + (swz % 64) / 2; }
__host__ __device__ __forceinline__ int perm32(int rho) { const int n = rho >> 4, i = rho & 15; return 8 * (i >> 2) + 4 * n + (i & 3); }

struct Unit { int pm, pn; };
struct Gemm { const bf16_t* A; const bf16_t* Bt; int M, N, K; };

struct StaticOrder {
    int nM, nN, nwg, G, c;
    __host__ __device__ void init(int M, int N, int G_, int c_) { nM = M / BM; nN = N / BM; nwg = nM * nN; G = G_; c = c_; }
    __host__ __device__ bool next(int i, Unit& u) const {
        const long L = (long)i * G + c; if (L >= nwg) return false;
        int wgid = (int)L; { const int q = nwg / NXCD, r = nwg % NXCD, xcd = wgid % NXCD, off = wgid / NXCD; wgid = (xcd < r ? xcd * (q + 1) : r * (q + 1) + (xcd - r) * q) + off; }
        const int nig = WGM * nN, gid = wgid / nig, fm = gid * WGM, gsz = (nM - fm) < WGM ? (nM - fm) : WGM;
        u.pm = fm + ((wgid % nig) % gsz); u.pn = (wgid % nig) / gsz; return true;
    }
    __device__ __forceinline__ void a_ready(const Unit&) const {}
    __device__ __forceinline__ void done(const Unit&) const {}
};

__device__ __forceinline__ unsigned cvt_pk_bf16(float lo, float hi) { unsigned r; asm volatile("v_cvt_pk_bf16_f32 %0, %1, %2" : "=v"(r) : "v"(lo), "v"(hi)); return r; }
typedef float f32x2 __attribute__((ext_vector_type(2)));
__device__ __forceinline__ f32x2 gelu_pk(f32x2 v) {
    const f32x2 av = __builtin_elementwise_abs(v), d = av * 0.2316418882f + 1.0f;
    f32x2 t; t.x = __builtin_amdgcn_rcpf(d.x); t.y = __builtin_amdgcn_rcpf(d.y);
    f32x2 q = t * 0.5307027145f + (-0.7265760135f); q = q * t + 0.7107068705f; q = q * t + (-0.142248368f); q = q * t + 0.127414796f; q = q * t;
    const f32x2 s = (v * v) * (-0.72134752044f);
    f32x2 e; e.x = __builtin_amdgcn_exp2f(s.x); e.y = __builtin_amdgcn_exp2f(s.y);
    const f32x2 m = v * (q * e), r = v - m;
    f32x2 o; o.x = v.x < 0.f ? m.x : r.x; o.y = v.y < 0.f ? m.y : r.y; return o;
}
constexpr float RS_INV = 1.0f / 2048.0f, RS_EPS = 1e-6f;
template <int MODE, bool RSCALE> struct EpiBf {
    static constexpr bool PERM = true, AFTER_DRAIN = false;
    bf16_t* O; int ldc; int split_pn; float* ss; const float* rs;
    __device__ __forceinline__ void operator()(const f32x4 (&acc)[2][2][4][2], const Unit& u, int wr, int wc, int fr, int fq) const {
        const int row0 = u.pm * BM + wr * 64 + fr, col0 = u.pn * BM + wc * 32 + 8 * fq;
        const bool up = u.pn >= split_pn;
        float rr[2][4];
#pragma unroll
        for (int ai = 0; ai < 2; ++ai)
#pragma unroll
            for (int m = 0; m < 4; ++m) { rr[ai][m] = 1.f;
                if (RSCALE) { const f32x4* p = (const f32x4*)(rs + (size_t)(row0 + ai * HALF + m * 16) * 32 + fq * 8); const f32x4 a = p[0], b = p[1];
                    float t = ((a[0] + a[1]) + (a[2] + a[3])) + ((b[0] + b[1]) + (b[2] + b[3])); t += __shfl_xor(t, 16); t += __shfl_xor(t, 32); rr[ai][m] = 1.0f / sqrtf(t * RS_INV + RS_EPS); } }
#pragma unroll
        for (int ai = 0; ai < 2; ++ai)
#pragma unroll
            for (int m = 0; m < 4; ++m) { const int row = row0 + ai * HALF + m * 16; bf16_t* rowp = O + (size_t)row * ldc + col0; float s = 0.f;
#pragma unroll
                for (int bj = 0; bj < 2; ++bj) { f32x4 v0 = acc[ai][bj][m][0], v1 = acc[ai][bj][m][1];
                    if (RSCALE) { v0 = v0 * rr[ai][m]; v1 = v1 * rr[ai][m]; }
                    if (MODE == 1) { f32x2 a = gelu_pk((f32x2){v0[0], v0[1]}), b = gelu_pk((f32x2){v0[2], v0[3]}), c = gelu_pk((f32x2){v1[0], v1[1]}), d = gelu_pk((f32x2){v1[2], v1[3]});
                        v0 = (f32x4){a.x, a.y, b.x, b.y}; v1 = (f32x4){c.x, c.y, d.x, d.y};
                        s += (v0[0] * v0[0] + v0[1] * v0[1]) + (v0[2] * v0[2] + v0[3] * v0[3]) + (v1[0] * v1[0] + v1[1] * v1[1]) + (v1[2] * v1[2] + v1[3] * v1[3]); }
                    if (MODE == 2) { if (up) {
#pragma unroll
                        for (int e = 0; e < 4; ++e) { v0[e] = __builtin_amdgcn_rcpf(1.0f + __builtin_amdgcn_exp2f(-1.4426950408889634f * v0[e])); v1[e] = __builtin_amdgcn_rcpf(1.0f + __builtin_amdgcn_exp2f(-1.4426950408889634f * v1[e])); } } }
                    u32x4 w; w.x = cvt_pk_bf16(v0[0], v0[1]); w.y = cvt_pk_bf16(v0[2], v0[3]); w.z = cvt_pk_bf16(v1[0], v1[1]); w.w = cvt_pk_bf16(v1[2], v1[3]);
                    *(u32x4*)(rowp + bj * HALF) = w; }
                if (MODE == 1) { if (up) { s += __shfl_xor(s, 16); s += __shfl_xor(s, 32); if (fq == 0) ss[(size_t)row * 32 + (u.pn - split_pn) * 4 + wc] = s; } } }
    }
};
struct EpiRes {
    static constexpr bool PERM = true, AFTER_DRAIN = false;
    const float* base; float* out; bf16_t* hb; float* rss; int ldc;
    __device__ __forceinline__ void operator()(const f32x4 (&acc)[2][2][4][2], const Unit& u, int wr, int wc, int fr, int fq) const {
        const int row0 = u.pm * BM + wr * 64 + fr, col0 = u.pn * BM + wc * 32 + 8 * fq;
#pragma unroll
        for (int ai = 0; ai < 2; ++ai)
#pragma unroll
            for (int m = 0; m < 4; ++m) { const int row = row0 + ai * HALF + m * 16; const size_t off = (size_t)row * ldc + col0; f32x4 b[2][2]; float s = 0.f;
#pragma unroll
                for (int bj = 0; bj < 2; ++bj)
#pragma unroll
                    for (int n = 0; n < 2; ++n) b[bj][n] = *(const f32x4*)(base + off + bj * HALF + n * 4);
#pragma unroll
                for (int bj = 0; bj < 2; ++bj) { const f32x4 o0 = b[bj][0] + acc[ai][bj][m][0], o1 = b[bj][1] + acc[ai][bj][m][1];
                    *(f32x4*)(out + off + bj * HALF) = o0; *(f32x4*)(out + off + bj * HALF + 4) = o1;
                    u32x4 w; w.x = cvt_pk_bf16(o0[0], o0[1]); w.y = cvt_pk_bf16(o0[2], o0[3]); w.z = cvt_pk_bf16(o1[0], o1[1]); w.w = cvt_pk_bf16(o1[2], o1[3]);
                    *(u32x4*)(hb + off + bj * HALF) = w;
                    s += ((o0[0] * o0[0] + o0[1] * o0[1]) + (o0[2] * o0[2] + o0[3] * o0[3])) + ((o1[0] * o1[0] + o1[1] * o1[1]) + (o1[2] * o1[2] + o1[3] * o1[3])); }
                s += __shfl_xor(s, 16); s += __shfl_xor(s, 32); if (fq == 0) rss[(size_t)row * 32 + u.pn * 4 + wc] = s;
                if (m & 1) asm volatile("" ::: "memory"); }
    }
};
template <class Epi, class Sched, bool ALIGN_EPI = false, bool SP2 = false>
__device__ __forceinline__ void gemm_phase(PG8_LAS unsigned char* lds, const Gemm g, const Sched& S, const Epi& E) {
    const int tid = opaque_tid(), wid = __builtin_amdgcn_readfirstlane(tid >> 6), lane = tid & 63, wr = wid >> 2, wc = wid & 3, fr = lane & 15, fq = lane >> 4;
    const int K = g.K, nt = K / BK;
    unsigned voffA[2], voffB[2];
#pragma unroll
    for (int i = 0; i < 2; ++i) { int R, C; stage_rc(tid * 16 + i * 8192, R, C); const int Rb = Epi::PERM ? ((R & ~31) + perm32(R & 31)) : R;
        voffA[i] = (unsigned)(R * K + C) * 2u; voffB[i] = (unsigned)(Rb * K + C) * 2u; }
    const size_t kstep = (size_t)(BK * 2);
    const size_t hstep = (size_t)HALF * K * 2;
    const size_t tstep = 2 * hstep;
    const unsigned ldsw = (unsigned)wid * 1024u;
    const int aoff = lds_byte(wr * 64 + fr, fq * 8), boff = lds_byte(wc * 32 + fr, fq * 8);
#define PG8_SA(b, h) (((b) * 2 + (h)) * HTB)
#define PG8_SB(b, h) ((4 + (b) * 2 + (h)) * HTB)
#define PG8_STAGE(bufoff, gbase, voff) do { _Pragma("unroll") for (int _i = 0; _i < 2; ++_i) \
        __builtin_amdgcn_global_load_lds((const unsigned*)((const char*)(gbase) + (voff)[_i]), (PG8_LAS unsigned*)(lds + (bufoff) + ldsw + _i * 8192), 16, 0, 0); } while (0)
#define PG8_LDA(dst, b, h) do { _Pragma("unroll") for (int m = 0; m < 4; ++m) _Pragma("unroll") for (int k = 0; k < 2; ++k) dst[m][k] = *(const PG8_LAS bf16x8*)(lds + PG8_SA(b, h) + aoff + m * 2048 + k * 1024); } while (0)
#define PG8_LDB(dst, b, h) do { _Pragma("unroll") for (int n = 0; n < 2; ++n) _Pragma("unroll") for (int k = 0; k < 2; ++k) dst[n][k] = *(const PG8_LAS bf16x8*)(lds + PG8_SB(b, h) + boff + n * 2048 + k * 1024); } while (0)
#define PG8_MMA(ai, bj, At, Bt) do { __builtin_amdgcn_s_setprio(1); _Pragma("unroll") for (int m = 0; m < 4; ++m) _Pragma("unroll") for (int n = 0; n < 2; ++n) _Pragma("unroll") for (int k = 0; k < 2; ++k) \
        acc[ai][bj][m][n] = __builtin_amdgcn_mfma_f32_16x16x32_bf16(Bt[n][k], At[m][k], acc[ai][bj][m][n], 0, 0, 0); __builtin_amdgcn_s_setprio(0); } while (0)
#define PG8_WAIT_V(n) asm volatile("s_waitcnt vmcnt(" #n ")" ::: "memory")
#define PG8_WAIT_L(n) asm volatile("s_waitcnt lgkmcnt(" #n ")" ::: "memory")
#define PG8_BAR __builtin_amdgcn_s_barrier()
#define PG8_SCHED __builtin_amdgcn_sched_barrier(0)
    Unit cur, nxt; int ui = 0;
    if (!S.next(0, cur)) return;
    f32x4 acc[2][2][4][2];
#pragma unroll
    for (int a = 0; a < 2; ++a)
#pragma unroll
        for (int b = 0; b < 2; ++b)
#pragma unroll
            for (int m = 0; m < 4; ++m)
#pragma unroll
                for (int n = 0; n < 2; ++n) acc[a][b][m][n] = (f32x4){0.f, 0.f, 0.f, 0.f};
    bf16x8 At[4][2], B0[2][2], B1[2][2];
    const char* cA = (const char*)g.A + (size_t)cur.pm * tstep; const char* cB = (const char*)g.Bt + (size_t)cur.pn * tstep;
    S.a_ready(cur);
    if constexpr (SP2) {
        PG8_STAGE(PG8_SB(0, 0), cB, voffB); PG8_STAGE(PG8_SB(0, 1), cB + hstep, voffB); PG8_STAGE(PG8_SA(0, 0), cA, voffA); PG8_STAGE(PG8_SA(0, 1), cA + hstep, voffA);
        if (wr == 1) PG8_BAR;
        PG8_WAIT_V(2); PG8_BAR;
        PG8_STAGE(PG8_SB(1, 0), cB + kstep, voffB); PG8_STAGE(PG8_SA(1, 0), cA + kstep, voffA); PG8_STAGE(PG8_SB(1, 1), cB + hstep + kstep, voffB);
        PG8_WAIT_V(6); PG8_BAR;
    } else {
        PG8_STAGE(PG8_SB(0, 0), cB, voffB); PG8_STAGE(PG8_SA(0, 0), cA, voffA); PG8_STAGE(PG8_SB(0, 1), cB + hstep, voffB); PG8_STAGE(PG8_SA(0, 1), cA + hstep, voffA);
        if (wr == 1) PG8_BAR;
        PG8_WAIT_V(4); PG8_BAR;
        PG8_STAGE(PG8_SB(1, 0), cB + kstep, voffB); PG8_STAGE(PG8_SA(1, 0), cA + kstep, voffA); PG8_STAGE(PG8_SB(1, 1), cB + hstep + kstep, voffB);
        PG8_WAIT_V(6); PG8_BAR;
    }
    for (;;) {
        const bool has_next = S.next(ui + 1, nxt);
        const char* nA = has_next ? (const char*)g.A + (size_t)nxt.pm * tstep : cA; const char* nB = has_next ? (const char*)g.Bt + (size_t)nxt.pn * tstep : cB;
        for (int t = 0; t < nt; t += 2) {
            const bool last = (t == nt - 2);
            const char* a1 = cA + (size_t)(t + 1) * kstep;
            const char* a2 = last ? nA : cA + (size_t)(t + 2) * kstep; const char* b2 = last ? nB : cB + (size_t)(t + 2) * kstep;
            const char* a3 = a2 + kstep; const char* b3 = b2 + kstep;
            if (last && has_next) S.a_ready(nxt);
            if constexpr (SP2) {
            PG8_LDB(B0, 0, 0); PG8_LDB(B1, 0, 1); PG8_SCHED; PG8_LDA(At, 0, 0); PG8_STAGE(PG8_SA(1, 1), a1 + hstep, voffA);
            PG8_WAIT_V(8); PG8_WAIT_L(0); PG8_BAR; PG8_MMA(0, 0, At, B0); PG8_MMA(0, 1, At, B1); PG8_BAR; PG8_SCHED;
            PG8_LDA(At, 0, 1); PG8_STAGE(PG8_SB(0, 0), b2, voffB); PG8_STAGE(PG8_SB(0, 1), b2 + hstep, voffB); PG8_STAGE(PG8_SA(0, 0), a2, voffA);
            PG8_WAIT_V(8); PG8_WAIT_L(0); PG8_BAR; PG8_MMA(1, 0, At, B0); PG8_MMA(1, 1, At, B1); PG8_BAR; PG8_SCHED;
            PG8_LDB(B0, 1, 0); PG8_LDB(B1, 1, 1); PG8_SCHED; PG8_LDA(At, 1, 0); PG8_STAGE(PG8_SA(0, 1), a2 + hstep, voffA);
            PG8_WAIT_V(8); PG8_WAIT_L(0); PG8_BAR; PG8_MMA(0, 0, At, B0); PG8_MMA(0, 1, At, B1); PG8_BAR; PG8_SCHED;
            PG8_LDA(At, 1, 1); PG8_STAGE(PG8_SB(1, 0), b3, voffB); PG8_STAGE(PG8_SB(1, 1), b3 + hstep, voffB); PG8_STAGE(PG8_SA(1, 0), a3, voffA);
            PG8_WAIT_V(8); PG8_WAIT_L(0); PG8_BAR; PG8_MMA(1, 0, At, B0); PG8_MMA(1, 1, At, B1); PG8_BAR; PG8_SCHED;
            } else {
            PG8_LDB(B0, 0, 0); PG8_SCHED; PG8_LDA(At, 0, 0); PG8_STAGE(PG8_SA(1, 1), a1 + hstep, voffA);
            PG8_WAIT_L(8); PG8_BAR; PG8_WAIT_L(0); PG8_MMA(0, 0, At, B0); PG8_BAR; PG8_SCHED;
            PG8_LDB(B1, 0, 1); PG8_STAGE(PG8_SB(0, 0), b2, voffB);
            PG8_BAR; PG8_WAIT_L(0); PG8_MMA(0, 1, At, B1); PG8_BAR;
            PG8_LDA(At, 0, 1); PG8_STAGE(PG8_SA(0, 0), a2, voffA);
            PG8_BAR; PG8_WAIT_L(0); PG8_MMA(1, 0, At, B0); PG8_BAR; PG8_SCHED;
            PG8_STAGE(PG8_SB(0, 1), b2 + hstep, voffB);
            PG8_WAIT_V(6); PG8_BAR; PG8_MMA(1, 1, At, B1); PG8_BAR;
            PG8_LDB(B0, 1, 0); PG8_SCHED; PG8_LDA(At, 1, 0); PG8_STAGE(PG8_SA(0, 1), a2 + hstep, voffA);
            PG8_WAIT_L(8); PG8_BAR; PG8_WAIT_L(0); PG8_MMA(0, 0, At, B0); PG8_BAR; PG8_SCHED;
            PG8_LDB(B1, 1, 1); PG8_STAGE(PG8_SB(1, 0), b3, voffB);
            PG8_BAR; PG8_WAIT_L(0); PG8_MMA(0, 1, At, B1); PG8_BAR;
            PG8_LDA(At, 1, 1); PG8_STAGE(PG8_SA(1, 0), a3, voffA);
            PG8_BAR; PG8_WAIT_L(0); PG8_MMA(1, 0, At, B0); PG8_BAR; PG8_SCHED;
            PG8_STAGE(PG8_SB(1, 1), b3 + hstep, voffB);
            PG8_WAIT_V(6); PG8_BAR; PG8_MMA(1, 1, At, B1); PG8_BAR;
            }
        }
        if constexpr (ALIGN_EPI) { if (wr == 0) PG8_BAR; }
        if constexpr (!Epi::AFTER_DRAIN) { E(acc, cur, wr, wc, fr, fq); S.done(cur); }
        if (!has_next) break;
#pragma unroll
        for (int a = 0; a < 2; ++a)
#pragma unroll
            for (int b = 0; b < 2; ++b)
#pragma unroll
                for (int m = 0; m < 4; ++m)
#pragma unroll
                    for (int n = 0; n < 2; ++n) acc[a][b][m][n] = (f32x4){0.f, 0.f, 0.f, 0.f};
        cur = nxt; cA = nA; cB = nB; ++ui;
        if constexpr (ALIGN_EPI) { if (wr == 1) PG8_BAR; }
    }
    PG8_WAIT_V(0);
    if constexpr (!ALIGN_EPI) { if (wr == 0) PG8_BAR; }
    PG8_BAR;
    if constexpr (Epi::AFTER_DRAIN) { E.fused(acc, cur, wr, wc, fr, fq, lds, wid, lane); S.done(cur); }
#undef PG8_SA
#undef PG8_SB
#undef PG8_STAGE
#undef PG8_LDA
#undef PG8_LDB
#undef PG8_MMA
#undef PG8_WAIT_V
#undef PG8_WAIT_L
#undef PG8_BAR
#undef PG8_SCHED
}
}
namespace att {
constexpr int D = 128, LDQ = 4096, LDK = 4096, LDO = 2048, LDG = 4096;
constexpr float THR = 8.f; constexpr bool WSKIP = false;
typedef unsigned u32x4_t __attribute__((ext_vector_type(4)));
typedef short bf16x8_t __attribute__((ext_vector_type(8)));
__device__ __forceinline__ bf16x8_t ka_frag(unsigned lo, unsigned up, int hi) {
    u32x4_t w;
    w.x = 0x3f803f80u; w.y = 0x3f80u | (((lo & 0xffffu) ^ 0x8000u) << 16); w.z = ((lo >> 16) ^ 0x8000u) | (((up & 0xffffu) ^ 0x8000u) << 16); w.w = 0u;
    if (hi) { w.x = 0u; w.y = 0u; w.z = 0u; }
    return __builtin_bit_cast(bf16x8_t, w);
}
__device__ __forceinline__ bf16x8_t qa_frag(unsigned lo, unsigned up, int hi) {
    u32x4_t w;
    w.x = lo; w.y = (up & 0xffffu) | 0x3f800000u; w.z = 0x3f803f80u; w.w = 0u;
    if (hi) { w.x = 0u; w.y = 0u; w.z = 0u; }
    return __builtin_bit_cast(bf16x8_t, w);
}
constexpr float SCALE = 0.08838834764831845f;
constexpr int NW = 8, QBLK = 32, KVBLK = 64, QB = NW * QBLK;
constexpr int SHM_V = KVBLK * D * 2, SHM_K = KVBLK * D * 2;
constexpr int ATT_LDS_BYTES = 2 * SHM_V + 2 * SHM_K + NW * 64 * 4;

using bf16 = __hip_bfloat16;
typedef short bf16x8 __attribute__((ext_vector_type(8)));
typedef short s16x4 __attribute__((ext_vector_type(4)));
typedef float f32x16 __attribute__((ext_vector_type(16)));
typedef float f32x4 __attribute__((ext_vector_type(4)));
typedef unsigned u32x4 __attribute__((ext_vector_type(4)));
template <class A, class Bt> struct same_t { static constexpr bool v = false; };
template <class A> struct same_t<A, A> { static constexpr bool v = true; };

#define KSWZ(row, colB) ((row) * 256 + ((colB) ^ (((row) & 7) << 4)))
#define SBAR() __builtin_amdgcn_sched_barrier(0)
__device__ __forceinline__ int v_st(int k, int c) { const int kk = (k & ~0xC) | ((k & 4) << 1) | ((k & 8) >> 1); return ((kk >> 3) * 4 + (c >> 5)) * 512 + ((kk & 7) * 32 + (c & 31)) * 2; }
__device__ __forceinline__ int v_rd_base(int lane) { return ((lane & 3) << 3) | (((lane >> 2) & 3) << 6) | (((lane >> 4) & 1) << 5) | (((lane >> 5) & 1) << 8); }
constexpr int v_rd_off(int d0, int ks, int half) { return d0 * 512 + ks * 4096 + half * 2048; }
__device__ __forceinline__ int crow(int r, int hi) { return (r & 3) + 8 * (r >> 2) + 4 * hi; }
__device__ __forceinline__ unsigned cvtpk(float lo, float hi) {
    unsigned r; asm volatile("v_cvt_pk_bf16_f32 %0, %1, %2" : "=v"(r) : "v"(lo), "v"(hi)); return r;
}
__device__ __forceinline__ bf16x8 pack8(f32x4 a, f32x4 b) {
    u32x4 w = {cvtpk(a[0], a[1]), cvtpk(a[2], a[3]), cvtpk(b[0], b[1]), cvtpk(b[2], b[3])};
    return *reinterpret_cast<bf16x8*>(&w);
}
template <class T> __device__ __forceinline__ bf16x8 load8(const T* p) {
    if constexpr (same_t<T, float>::v) { return pack8(*(const f32x4*)p, *(const f32x4*)(p + 4)); }
    else { return *reinterpret_cast<const bf16x8*>(p); }
}
__device__ __forceinline__ void mask_tile(f32x16& p0, f32x16& p1, int dq, unsigned W) {
    const float NEG = -__builtin_inff();
#pragma unroll
    for (int r = 0; r < 16; ++r) {
        const int c = (r & 3) + 8 * (r >> 2);
        if ((unsigned)(dq - c) >= W) p0[r] = NEG;
        if ((unsigned)(dq - c - 32) >= W) p1[r] = NEG;
    }
}
__device__ __forceinline__ void partialSM(f32x16& p0, f32x16& p1, float& m_reg, float& mn, float& alpha) {
    float pmax = p0[0]; for (int r = 1; r < 16; ++r) pmax = fmaxf(pmax, p0[r]); for (int r = 0; r < 16; ++r) pmax = fmaxf(pmax, p1[r]);
    { auto rr = __builtin_amdgcn_permlane32_swap(__float_as_uint(pmax), __float_as_uint(pmax), false, false);
      pmax = fmaxf(__uint_as_float(rr[0]), __uint_as_float(rr[1])); }
    constexpr float C2 = 1.4426950408889634f * SCALE;
    if (__builtin_expect(__all((pmax - m_reg) * SCALE <= THR), 1)) { mn = m_reg; alpha = 1.f; }
    else { mn = fmaxf(m_reg, pmax); alpha = __builtin_amdgcn_exp2f((m_reg - mn) * C2); m_reg = mn; }
    const float mnL = -mn * C2;
    for (int r = 0; r < 16; ++r) p0[r] = fmaf(p0[r], C2, mnL); for (int r = 0; r < 16; ++r) p1[r] = fmaf(p1[r], C2, mnL);
    for (int r = 0; r < 16; ++r) p0[r] = __builtin_amdgcn_exp2f(p0[r]);
}
__device__ __forceinline__ void finishSM(f32x16& p0, f32x16& p1, float alpha, float& l_reg, bf16x8& pa0, bf16x8& pa1, bf16x8& pa2, bf16x8& pa3) {
    for (int r = 0; r < 16; ++r) p1[r] = __builtin_amdgcn_exp2f(p1[r]);
    float ps = 0; for (int r = 0; r < 16; ++r) ps += p0[r]; for (int r = 0; r < 16; ++r) ps += p1[r];
    { auto rr = __builtin_amdgcn_permlane32_swap(__float_as_uint(ps), __float_as_uint(ps), false, false);
      ps = __uint_as_float(rr[0]) + __uint_as_float(rr[1]); }
    l_reg = l_reg * alpha + ps;
#define PK4(P, B_, OUT) do { unsigned a0 = cvtpk(P[B_+0], P[B_+1]), a1 = cvtpk(P[B_+2], P[B_+3]);                          \
        unsigned b0 = cvtpk(P[B_+4], P[B_+5]), b1 = cvtpk(P[B_+6], P[B_+7]);                                             \
        auto r0 = __builtin_amdgcn_permlane32_swap(a0, b0, false, false); auto r1 = __builtin_amdgcn_permlane32_swap(a1, b1, false, false); \
        u32x4 w = {r0[0], r1[0], r0[1], r1[1]}; OUT = *reinterpret_cast<bf16x8*>(&w); } while (0)
    PK4(p0, 0, pa0); PK4(p0, 8, pa1); PK4(p1, 0, pa2); PK4(p1, 8, pa3);
#undef PK4
}
template <int KB, bool SK>
__device__ __forceinline__ void qkt(f32x16& p0, f32x16& p1, const char* K_lds, int r32, int hi, const bf16x8* qr, bool act, unsigned long long qa, unsigned long long c) {
    if (SK && !act) { const float NEG = -__builtin_inff();
#pragma unroll
        for (int r = 0; r < 16; ++r) { p0[r] = NEG; p1[r] = NEG; } return; }
    p0 = f32x16{}; p1 = f32x16{};
    const char* kb[4];
#pragma unroll
    for (int dd = 0; dd < 4; ++dd) kb[dd] = K_lds + KB * SHM_K + KSWZ(r32, (dd * 16 + hi * 8) * 2);
#pragma unroll
    for (int d0 = 0; d0 < 8; ++d0) { const char* a = kb[d0 & 3] + (d0 >> 2) * 128;
        bf16x8 b0 = *reinterpret_cast<const bf16x8*>(a);
        bf16x8 b1 = *reinterpret_cast<const bf16x8*>(a + 32 * 256);
        p0 = __builtin_amdgcn_mfma_f32_32x32x16_bf16(b0, qr[d0], p0, 0, 0, 0);
        p1 = __builtin_amdgcn_mfma_f32_32x32x16_bf16(b1, qr[d0], p1, 0, 0, 0); }
    { unsigned ql = (unsigned)qa, qu = (unsigned)(qa >> 32); asm volatile("" : "+v"(ql), "+v"(qu));
      const bf16x8 qaf = qa_frag(ql, qu, hi);
      const unsigned cl = (unsigned)c, cu = (unsigned)(c >> 32);
      auto r0 = __builtin_amdgcn_permlane32_swap(cl, cl, false, false); auto r1 = __builtin_amdgcn_permlane32_swap(cu, cu, false, false);
      p0 = __builtin_amdgcn_mfma_f32_32x32x16_bf16(ka_frag(r0[0], r1[0], hi), qaf, p0, 0, 0, 0);
      p1 = __builtin_amdgcn_mfma_f32_32x32x16_bf16(ka_frag(r0[1], r1[1], hi), qaf, p1, 0, 0, 0); }
}
template <int VB, bool SK>
__device__ __forceinline__ void pv_tile(f32x16* o, int vb0, bf16x8 pa0, bf16x8 pa1, bf16x8 pa2, bf16x8 pa3, bool act) {
    if (SK && !act) return;
#define TRRD(dst, off) asm volatile("ds_read_b64_tr_b16 %0, %1 offset:%2" : "=&v"(dst) : "v"(vb0), "i"(off) : "memory")
#define PV_D0(d0) do { s16x4 l0, l1, l2, l3, h0, h1, h2, h3; constexpr int b_ = VB * SHM_V + v_rd_off(d0, 0, 0);     \
        TRRD(l0, b_); TRRD(h0, b_ + 2048); TRRD(l1, b_ + 4096); TRRD(h1, b_ + 6144); TRRD(l2, b_ + 8192); TRRD(h2, b_ + 10240); TRRD(l3, b_ + 12288); TRRD(h3, b_ + 14336); \
        asm volatile("s_waitcnt lgkmcnt(0)" ::: "memory"); SBAR();                 \
        o[d0] = __builtin_amdgcn_mfma_f32_32x32x16_bf16(pa0, (bf16x8){l0[0], l0[1], l0[2], l0[3], h0[0], h0[1], h0[2], h0[3]}, o[d0], 0, 0, 0);   \
        o[d0] = __builtin_amdgcn_mfma_f32_32x32x16_bf16(pa1, (bf16x8){l1[0], l1[1], l1[2], l1[3], h1[0], h1[1], h1[2], h1[3]}, o[d0], 0, 0, 0);   \
        o[d0] = __builtin_amdgcn_mfma_f32_32x32x16_bf16(pa2, (bf16x8){l2[0], l2[1], l2[2], l2[3], h2[0], h2[1], h2[2], h2[3]}, o[d0], 0, 0, 0);   \
        o[d0] = __builtin_amdgcn_mfma_f32_32x32x16_bf16(pa3, (bf16x8){l3[0], l3[1], l3[2], l3[3], h3[0], h3[1], h3[2], h3[3]}, o[d0], 0, 0, 0); } while (0)
    PV_D0(0); PV_D0(1); PV_D0(2); PV_D0(3);
#undef PV_D0
#undef TRRD
}

template <class TIn, class TOut> struct BlockRef { const TIn* Q; const TIn* K; const TIn* V; TOut* O; const unsigned short* G; const unsigned long long* CA; int P0; };
template <class TIn> struct Seam {
    bf16x8 qr[8];
    bf16x8 st_v0, st_v1, st_k0, st_k1; f32x4 sf0, sf1, sf2, sf3;
    unsigned long long ca, qa;
    f32x4 tq[16];
};
__device__ __forceinline__ int swa_jlo(int P0, int W) { const int lowk = P0 - W + 1; return lowk > 0 ? lowk / KVBLK : 0; }
#define ROW(p, k0, rr) ((p) + (size_t)((k0) + (rr)) * LDK + sc)
#define VMW() asm volatile("s_waitcnt vmcnt(0)" ::: "memory")
#define VMWN(n) asm volatile("s_waitcnt vmcnt(%0)" :: "i"(n) : "memory")
#define SLOAD_H(Kp, Vp, CAp, k0) do { S.st_v0 = load8<TIn>(ROW(Vp, k0, sr)); S.st_v1 = load8<TIn>(ROW(Vp, k0, 32 + sr));              \
                         S.st_k0 = load8<TIn>(ROW(Kp, k0, sr)); S.st_k1 = load8<TIn>(ROW(Kp, k0, 32 + sr)); S.ca = (CAp)[(k0) + lane]; } while (0)
#define SWRITE_HK(bf) do { *(bf16x8*)(K_lds + (bf) * SHM_K + kws) = S.st_k0; *(bf16x8*)(K_lds + (bf) * SHM_K + kws + 32 * 256) = S.st_k1; } while (0)
#define SWRITE_HV(bf) do { *(bf16x8*)(V_lds + (bf) * SHM_V + vst0) = S.st_v0; *(bf16x8*)(V_lds + (bf) * SHM_V + vst1) = S.st_v1; } while (0)
#define SWRITE_H(bf) do { SWRITE_HV(bf); SWRITE_HK(bf); } while (0)
#define SLOAD_F(p, k0) do { S.sf0 = *(const f32x4*)ROW(p, k0, sr); S.sf1 = *(const f32x4*)(ROW(p, k0, sr) + 4);                \
                            S.sf2 = *(const f32x4*)ROW(p, k0, 32 + sr); S.sf3 = *(const f32x4*)(ROW(p, k0, 32 + sr) + 4); } while (0)
#define SWRITE_KF(bf) do { *(bf16x8*)(K_lds + (bf) * SHM_K + kws) = pack8(S.sf0, S.sf1); *(bf16x8*)(K_lds + (bf) * SHM_K + kws + 32 * 256) = pack8(S.sf2, S.sf3); } while (0)
#define SWRITE_VF(bf) do { *(bf16x8*)(V_lds + (bf) * SHM_V + vst0) = pack8(S.sf0, S.sf1); *(bf16x8*)(V_lds + (bf) * SHM_V + vst1) = pack8(S.sf2, S.sf3); } while (0)
template <class TIn, class TOut>
__device__ __forceinline__ void causal_swa_prime(const BlockRef<TIn, TOut>& cur, int W, char* lds, Seam<TIn>& S) {
    constexpr bool F32 = same_t<TIn, float>::v;
    const int tid = opaque_tid(), wid = __builtin_amdgcn_readfirstlane(tid >> 6), lane = tid & 63, r32 = lane & 31, hi = lane >> 5;
    const int sr = tid >> 4, sc = (tid & 15) * 8, kws = KSWZ(sr, sc * 2); char* K_lds = lds + 2 * SHM_V;
    const int kb0 = swa_jlo(cur.P0, W) * KVBLK;
    for (int d0 = 0; d0 < 8; ++d0) S.qr[d0] = load8<TIn>(cur.Q + (size_t)(wid * QBLK + r32) * LDQ + d0 * 16 + hi * 8);
    S.qa = cur.CA[cur.P0 + wid * QBLK + r32];
    if constexpr (F32) { SLOAD_F((const float*)cur.K, kb0); VMW(); SWRITE_KF(0); SBAR(); SLOAD_F((const float*)cur.V, kb0); }
    else { SLOAD_H(cur.K, cur.V, cur.CA, kb0); VMW(); SWRITE_HK(0); }
    __syncthreads();
}
template <class TIn, class TOut>
__device__ __forceinline__ void causal_swa_block(const BlockRef<TIn, TOut>& cur, const BlockRef<TIn, TOut>& nxt, int skv, int W, char* lds, Seam<TIn>& S) {
    constexpr bool F32 = same_t<TIn, float>::v;
    const int tid = opaque_tid(), wid = __builtin_amdgcn_readfirstlane(tid >> 6), lane = tid & 63, r32 = lane & 31, hi = lane >> 5;
    const int j_lo = swa_jlo(cur.P0, W);
    int j_hi = (cur.P0 + QB - 1) / KVBLK + 1; if (j_hi > skv / KVBLK) j_hi = skv / KVBLK;
    const int NT = j_hi - j_lo;
    const int kbn = swa_jlo(nxt.P0, W) * KVBLK;
    const int qlo = cur.P0 + wid * QBLK, qm = qlo + r32 - 4 * hi;
    char* V_lds = lds; char* K_lds = lds + 2 * SHM_V;
    float* ws = (float*)(lds + 2 * SHM_V + 2 * SHM_K) + wid * 64; float* li_l = ws, * al_l = ws + 32;
    float m_reg = -1e30f, l_reg = 0; f32x16 o[4] = {};
    const int sr = tid >> 4, sc = (tid & 15) * 8, vst0 = v_st(sr, sc), vst1 = v_st(32 + sr, sc), kws = KSWZ(sr, sc * 2);
    const int vb0 = (int)(uintptr_t)V_lds + v_rd_base(lane);
    const TIn* Kh = cur.K; const TIn* Vh = cur.V; const unsigned long long* CAh = cur.CA;
#define RESC(a) do { if (__any((a) < 1.f)) { if (hi == 0) al_l[r32] = (a); asm volatile("s_waitcnt lgkmcnt(0)" ::: "memory");              \
                     for (int d_ = 0; d_ < 4; ++d_) for (int r = 0; r < 16; ++r) o[d_][r] *= al_l[crow(r, hi)]; } } while (0)
#define KBASE(t) ((j_lo + (t)) * KVBLK)
#define ACT(t) (KBASE(t) <= qlo + QBLK - 1 && KBASE(t) + KVBLK - 1 >= qlo - W + 1)
#define MASKT(P0_, P1_, t) do { const int kb_ = KBASE(t); if ((!SK || ACT(t)) && (kb_ + KVBLK - 1 > qlo || kb_ <= qlo + QBLK - 1 - W)) mask_tile(P0_, P1_, qm - kb_, (unsigned)W); } while (0)
    constexpr int NQL = F32 ? 16 : 8;
    constexpr bool SK = WSKIP && !F32;
#define SEAM_K0() do { VMWN(NQL); if constexpr (F32) { SWRITE_KF(0); SBAR(); SLOAD_F((const float*)nxt.V, kbn); } else { SWRITE_HK(0); } SBAR(); } while (0)
    f32x16 pA0, pA1, pB0, pB1; float mnA, mnB, alA, alB; bf16x8 pa0, pa1, pa2, pa3;
    if constexpr (F32) { VMW(); SWRITE_VF(0); SBAR(); } else { SWRITE_HV(0); SBAR(); }
    const unsigned long long qa_ = S.qa, hc = S.ca;
    if (NT > 1) { if constexpr (F32) SLOAD_F((const float*)Kh, KBASE(1)); else SLOAD_H(Kh, Vh, CAh, KBASE(1)); }
    SBAR(); qkt<0, SK>(pA0, pA1, K_lds, r32, hi, S.qr, ACT(0), qa_, hc);
    if constexpr (F32) { if (NT > 1) { VMW(); SWRITE_KF(1); SBAR(); SLOAD_F((const float*)Vh, KBASE(1)); } }
    MASKT(pA0, pA1, 0); partialSM(pA0, pA1, m_reg, mnA, alA);
    if (NT > 1) { VMW(); if constexpr (F32) { SWRITE_VF(1); SBAR(); if (NT > 2) SLOAD_F((const float*)Kh, KBASE(2)); } else SWRITE_H(1); }
    __syncthreads();
#define HALF_STEP(PX0, PX1, mnX, alX, PY0, PY1, alY, t, KB, VB, SB) do {                                                      \
        { const unsigned long long c_ = S.ca; SBAR(); qkt<KB, SK>(PX0, PX1, K_lds, r32, hi, S.qr, ACT(t), qa_, c_); }                                             \
        finishSM(PY0, PY1, alY, l_reg, pa0, pa1, pa2, pa3); SBAR();                                                           \
        if ((t) + 1 < NT) { if constexpr (F32) { VMW(); SWRITE_KF(SB); SBAR(); SLOAD_F((const float*)Vh, KBASE((t) + 1)); }  \
                            else { SLOAD_H(Kh, Vh, CAh, KBASE((t) + 1)); } SBAR(); }                                               \
        pv_tile<VB, SK>(o, vb0, pa0, pa1, pa2, pa3, ACT((t) - 1)); MASKT(PX0, PX1, (t)); partialSM(PX0, PX1, m_reg, mnX, alX);                                        \
        __syncthreads();                                                                                                      \
        if ((t) + 1 < NT) { VMW(); if constexpr (F32) { SWRITE_VF(SB); SBAR(); if ((t) + 2 < NT) SLOAD_F((const float*)Kh, KBASE((t) + 2)); } \
                            else { SWRITE_H(SB); } }                                                                          \
        RESC(alX); __syncthreads(); } while (0)
    for (int t = 1; t + 1 < NT; t += 2) {
        HALF_STEP(pB0, pB1, mnB, alB, pA0, pA1, alA, t, 1, 0, 0);
        HALF_STEP(pA0, pA1, mnA, alA, pB0, pB1, alB, t + 1, 0, 1, 1);
    }
    const bool even = (NT & 1) == 0;
    if (even) { const unsigned long long c_ = S.ca; SBAR(); qkt<1, SK>(pB0, pB1, K_lds, r32, hi, S.qr, ACT(NT - 1), qa_, c_); SBAR(); }
#define QROW(e) (nxt.Q + (size_t)(wid * QBLK + r32) * D + ((e) >> 1) * 16 + hi * 8 + ((e) & 1) * 4)
    if constexpr (F32) { SLOAD_F((const float*)nxt.K, kbn); SBAR();
#pragma unroll
        for (int e = 0; e < 8; ++e) S.tq[e] = *(const f32x4*)QROW(e); }
    else { SLOAD_H(nxt.K, nxt.V, nxt.CA, kbn); SBAR();
#pragma unroll
        for (int d0 = 0; d0 < 8; ++d0) S.qr[d0] = load8<TIn>(nxt.Q + (size_t)(wid * QBLK + r32) * LDQ + d0 * 16 + hi * 8);
        S.qa = nxt.CA[nxt.P0 + wid * QBLK + r32]; }
    SBAR();
    finishSM(pA0, pA1, alA, l_reg, pa0, pa1, pa2, pa3); SBAR();
    if constexpr (F32) {
#pragma unroll
        for (int e = 8; e < 16; ++e) S.tq[e] = *(const f32x4*)QROW(e); SBAR(); }
#undef QROW
    pv_tile<0, SK>(o, vb0, pa0, pa1, pa2, pa3, ACT(even ? NT - 2 : NT - 1));
    if (even) { MASKT(pB0, pB1, NT - 1); partialSM(pB0, pB1, m_reg, mnB, alB); __syncthreads(); RESC(alB);
        finishSM(pB0, pB1, alB, l_reg, pa0, pa1, pa2, pa3); SBAR(); pv_tile<1, SK>(o, vb0, pa0, pa1, pa2, pa3, ACT(NT - 1)); }
    SBAR(); SEAM_K0();
    if (hi == 0) li_l[r32] = l_reg; asm volatile("s_waitcnt lgkmcnt(0)" ::: "memory");
    float rli[16];
#pragma unroll
    for (int r = 0; r < 16; ++r) rli[r] = __builtin_amdgcn_rcpf(li_l[crow(r, hi)]);
    TOut* Ow = cur.O + (size_t)(wid * QBLK) * LDO; const unsigned short* Gw = cur.G + (size_t)(wid * QBLK) * LDG;
#pragma unroll
    for (int r = 0; r < 16; ++r) { const int orow = crow(r, hi);
#pragma unroll
        for (int d0 = 0; d0 < 4; ++d0) { const float v = o[d0][r] * rli[r];
            if constexpr (same_t<TOut, float>::v) { Ow[(size_t)orow * LDO + d0 * 32 + r32] = v; }
            else { const float vn = __shfl_xor(v, 1);
                   if ((r32 & 1) == 0) { const unsigned g2 = *(const unsigned*)(Gw + (size_t)orow * LDG + d0 * 32 + r32);
                       *(unsigned*)(Ow + (size_t)orow * LDO + d0 * 32 + r32) = cvtpk(v * __uint_as_float(g2 << 16), vn * __uint_as_float(g2 & 0xffff0000u)); } } } }
    if constexpr (F32) {
#pragma unroll
        for (int d0 = 0; d0 < 8; ++d0) S.qr[d0] = pack8(S.tq[2 * d0], S.tq[2 * d0 + 1]); }
    __syncthreads();
#undef RESC
#undef KBASE
#undef ACT
#undef MASKT
#undef SEAM_K0
#undef HALF_STEP
}
#undef ROW
#undef VMW
#undef VMWN
#undef SLOAD_H
#undef SWRITE_HK
#undef SWRITE_HV
#undef SWRITE_H
#undef SLOAD_F
#undef SWRITE_KF
#undef SWRITE_VF

__host__ __device__ inline int swa_nx(int nqb, int nramp) { return (nramp + 1) / 2 + (nqb - nramp); }
struct SwaItem { int bh, qb0, qb1; };
__device__ __forceinline__ SwaItem swa_decode(int L, int nqb, int nx) {
    SwaItem it; const int xcd = L & 7, k = L >> 3, gi = k / nx, r = k - gi * nx;
    it.bh = gi * 8 + xcd; const int x = r;
    it.qb0 = x; it.qb1 = nqb - 1 - x;
    return it;
}
struct AttnT { const bf16* Q; const bf16* K; const bf16* V; bf16* O; const unsigned short* G; const unsigned long long* CA; };
__device__ __forceinline__ BlockRef<bf16, bf16> swa_ref(const SwaItem& it, int pass, const AttnT& T, int seq, int nh) {
    const int qb = pass ? it.qb1 : it.qb0, b = it.bh / nh, h = it.bh % nh; const size_t tok0 = (size_t)b * seq;
    BlockRef<bf16, bf16> r;
    r.Q = T.Q + (tok0 + (size_t)qb * QB) * LDQ + h * D; r.O = T.O + (tok0 + (size_t)qb * QB) * LDO + h * D; r.G = T.G + (tok0 + (size_t)qb * QB) * LDG + h * D;
    r.K = T.K + tok0 * LDK + h * D; r.V = T.V + tok0 * LDK + h * D; r.CA = T.CA + (size_t)it.bh * seq; r.P0 = qb * QB;
    return r;
}
__device__ __forceinline__ void attn_phase(char* lds, const AttnT& T, int nb, int nh, int seq) {
    const int W = 1 << 30, nqb = seq / QB, nx = nqb / 2, total = nx * nb * nh, stride = gridDim.x;
    int L = blockIdx.x; if (L >= total) return;
    SwaItem it = swa_decode(L, nqb, nx); int pass = 0;
    BlockRef<bf16, bf16> cur = swa_ref(it, 0, T, seq, nh);
    Seam<bf16> S;
    causal_swa_prime<bf16, bf16>(cur, W, lds, S);
    for (;;) {
        const bool more_pass = pass == 0 && it.qb1 != it.qb0, more_item = L + stride < total, last = !more_pass && !more_item;
        SwaItem itn = it; int passn = pass + 1, Ln = L;
        if (!more_pass) { passn = 0; Ln = more_item ? L + stride : L; itn = swa_decode(Ln, nqb, nx); }
        const BlockRef<bf16, bf16> nxt = last ? cur : swa_ref(itn, passn, T, seq, nh);
        causal_swa_block<bf16, bf16>(cur, nxt, seq, W, lds, S);
        if (last) break;
        cur = nxt; it = itn; pass = passn; L = Ln;
    }
}
#undef KSWZ
#undef SBAR
}
constexpr int DM = 2048, NB = 4, SEQ = 4096, MT = NB * SEQ, FF = 5632, FF2 = 2 * FF, NH = 16, HD = 128, CH = 128, NG = 16;
constexpr float EPS = 1e-6f;
constexpr int NWAVES = 8, NTHREADS = NWAVES * 64;
constexpr size_t MiB = 1u << 20;
constexpr size_t WS_VSS = 0;
constexpr size_t WS_LOGF = 1 * MiB;
constexpr size_t WS_CA = 2 * MiB;
constexpr size_t WS_WSB = 4 * MiB;
constexpr size_t WS_WF = 5 * MiB;
constexpr size_t WS_W_AIN = 6 * MiB;
constexpr size_t WS_W_AOUT = WS_W_AIN + 32 * MiB;
constexpr size_t WS_W_KV = WS_W_AOUT + 16 * MiB;
constexpr size_t WS_W_QG = WS_W_KV + 16 * MiB;
constexpr size_t WS_W_BOUT = WS_W_QG + 32 * MiB;
constexpr size_t WS_W_UP = WS_W_BOUT + 16 * MiB;
constexpr size_t WS_W_DN = WS_W_UP + 176 * MiB;
constexpr size_t WS_XN = WS_W_DN + 88 * MiB;
constexpr size_t WS_XN2 = WS_XN + 64 * MiB;
constexpr size_t WS_KV = WS_XN2 + 64 * MiB;
constexpr size_t WS_BIG = WS_KV + 128 * MiB;
constexpr size_t WS_ACT = WS_BIG + 352 * MiB;
constexpr size_t WS_SSP = WS_ACT + 176 * MiB;
constexpr size_t WS_END = WS_SSP + 2 * MiB;
constexpr int LDS_BYTES = 147456;

typedef unsigned short bf16_t;
typedef float f32x4 __attribute__((ext_vector_type(4)));
typedef unsigned u32x4 __attribute__((ext_vector_type(4)));
typedef unsigned u32x2 __attribute__((ext_vector_type(2)));
typedef short bf16x8 __attribute__((ext_vector_type(8)));
#define LAS __attribute__((address_space(3)))
__device__ __forceinline__ unsigned pk2(float lo, float hi) { return pg8::cvt_pk_bf16(lo, hi); }
__device__ __forceinline__ float bf_lo(unsigned w) { return __uint_as_float(w << 16); }
__device__ __forceinline__ float bf_hi(unsigned w) { return __uint_as_float(w & 0xffff0000u); }
__device__ __forceinline__ float wave_sum(float v) {
#pragma unroll
    for (int o = 1; o < 64; o <<= 1) v += __shfl_xor(v, o);
    return v;
}
struct Args { const float* in[21]; float* out; unsigned char* ws; };

__device__ __forceinline__ int up_row(int n) { return n < FF ? (n >> 7) * 256 + (n & 127) : ((n - FF) >> 7) * 256 + 128 + ((n - FF) & 127); }
constexpr int TR_LDS_PER_WAVE = 64 * 65 * 4;
__device__ __forceinline__ void transpose_item(const float* W, int K, int ld, int ncols, const float* gk, bf16_t* WT, int mode, LAS float* scr, int item, int lane) {
    const int nblk = ncols / 64, kb = item / nblk, nb = item % nblk, k0 = 64 * kb, n0 = 64 * nb, kr = lane >> 4, n4 = (lane & 15) * 4;
    f32x4 v[16];
#pragma unroll
    for (int i = 0; i < 16; ++i) v[i] = *(const f32x4*)(W + (size_t)(k0 + 4 * i + kr) * ld + n0 + n4);
#pragma unroll
    for (int i = 0; i < 16; ++i) { const int kk = 4 * i + kr; const float g = gk ? gk[k0 + kk] : 1.f; LAS float* d = scr + kk * 65 + n4; d[0] = v[i].x * g; d[1] = v[i].y * g; d[2] = v[i].z * g; d[3] = v[i].w * g; }
    asm volatile("s_waitcnt lgkmcnt(0)" ::: "memory");
    const int c = lane & 7; const int r0 = mode ? up_row(n0) : n0;
#pragma unroll
    for (int j = 0; j < 8; ++j) { const int n = (lane >> 3) + 8 * j; const LAS float* p = scr + (8 * c) * 65 + n;
        u32x4 o; o.x = pk2(p[0 * 65], p[1 * 65]); o.y = pk2(p[2 * 65], p[3 * 65]); o.z = pk2(p[4 * 65], p[5 * 65]); o.w = pk2(p[6 * 65], p[7 * 65]);
        *(u32x4*)(WT + (size_t)(r0 + n) * K + k0 + 8 * c) = o; }
    asm volatile("s_waitcnt lgkmcnt(0)" ::: "memory");
}
template <bool F32OUT>
__device__ __forceinline__ void norm_rows(const float* src, const float* g, void* dst, int gw, int NGW, int lane) {
    for (int m = gw; m < MT; m += NGW) {
        const f32x4* xr = (const f32x4*)(src + (size_t)m * DM) + lane; f32x4 v[8]; float s = 0.f;
#pragma unroll
        for (int j = 0; j < 8; ++j) { v[j] = xr[64 * j]; s += (v[j].x * v[j].x + v[j].y * v[j].y) + (v[j].z * v[j].z + v[j].w * v[j].w); }
        const float r = 1.0f / sqrtf(wave_sum(s) * (1.0f / DM) + EPS);
        const f32x4* gr = (const f32x4*)g + lane;
        if constexpr (F32OUT) { f32x4* o = (f32x4*)((float*)dst + (size_t)m * DM) + lane;
#pragma unroll
            for (int j = 0; j < 8; ++j) o[64 * j] = (v[j] * r) * gr[64 * j]; }
        else { u32x2* o = (u32x2*)((bf16_t*)dst + (size_t)m * DM) + lane;
#pragma unroll
            for (int j = 0; j < 8; ++j) { const f32x4 y = (v[j] * r) * gr[64 * j]; u32x2 w; w.x = pk2(y.x, y.y); w.y = pk2(y.z, y.w); o[64 * j] = w; } }
    }
}
__device__ __forceinline__ void headnorm_rows(bf16_t* buf, int ld, const float* gain, int gw, int NGW, int lane) {
    const f32x4 g0 = *(const f32x4*)(gain + (lane & 15) * 8), g1 = *(const f32x4*)(gain + (lane & 15) * 8 + 4);
    for (int m = gw; m < MT; m += NGW) {
        u32x4* p = (u32x4*)(buf + (size_t)m * ld) + lane; u32x4 w[4];
#pragma unroll
        for (int j = 0; j < 4; ++j) w[j] = p[64 * j];
#pragma unroll
        for (int j = 0; j < 4; ++j) {
            float x[8] = {bf_lo(w[j].x), bf_hi(w[j].x), bf_lo(w[j].y), bf_hi(w[j].y), bf_lo(w[j].z), bf_hi(w[j].z), bf_lo(w[j].w), bf_hi(w[j].w)};
            float s = 0.f;
#pragma unroll
            for (int e = 0; e < 8; ++e) s += x[e] * x[e];
            s += __shfl_xor(s, 1); s += __shfl_xor(s, 2); s += __shfl_xor(s, 4); s += __shfl_xor(s, 8);
            const float r = 1.0f / sqrtf(s * (1.0f / HD) + EPS);
            u32x4 o; o.x = pk2(x[0] * r * g0.x, x[1] * r * g0.y); o.y = pk2(x[2] * r * g0.z, x[3] * r * g0.w); o.z = pk2(x[4] * r * g1.x, x[5] * r * g1.y); o.w = pk2(x[6] * r * g1.z, x[7] * r * g1.w);
            p[64 * j] = o; }
    }
}
__device__ __forceinline__ void fgate_rows(const float* h, const bf16_t* wfh, const bf16_t* wfl, const float* bf, float* logf, int gw, int NGW, int lane) {
    const int fr = lane & 15, fq = lane >> 4;
    for (int rg = gw; rg < MT / 16; rg += NGW) {
        const float* hrow = h + (size_t)(rg * 16 + fr) * DM + 8 * fq; const bf16_t* wh = wfh + fr * DM + 8 * fq; const bf16_t* wl = wfl + fr * DM + 8 * fq;
        f32x4 acc = {0.f, 0.f, 0.f, 0.f}; float ssq = 0.f;
#pragma unroll 4
        for (int ks = 0; ks < DM / 32; ++ks) {
            const f32x4 a0 = *(const f32x4*)(hrow + 32 * ks), a1 = *(const f32x4*)(hrow + 32 * ks + 4);
            ssq += (a0.x * a0.x + a0.y * a0.y) + (a0.z * a0.z + a0.w * a0.w) + (a1.x * a1.x + a1.y * a1.y) + (a1.z * a1.z + a1.w * a1.w);
            u32x4 hi; hi.x = pk2(a0.x, a0.y); hi.y = pk2(a0.z, a0.w); hi.z = pk2(a1.x, a1.y); hi.w = pk2(a1.z, a1.w);
            u32x4 lo; lo.x = pk2(a0.x - bf_lo(hi.x), a0.y - bf_hi(hi.x)); lo.y = pk2(a0.z - bf_lo(hi.y), a0.w - bf_hi(hi.y)); lo.z = pk2(a1.x - bf_lo(hi.z), a1.y - bf_hi(hi.z)); lo.w = pk2(a1.z - bf_lo(hi.w), a1.w - bf_hi(hi.w));
            const bf16x8 whv = *(const bf16x8*)(wh + 32 * ks), wlv = *(const bf16x8*)(wl + 32 * ks);
            const bf16x8 hv = __builtin_bit_cast(bf16x8, hi), lv = __builtin_bit_cast(bf16x8, lo);
            acc = __builtin_amdgcn_mfma_f32_16x16x32_bf16(whv, hv, acc, 0, 0, 0);
            acc = __builtin_amdgcn_mfma_f32_16x16x32_bf16(wlv, hv, acc, 0, 0, 0);
            acc = __builtin_amdgcn_mfma_f32_16x16x32_bf16(whv, lv, acc, 0, 0, 0);
        }
        ssq += __shfl_xor(ssq, 16); ssq += __shfl_xor(ssq, 32);
        const float r = 1.0f / sqrtf(ssq * (1.0f / DM) + EPS);
        const f32x4 b = *(const f32x4*)(bf + 4 * fq); f32x4 o;
#pragma unroll
        for (int e = 0; e < 4; ++e) { const float f = acc[e] * r + b[e]; o[e] = fminf(f, 0.f) - log1pf(expf(-fabsf(f))); }
        *(f32x4*)(logf + (size_t)(rg * 16 + fr) * 16 + 4 * fq) = o;
    }
}
__device__ __forceinline__ void scan_seq(const float* logf, unsigned long long* CA, int seq, int lane) {
    const int b = seq >> 4, hh = seq & 15;
    const float* lf = logf + ((size_t)b * SEQ + (size_t)lane * 64) * 16 + hh;
    float v[64];
#pragma unroll
    for (int i = 0; i < 64; ++i) v[i] = lf[i * 16];
#pragma unroll
    for (int i = 1; i < 64; ++i) v[i] += v[i - 1];
    const float tot = v[63]; float t = tot;
#pragma unroll
    for (int o = 1; o < 64; o <<= 1) { const float y = __shfl_up(t, o); if (lane >= o) t += y; }
    const float excl = t - tot;
    unsigned long long* out = CA + (size_t)seq * SEQ + lane * 64;
#pragma unroll
    for (int i = 0; i < 64; ++i) { const float c = (excl + v[i]) * 11.313708498984761f;
        const unsigned h1 = pk2(c, 0.f) & 0xffffu; const float r1 = c - bf_lo(h1);
        const unsigned h2 = pk2(r1, 0.f) & 0xffffu; const float r2 = r1 - bf_lo(h2);
        const unsigned h3 = pk2(r2, 0.f) & 0xffffu;
        out[i] = (unsigned long long)(h1 | (h2 << 16)) | ((unsigned long long)h3 << 32); }
}
__device__ __forceinline__ void spatial_phase(LAS unsigned char* ldsp, const bf16_t* Z, const float* ssp, const bf16_t* wsb, const float* vnorm, const float* bs, bf16_t* GATED, int wave, int lane) {
    const int fr = lane & 15, fq = lane >> 4;
    for (int item = blockIdx.x; item < (MT / CH) * NG; item += gridDim.x) {
        const int ch = item >> 4, g = item & 15, row0 = ch * CH, cw = g * 128 + wave * 16;
        LAS float* rvs = (LAS float*)ldsp;
        __syncthreads();
        { const int t_ = wave * 64 + lane; if (t_ < CH) { const f32x4* p = (const f32x4*)(ssp + (size_t)(row0 + t_) * 32); float sq = 0.f;
#pragma unroll
            for (int q = 0; q < 8; ++q) { const f32x4 v = p[q]; sq += (v.x + v.y) + (v.z + v.w); }
            rvs[t_] = 1.0f / sqrtf(sq * (1.0f / DM) + EPS); } }
        __syncthreads();
        bf16x8 vf[4];
#pragma unroll
        for (int ks = 0; ks < 4; ++ks) {
            const bf16_t* vp = Z + (size_t)(row0 + 32 * ks + 8 * fq) * 4096 + 2048 + cw + fr; float x[8];
#pragma unroll
            for (int i = 0; i < 8; ++i) x[i] = __uint_as_float((unsigned)vp[(size_t)i * 4096] << 16) * rvs[32 * ks + 8 * fq + i];
            u32x4 w; w.x = pk2(x[0], x[1]); w.y = pk2(x[2], x[3]); w.z = pk2(x[4], x[5]); w.w = pk2(x[6], x[7]); vf[ks] = __builtin_bit_cast(bf16x8, w);
        }
        f32x4 acc[8];
#pragma unroll
        for (int m = 0; m < 8; ++m) { acc[m] = (f32x4){0.f, 0.f, 0.f, 0.f};
#pragma unroll
            for (int ks = 0; ks < 4; ++ks) if (32 * ks <= 16 * m + 15) {
                const bf16x8 wf = *(const bf16x8*)(wsb + ((size_t)(g * 128 + 16 * m + fr) * 128 + 32 * ks + 8 * fq));
                acc[m] = __builtin_amdgcn_mfma_f32_16x16x32_bf16(vf[ks], wf, acc[m], 0, 0, 0); } }
        const f32x4 vn = *(const f32x4*)(vnorm + cw + 4 * fq);
#pragma unroll
        for (int m = 0; m < 8; ++m) { const int t = 16 * m + fr; const size_t row = (size_t)(row0 + t); const float bias = bs[g * 128 + t];
            const u32x2 uu = *(const u32x2*)(Z + row * 4096 + cw + 4 * fq);
            const float o0 = bf_lo(uu.x) * (acc[m][0] * vn[0] + bias), o1 = bf_hi(uu.x) * (acc[m][1] * vn[1] + bias), o2 = bf_lo(uu.y) * (acc[m][2] * vn[2] + bias), o3 = bf_hi(uu.y) * (acc[m][3] * vn[3] + bias);
            u32x2 w; w.x = pk2(o0, o1); w.y = pk2(o2, o3); *(u32x2*)(GATED + row * DM + cw + 4 * fq) = w; }
    }
}
__device__ __forceinline__ void conv_phase(const bf16_t* BIG, const float* cw, const float* cb, bf16_t* ACT) {
    constexpr int NQ = FF / 8, RS = 32, NTASK = NQ * (MT / RS);
    const int tid_ = opaque_tid();
    for (int T = blockIdx.x * NTHREADS + tid_; T < NTASK; T += gridDim.x * NTHREADS) {
        const int q = T % NQ, strip = T / NQ, j0 = 8 * q, pg = (q >> 4) * 256 + (q & 15) * 8, row0 = strip * RS;
        float wg[3][8], wv[3][8], bg[8], bv[8];
#pragma unroll
        for (int k = 0; k < 3; ++k)
#pragma unroll
            for (int e = 0; e < 8; ++e) { wg[k][e] = cw[(size_t)k * FF2 + j0 + e]; wv[k][e] = cw[(size_t)k * FF2 + FF + j0 + e]; }
#pragma unroll
        for (int e = 0; e < 8; ++e) { bg[e] = cb[j0 + e]; bv[e] = cb[FF + j0 + e]; }
        const bf16_t* src = BIG + (size_t)row0 * FF2 + pg; bf16_t* dst = ACT + (size_t)row0 * FF + j0;
        u32x4 g2 = {0u, 0u, 0u, 0u}, g1 = g2, v2 = g2, v1 = g2;
        if ((row0 & (SEQ - 1)) != 0) { g2 = *(const u32x4*)(src - 2 * (size_t)FF2); v2 = *(const u32x4*)(src - 2 * (size_t)FF2 + 128); g1 = *(const u32x4*)(src - (size_t)FF2); v1 = *(const u32x4*)(src - (size_t)FF2 + 128); }
        for (int i0 = 0; i0 < RS; i0 += 8) {
            u32x4 gc[8], vc[8];
#pragma unroll
            for (int i = 0; i < 8; ++i) { gc[i] = *(const u32x4*)(src + (size_t)(i0 + i) * FF2); vc[i] = *(const u32x4*)(src + (size_t)(i0 + i) * FF2 + 128); }
#pragma unroll
            for (int i = 0; i < 8; ++i) { u32x4 o;
#pragma unroll
                for (int p = 0; p < 4; ++p) {
                    const float ga = wg[0][2 * p] * bf_lo(g2[p]) + wg[1][2 * p] * bf_lo(g1[p]) + wg[2][2 * p] * bf_lo(gc[i][p]) + bg[2 * p];
                    const float gb = wg[0][2 * p + 1] * bf_hi(g2[p]) + wg[1][2 * p + 1] * bf_hi(g1[p]) + wg[2][2 * p + 1] * bf_hi(gc[i][p]) + bg[2 * p + 1];
                    const float va = wv[0][2 * p] * bf_lo(v2[p]) + wv[1][2 * p] * bf_lo(v1[p]) + wv[2][2 * p] * bf_lo(vc[i][p]) + bv[2 * p];
                    const float vb = wv[0][2 * p + 1] * bf_hi(v2[p]) + wv[1][2 * p + 1] * bf_hi(v1[p]) + wv[2][2 * p + 1] * bf_hi(vc[i][p]) + bv[2 * p + 1];
                    const float sa = ga * __builtin_amdgcn_rcpf(1.0f + __builtin_amdgcn_exp2f(-1.4426950408889634f * ga)), sb = gb * __builtin_amdgcn_rcpf(1.0f + __builtin_amdgcn_exp2f(-1.4426950408889634f * gb));
                    o[p] = pk2(sa * va, sb * vb); }
                *(u32x4*)(dst + (size_t)(i0 + i) * FF) = o; g2 = g1; g1 = gc[i]; v2 = v1; v1 = vc[i]; }
        }
    }
}

typedef const Args __attribute__((address_space(4))) CArgs;
__device__ __forceinline__ CArgs* kargs() { CArgs* p = (CArgs*)__builtin_amdgcn_kernarg_segment_ptr(); asm volatile("" : "+s"(p)); return p; }
#define PTRS \
    CArgs* ap_ = kargs(); unsigned char* ws = ap_->ws; float* h = ap_->out; (void)ws; (void)h; \
    const float* x = ap_->in[0]; const float* a_norm = ap_->in[1]; const float* a_w_in = ap_->in[2]; const float* a_v_norm = ap_->in[3]; const float* a_w_s = ap_->in[4]; const float* a_b_s = ap_->in[5]; \
    const float* a_w_out = ap_->in[6]; const float* kv_norm = ap_->in[7]; const float* w_kvf = ap_->in[8]; const float* b_f = ap_->in[9]; const float* k_norm = ap_->in[10]; const float* b_norm = ap_->in[11]; \
    const float* b_w_qg = ap_->in[12]; const float* q_norm = ap_->in[13]; const float* b_w_out = ap_->in[14]; const float* f_norm = ap_->in[15]; const float* f_w_up = ap_->in[16]; const float* f_conv_w = ap_->in[17]; \
    const float* f_conv_b = ap_->in[18]; const float* f_w_down = ap_->in[19]; const float* final_norm = ap_->in[20]; \
    (void)x; (void)a_norm; (void)a_w_in; (void)a_v_norm; (void)a_w_s; (void)a_b_s; (void)a_w_out; (void)kv_norm; (void)w_kvf; (void)b_f; (void)k_norm; (void)b_norm; (void)b_w_qg; (void)q_norm; (void)b_w_out; \
    (void)f_norm; (void)f_w_up; (void)f_conv_w; (void)f_conv_b; (void)f_w_down; (void)final_norm; \
    float* VSS = (float*)(ws + WS_SSP); float* LOGF = (float*)(ws + WS_LOGF); unsigned long long* CA = (unsigned long long*)(ws + WS_CA); \
    bf16_t* WSB = (bf16_t*)(ws + WS_WSB); bf16_t* WFH = (bf16_t*)(ws + WS_WF); bf16_t* WFL = WFH + 16 * DM; \
    bf16_t* W_AIN = (bf16_t*)(ws + WS_W_AIN); bf16_t* W_AOUT = (bf16_t*)(ws + WS_W_AOUT); bf16_t* W_KV = (bf16_t*)(ws + WS_W_KV); bf16_t* W_QG = (bf16_t*)(ws + WS_W_QG); \
    bf16_t* W_BOUT = (bf16_t*)(ws + WS_W_BOUT); bf16_t* W_UP = (bf16_t*)(ws + WS_W_UP); bf16_t* W_DN = (bf16_t*)(ws + WS_W_DN); \
    bf16_t* HB = (bf16_t*)(ws + WS_XN); float* RSS = (float*)(ws + WS_XN2); bf16_t* KVB = (bf16_t*)(ws + WS_KV); bf16_t* BIG = (bf16_t*)(ws + WS_BIG); bf16_t* ACT = (bf16_t*)(ws + WS_ACT); \
    (void)VSS; (void)LOGF; (void)CA; (void)WSB; (void)WFH; (void)WFL; (void)W_AIN; (void)W_AOUT; (void)W_KV; (void)W_QG; (void)W_BOUT; (void)W_UP; (void)W_DN; (void)HB; (void)RSS; (void)KVB; (void)BIG; (void)ACT;
typedef pg8::EpiBf<1, true> EPI_A1; typedef pg8::EpiBf<0, true> EPI_KV; typedef pg8::EpiBf<2, true> EPI_QG; typedef pg8::EpiBf<0, true> EPI_UP;
#define GEMM_PHASE(EPI, Aptr, Bptr, NN, KK, ...) do { pg8::Gemm g_{Aptr, Bptr, MT, NN, KK}; pg8::StaticOrder S_; S_.init(MT, NN, G, (int)blockIdx.x); EPI E_{__VA_ARGS__}; \
    pg8::gemm_phase<EPI, pg8::StaticOrder, true, true>(ldsp, g_, S_, E_); } while (0)

__global__ void __launch_bounds__(NTHREADS, 2) fwd_megakernel(Args a) {
    extern __shared__ __attribute__((aligned(16))) unsigned char lds[];
    cg::grid_group grid = cg::this_grid();
#define GSYNC() do { asm volatile("s_waitcnt vmcnt(0)" ::: "memory"); grid.sync(); } while (0)
    const int wave = __builtin_amdgcn_readfirstlane(threadIdx.x >> 6);
    const int G = gridDim.x, gw = blockIdx.x * NWAVES + wave, NGW = G * NWAVES;
    LAS unsigned char* ldsp = (LAS unsigned char*)lds;

    {
        PTRS
        const int tid = opaque_tid(), lane = tid & 63;
        const int gt = blockIdx.x * NTHREADS + tid, NGT = G * NTHREADS;
        for (int i = gt; i < 2 * NG * CH * CH / 8; i += NGT) {
            const int e0 = i * 8, s0 = e0 & 127, t = (e0 >> 7) & 127; const f32x4 w0 = *(const f32x4*)(a_w_s + e0), w1 = *(const f32x4*)(a_w_s + e0 + 4);
            float y[8] = {w0.x, w0.y, w0.z, w0.w, w1.x, w1.y, w1.z, w1.w};
#pragma unroll
            for (int e = 0; e < 8; ++e) if (s0 + e > t) y[e] = 0.f;
            u32x4 o; o.x = pk2(y[0], y[1]); o.y = pk2(y[2], y[3]); o.z = pk2(y[4], y[5]); o.w = pk2(y[6], y[7]); *(u32x4*)(WSB + e0) = o; }
        for (int i = gt; i < 16 * DM; i += NGT) { const int n = i / DM, k = i % DM; const float w = kv_norm[k] * w_kvf[(size_t)k * 4112 + 4096 + n];
            const unsigned hi = pk2(w, 0.f) & 0xffffu; WFH[i] = (bf16_t)hi; WFL[i] = (bf16_t)(pk2(w - bf_lo(hi), 0.f) & 0xffffu); }
        LAS float* scr = (LAS float*)(ldsp + wave * TR_LDS_PER_WAVE);
        for (int it = gw; it < 48128; it += NGW) {
            int r = it, K = DM, ld, ncols, mode = 0; const float* W; const float* g = nullptr; bf16_t* WT;
            if (r < 4096) { const int l = r >> 11; r &= 2047; W = a_w_in + (size_t)l * DM * 4096; g = a_norm + l * DM; WT = W_AIN + (size_t)l * 4096 * DM; ld = 4096; ncols = 4096; }
            else if ((r -= 4096) < 2048) { const int l = r >> 10; r &= 1023; W = a_w_out + (size_t)l * DM * DM; WT = W_AOUT + (size_t)l * DM * DM; ld = DM; ncols = DM; }
            else if ((r -= 2048) < 2048) { W = w_kvf; g = kv_norm; WT = W_KV; ld = 4112; ncols = 4096; }
            else if ((r -= 2048) < 4096) { const int l = r >> 11; r &= 2047; W = b_w_qg + (size_t)l * DM * 4096; g = b_norm + l * DM; WT = W_QG + (size_t)l * 4096 * DM; ld = 4096; ncols = 4096; }
            else if ((r -= 4096) < 2048) { const int l = r >> 10; r &= 1023; W = b_w_out + (size_t)l * DM * DM; WT = W_BOUT + (size_t)l * DM * DM; ld = DM; ncols = DM; }
            else if ((r -= 2048) < 22528) { const int l = r / 5632; r -= l * 5632; W = f_w_up + (size_t)l * DM * FF2; g = f_norm + l * DM; WT = W_UP + (size_t)l * FF2 * DM; ld = FF2; ncols = FF2; mode = 1; }
            else { r -= 22528; const int l = r / 2816; r -= l * 2816; W = f_w_down + (size_t)l * FF * DM; WT = W_DN + (size_t)l * DM * FF; K = FF; ld = DM; ncols = DM; }
            transpose_item(W, K, ld, ncols, g, WT, mode, scr, r, lane);
        }
        for (int m = gw; m < MT; m += NGW) {
            const f32x4* xr = (const f32x4*)(x + (size_t)m * DM) + lane; u32x2* o = (u32x2*)(HB + (size_t)m * DM) + lane; float sq = 0.f;
#pragma unroll
            for (int j = 0; j < 8; ++j) { const f32x4 v = xr[64 * j]; sq += (v.x * v.x + v.y * v.y) + (v.z * v.z + v.w * v.w); u32x2 w; w.x = pk2(v.x, v.y); w.y = pk2(v.z, v.w); o[64 * j] = w; }
            sq = wave_sum(sq); if (lane < 32) RSS[(size_t)m * 32 + lane] = lane == 0 ? sq : 0.f;
        }
    }
    GSYNC();

    for (int l = 0; l < 4; ++l) {
        if (l < 2) {
            { PTRS GEMM_PHASE(EPI_A1, HB, W_AIN + (size_t)l * 4096 * DM, 4096, DM, BIG, 4096, 8, VSS, RSS); }
            GSYNC();
            { PTRS const int lane = opaque_tid() & 63;
              spatial_phase(ldsp, BIG, VSS, WSB + (size_t)l * NG * CH * CH, a_v_norm + (size_t)l * DM, a_b_s + (size_t)l * NG * CH, ACT, wave, lane); }
            GSYNC();
        } else {
            const int j = l - 2;
            if (j == 0) { PTRS const int lane = opaque_tid() & 63; fgate_rows(h, WFH, WFL, b_f, LOGF, gw, NGW, lane);
                          GEMM_PHASE(EPI_KV, HB, W_KV, 4096, DM, KVB, 4096, 1 << 30, nullptr, RSS); }
            { PTRS GEMM_PHASE(EPI_QG, HB, W_QG + (size_t)j * 4096 * DM, 4096, DM, BIG, 4096, 8, nullptr, RSS); }
            GSYNC();
            { PTRS const int lane = opaque_tid() & 63;
              if (j == 0) { if (blockIdx.x < 8) scan_seq(LOGF, CA, blockIdx.x * 8 + wave, lane); headnorm_rows(KVB, 4096, k_norm, gw, NGW, lane); }
              headnorm_rows(BIG, 4096, q_norm + (size_t)j * HD, gw, NGW, lane); }
            GSYNC();
            { PTRS att::AttnT T{(const att::bf16*)BIG, (const att::bf16*)KVB, (const att::bf16*)(KVB + 2048), (att::bf16*)ACT, BIG + 2048, CA};
              att::attn_phase((char*)lds, T, NB, NH, SEQ); }
            GSYNC();
        }
        { PTRS const bf16_t* Wt = l < 2 ? W_AOUT + (size_t)l * DM * DM : W_BOUT + (size_t)(l - 2) * DM * DM;
          GEMM_PHASE(pg8::EpiRes, ACT, Wt, DM, DM, l == 0 ? x : (const float*)h, h, HB, RSS, DM); }
        GSYNC();
        { PTRS GEMM_PHASE(EPI_UP, HB, W_UP + (size_t)l * FF2 * DM, FF2, DM, BIG, FF2, 1 << 30, nullptr, RSS); }
        GSYNC();
        { PTRS conv_phase(BIG, f_conv_w + (size_t)l * 3 * FF2, f_conv_b + (size_t)l * FF2, ACT); }
        GSYNC();
        { PTRS GEMM_PHASE(pg8::EpiRes, ACT, W_DN + (size_t)l * DM * FF, DM, FF, h, h, HB, RSS, DM); }
        GSYNC();
    }
    { PTRS const int lane = opaque_tid() & 63; norm_rows<true>(h, final_norm, h, gw, NGW, lane); }
}

extern "C" void kernel_launch(void* const* d_in, const int* in_sizes, int n_in, void* d_out, int out_size, void* d_ws, size_t ws_size, hipStream_t stream) {
    static int grid = 0;
    if (grid == 0) {
        if (n_in != 21 || out_size != MT * DM || ws_size < WS_END) { fprintf(stderr, "kernel_launch: unexpected shapes (n_in %d out %d ws %zu, need ws >= %zu)\n", n_in, out_size, ws_size, (size_t)WS_END); grid = -1; return; }
        int dev = 0, cus = 0, per_cu = 0;
        (void)hipGetDevice(&dev); (void)hipDeviceGetAttribute(&cus, hipDeviceAttributeMultiprocessorCount, dev);
        (void)hipFuncSetAttribute((const void*)fwd_megakernel, hipFuncAttributeMaxDynamicSharedMemorySize, LDS_BYTES);
        (void)hipOccupancyMaxActiveBlocksPerMultiprocessor(&per_cu, (const void*)fwd_megakernel, NTHREADS, LDS_BYTES);
        if (per_cu < 1) { fprintf(stderr, "kernel_launch: occupancy query says %d blocks per CU\n", per_cu); per_cu = 1; }
        grid = cus * 1;
        (void)hipGetLastError();
    }
    if (grid < 0) return;
    Args a{};
    for (int i = 0; i < 21; ++i) a.in[i] = (const float*)d_in[i];
    a.out = (float*)d_out; a.ws = (unsigned char*)d_ws;
    void* args[] = {&a};
    hipError_t e = hipLaunchCooperativeKernel((const void*)fwd_megakernel, dim3(grid), dim3(NTHREADS), args, LDS_BYTES, stream);
    if (e != hipSuccess) fprintf(stderr, "cooperative launch failed: %s (grid %d)\n", hipGetErrorString(e), grid);
}
```

```cpp
#include <hip/hip_runtime.h>
#include <hip/hip_cooperative_groups.h>
#include <hip/hip_bf16.h>
#include <cstdio>
#include <cstdint>
namespace cg = cooperative_groups;
#ifndef PROBE
#define PROBE 0
#endif
__device__ __forceinline__ int opaque_tid() { int t = threadIdx.x; asm volatile("" : "+v"(t)); return t; }
namespace pg8 {
#define PG8_LAS __attribute__((address_space(3)))
typedef unsigned short bf16_t;
typedef short bf16x8 __attribute__((ext_vector_type(8)));
typedef float f32x4 __attribute__((ext_vector_type(4)));
typedef unsigned u32x4 __attribute__((ext_vector_type(4)));
constexpr int BM = 256, BK = 64, HALF = 128, HTB = HALF * BK * 2  , STAGE_BYTES = 8 * HTB, NXCD = 8, WGM = 8;

__host__ __device__ __forceinline__ int lds_byte(int r, int c) { const int st = (r >> 4) * 2 + (c >> 5), rr = r & 15, cc = c & 31, ob = rr * 64 + cc * 2; return st * 1024 + (ob ^ (((ob >> 9) & 1) << 5)); }
__host__ __device__ __forceinline__ void stage_rc(int b, int& R, int& C) { const int st = b / 1024, sb = b % 1024, swz = sb ^ (((sb >> 9) & 1) << 5); R = (st >> 1) * 16 + swz / 64; C = (st & 1) * 32 + (swz % 64) / 2; }
__host__ __device__ __forceinline__ int perm32(int rho) { const int n = rho >> 4, i = rho & 15; return 8 * (i >> 2) + 4 * n + (i & 3); }

struct Unit { int pm, pn; };
struct Gemm { const bf16_t* A; const bf16_t* Bt; int M, N, K; };

struct StaticOrder {
    int nM, nN, nwg, G, c;
    __host__ __device__ void init(int M, int N, int G_, int c_) { nM = M / BM; nN = N / BM; nwg = nM * nN; G = G_; c = c_; }
    __host__ __device__ bool next(int i, Unit& u) const {
        const long L = (long)i * G + c; if (L >= nwg) return false;
        int wgid = (int)L; { const int q = nwg / NXCD, r = nwg % NXCD, xcd = wgid % NXCD, off = wgid / NXCD; wgid = (xcd < r ? xcd * (q + 1) : r * (q + 1) + (xcd - r) * q) + off; }
        const int nig = WGM * nN, gid = wgid / nig, fm = gid * WGM, gsz = (nM - fm) < WGM ? (nM - fm) : WGM;
        u.pm = fm + ((wgid % nig) % gsz); u.pn = (wgid % nig) / gsz; return true;
    }
    __device__ __forceinline__ void a_ready(const Unit&) const {}
    __device__ __forceinline__ void done(const Unit&) const {}
};

__device__ __forceinline__ unsigned cvt_pk_bf16(float lo, float hi) { unsigned r; asm volatile("v_cvt_pk_bf16_f32 %0, %1, %2" : "=v"(r) : "v"(lo), "v"(hi)); return r; }
typedef float f32x2 __attribute__((ext_vector_type(2)));
__device__ __forceinline__ f32x2 gelu_pk(f32x2 v) {
    const f32x2 av = __builtin_elementwise_abs(v), d = av * 0.2316418882f + 1.0f;
    f32x2 t; t.x = __builtin_amdgcn_rcpf(d.x); t.y = __builtin_amdgcn_rcpf(d.y);
    f32x2 q = t * 0.5307027145f + (-0.7265760135f); q = q * t + 0.7107068705f; q = q * t + (-0.142248368f); q = q * t + 0.127414796f; q = q * t;
    const f32x2 s = (v * v) * (-0.72134752044f);
    f32x2 e; e.x = __builtin_amdgcn_exp2f(s.x); e.y = __builtin_amdgcn_exp2f(s.y);
    const f32x2 m = v * (q * e), r = v - m;
    f32x2 o; o.x = v.x < 0.f ? m.x : r.x; o.y = v.y < 0.f ? m.y : r.y; return o;
}
constexpr float RS_INV = 1.0f / 2048.0f, RS_EPS = 1e-6f;
template <int MODE, bool RSCALE> struct EpiBf {
    static constexpr bool PERM = true, AFTER_DRAIN = false;
    bf16_t* O; int ldc; int split_pn; float* ss; const float* rs;
    __device__ __forceinline__ void operator()(const f32x4 (&acc)[2][2][4][2], const Unit& u, int wr, int wc, int fr, int fq) const {
        const int row0 = u.pm * BM + wr * 64 + fr, col0 = u.pn * BM + wc * 32 + 8 * fq;
        const bool up = u.pn >= split_pn;
        float rr[2][4];
#pragma unroll
        for (int ai = 0; ai < 2; ++ai)
#pragma unroll
            for (int m = 0; m < 4; ++m) { rr[ai][m] = 1.f;
                if (RSCALE) { const f32x4* p = (const f32x4*)(rs + (size_t)(row0 + ai * HALF + m * 16) * 32 + fq * 8); const f32x4 a = p[0], b = p[1];
                    float t = ((a[0] + a[1]) + (a[2] + a[3])) + ((b[0] + b[1]) + (b[2] + b[3])); t += __shfl_xor(t, 16); t += __shfl_xor(t, 32); rr[ai][m] = 1.0f / sqrtf(t * RS_INV + RS_EPS); } }
#pragma unroll
        for (int ai = 0; ai < 2; ++ai)
#pragma unroll
            for (int m = 0; m < 4; ++m) { const int row = row0 + ai * HALF + m * 16; bf16_t* rowp = O + (size_t)row * ldc + col0; float s = 0.f;
#pragma unroll
                for (int bj = 0; bj < 2; ++bj) { f32x4 v0 = acc[ai][bj][m][0], v1 = acc[ai][bj][m][1];
                    if (RSCALE) { v0 = v0 * rr[ai][m]; v1 = v1 * rr[ai][m]; }
                    if (MODE == 1) { f32x2 a = gelu_pk((f32x2){v0[0], v0[1]}), b = gelu_pk((f32x2){v0[2], v0[3]}), c = gelu_pk((f32x2){v1[0], v1[1]}), d = gelu_pk((f32x2){v1[2], v1[3]});
                        v0 = (f32x4){a.x, a.y, b.x, b.y}; v1 = (f32x4){c.x, c.y, d.x, d.y};
                        s += (v0[0] * v0[0] + v0[1] * v0[1]) + (v0[2] * v0[2] + v0[3] * v0[3]) + (v1[0] * v1[0] + v1[1] * v1[1]) + (v1[2] * v1[2] + v1[3] * v1[3]); }
                    if (MODE == 2) { if (up) {
#pragma unroll
                        for (int e = 0; e < 4; ++e) { v0[e] = __builtin_amdgcn_rcpf(1.0f + __builtin_amdgcn_exp2f(-1.4426950408889634f * v0[e])); v1[e] = __builtin_amdgcn_rcpf(1.0f + __builtin_amdgcn_exp2f(-1.4426950408889634f * v1[e])); } } }
                    u32x4 w; w.x = cvt_pk_bf16(v0[0], v0[1]); w.y = cvt_pk_bf16(v0[2], v0[3]); w.z = cvt_pk_bf16(v1[0], v1[1]); w.w = cvt_pk_bf16(v1[2], v1[3]);
                    *(u32x4*)(rowp + bj * HALF) = w; }
                if (MODE == 1) { if (up) { s += __shfl_xor(s, 16); s += __shfl_xor(s, 32); if (fq == 0) ss[(size_t)row * 32 + (u.pn - split_pn) * 4 + wc] = s; } } }
    }
};
struct EpiRes {
    static constexpr bool PERM = true, AFTER_DRAIN = false;
    const float* base; float* out; bf16_t* hb; float* rss; int ldc;
    __device__ __forceinline__ void operator()(const f32x4 (&acc)[2][2][4][2], const Unit& u, int wr, int wc, int fr, int fq) const {
        const int row0 = u.pm * BM + wr * 64 + fr, col0 = u.pn * BM + wc * 32 + 8 * fq;
#pragma unroll
        for (int ai = 0; ai < 2; ++ai)
#pragma unroll
            for (int m = 0; m < 4; ++m) { const int row = row0 + ai * HALF + m * 16; const size_t off = (size_t)row * ldc + col0; f32x4 b[2][2]; float s = 0.f;
#pragma unroll
                for (int bj = 0; bj < 2; ++bj)
#pragma unroll
                    for (int n = 0; n < 2; ++n) b[bj][n] = *(const f32x4*)(base + off + bj * HALF + n * 4);
#pragma unroll
                for (int bj = 0; bj < 2; ++bj) { const f32x4 o0 = b[bj][0] + acc[ai][bj][m][0], o1 = b[bj][1] + acc[ai][bj][m][1];
                    *(f32x4*)(out + off + bj * HALF) = o0; *(f32x4*)(out + off + bj * HALF + 4) = o1;
                    u32x4 w; w.x = cvt_pk_bf16(o0[0], o0[1]); w.y = cvt_pk_bf16(o0[2], o0[3]); w.z = cvt_pk_bf16(o1[0], o1[1]); w.w = cvt_pk_bf16(o1[2], o1[3]);
                    *(u32x4*)(hb + off + bj * HALF) = w;
                    s += ((o0[0] * o0[0] + o0[1] * o0[1]) + (o0[2] * o0[2] + o0[3] * o0[3])) + ((o1[0] * o1[0] + o1[1] * o1[1]) + (o1[2] * o1[2] + o1[3] * o1[3])); }
                s += __shfl_xor(s, 16); s += __shfl_xor(s, 32); if (fq == 0) rss[(size_t)row * 32 + u.pn * 4 + wc] = s;
                if (m & 1) asm volatile("" ::: "memory"); }
    }
};
template <class Epi, class Sched, bool ALIGN_EPI = false, bool SP2 = false>
__device__ __forceinline__ void gemm_phase(PG8_LAS unsigned char* lds, const Gemm g, const Sched& S, const Epi& E) {
    const int tid = opaque_tid(), wid = __builtin_amdgcn_readfirstlane(tid >> 6), lane = tid & 63, wr = wid >> 2, wc = wid & 3, fr = lane & 15, fq = lane >> 4;
    const int K = g.K, nt = K / BK;
    unsigned voffA[2], voffB[2];
#pragma unroll
    for (int i = 0; i < 2; ++i) { int R, C; stage_rc(tid * 16 + i * 8192, R, C); const int Rb = Epi::PERM ? ((R & ~31) + perm32(R & 31)) : R;
        voffA[i] = (unsigned)(R * K + C) * 2u; voffB[i] = (unsigned)(Rb * K + C) * 2u; }
    const size_t kstep = (size_t)(BK * 2);
    const size_t hstep = (size_t)HALF * K * 2;
    const size_t tstep = 2 * hstep;
    const unsigned ldsw = (unsigned)wid * 1024u;
    const int aoff = lds_byte(wr * 64 + fr, fq * 8), boff = lds_byte(wc * 32 + fr, fq * 8);
#define PG8_SA(b, h) (((b) * 2 + (h)) * HTB)
#define PG8_SB(b, h) ((4 + (b) * 2 + (h)) * HTB)
#define PG8_STAGE(bufoff, gbase, voff) do { _Pragma("unroll") for (int _i = 0; _i < 2; ++_i) \
        __builtin_amdgcn_global_load_lds((const unsigned*)((const char*)(gbase) + (voff)[_i]), (PG8_LAS unsigned*)(lds + (bufoff) + ldsw + _i * 8192), 16, 0, 0); } while (0)
#define PG8_LDA(dst, b, h) do { _Pragma("unroll") for (int m = 0; m < 4; ++m) _Pragma("unroll") for (int k = 0; k < 2; ++k) dst[m][k] = *(const PG8_LAS bf16x8*)(lds + PG8_SA(b, h) + aoff + m * 2048 + k * 1024); } while (0)
#define PG8_LDB(dst, b, h) do { _Pragma("unroll") for (int n = 0; n < 2; ++n) _Pragma("unroll") for (int k = 0; k < 2; ++k) dst[n][k] = *(const PG8_LAS bf16x8*)(lds + PG8_SB(b, h) + boff + n * 2048 + k * 1024); } while (0)
#define PG8_MMA(ai, bj, At, Bt) do { __builtin_amdgcn_s_setprio(1); _Pragma("unroll") for (int m = 0; m < 4; ++m) _Pragma("unroll") for (int n = 0; n < 2; ++n) _Pragma("unroll") for (int k = 0; k < 2; ++k) \
        acc[ai][bj][m][n] = __builtin_amdgcn_mfma_f32_16x16x32_bf16(Bt[n][k], At[m][k], acc[ai][bj][m][n], 0, 0, 0); __builtin_amdgcn_s_setprio(0); } while (0)
#define PG8_WAIT_V(n) asm volatile("s_waitcnt vmcnt(" #n ")" ::: "memory")
#define PG8_WAIT_L(n) asm volatile("s_waitcnt lgkmcnt(" #n ")" ::: "memory")
#define PG8_BAR __builtin_amdgcn_s_barrier()
#define PG8_SCHED __builtin_amdgcn_sched_barrier(0)
    Unit cur, nxt; int ui = 0;
    if (!S.next(0, cur)) return;
    f32x4 acc[2][2][4][2];
#pragma unroll
    for (int a = 0; a < 2; ++a)
#pragma unroll
        for (int b = 0; b < 2; ++b)
#pragma unroll
            for (int m = 0; m < 4; ++m)
#pragma unroll
                for (int n = 0; n < 2; ++n) acc[a][b][m][n] = (f32x4){0.f, 0.f, 0.f, 0.f};
    bf16x8 At[4][2], B0[2][2], B1[2][2];
    const char* cA = (const char*)g.A + (size_t)cur.pm * tstep; const char* cB = (const char*)g.Bt + (size_t)cur.pn * tstep;
    S.a_ready(cur);
    if constexpr (SP2) {
        PG8_STAGE(PG8_SB(0, 0), cB, voffB); PG8_STAGE(PG8_SB(0, 1), cB + hstep, voffB); PG8_STAGE(PG8_SA(0, 0), cA, voffA); PG8_STAGE(PG8_SA(0, 1), cA + hstep, voffA);
        if (wr == 1) PG8_BAR;
        PG8_WAIT_V(2); PG8_BAR;
        PG8_STAGE(PG8_SB(1, 0), cB + kstep, voffB); PG8_STAGE(PG8_SA(1, 0), cA + kstep, voffA); PG8_STAGE(PG8_SB(1, 1), cB + hstep + kstep, voffB);
        PG8_WAIT_V(6); PG8_BAR;
    } else {
        PG8_STAGE(PG8_SB(0, 0), cB, voffB); PG8_STAGE(PG8_SA(0, 0), cA, voffA); PG8_STAGE(PG8_SB(0, 1), cB + hstep, voffB); PG8_STAGE(PG8_SA(0, 1), cA + hstep, voffA);
        if (wr == 1) PG8_BAR;
        PG8_WAIT_V(4); PG8_BAR;
        PG8_STAGE(PG8_SB(1, 0), cB + kstep, voffB); PG8_STAGE(PG8_SA(1, 0), cA + kstep, voffA); PG8_STAGE(PG8_SB(1, 1), cB + hstep + kstep, voffB);
        PG8_WAIT_V(6); PG8_BAR;
    }
    for (;;) {
        const bool has_next = S.next(ui + 1, nxt);
        const char* nA = has_next ? (const char*)g.A + (size_t)nxt.pm * tstep : cA; const char* nB = has_next ? (const char*)g.Bt + (size_t)nxt.pn * tstep : cB;
        for (int t = 0; t < nt; t += 2) {
            const bool last = (t == nt - 2);
            const char* a1 = cA + (size_t)(t + 1) * kstep;
            const char* a2 = last ? nA : cA + (size_t)(t + 2) * kstep; const char* b2 = last ? nB : cB + (size_t)(t + 2) * kstep;
            const char* a3 = a2 + kstep; const char* b3 = b2 + kstep;
            if (last && has_next) S.a_ready(nxt);
            if constexpr (SP2) {
            PG8_LDB(B0, 0, 0); PG8_LDB(B1, 0, 1); PG8_SCHED; PG8_LDA(At, 0, 0); PG8_STAGE(PG8_SA(1, 1), a1 + hstep, voffA);
            PG8_WAIT_V(8); PG8_WAIT_L(0); PG8_BAR; PG8_MMA(0, 0, At, B0); PG8_MMA(0, 1, At, B1); PG8_BAR; PG8_SCHED;
            PG8_LDA(At, 0, 1); PG8_STAGE(PG8_SB(0, 0), b2, voffB); PG8_STAGE(PG8_SB(0, 1), b2 + hstep, voffB); PG8_STAGE(PG8_SA(0, 0), a2, voffA);
            PG8_WAIT_V(8); PG8_WAIT_L(0); PG8_BAR; PG8_MMA(1, 0, At, B0); PG8_MMA(1, 1, At, B1); PG8_BAR; PG8_SCHED;
            PG8_LDB(B0, 1, 0); PG8_LDB(B1, 1, 1); PG8_SCHED; PG8_LDA(At, 1, 0); PG8_STAGE(PG8_SA(0, 1), a2 + hstep, voffA);
            PG8_WAIT_V(8); PG8_WAIT_L(0); PG8_BAR; PG8_MMA(0, 0, At, B0); PG8_MMA(0, 1, At, B1); PG8_BAR; PG8_SCHED;
            PG8_LDA(At, 1, 1); PG8_STAGE(PG8_SB(1, 0), b3, voffB); PG8_STAGE(PG8_SB(1, 1), b3 + hstep, voffB); PG8_STAGE(PG8_SA(1, 0), a3, voffA);
            PG8_WAIT_V(8); PG8_WAIT_L(0); PG8_BAR; PG8_MMA(1, 0, At, B0); PG8_MMA(1, 1, At, B1); PG8_BAR; PG8_SCHED;
            } else {
            PG8_LDB(B0, 0, 0); PG8_SCHED; PG8_LDA(At, 0, 0); PG8_STAGE(PG8_SA(1, 1), a1 + hstep, voffA);
            PG8_WAIT_L(8); PG8_BAR; PG8_WAIT_L(0); PG8_MMA(0, 0, At, B0); PG8_BAR; PG8_SCHED;
            PG8_LDB(B1, 0, 1); PG8_STAGE(PG8_SB(0, 0), b2, voffB);
            PG8_BAR; PG8_WAIT_L(0); PG8_MMA(0, 1, At, B1); PG8_BAR;
            PG8_LDA(At, 0, 1); PG8_STAGE(PG8_SA(0, 0), a2, voffA);
            PG8_BAR; PG8_WAIT_L(0); PG8_MMA(1, 0, At, B0); PG8_BAR; PG8_SCHED;
            PG8_STAGE(PG8_SB(0, 1), b2 + hstep, voffB);
            PG8_WAIT_V(6); PG8_BAR; PG8_MMA(1, 1, At, B1); PG8_BAR;
            PG8_LDB(B0, 1, 0); PG8_SCHED; PG8_LDA(At, 1, 0); PG8_STAGE(PG8_SA(0, 1), a2 + hstep, voffA);
            PG8_WAIT_L(8); PG8_BAR; PG8_WAIT_L(0); PG8_MMA(0, 0, At, B0); PG8_BAR; PG8_SCHED;
            PG8_LDB(B1, 1, 1); PG8_STAGE(PG8_SB(1, 0), b3, voffB);
            PG8_BAR; PG8_WAIT_L(0); PG8_MMA(0, 1, At, B1); PG8_BAR;
            PG8_LDA(At, 1, 1); PG8_STAGE(PG8_SA(1, 0), a3, voffA);
            PG8_BAR; PG8_WAIT_L(0); PG8_MMA(1, 0, At, B0); PG8_BAR; PG8_SCHED;
            PG8_STAGE(PG8_SB(1, 1), b3 + hstep, voffB);
            PG8_WAIT_V(6); PG8_BAR; PG8_MMA(1, 1, At, B1); PG8_BAR;
            }
        }
        if constexpr (ALIGN_EPI) { if (wr == 0) PG8_BAR; }
        if constexpr (!Epi::AFTER_DRAIN) { E(acc, cur, wr, wc, fr, fq); S.done(cur); }
        if (!has_next) break;
#pragma unroll
        for (int a = 0; a < 2; ++a)
#pragma unroll
            for (int b = 0; b < 2; ++b)
#pragma unroll
                for (int m = 0; m < 4; ++m)
#pragma unroll
                    for (int n = 0; n < 2; ++n) acc[a][b][m][n] = (f32x4){0.f, 0.f, 0.f, 0.f};
        cur = nxt; cA = nA; cB = nB; ++ui;
        if constexpr (ALIGN_EPI) { if (wr == 1) PG8_BAR; }
    }
    PG8_WAIT_V(0);
    if constexpr (!ALIGN_EPI) { if (wr == 0) PG8_BAR; }
    PG8_BAR;
    if constexpr (Epi::AFTER_DRAIN) { E.fused(acc, cur, wr, wc, fr, fq, lds, wid, lane); S.done(cur); }
#undef PG8_SA
#undef PG8_SB
#undef PG8_STAGE
#undef PG8_LDA
#undef PG8_LDB
#undef PG8_MMA
#undef PG8_WAIT_V
#undef PG8_WAIT_L
#undef PG8_BAR
#undef PG8_SCHED
}
}
namespace att {
constexpr int D = 128, LDQ = 4096, LDK = 4096, LDO = 2048, LDG = 4096;
constexpr float THR = 8.f; constexpr bool WSKIP = false;
typedef unsigned u32x4_t __attribute__((ext_vector_type(4)));
typedef short bf16x8_t __attribute__((ext_vector_type(8)));
__device__ __forceinline__ bf16x8_t ka_frag(unsigned lo, unsigned up, int hi) {
    u32x4_t w;
    w.x = 0x3f803f80u; w.y = 0x3f80u | (((lo & 0xffffu) ^ 0x8000u) << 16); w.z = ((lo >> 16) ^ 0x8000u) | (((up & 0xffffu) ^ 0x8000u) << 16); w.w = 0u;
    if (hi) { w.x = 0u; w.y = 0u; w.z = 0u; }
    return __builtin_bit_cast(bf16x8_t, w);
}
__device__ __forceinline__ bf16x8_t qa_frag(unsigned lo, unsigned up, int hi) {
    u32x4_t w;
    w.x = lo; w.y = (up & 0xffffu) | 0x3f800000u; w.z = 0x3f803f80u; w.w = 0u;
    if (hi) { w.x = 0u; w.y = 0u; w.z = 0u; }
    return __builtin_bit_cast(bf16x8_t, w);
}
constexpr float SCALE = 0.08838834764831845f;
constexpr int NW = 8, QBLK = 32, KVBLK = 64, QB = NW * QBLK;
constexpr int SHM_V = KVBLK * D * 2, SHM_K = KVBLK * D * 2;
constexpr int ATT_LDS_BYTES = 2 * SHM_V + 2 * SHM_K + NW * 64 * 4;

using bf16 = __hip_bfloat16;
typedef short bf16x8 __attribute__((ext_vector_type(8)));
typedef short s16x4 __attribute__((ext_vector_type(4)));
typedef float f32x16 __attribute__((ext_vector_type(16)));
typedef float f32x4 __attribute__((ext_vector_type(4)));
typedef unsigned u32x4 __attribute__((ext_vector_type(4)));
template <class A, class Bt> struct same_t { static constexpr bool v = false; };
template <class A> struct same_t<A, A> { static constexpr bool v = true; };

#define KSWZ(row, colB) ((row) * 256 + ((colB) ^ (((row) & 7) << 4)))
#define SBAR() __builtin_amdgcn_sched_barrier(0)
__device__ __forceinline__ int v_st(int k, int c) { const int kk = (k & ~0xC) | ((k & 4) << 1) | ((k & 8) >> 1); return ((kk >> 3) * 4 + (c >> 5)) * 512 + ((kk & 7) * 32 + (c & 31)) * 2; }
__device__ __forceinline__ int v_rd_base(int lane) { return ((lane & 3) << 3) | (((lane >> 2) & 3) << 6) | (((lane >> 4) & 1) << 5) | (((lane >> 5) & 1) << 8); }
constexpr int v_rd_off(int d0, int ks, int half) { return d0 * 512 + ks * 4096 + half * 2048; }
__device__ __forceinline__ int crow(int r, int hi) { return (r & 3) + 8 * (r >> 2) + 4 * hi; }
__device__ __forceinline__ unsigned cvtpk(float lo, float hi) {
    unsigned r; asm volatile("v_cvt_pk_bf16_f32 %0, %1, %2" : "=v"(r) : "v"(lo), "v"(hi)); return r;
}
__device__ __forceinline__ bf16x8 pack8(f32x4 a, f32x4 b) {
    u32x4 w = {cvtpk(a[0], a[1]), cvtpk(a[2], a[3]), cvtpk(b[0], b[1]), cvtpk(b[2], b[3])};
    return *reinterpret_cast<bf16x8*>(&w);
}
template <class T> __device__ __forceinline__ bf16x8 load8(const T* p) {
    if constexpr (same_t<T, float>::v) { return pack8(*(const f32x4*)p, *(const f32x4*)(p + 4)); }
    else { return *reinterpret_cast<const bf16x8*>(p); }
}
__device__ __forceinline__ void mask_tile(f32x16& p0, f32x16& p1, int dq, unsigned W) {
    const float NEG = -__builtin_inff();
#pragma unroll
    for (int r = 0; r < 16; ++r) {
        const int c = (r & 3) + 8 * (r >> 2);
        if ((unsigned)(dq - c) >= W) p0[r] = NEG;
        if ((unsigned)(dq - c - 32) >= W) p1[r] = NEG;
    }
}
__device__ __forceinline__ void partialSM(f32x16& p0, f32x16& p1, float& m_reg, float& mn, float& alpha) {
    float pmax = p0[0]; for (int r = 1; r < 16; ++r) pmax = fmaxf(pmax, p0[r]); for (int r = 0; r < 16; ++r) pmax = fmaxf(pmax, p1[r]);
    { auto rr = __builtin_amdgcn_permlane32_swap(__float_as_uint(pmax), __float_as_uint(pmax), false, false);
      pmax = fmaxf(__uint_as_float(rr[0]), __uint_as_float(rr[1])); }
    constexpr float C2 = 1.4426950408889634f * SCALE;
    if (__builtin_expect(__all((pmax - m_reg) * SCALE <= THR), 1)) { mn = m_reg; alpha = 1.f; }
    else { mn = fmaxf(m_reg, pmax); alpha = __builtin_amdgcn_exp2f((m_reg - mn) * C2); m_reg = mn; }
    const float mnL = -mn * C2;
    for (int r = 0; r < 16; ++r) p0[r] = fmaf(p0[r], C2, mnL); for (int r = 0; r < 16; ++r) p1[r] = fmaf(p1[r], C2, mnL);
    for (int r = 0; r < 16; ++r) p0[r] = __builtin_amdgcn_exp2f(p0[r]);
}
__device__ __forceinline__ void finishSM(f32x16& p0, f32x16& p1, float alpha, float& l_reg, bf16x8& pa0, bf16x8& pa1, bf16x8& pa2, bf16x8& pa3) {
    for (int r = 0; r < 16; ++r) p1[r] = __builtin_amdgcn_exp2f(p1[r]);
    float ps = 0; for (int r = 0; r < 16; ++r) ps += p0[r]; for (int r = 0; r < 16; ++r) ps += p1[r];
    { auto rr = __builtin_amdgcn_permlane32_swap(__float_as_uint(ps), __float_as_uint(ps), false, false);
      ps = __uint_as_float(rr[0]) + __uint_as_float(rr[1]); }
    l_reg = l_reg * alpha + ps;
#define PK4(P, B_, OUT) do { unsigned a0 = cvtpk(P[B_+0], P[B_+1]), a1 = cvtpk(P[B_+2], P[B_+3]);                          \
        unsigned b0 = cvtpk(P[B_+4], P[B_+5]), b1 = cvtpk(P[B_+6], P[B_+7]);                                             \
        auto r0 = __builtin_amdgcn_permlane32_swap(a0, b0, false, false); auto r1 = __builtin_amdgcn_permlane32_swap(a1, b1, false, false); \
        u32x4 w = {r0[0], r1[0], r0[1], r1[1]}; OUT = *reinterpret_cast<bf16x8*>(&w); } while (0)
    PK4(p0, 0, pa0); PK4(p0, 8, pa1); PK4(p1, 0, pa2); PK4(p1, 8, pa3);
#undef PK4
}
template <int KB, bool SK>
__device__ __forceinline__ void qkt(f32x16& p0, f32x16& p1, const char* K_lds, int r32, int hi, const bf16x8* qr, bool act, unsigned long long qa, unsigned long long c) {
    if (SK && !act) { const float NEG = -__builtin_inff();
#pragma unroll
        for (int r = 0; r < 16; ++r) { p0[r] = NEG; p1[r] = NEG; } return; }
    p0 = f32x16{}; p1 = f32x16{};
    const char* kb[4];
#pragma unroll
    for (int dd = 0; dd < 4; ++dd) kb[dd] = K_lds + KB * SHM_K + KSWZ(r32, (dd * 16 + hi * 8) * 2);
#pragma unroll
    for (int d0 = 0; d0 < 8; ++d0) { const char* a = kb[d0 & 3] + (d0 >> 2) * 128;
        bf16x8 b0 = *reinterpret_cast<const bf16x8*>(a);
        bf16x8 b1 = *reinterpret_cast<const bf16x8*>(a + 32 * 256);
        p0 = __builtin_amdgcn_mfma_f32_32x32x16_bf16(b0, qr[d0], p0, 0, 0, 0);
        p1 = __builtin_amdgcn_mfma_f32_32x32x16_bf16(b1, qr[d0], p1, 0, 0, 0); }
    { unsigned ql = (unsigned)qa, qu = (unsigned)(qa >> 32); asm volatile("" : "+v"(ql), "+v"(qu));
      const bf16x8 qaf = qa_frag(ql, qu, hi);
      const unsigned cl = (unsigned)c, cu = (unsigned)(c >> 32);
      auto r0 = __builtin_amdgcn_permlane32_swap(cl, cl, false, false); auto r1 = __builtin_amdgcn_permlane32_swap(cu, cu, false, false);
      p0 = __builtin_amdgcn_mfma_f32_32x32x16_bf16(ka_frag(r0[0], r1[0], hi), qaf, p0, 0, 0, 0);
      p1 = __builtin_amdgcn_mfma_f32_32x32x16_bf16(ka_frag(r0[1], r1[1], hi), qaf, p1, 0, 0, 0); }
}
template <int VB, bool SK>
__device__ __forceinline__ void pv_tile(f32x16* o, int vb0, bf16x8 pa0, bf16x8 pa1, bf16x8 pa2, bf16x8 pa3, bool act) {
    if (SK && !act) return;
#define TRRD(dst, off) asm volatile("ds_read_b64_tr_b16 %0, %1 offset:%2" : "=&v"(dst) : "v"(vb0), "i"(off) : "memory")
#define PV_D0(d0) do { s16x4 l0, l1, l2, l3, h0, h1, h2, h3; constexpr int b_ = VB * SHM_V + v_rd_off(d0, 0, 0);     \
        TRRD(l0, b_); TRRD(h0, b_ + 2048); TRRD(l1, b_ + 4096); TRRD(h1, b_ + 6144); TRRD(l2, b_ + 8192); TRRD(h2, b_ + 10240); TRRD(l3, b_ + 12288); TRRD(h3, b_ + 14336); \
        asm volatile("s_waitcnt lgkmcnt(0)" ::: "memory"); SBAR();                 \
        o[d0] = __builtin_amdgcn_mfma_f32_32x32x16_bf16(pa0, (bf16x8){l0[0], l0[1], l0[2], l0[3], h0[0], h0[1], h0[2], h0[3]}, o[d0], 0, 0, 0);   \
        o[d0] = __builtin_amdgcn_mfma_f32_32x32x16_bf16(pa1, (bf16x8){l1[0], l1[1], l1[2], l1[3], h1[0], h1[1], h1[2], h1[3]}, o[d0], 0, 0, 0);   \
        o[d0] = __builtin_amdgcn_mfma_f32_32x32x16_bf16(pa2, (bf16x8){l2[0], l2[1], l2[2], l2[3], h2[0], h2[1], h2[2], h2[3]}, o[d0], 0, 0, 0);   \
        o[d0] = __builtin_amdgcn_mfma_f32_32x32x16_bf16(pa3, (bf16x8){l3[0], l3[1], l3[2], l3[3], h3[0], h3[1], h3[2], h3[3]}, o[d0], 0, 0, 0); } while (0)
    PV_D0(0); PV_D0(1); PV_D0(2); PV_D0(3);
#undef PV_D0
#undef TRRD
}

template <class TIn, class TOut> struct BlockRef { const TIn* Q; const TIn* K; const TIn* V; TOut* O; const unsigned short* G; const unsigned long long* CA; int P0; };
template <class TIn> struct Seam {
    bf16x8 qr[8];
    bf16x8 st_v0, st_v1, st_k0, st_k1; f32x4 sf0, sf1, sf2, sf3;
    unsigned long long ca, qa;
    f32x4 tq[16];
};
__device__ __forceinline__ int swa_jlo(int P0, int W) { const int lowk = P0 - W + 1; return lowk > 0 ? lowk / KVBLK : 0; }
#define ROW(p, k0, rr) ((p) + (size_t)((k0) + (rr)) * LDK + sc)
#define VMW() asm volatile("s_waitcnt vmcnt(0)" ::: "memory")
#define VMWN(n) asm volatile("s_waitcnt vmcnt(%0)" :: "i"(n) : "memory")
#define SLOAD_H(Kp, Vp, CAp, k0) do { S.st_v0 = load8<TIn>(ROW(Vp, k0, sr)); S.st_v1 = load8<TIn>(ROW(Vp, k0, 32 + sr));              \
                         S.st_k0 = load8<TIn>(ROW(Kp, k0, sr)); S.st_k1 = load8<TIn>(ROW(Kp, k0, 32 + sr)); S.ca = (CAp)[(k0) + lane]; } while (0)
#define SWRITE_HK(bf) do { *(bf16x8*)(K_lds + (bf) * SHM_K + kws) = S.st_k0; *(bf16x8*)(K_lds + (bf) * SHM_K + kws + 32 * 256) = S.st_k1; } while (0)
#define SWRITE_HV(bf) do { *(bf16x8*)(V_lds + (bf) * SHM_V + vst0) = S.st_v0; *(bf16x8*)(V_lds + (bf) * SHM_V + vst1) = S.st_v1; } while (0)
#define SWRITE_H(bf) do { SWRITE_HV(bf); SWRITE_HK(bf); } while (0)
#define SLOAD_F(p, k0) do { S.sf0 = *(const f32x4*)ROW(p, k0, sr); S.sf1 = *(const f32x4*)(ROW(p, k0, sr) + 4);                \
                            S.sf2 = *(const f32x4*)ROW(p, k0, 32 + sr); S.sf3 = *(const f32x4*)(ROW(p, k0, 32 + sr) + 4); } while (0)
#define SWRITE_KF(bf) do { *(bf16x8*)(K_lds + (bf) * SHM_K + kws) = pack8(S.sf0, S.sf1); *(bf16x8*)(K_lds + (bf) * SHM_K + kws + 32 * 256) = pack8(S.sf2, S.sf3); } while (0)
#define SWRITE_VF(bf) do { *(bf16x8*)(V_lds + (bf) * SHM_V + vst0) = pack8(S.sf0, S.sf1); *(bf16x8*)(V_lds + (bf) * SHM_V + vst1) = pack8(S.sf2, S.sf3); } while (0)
template <class TIn, class TOut>
__device__ __forceinline__ void causal_swa_prime(const BlockRef<TIn, TOut>& cur, int W, char* lds, Seam<TIn>& S) {
    constexpr bool F32 = same_t<TIn, float>::v;
    const int tid = opaque_tid(), wid = __builtin_amdgcn_readfirstlane(tid >> 6), lane = tid & 63, r32 = lane & 31, hi = lane >> 5;
    const int sr = tid >> 4, sc = (tid & 15) * 8, kws = KSWZ(sr, sc * 2); char* K_lds = lds + 2 * SHM_V;
    const int kb0 = swa_jlo(cur.P0, W) * KVBLK;
    for (int d0 = 0; d0 < 8; ++d0) S.qr[d0] = load8<TIn>(cur.Q + (size_t)(wid * QBLK + r32) * LDQ + d0 * 16 + hi * 8);
    S.qa = cur.CA[cur.P0 + wid * QBLK + r32];
    if constexpr (F32) { SLOAD_F((const float*)cur.K, kb0); VMW(); SWRITE_KF(0); SBAR(); SLOAD_F((const float*)cur.V, kb0); }
    else { SLOAD_H(cur.K, cur.V, cur.CA, kb0); VMW(); SWRITE_HK(0); }
    __syncthreads();
}
template <class TIn, class TOut>
__device__ __forceinline__ void causal_swa_block(const BlockRef<TIn, TOut>& cur, const BlockRef<TIn, TOut>& nxt, int skv, int W, char* lds, Seam<TIn>& S) {
    constexpr bool F32 = same_t<TIn, float>::v;
    const int tid = opaque_tid(), wid = __builtin_amdgcn_readfirstlane(tid >> 6), lane = tid & 63, r32 = lane & 31, hi = lane >> 5;
    const int j_lo = swa_jlo(cur.P0, W);
    int j_hi = (cur.P0 + QB - 1) / KVBLK + 1; if (j_hi > skv / KVBLK) j_hi = skv / KVBLK;
    const int NT = j_hi - j_lo;
    const int kbn = swa_jlo(nxt.P0, W) * KVBLK;
    const int qlo = cur.P0 + wid * QBLK, qm = qlo + r32 - 4 * hi;
    char* V_lds = lds; char* K_lds = lds + 2 * SHM_V;
    float* ws = (float*)(lds + 2 * SHM_V + 2 * SHM_K) + wid * 64; float* li_l = ws, * al_l = ws + 32;
    float m_reg = -1e30f, l_reg = 0; f32x16 o[4] = {};
    const int sr = tid >> 4, sc = (tid & 15) * 8, vst0 = v_st(sr, sc), vst1 = v_st(32 + sr, sc), kws = KSWZ(sr, sc * 2);
    const int vb0 = (int)(uintptr_t)V_lds + v_rd_base(lane);
    const TIn* Kh = cur.K; const TIn* Vh = cur.V; const unsigned long long* CAh = cur.CA;
#define RESC(a) do { if (__any((a) < 1.f)) { if (hi == 0) al_l[r32] = (a); asm volatile("s_waitcnt lgkmcnt(0)" ::: "memory");              \
                     for (int d_ = 0; d_ < 4; ++d_) for (int r = 0; r < 16; ++r) o[d_][r] *= al_l[crow(r, hi)]; } } while (0)
#define KBASE(t) ((j_lo + (t)) * KVBLK)
#define ACT(t) (KBASE(t) <= qlo + QBLK - 1 && KBASE(t) + KVBLK - 1 >= qlo - W + 1)
#define MASKT(P0_, P1_, t) do { const int kb_ = KBASE(t); if ((!SK || ACT(t)) && (kb_ + KVBLK - 1 > qlo || kb_ <= qlo + QBLK - 1 - W)) mask_tile(P0_, P1_, qm - kb_, (unsigned)W); } while (0)
    constexpr int NQL = F32 ? 16 : 8;
    constexpr bool SK = WSKIP && !F32;
#define SEAM_K0() do { VMWN(NQL); if constexpr (F32) { SWRITE_KF(0); SBAR(); SLOAD_F((const float*)nxt.V, kbn); } else { SWRITE_HK(0); } SBAR(); } while (0)
    f32x16 pA0, pA1, pB0, pB1; float mnA, mnB, alA, alB; bf16x8 pa0, pa1, pa2, pa3;
    if constexpr (F32) { VMW(); SWRITE_VF(0); SBAR(); } else { SWRITE_HV(0); SBAR(); }
    const unsigned long long qa_ = S.qa, hc = S.ca;
    if (NT > 1) { if constexpr (F32) SLOAD_F((const float*)Kh, KBASE(1)); else SLOAD_H(Kh, Vh, CAh, KBASE(1)); }
    SBAR(); qkt<0, SK>(pA0, pA1, K_lds, r32, hi, S.qr, ACT(0), qa_, hc);
    if constexpr (F32) { if (NT > 1) { VMW(); SWRITE_KF(1); SBAR(); SLOAD_F((const float*)Vh, KBASE(1)); } }
    MASKT(pA0, pA1, 0); partialSM(pA0, pA1, m_reg, mnA, alA);
    if (NT > 1) { VMW(); if constexpr (F32) { SWRITE_VF(1); SBAR(); if (NT > 2) SLOAD_F((const float*)Kh, KBASE(2)); } else SWRITE_H(1); }
    __syncthreads();
#define HALF_STEP(PX0, PX1, mnX, alX, PY0, PY1, alY, t, KB, VB, SB) do {                                                      \
        { const unsigned long long c_ = S.ca; SBAR(); qkt<KB, SK>(PX0, PX1, K_lds, r32, hi, S.qr, ACT(t), qa_, c_); }                                             \
        finishSM(PY0, PY1, alY, l_reg, pa0, pa1, pa2, pa3); SBAR();                                                           \
        if ((t) + 1 < NT) { if constexpr (F32) { VMW(); SWRITE_KF(SB); SBAR(); SLOAD_F((const float*)Vh, KBASE((t) + 1)); }  \
                            else { SLOAD_H(Kh, Vh, CAh, KBASE((t) + 1)); } SBAR(); }                                               \
        pv_tile<VB, SK>(o, vb0, pa0, pa1, pa2, pa3, ACT((t) - 1)); MASKT(PX0, PX1, (t)); partialSM(PX0, PX1, m_reg, mnX, alX);                                        \
        __syncthreads();                                                                                                      \
        if ((t) + 1 < NT) { VMW(); if constexpr (F32) { SWRITE_VF(SB); SBAR(); if ((t) + 2 < NT) SLOAD_F((const float*)Kh, KBASE((t) + 2)); } \
                            else { SWRITE_H(SB); } }                                                                          \
        RESC(alX); __syncthreads(); } while (0)
    for (int t = 1; t + 1 < NT; t += 2) {
        HALF_STEP(pB0, pB1, mnB, alB, pA0, pA1, alA, t, 1, 0, 0);
        HALF_STEP(pA0, pA1, mnA, alA, pB0, pB1, alB, t + 1, 0, 1, 1);
    }
    const bool even = (NT & 1) == 0;
    if (even) { const unsigned long long c_ = S.ca; SBAR(); qkt<1, SK>(pB0, pB1, K_lds, r32, hi, S.qr, ACT(NT - 1), qa_, c_); SBAR(); }
#define QROW(e) (nxt.Q + (size_t)(wid * QBLK + r32) * D + ((e) >> 1) * 16 + hi * 8 + ((e) & 1) * 4)
    if constexpr (F32) { SLOAD_F((const float*)nxt.K, kbn); SBAR();
#pragma unroll
        for (int e = 0; e < 8; ++e) S.tq[e] = *(const f32x4*)QROW(e); }
    else { SLOAD_H(nxt.K, nxt.V, nxt.CA, kbn); SBAR();
#pragma unroll
        for (int d0 = 0; d0 < 8; ++d0) S.qr[d0] = load8<TIn>(nxt.Q + (size_t)(wid * QBLK + r32) * LDQ + d0 * 16 + hi * 8);
        S.qa = nxt.CA[nxt.P0 + wid * QBLK + r32]; }
    SBAR();
    finishSM(pA0, pA1, alA, l_reg, pa0, pa1, pa2, pa3); SBAR();
    if constexpr (F32) {
#pragma unroll
        for (int e = 8; e < 16; ++e) S.tq[e] = *(const f32x4*)QROW(e); SBAR(); }
#undef QROW
    pv_tile<0, SK>(o, vb0, pa0, pa1, pa2, pa3, ACT(even ? NT - 2 : NT - 1));
    if (even) { MASKT(pB0, pB1, NT - 1); partialSM(pB0, pB1, m_reg, mnB, alB); __syncthreads(); RESC(alB);
        finishSM(pB0, pB1, alB, l_reg, pa0, pa1, pa2, pa3); SBAR(); pv_tile<1, SK>(o, vb0, pa0, pa1, pa2, pa3, ACT(NT - 1)); }
    SBAR(); SEAM_K0();
    if (hi == 0) li_l[r32] = l_reg; asm volatile("s_waitcnt lgkmcnt(0)" ::: "memory");
    float rli[16];
#pragma unroll
    for (int r = 0; r < 16; ++r) rli[r] = __builtin_amdgcn_rcpf(li_l[crow(r, hi)]);
    TOut* Ow = cur.O + (size_t)(wid * QBLK) * LDO; const unsigned short* Gw = cur.G + (size_t)(wid * QBLK) * LDG;
#pragma unroll
    for (int r = 0; r < 16; ++r) { const int orow = crow(r, hi);
#pragma unroll
        for (int d0 = 0; d0 < 4; ++d0) { const float v = o[d0][r] * rli[r];
            if constexpr (same_t<TOut, float>::v) { Ow[(size_t)orow * LDO + d0 * 32 + r32] = v; }
            else { const float vn = __shfl_xor(v, 1);
                   if ((r32 & 1) == 0) { const unsigned g2 = *(const unsigned*)(Gw + (size_t)orow * LDG + d0 * 32 + r32);
                       *(unsigned*)(Ow + (size_t)orow * LDO + d0 * 32 + r32) = cvtpk(v * __uint_as_float(g2 << 16), vn * __uint_as_float(g2 & 0xffff0000u)); } } } }
    if constexpr (F32) {
#pragma unroll
        for (int d0 = 0; d0 < 8; ++d0) S.qr[d0] = pack8(S.tq[2 * d0], S.tq[2 * d0 + 1]); }
    __syncthreads();
#undef RESC
#undef KBASE
#undef ACT
#undef MASKT
#undef SEAM_K0
#undef HALF_STEP
}
#undef ROW
#undef VMW
#undef VMWN
#undef SLOAD_H
#undef SWRITE_HK
#undef SWRITE_HV
#undef SWRITE_H
#undef SLOAD_F
#undef SWRITE_KF
#undef SWRITE_VF

__host__ __device__ inline int swa_nx(int nqb, int nramp) { return (nramp + 1) / 2 + (nqb - nramp); }
struct SwaItem { int bh, qb0, qb1; };
__device__ __forceinline__ SwaItem swa_decode(int L, int nqb, int nx) {
    SwaItem it; const int xcd = L & 7, k = L >> 3, gi = k / nx, r = k - gi * nx;
    it.bh = gi * 8 + xcd; const int x = r;
    it.qb0 = x; it.qb1 = nqb - 1 - x;
    return it;
}
struct AttnT { const bf16* Q; const bf16* K; const bf16* V; bf16* O; const unsigned short* G; const unsigned long long* CA; };
__device__ __forceinline__ BlockRef<bf16, bf16> swa_ref(const SwaItem& it, int pass, const AttnT& T, int seq, int nh) {
    const int qb = pass ? it.qb1 : it.qb0, b = it.bh / nh, h = it.bh % nh; const size_t tok0 = (size_t)b * seq;
    BlockRef<bf16, bf16> r;
    r.Q = T.Q + (tok0 + (size_t)qb * QB) * LDQ + h * D; r.O = T.O + (tok0 + (size_t)qb * QB) * LDO + h * D; r.G = T.G + (tok0 + (size_t)qb * QB) * LDG + h * D;
    r.K = T.K + tok0 * LDK + h * D; r.V = T.V + tok0 * LDK + h * D; r.CA = T.CA + (size_t)it.bh * seq; r.P0 = qb * QB;
    return r;
}
__device__ __forceinline__ void attn_phase(char* lds, const AttnT& T, int nb, int nh, int seq) {
    const int W = 1 << 30, nqb = seq / QB, nx = nqb / 2, total = nx * nb * nh, stride = gridDim.x;
    int L = blockIdx.x; if (L >= total) return;
    SwaItem it = swa_decode(L, nqb, nx); int pass = 0;
    BlockRef<bf16, bf16> cur = swa_ref(it, 0, T, seq, nh);
    Seam<bf16> S;
    causal_swa_prime<bf16, bf16>(cur, W, lds, S);
    for (;;) {
        const bool more_pass = pass == 0 && it.qb1 != it.qb0, more_item = L + stride < total, last = !more_pass && !more_item;
        SwaItem itn = it; int passn = pass + 1, Ln = L;
        if (!more_pass) { passn = 0; Ln = more_item ? L + stride : L; itn = swa_decode(Ln, nqb, nx); }
        const BlockRef<bf16, bf16> nxt = last ? cur : swa_ref(itn, passn, T, seq, nh);
        causal_swa_block<bf16, bf16>(cur, nxt, seq, W, lds, S);
        if (last) break;
        cur = nxt; it = itn; pass = passn; L = Ln;
    }
}
#undef KSWZ
#undef SBAR
}
constexpr int DM = 2048, NB = 4, SEQ = 4096, MT = NB * SEQ, FF = 5632, FF2 = 2 * FF, NH = 16, HD = 128, CH = 128, NG = 16;
constexpr float EPS = 1e-6f;
constexpr int NWAVES = 8, NTHREADS = NWAVES * 64;
constexpr size_t MiB = 1u << 20;
constexpr size_t WS_BAR = 0, BAR_ZERO_BYTES = 16384;
constexpr size_t WS_LOGF = 1 * MiB;
constexpr size_t WS_CA = 2 * MiB;
constexpr size_t WS_WSB = 4 * MiB;
constexpr size_t WS_WF = 5 * MiB;
constexpr size_t WS_W_AIN = 6 * MiB;
constexpr size_t WS_W_AOUT = WS_W_AIN + 32 * MiB;
constexpr size_t WS_W_KV = WS_W_AOUT + 16 * MiB;
constexpr size_t WS_W_QG = WS_W_KV + 16 * MiB;
constexpr size_t WS_W_BOUT = WS_W_QG + 32 * MiB;
constexpr size_t WS_W_UP = WS_W_BOUT + 16 * MiB;
constexpr size_t WS_W_DN = WS_W_UP + 176 * MiB;
constexpr size_t WS_XN = WS_W_DN + 88 * MiB;
constexpr size_t WS_XN2 = WS_XN + 64 * MiB;
constexpr size_t WS_KV = WS_XN2 + 64 * MiB;
constexpr size_t WS_BIG = WS_KV + 128 * MiB;
constexpr size_t WS_ACT = WS_BIG + 352 * MiB;
constexpr size_t WS_SSP = WS_ACT + 176 * MiB;
constexpr size_t WS_END = WS_SSP + 2 * MiB;
constexpr int LDS_BYTES = 147456, MISC_OFF = LDS_BYTES - 64;

typedef unsigned short bf16_t;
typedef float f32x4 __attribute__((ext_vector_type(4)));
typedef unsigned u32x4 __attribute__((ext_vector_type(4)));
typedef unsigned u32x2 __attribute__((ext_vector_type(2)));
typedef short bf16x8 __attribute__((ext_vector_type(8)));
#define LAS __attribute__((address_space(3)))
__device__ __forceinline__ unsigned pk2(float lo, float hi) { return pg8::cvt_pk_bf16(lo, hi); }
__device__ __forceinline__ float bf_lo(unsigned w) { return __uint_as_float(w << 16); }
__device__ __forceinline__ float bf_hi(unsigned w) { return __uint_as_float(w & 0xffff0000u); }
__device__ __forceinline__ float wave_sum(float v) {
#pragma unroll
    for (int o = 1; o < 64; o <<= 1) v += __shfl_xor(v, o);
    return v;
}
struct Args { const float* in[21]; float* out; unsigned char* ws; };
#define XB_TMO      128
#define XB_XCNT(j)  (256  + 64 * (j))
#define XB_XSUB(j)  (1280 + 64 * (j))
#define XB_XGEN(j)  (2304 + 64 * (j))
#define XB_TOP      3328
#define XB_TOPGEN   3392
#define XCD_BAR_WORDS 3456
#define XB_SPIN_CAP (1u << 18)

__device__ __forceinline__ unsigned xb_ld(unsigned* p)              { return __hip_atomic_load(p, __ATOMIC_RELAXED, __HIP_MEMORY_SCOPE_AGENT); }
__device__ __forceinline__ unsigned xb_add(unsigned* p, unsigned v) { return __hip_atomic_fetch_add(p, v, __ATOMIC_RELAXED, __HIP_MEMORY_SCOPE_AGENT); }
__device__ __forceinline__ unsigned xb_xcc_id() { return (unsigned)__builtin_amdgcn_s_getreg((3 << 11) | 20) & 0xFu; }
#define XB_SPIN(cond, bar) do { unsigned _sp = 0; while (cond) { __builtin_amdgcn_s_sleep(1); \
    if ((++_sp & 255u) == 0u) { if (xb_ld(&(bar)[XB_TMO])) break; if (_sp > XB_SPIN_CAP) { atomicAdd(&(bar)[XB_TMO], 1u); break; } } } } while (0)

struct XcdBarrier {
    unsigned* bar; unsigned x;
    volatile LAS unsigned* st;
};

__device__ __forceinline__ XcdBarrier xcd_barrier_post(unsigned* bar, volatile LAS unsigned* st) {
    XcdBarrier b; b.bar = bar; b.x = xb_xcc_id(); b.st = st;
    if (threadIdx.x == 0) (void)xb_add(&bar[XB_XCNT(b.x)], 1u);
    return b;
}
__device__ __forceinline__ void xcd_barrier_complete(unsigned* bar, unsigned x, unsigned& nloc, unsigned& nx) {
    const unsigned G = gridDim.x * gridDim.y * gridDim.z;
    unsigned sum, cnt, mine, sp = 0u;
    for (;;) {
        sum = 0u; cnt = 0u; mine = 0u;
#pragma unroll
        for (unsigned j = 0; j < 16; ++j) { const unsigned c = xb_ld(&bar[XB_XCNT(j)]); sum += c; cnt += (c > 0u) ? 1u : 0u; mine = (j == x) ? c : mine; }
        if (sum == G) break;
        __builtin_amdgcn_s_sleep(1);
        if ((++sp & 255u) == 0u) { if (xb_ld(&bar[XB_TMO])) break; if (sp > XB_SPIN_CAP) { atomicAdd(&bar[XB_TMO], 1u); break; } }
    }
    nloc = mine > 0u ? mine : 1u; nx = cnt > 0u ? cnt : 1u;
}

__device__ __forceinline__ void xcd_barrier(const XcdBarrier& b) {
    asm volatile("s_waitcnt vmcnt(0)" ::: "memory");
    __syncthreads();
    if (threadIdx.x == 0) {
        unsigned* bar = b.bar;
        __builtin_amdgcn_s_waitcnt(0);
        unsigned nloc = b.st[0], nx = b.st[1];
        if (nloc == 0u) { xcd_barrier_complete(bar, b.x, nloc, nx); b.st[0] = nloc; b.st[1] = nx; }
        const unsigned old = xb_add(&bar[XB_XSUB(b.x)], 1u);
        const unsigned gen = old / nloc;
        if (old + 1u == (gen + 1u) * nloc) {
            __builtin_amdgcn_fence(__ATOMIC_RELEASE, "agent");
            asm volatile("s_waitcnt vmcnt(0)" ::: "memory");
            const unsigned og = xb_add(&bar[XB_TOP], 1u);
            const unsigned tg = og / nx;
            if (og + 1u == (tg + 1u) * nx) xb_add(&bar[XB_TOPGEN], 1u);
            else XB_SPIN(xb_ld(&bar[XB_TOPGEN]) == tg, bar);
            __builtin_amdgcn_fence(__ATOMIC_ACQUIRE, "agent");
            xb_add(&bar[XB_XGEN(b.x)], 1u);
            asm volatile("s_waitcnt vmcnt(0)" ::: "memory");
        } else {
            XB_SPIN(xb_ld(&bar[XB_XGEN(b.x)]) == gen, bar);
            __builtin_amdgcn_fence(__ATOMIC_ACQUIRE, "agent");
            asm volatile("s_waitcnt vmcnt(0)" ::: "memory");
        }
    }
    __syncthreads();
}


__device__ __forceinline__ int up_row(int n) { return n < FF ? (n >> 7) * 256 + (n & 127) : ((n - FF) >> 7) * 256 + 128 + ((n - FF) & 127); }
constexpr int TR_LDS_PER_WAVE = 64 * 65 * 4;
__device__ __forceinline__ void transpose_item(const float* W, int K, int ld, int ncols, const float* gk, bf16_t* WT, int mode, LAS float* scr, int item, int lane) {
    const int nblk = ncols / 64, kb = item / nblk, nb = item % nblk, k0 = 64 * kb, n0 = 64 * nb, kr = lane >> 4, n4 = (lane & 15) * 4;
    f32x4 v[16];
#pragma unroll
    for (int i = 0; i < 16; ++i) v[i] = *(const f32x4*)(W + (size_t)(k0 + 4 * i + kr) * ld + n0 + n4);
#pragma unroll
    for (int i = 0; i < 16; ++i) { const int kk = 4 * i + kr; const float g = gk ? gk[k0 + kk] : 1.f; LAS float* d = scr + kk * 65 + n4; d[0] = v[i].x * g; d[1] = v[i].y * g; d[2] = v[i].z * g; d[3] = v[i].w * g; }
    asm volatile("s_waitcnt lgkmcnt(0)" ::: "memory");
    const int c = lane & 7; const int r0 = mode ? up_row(n0) : n0;
#pragma unroll
    for (int j = 0; j < 8; ++j) { const int n = (lane >> 3) + 8 * j; const LAS float* p = scr + (8 * c) * 65 + n;
        u32x4 o; o.x = pk2(p[0 * 65], p[1 * 65]); o.y = pk2(p[2 * 65], p[3 * 65]); o.z = pk2(p[4 * 65], p[5 * 65]); o.w = pk2(p[6 * 65], p[7 * 65]);
        *(u32x4*)(WT + (size_t)(r0 + n) * K + k0 + 8 * c) = o; }
    asm volatile("s_waitcnt lgkmcnt(0)" ::: "memory");
}
template <bool F32OUT>
__device__ __forceinline__ void norm_rows(const float* src, const float* g, void* dst, int gw, int NGW, int lane) {
    for (int m = gw; m < MT; m += NGW) {
        const f32x4* xr = (const f32x4*)(src + (size_t)m * DM) + lane; f32x4 v[8]; float s = 0.f;
#pragma unroll
        for (int j = 0; j < 8; ++j) { v[j] = xr[64 * j]; s += (v[j].x * v[j].x + v[j].y * v[j].y) + (v[j].z * v[j].z + v[j].w * v[j].w); }
        const float r = 1.0f / sqrtf(wave_sum(s) * (1.0f / DM) + EPS);
        const f32x4* gr = (const f32x4*)g + lane;
        if constexpr (F32OUT) { f32x4* o = (f32x4*)((float*)dst + (size_t)m * DM) + lane;
#pragma unroll
            for (int j = 0; j < 8; ++j) o[64 * j] = (v[j] * r) * gr[64 * j]; }
        else { u32x2* o = (u32x2*)((bf16_t*)dst + (size_t)m * DM) + lane;
#pragma unroll
            for (int j = 0; j < 8; ++j) { const f32x4 y = (v[j] * r) * gr[64 * j]; u32x2 w; w.x = pk2(y.x, y.y); w.y = pk2(y.z, y.w); o[64 * j] = w; } }
    }
}
__device__ __forceinline__ void headnorm_rows(bf16_t* buf, int ld, const float* gain, int gw, int NGW, int lane) {
    const f32x4 g0 = *(const f32x4*)(gain + (lane & 15) * 8), g1 = *(const f32x4*)(gain + (lane & 15) * 8 + 4);
    for (int m = gw; m < MT; m += NGW) {
        u32x4* p = (u32x4*)(buf + (size_t)m * ld) + lane; u32x4 w[4];
#pragma unroll
        for (int j = 0; j < 4; ++j) w[j] = p[64 * j];
#pragma unroll
        for (int j = 0; j < 4; ++j) {
            float x[8] = {bf_lo(w[j].x), bf_hi(w[j].x), bf_lo(w[j].y), bf_hi(w[j].y), bf_lo(w[j].z), bf_hi(w[j].z), bf_lo(w[j].w), bf_hi(w[j].w)};
            float s = 0.f;
#pragma unroll
            for (int e = 0; e < 8; ++e) s += x[e] * x[e];
            s += __shfl_xor(s, 1); s += __shfl_xor(s, 2); s += __shfl_xor(s, 4); s += __shfl_xor(s, 8);
            const float r = 1.0f / sqrtf(s * (1.0f / HD) + EPS);
            u32x4 o; o.x = pk2(x[0] * r * g0.x, x[1] * r * g0.y); o.y = pk2(x[2] * r * g0.z, x[3] * r * g0.w); o.z = pk2(x[4] * r * g1.x, x[5] * r * g1.y); o.w = pk2(x[6] * r * g1.z, x[7] * r * g1.w);
            p[64 * j] = o; }
    }
}
__device__ __forceinline__ void fgate_rows(const float* h, const bf16_t* wfh, const bf16_t* wfl, const float* bf, float* logf, int gw, int NGW, int lane) {
    const int fr = lane & 15, fq = lane >> 4;
    for (int rg = gw; rg < MT / 16; rg += NGW) {
        const float* hrow = h + (size_t)(rg * 16 + fr) * DM + 8 * fq; const bf16_t* wh = wfh + fr * DM + 8 * fq; const bf16_t* wl = wfl + fr * DM + 8 * fq;
        f32x4 acc = {0.f, 0.f, 0.f, 0.f}; float ssq = 0.f;
#pragma unroll 4
        for (int ks = 0; ks < DM / 32; ++ks) {
            const f32x4 a0 = *(const f32x4*)(hrow + 32 * ks), a1 = *(const f32x4*)(hrow + 32 * ks + 4);
            ssq += (a0.x * a0.x + a0.y * a0.y) + (a0.z * a0.z + a0.w * a0.w) + (a1.x * a1.x + a1.y * a1.y) + (a1.z * a1.z + a1.w * a1.w);
            u32x4 hi; hi.x = pk2(a0.x, a0.y); hi.y = pk2(a0.z, a0.w); hi.z = pk2(a1.x, a1.y); hi.w = pk2(a1.z, a1.w);
            u32x4 lo; lo.x = pk2(a0.x - bf_lo(hi.x), a0.y - bf_hi(hi.x)); lo.y = pk2(a0.z - bf_lo(hi.y), a0.w - bf_hi(hi.y)); lo.z = pk2(a1.x - bf_lo(hi.z), a1.y - bf_hi(hi.z)); lo.w = pk2(a1.z - bf_lo(hi.w), a1.w - bf_hi(hi.w));
            const bf16x8 whv = *(const bf16x8*)(wh + 32 * ks), wlv = *(const bf16x8*)(wl + 32 * ks);
            const bf16x8 hv = __builtin_bit_cast(bf16x8, hi), lv = __builtin_bit_cast(bf16x8, lo);
            acc = __builtin_amdgcn_mfma_f32_16x16x32_bf16(whv, hv, acc, 0, 0, 0);
            acc = __builtin_amdgcn_mfma_f32_16x16x32_bf16(wlv, hv, acc, 0, 0, 0);
            acc = __builtin_amdgcn_mfma_f32_16x16x32_bf16(whv, lv, acc, 0, 0, 0);
        }
        ssq += __shfl_xor(ssq, 16); ssq += __shfl_xor(ssq, 32);
        const float r = 1.0f / sqrtf(ssq * (1.0f / DM) + EPS);
        const f32x4 b = *(const f32x4*)(bf + 4 * fq); f32x4 o;
#pragma unroll
        for (int e = 0; e < 4; ++e) { const float f = acc[e] * r + b[e]; o[e] = fminf(f, 0.f) - log1pf(expf(-fabsf(f))); }
        *(f32x4*)(logf + (size_t)(rg * 16 + fr) * 16 + 4 * fq) = o;
    }
}
__device__ __forceinline__ void scan_seq(const float* logf, unsigned long long* CA, int seq, int lane) {
    const int b = seq >> 4, hh = seq & 15;
    const float* lf = logf + ((size_t)b * SEQ + (size_t)lane * 64) * 16 + hh;
    float v[64];
#pragma unroll
    for (int i = 0; i < 64; ++i) v[i] = lf[i * 16];
#pragma unroll
    for (int i = 1; i < 64; ++i) v[i] += v[i - 1];
    const float tot = v[63]; float t = tot;
#pragma unroll
    for (int o = 1; o < 64; o <<= 1) { const float y = __shfl_up(t, o); if (lane >= o) t += y; }
    const float excl = t - tot;
    unsigned long long* out = CA + (size_t)seq * SEQ + lane * 64;
#pragma unroll
    for (int i = 0; i < 64; ++i) { const float c = (excl + v[i]) * 11.313708498984761f;
        const unsigned h1 = pk2(c, 0.f) & 0xffffu; const float r1 = c - bf_lo(h1);
        const unsigned h2 = pk2(r1, 0.f) & 0xffffu; const float r2 = r1 - bf_lo(h2);
        const unsigned h3 = pk2(r2, 0.f) & 0xffffu;
        out[i] = (unsigned long long)(h1 | (h2 << 16)) | ((unsigned long long)h3 << 32); }
}
__device__ __forceinline__ void spatial_phase(LAS unsigned char* ldsp, const bf16_t* Z, const float* ssp, const bf16_t* wsb, const float* vnorm, const float* bs, bf16_t* GATED, int wave, int lane) {
    const int fr = lane & 15, fq = lane >> 4;
    for (int item = blockIdx.x; item < (MT / CH) * NG; item += gridDim.x) {
        const int ch = item >> 4, g = item & 15, row0 = ch * CH, cw = g * 128 + wave * 16;
        LAS float* rvs = (LAS float*)ldsp;
        __syncthreads();
        { const int t_ = wave * 64 + lane; if (t_ < CH) { const f32x4* p = (const f32x4*)(ssp + (size_t)(row0 + t_) * 32); float sq = 0.f;
#pragma unroll
            for (int q = 0; q < 8; ++q) { const f32x4 v = p[q]; sq += (v.x + v.y) + (v.z + v.w); }
            rvs[t_] = 1.0f / sqrtf(sq * (1.0f / DM) + EPS); } }
        __syncthreads();
        bf16x8 vf[4];
#pragma unroll
        for (int ks = 0; ks < 4; ++ks) {
            const bf16_t* vp = Z + (size_t)(row0 + 32 * ks + 8 * fq) * 4096 + 2048 + cw + fr; float x[8];
#pragma unroll
            for (int i = 0; i < 8; ++i) x[i] = __uint_as_float((unsigned)vp[(size_t)i * 4096] << 16) * rvs[32 * ks + 8 * fq + i];
            u32x4 w; w.x = pk2(x[0], x[1]); w.y = pk2(x[2], x[3]); w.z = pk2(x[4], x[5]); w.w = pk2(x[6], x[7]); vf[ks] = __builtin_bit_cast(bf16x8, w);
        }
        f32x4 acc[8];
#pragma unroll
        for (int m = 0; m < 8; ++m) { acc[m] = (f32x4){0.f, 0.f, 0.f, 0.f};
#pragma unroll
            for (int ks = 0; ks < 4; ++ks) if (32 * ks <= 16 * m + 15) {
                const bf16x8 wf = *(const bf16x8*)(wsb + ((size_t)(g * 128 + 16 * m + fr) * 128 + 32 * ks + 8 * fq));
                acc[m] = __builtin_amdgcn_mfma_f32_16x16x32_bf16(vf[ks], wf, acc[m], 0, 0, 0); } }
        const f32x4 vn = *(const f32x4*)(vnorm + cw + 4 * fq);
#pragma unroll
        for (int m = 0; m < 8; ++m) { const int t = 16 * m + fr; const size_t row = (size_t)(row0 + t); const float bias = bs[g * 128 + t];
            const u32x2 uu = *(const u32x2*)(Z + row * 4096 + cw + 4 * fq);
            const float o0 = bf_lo(uu.x) * (acc[m][0] * vn[0] + bias), o1 = bf_hi(uu.x) * (acc[m][1] * vn[1] + bias), o2 = bf_lo(uu.y) * (acc[m][2] * vn[2] + bias), o3 = bf_hi(uu.y) * (acc[m][3] * vn[3] + bias);
            u32x2 w; w.x = pk2(o0, o1); w.y = pk2(o2, o3); *(u32x2*)(GATED + row * DM + cw + 4 * fq) = w; }
    }
}
__device__ __forceinline__ void conv_phase(const bf16_t* BIG, const float* cw, const float* cb, bf16_t* ACT) {
    constexpr int NQ = FF / 8, RS = 32, NTASK = NQ * (MT / RS);
    const int tid_ = opaque_tid();
    for (int T = blockIdx.x * NTHREADS + tid_; T < NTASK; T += gridDim.x * NTHREADS) {
        const int q = T % NQ, strip = T / NQ, j0 = 8 * q, pg = (q >> 4) * 256 + (q & 15) * 8, row0 = strip * RS;
        float wg[3][8], wv[3][8], bg[8], bv[8];
#pragma unroll
        for (int k = 0; k < 3; ++k)
#pragma unroll
            for (int e = 0; e < 8; ++e) { wg[k][e] = cw[(size_t)k * FF2 + j0 + e]; wv[k][e] = cw[(size_t)k * FF2 + FF + j0 + e]; }
#pragma unroll
        for (int e = 0; e < 8; ++e) { bg[e] = cb[j0 + e]; bv[e] = cb[FF + j0 + e]; }
        const bf16_t* src = BIG + (size_t)row0 * FF2 + pg; bf16_t* dst = ACT + (size_t)row0 * FF + j0;
        u32x4 g2 = {0u, 0u, 0u, 0u}, g1 = g2, v2 = g2, v1 = g2;
        if ((row0 & (SEQ - 1)) != 0) { g2 = *(const u32x4*)(src - 2 * (size_t)FF2); v2 = *(const u32x4*)(src - 2 * (size_t)FF2 + 128); g1 = *(const u32x4*)(src - (size_t)FF2); v1 = *(const u32x4*)(src - (size_t)FF2 + 128); }
        for (int i0 = 0; i0 < RS; i0 += 8) {
            u32x4 gc[8], vc[8];
#pragma unroll
            for (int i = 0; i < 8; ++i) { gc[i] = *(const u32x4*)(src + (size_t)(i0 + i) * FF2); vc[i] = *(const u32x4*)(src + (size_t)(i0 + i) * FF2 + 128); }
#pragma unroll
            for (int i = 0; i < 8; ++i) { u32x4 o;
#pragma unroll
                for (int p = 0; p < 4; ++p) {
                    const float ga = wg[0][2 * p] * bf_lo(g2[p]) + wg[1][2 * p] * bf_lo(g1[p]) + wg[2][2 * p] * bf_lo(gc[i][p]) + bg[2 * p];
                    const float gb = wg[0][2 * p + 1] * bf_hi(g2[p]) + wg[1][2 * p + 1] * bf_hi(g1[p]) + wg[2][2 * p + 1] * bf_hi(gc[i][p]) + bg[2 * p + 1];
                    const float va = wv[0][2 * p] * bf_lo(v2[p]) + wv[1][2 * p] * bf_lo(v1[p]) + wv[2][2 * p] * bf_lo(vc[i][p]) + bv[2 * p];
                    const float vb = wv[0][2 * p + 1] * bf_hi(v2[p]) + wv[1][2 * p + 1] * bf_hi(v1[p]) + wv[2][2 * p + 1] * bf_hi(vc[i][p]) + bv[2 * p + 1];
                    const float sa = ga * __builtin_amdgcn_rcpf(1.0f + __builtin_amdgcn_exp2f(-1.4426950408889634f * ga)), sb = gb * __builtin_amdgcn_rcpf(1.0f + __builtin_amdgcn_exp2f(-1.4426950408889634f * gb));
                    o[p] = pk2(sa * va, sb * vb); }
                *(u32x4*)(dst + (size_t)(i0 + i) * FF) = o; g2 = g1; g1 = gc[i]; v2 = v1; v1 = vc[i]; }
        }
    }
}

typedef const Args __attribute__((address_space(4))) CArgs;
__device__ __forceinline__ CArgs* kargs() { CArgs* p = (CArgs*)__builtin_amdgcn_kernarg_segment_ptr(); asm volatile("" : "+s"(p)); return p; }
#define PTRS \
    CArgs* ap_ = kargs(); unsigned char* ws = ap_->ws; float* h = ap_->out; (void)ws; (void)h; \
    const float* x = ap_->in[0]; const float* a_norm = ap_->in[1]; const float* a_w_in = ap_->in[2]; const float* a_v_norm = ap_->in[3]; const float* a_w_s = ap_->in[4]; const float* a_b_s = ap_->in[5]; \
    const float* a_w_out = ap_->in[6]; const float* kv_norm = ap_->in[7]; const float* w_kvf = ap_->in[8]; const float* b_f = ap_->in[9]; const float* k_norm = ap_->in[10]; const float* b_norm = ap_->in[11]; \
    const float* b_w_qg = ap_->in[12]; const float* q_norm = ap_->in[13]; const float* b_w_out = ap_->in[14]; const float* f_norm = ap_->in[15]; const float* f_w_up = ap_->in[16]; const float* f_conv_w = ap_->in[17]; \
    const float* f_conv_b = ap_->in[18]; const float* f_w_down = ap_->in[19]; const float* final_norm = ap_->in[20]; \
    (void)x; (void)a_norm; (void)a_w_in; (void)a_v_norm; (void)a_w_s; (void)a_b_s; (void)a_w_out; (void)kv_norm; (void)w_kvf; (void)b_f; (void)k_norm; (void)b_norm; (void)b_w_qg; (void)q_norm; (void)b_w_out; \
    (void)f_norm; (void)f_w_up; (void)f_conv_w; (void)f_conv_b; (void)f_w_down; (void)final_norm; \
    float* VSS = (float*)(ws + WS_SSP); float* LOGF = (float*)(ws + WS_LOGF); unsigned long long* CA = (unsigned long long*)(ws + WS_CA); \
    bf16_t* WSB = (bf16_t*)(ws + WS_WSB); bf16_t* WFH = (bf16_t*)(ws + WS_WF); bf16_t* WFL = WFH + 16 * DM; \
    bf16_t* W_AIN = (bf16_t*)(ws + WS_W_AIN); bf16_t* W_AOUT = (bf16_t*)(ws + WS_W_AOUT); bf16_t* W_KV = (bf16_t*)(ws + WS_W_KV); bf16_t* W_QG = (bf16_t*)(ws + WS_W_QG); \
    bf16_t* W_BOUT = (bf16_t*)(ws + WS_W_BOUT); bf16_t* W_UP = (bf16_t*)(ws + WS_W_UP); bf16_t* W_DN = (bf16_t*)(ws + WS_W_DN); \
    bf16_t* HB = (bf16_t*)(ws + WS_XN); float* RSS = (float*)(ws + WS_XN2); bf16_t* KVB = (bf16_t*)(ws + WS_KV); bf16_t* BIG = (bf16_t*)(ws + WS_BIG); bf16_t* ACT = (bf16_t*)(ws + WS_ACT); \
    (void)VSS; (void)LOGF; (void)CA; (void)WSB; (void)WFH; (void)WFL; (void)W_AIN; (void)W_AOUT; (void)W_KV; (void)W_QG; (void)W_BOUT; (void)W_UP; (void)W_DN; (void)HB; (void)RSS; (void)KVB; (void)BIG; (void)ACT;
typedef pg8::EpiBf<1, true> EPI_A1; typedef pg8::EpiBf<0, true> EPI_KV; typedef pg8::EpiBf<2, true> EPI_QG; typedef pg8::EpiBf<0, true> EPI_UP;
#define GEMM_PHASE(EPI, Aptr, Bptr, NN, KK, ...) do { pg8::Gemm g_{Aptr, Bptr, MT, NN, KK}; pg8::StaticOrder S_; S_.init(MT, NN, G, (int)blockIdx.x); EPI E_{__VA_ARGS__}; \
    pg8::gemm_phase<EPI, pg8::StaticOrder, true, true>(ldsp, g_, S_, E_); } while (0)

__global__ void __launch_bounds__(NTHREADS, 2) fwd_megakernel(Args a) {
    extern __shared__ __attribute__((aligned(16))) unsigned char lds[];
    cg::grid_group grid = cg::this_grid();
#define GSYNC_CG() do { asm volatile("s_waitcnt vmcnt(0)" ::: "memory"); grid.sync(); } while (0)
#define GSYNC() xcd_barrier(xbar)
    const int wave = __builtin_amdgcn_readfirstlane(threadIdx.x >> 6);
    const int G = gridDim.x, gw = blockIdx.x * NWAVES + wave, NGW = G * NWAVES;
    LAS unsigned char* ldsp = (LAS unsigned char*)lds;
    if (threadIdx.x < 16) ((LAS unsigned*)(ldsp + MISC_OFF))[threadIdx.x] = 0u;
    __syncthreads();
    const XcdBarrier xbar = xcd_barrier_post((unsigned*)(kargs()->ws + WS_BAR), (volatile LAS unsigned*)(ldsp + MISC_OFF));

    {
        PTRS
        const int tid = opaque_tid(), lane = tid & 63;
        const int gt = blockIdx.x * NTHREADS + tid, NGT = G * NTHREADS;
        for (int i = gt; i < 2 * NG * CH * CH / 8; i += NGT) {
            const int e0 = i * 8, s0 = e0 & 127, t = (e0 >> 7) & 127; const f32x4 w0 = *(const f32x4*)(a_w_s + e0), w1 = *(const f32x4*)(a_w_s + e0 + 4);
            float y[8] = {w0.x, w0.y, w0.z, w0.w, w1.x, w1.y, w1.z, w1.w};
#pragma unroll
            for (int e = 0; e < 8; ++e) if (s0 + e > t) y[e] = 0.f;
            u32x4 o; o.x = pk2(y[0], y[1]); o.y = pk2(y[2], y[3]); o.z = pk2(y[4], y[5]); o.w = pk2(y[6], y[7]); *(u32x4*)(WSB + e0) = o; }
        for (int i = gt; i < 16 * DM; i += NGT) { const int n = i / DM, k = i % DM; const float w = kv_norm[k] * w_kvf[(size_t)k * 4112 + 4096 + n];
            const unsigned hi = pk2(w, 0.f) & 0xffffu; WFH[i] = (bf16_t)hi; WFL[i] = (bf16_t)(pk2(w - bf_lo(hi), 0.f) & 0xffffu); }
        LAS float* scr = (LAS float*)(ldsp + wave * TR_LDS_PER_WAVE);
        for (int it = gw; it < 48128 * (PROBE == 4 ? 2 : 1); it += NGW) {
            int r = it % 48128, K = DM, ld, ncols, mode = 0; const float* W; const float* g = nullptr; bf16_t* WT;
            if (r < 4096) { const int l = r >> 11; r &= 2047; W = a_w_in + (size_t)l * DM * 4096; g = a_norm + l * DM; WT = W_AIN + (size_t)l * 4096 * DM; ld = 4096; ncols = 4096; }
            else if ((r -= 4096) < 2048) { const int l = r >> 10; r &= 1023; W = a_w_out + (size_t)l * DM * DM; WT = W_AOUT + (size_t)l * DM * DM; ld = DM; ncols = DM; }
            else if ((r -= 2048) < 2048) { W = w_kvf; g = kv_norm; WT = W_KV; ld = 4112; ncols = 4096; }
            else if ((r -= 2048) < 4096) { const int l = r >> 11; r &= 2047; W = b_w_qg + (size_t)l * DM * 4096; g = b_norm + l * DM; WT = W_QG + (size_t)l * 4096 * DM; ld = 4096; ncols = 4096; }
            else if ((r -= 4096) < 2048) { const int l = r >> 10; r &= 1023; W = b_w_out + (size_t)l * DM * DM; WT = W_BOUT + (size_t)l * DM * DM; ld = DM; ncols = DM; }
            else if ((r -= 2048) < 22528) { const int l = r / 5632; r -= l * 5632; W = f_w_up + (size_t)l * DM * FF2; g = f_norm + l * DM; WT = W_UP + (size_t)l * FF2 * DM; ld = FF2; ncols = FF2; mode = 1; }
            else { r -= 22528; const int l = r / 2816; r -= l * 2816; W = f_w_down + (size_t)l * FF * DM; WT = W_DN + (size_t)l * DM * FF; K = FF; ld = DM; ncols = DM; }
            transpose_item(W, K, ld, ncols, g, WT, mode, scr, r, lane);
        }
        for (int m = gw; m < MT; m += NGW) {
            const f32x4* xr = (const f32x4*)(x + (size_t)m * DM) + lane; u32x2* o = (u32x2*)(HB + (size_t)m * DM) + lane; float sq = 0.f;
#pragma unroll
            for (int j = 0; j < 8; ++j) { const f32x4 v = xr[64 * j]; sq += (v.x * v.x + v.y * v.y) + (v.z * v.z + v.w * v.w); u32x2 w; w.x = pk2(v.x, v.y); w.y = pk2(v.z, v.w); o[64 * j] = w; }
            sq = wave_sum(sq); if (lane < 32) RSS[(size_t)m * 32 + lane] = lane == 0 ? sq : 0.f;
        }
    }
    GSYNC_CG();

    for (int l = 0; l < 4; ++l) {
        if (l < 2) {
            { PTRS GEMM_PHASE(EPI_A1, HB, W_AIN + (size_t)l * 4096 * DM, 4096, DM, BIG, 4096, 8, VSS, RSS); }
            GSYNC();
            for (int rep_ = 0; rep_ < (PROBE == 6 ? 2 : 1); ++rep_) { if (rep_) GSYNC();
            { PTRS const int lane = opaque_tid() & 63;
              spatial_phase(ldsp, BIG, VSS, WSB + (size_t)l * NG * CH * CH, a_v_norm + (size_t)l * DM, a_b_s + (size_t)l * NG * CH, ACT, wave, lane); } }
            GSYNC();
        } else {
            const int j = l - 2;
            if (j == 0) { PTRS const int lane = opaque_tid() & 63; fgate_rows(h, WFH, WFL, b_f, LOGF, gw, NGW, lane);
                          GEMM_PHASE(EPI_KV, HB, W_KV, 4096, DM, KVB, 4096, 1 << 30, nullptr, RSS); }
            { PTRS GEMM_PHASE(EPI_QG, HB, W_QG + (size_t)j * 4096 * DM, 4096, DM, BIG, 4096, 8, nullptr, RSS); }
            GSYNC();
            { PTRS const int lane = opaque_tid() & 63;
              if (j == 0) { if (blockIdx.x < 8) scan_seq(LOGF, CA, blockIdx.x * 8 + wave, lane); headnorm_rows(KVB, 4096, k_norm, gw, NGW, lane); }
              headnorm_rows(BIG, 4096, q_norm + (size_t)j * HD, gw, NGW, lane); }
            GSYNC();
            for (int rep_ = 0; rep_ < (PROBE == 2 ? 2 : 1); ++rep_) {
            { PTRS att::AttnT T{(const att::bf16*)BIG, (const att::bf16*)KVB, (const att::bf16*)(KVB + 2048), (att::bf16*)ACT, BIG + 2048, CA};
              att::attn_phase((char*)lds, T, NB, NH, SEQ); }
            GSYNC(); }
        }
        { PTRS const bf16_t* Wt = l < 2 ? W_AOUT + (size_t)l * DM * DM : W_BOUT + (size_t)(l - 2) * DM * DM;
          GEMM_PHASE(pg8::EpiRes, ACT, Wt, DM, DM, l == 0 ? x : (const float*)h, h, HB, RSS, DM); }
        GSYNC();
        { PTRS GEMM_PHASE(EPI_UP, HB, W_UP + (size_t)l * FF2 * DM, FF2, DM, BIG, FF2, 1 << 30, nullptr, RSS); }
        GSYNC();
#if PROBE == 1
        { PTRS GEMM_PHASE(EPI_UP, HB, W_UP + (size_t)l * FF2 * DM, FF2, DM, BIG, FF2, 1 << 30, nullptr, RSS); }
        GSYNC();
#endif
        { PTRS conv_phase(BIG, f_conv_w + (size_t)l * 3 * FF2, f_conv_b + (size_t)l * FF2, ACT); }
        GSYNC();
#if PROBE == 3
        { PTRS conv_phase(BIG, f_conv_w + (size_t)l * 3 * FF2, f_conv_b + (size_t)l * FF2, ACT); }
        GSYNC();
#endif
        { PTRS GEMM_PHASE(pg8::EpiRes, ACT, W_DN + (size_t)l * DM * FF, DM, FF, h, h, HB, RSS, DM); }
        GSYNC();
    }
#if PROBE == 7
    for (int rep_ = 0; rep_ < 20; ++rep_) GSYNC();
#endif
    { PTRS const int lane = opaque_tid() & 63; norm_rows<true>(h, final_norm, h, gw, NGW, lane); }
}

extern "C" void kernel_launch(void* const* d_in, const int* in_sizes, int n_in, void* d_out, int out_size, void* d_ws, size_t ws_size, hipStream_t stream) {
    static int grid = 0;
    if (grid == 0) {
        if (n_in != 21 || out_size != MT * DM || ws_size < WS_END) { fprintf(stderr, "kernel_launch: unexpected shapes (n_in %d out %d ws %zu, need ws >= %zu)\n", n_in, out_size, ws_size, (size_t)WS_END); grid = -1; return; }
        int dev = 0, cus = 0, per_cu = 0;
        (void)hipGetDevice(&dev); (void)hipDeviceGetAttribute(&cus, hipDeviceAttributeMultiprocessorCount, dev);
        (void)hipFuncSetAttribute((const void*)fwd_megakernel, hipFuncAttributeMaxDynamicSharedMemorySize, LDS_BYTES);
        (void)hipOccupancyMaxActiveBlocksPerMultiprocessor(&per_cu, (const void*)fwd_megakernel, NTHREADS, LDS_BYTES);
        if (per_cu < 1) { fprintf(stderr, "kernel_launch: occupancy query says %d blocks per CU\n", per_cu); per_cu = 1; }
        grid = cus * 1;
        (void)hipGetLastError();
    }
    if (grid < 0) return;
    (void)hipMemsetAsync((char*)d_ws + WS_BAR, 0, BAR_ZERO_BYTES, stream);
    Args a{};
    for (int i = 0; i < 21; ++i) a.in[i] = (const float*)d_in[i];
    a.out = (float*)d_out; a.ws = (unsigned char*)d_ws;
    void* args[] = {&a};
    hipError_t e = hipLaunchCooperativeKernel((const void*)fwd_megakernel, dim3(grid), dim3(NTHREADS), args, LDS_BYTES, stream);
    if (e != hipSuccess) fprintf(stderr, "cooperative launch failed: %s (grid %d)\n", hipGetErrorString(e), grid);
}
```

```cpp
#include <hip/hip_runtime.h>
#include <hip/hip_cooperative_groups.h>
#include <hip/hip_bf16.h>
#include <cstdio>
#include <cstdint>
namespace cg = cooperative_groups;
#ifndef PROBE
#define PROBE 0
#endif
__device__ __forceinline__ int opaque_tid() { int t = threadIdx.x; asm volatile("" : "+v"(t)); return t; }
namespace pg8 {
#define PG8_LAS __attribute__((address_space(3)))
typedef unsigned short bf16_t;
typedef short bf16x8 __attribute__((ext_vector_type(8)));
typedef float f32x4 __attribute__((ext_vector_type(4)));
typedef unsigned u32x4 __attribute__((ext_vector_type(4)));
constexpr int BM = 256, BK = 64, HALF = 128, HTB = HALF * BK * 2  , STAGE_BYTES = 8 * HTB, NXCD = 8, WGM = 8;

__host__ __device__ __forceinline__ int lds_byte(int r, int c) { const int st = (r >> 4) * 2 + (c >> 5), rr = r & 15, cc = c & 31, ob = rr * 64 + cc * 2; return st * 1024 + (ob ^ (((ob >> 9) & 1) << 5)); }
__host__ __device__ __forceinline__ void stage_rc(int b, int& R, int& C) { const int st = b / 1024, sb = b % 1024, swz = sb ^ (((sb >> 9) & 1) << 5); R = (st >> 1) * 16 + swz / 64; C = (st & 1) * 32 + (swz % 64) / 2; }
__host__ __device__ __forceinline__ int perm32(int rho) { const int n = rho >> 4, i = rho & 15; return 8 * (i >> 2) + 4 * n + (i & 3); }

struct Unit { int pm, pn; };
struct Gemm { const bf16_t* A; const bf16_t* Bt; int M, N, K; };

struct StaticOrder {
    int nM, nN, nwg, G, c;
    __host__ __device__ void init(int M, int N, int G_, int c_) { nM = M / BM; nN = N / BM; nwg = nM * nN; G = G_; c = c_; }
    __host__ __device__ bool next(int i, Unit& u) const {
        const long L = (long)i * G + c; if (L >= nwg) return false;
        int wgid = (int)L; { const int q = nwg / NXCD, r = nwg % NXCD, xcd = wgid % NXCD, off = wgid / NXCD; wgid = (xcd < r ? xcd * (q + 1) : r * (q + 1) + (xcd - r) * q) + off; }
        const int nig = WGM * nN, gid = wgid / nig, fm = gid * WGM, gsz = (nM - fm) < WGM ? (nM - fm) : WGM;
        u.pm = fm + ((wgid % nig) % gsz); u.pn = (wgid % nig) / gsz; return true;
    }
    __device__ __forceinline__ void a_ready(const Unit&) const {}
    __device__ __forceinline__ void done(const Unit&) const {}
};

__device__ __forceinline__ unsigned cvt_pk_bf16(float lo, float hi) { unsigned r; asm volatile("v_cvt_pk_bf16_f32 %0, %1, %2" : "=v"(r) : "v"(lo), "v"(hi)); return r; }
typedef float f32x2 __attribute__((ext_vector_type(2)));
__device__ __forceinline__ f32x2 gelu_pk(f32x2 v) {
    const f32x2 av = __builtin_elementwise_abs(v), d = av * 0.2316418882f + 1.0f;
    f32x2 t; t.x = __builtin_amdgcn_rcpf(d.x); t.y = __builtin_amdgcn_rcpf(d.y);
    f32x2 q = t * 0.5307027145f + (-0.7265760135f); q = q * t + 0.7107068705f; q = q * t + (-0.142248368f); q = q * t + 0.127414796f; q = q * t;
    const f32x2 s = (v * v) * (-0.72134752044f);
    f32x2 e; e.x = __builtin_amdgcn_exp2f(s.x); e.y = __builtin_amdgcn_exp2f(s.y);
    const f32x2 m = v * (q * e), r = v - m;
    f32x2 o; o.x = v.x < 0.f ? m.x : r.x; o.y = v.y < 0.f ? m.y : r.y; return o;
}
constexpr float RS_INV = 1.0f / 2048.0f, RS_EPS = 1e-6f;
template <int MODE, bool RSCALE, bool HEADMAJOR = false> struct EpiBf {
    static constexpr bool PERM = true, AFTER_DRAIN = false, IDEMPOTENT = true;
    bf16_t* O; int ldc; int split_pn; float* ss; const float* rs;
    __device__ __forceinline__ void operator()(const f32x4 (&acc)[2][2][4][2], const Unit& u, int wr, int wc, int fr, int fq) const {
        const int row0 = u.pm * BM + wr * 64 + fr, col0 = u.pn * BM + wc * 32 + 8 * fq;
        const bool up = u.pn >= split_pn;
        float rr[2][4];
#pragma unroll
        for (int ai = 0; ai < 2; ++ai)
#pragma unroll
            for (int m = 0; m < 4; ++m) { rr[ai][m] = 1.f;
                if (RSCALE) { const f32x4* p = (const f32x4*)(rs + (size_t)(row0 + ai * HALF + m * 16) * 32 + fq * 8); const f32x4 a = p[0], b = p[1];
                    float t = ((a[0] + a[1]) + (a[2] + a[3])) + ((b[0] + b[1]) + (b[2] + b[3])); t += __shfl_xor(t, 16); t += __shfl_xor(t, 32); rr[ai][m] = 1.0f / sqrtf(t * RS_INV + RS_EPS); } }
#pragma unroll
        for (int ai = 0; ai < 2; ++ai)
#pragma unroll
            for (int m = 0; m < 4; ++m) { const int row = row0 + ai * HALF + m * 16; float s = 0.f;
                bf16_t* rowp = HEADMAJOR ? O + (u.pn >= 8 ? (size_t)16384 * 2048 : (size_t)0) + ((size_t)((row >> 12) * 16 + 2 * (u.pn & 7)) * 4096 + (row & 4095)) * 128 + wc * 32 + 8 * fq
                                         : O + (size_t)row * ldc + col0;
#pragma unroll
                for (int bj = 0; bj < 2; ++bj) { f32x4 v0 = acc[ai][bj][m][0], v1 = acc[ai][bj][m][1];
                    if (RSCALE) { v0 = v0 * rr[ai][m]; v1 = v1 * rr[ai][m]; }
                    if (MODE == 1) { f32x2 a = gelu_pk((f32x2){v0[0], v0[1]}), b = gelu_pk((f32x2){v0[2], v0[3]}), c = gelu_pk((f32x2){v1[0], v1[1]}), d = gelu_pk((f32x2){v1[2], v1[3]});
                        v0 = (f32x4){a.x, a.y, b.x, b.y}; v1 = (f32x4){c.x, c.y, d.x, d.y};
                        s += (v0[0] * v0[0] + v0[1] * v0[1]) + (v0[2] * v0[2] + v0[3] * v0[3]) + (v1[0] * v1[0] + v1[1] * v1[1]) + (v1[2] * v1[2] + v1[3] * v1[3]); }
                    if (MODE == 2) { if (up) {
#pragma unroll
                        for (int e = 0; e < 4; ++e) { v0[e] = __builtin_amdgcn_rcpf(1.0f + __builtin_amdgcn_exp2f(-1.4426950408889634f * v0[e])); v1[e] = __builtin_amdgcn_rcpf(1.0f + __builtin_amdgcn_exp2f(-1.4426950408889634f * v1[e])); } } }
                    u32x4 w; w.x = cvt_pk_bf16(v0[0], v0[1]); w.y = cvt_pk_bf16(v0[2], v0[3]); w.z = cvt_pk_bf16(v1[0], v1[1]); w.w = cvt_pk_bf16(v1[2], v1[3]);
                    *(u32x4*)(rowp + (HEADMAJOR ? (size_t)bj * 4096 * 128 : (size_t)bj * HALF)) = w; }
                if (MODE == 1) { if (up) { s += __shfl_xor(s, 16); s += __shfl_xor(s, 32); if (fq == 0) ss[(size_t)row * 32 + (u.pn - split_pn) * 4 + wc] = s; } } }
    }
};
struct EpiRes {
    static constexpr bool PERM = true, AFTER_DRAIN = false, IDEMPOTENT = false;
    const float* base; float* out; bf16_t* hb; float* rss; int ldc;
    __device__ __forceinline__ void operator()(const f32x4 (&acc)[2][2][4][2], const Unit& u, int wr, int wc, int fr, int fq) const {
        const int row0 = u.pm * BM + wr * 64 + fr, col0 = u.pn * BM + wc * 32 + 8 * fq;
#pragma unroll
        for (int ai = 0; ai < 2; ++ai)
#pragma unroll
            for (int m = 0; m < 4; ++m) { const int row = row0 + ai * HALF + m * 16; const size_t off = (size_t)row * ldc + col0; f32x4 b[2][2]; float s = 0.f;
#pragma unroll
                for (int bj = 0; bj < 2; ++bj)
#pragma unroll
                    for (int n = 0; n < 2; ++n) b[bj][n] = *(const f32x4*)(base + off + bj * HALF + n * 4);
#pragma unroll
                for (int bj = 0; bj < 2; ++bj) { const f32x4 o0 = b[bj][0] + acc[ai][bj][m][0], o1 = b[bj][1] + acc[ai][bj][m][1];
                    *(f32x4*)(out + off + bj * HALF) = o0; *(f32x4*)(out + off + bj * HALF + 4) = o1;
                    u32x4 w; w.x = cvt_pk_bf16(o0[0], o0[1]); w.y = cvt_pk_bf16(o0[2], o0[3]); w.z = cvt_pk_bf16(o1[0], o1[1]); w.w = cvt_pk_bf16(o1[2], o1[3]);
                    *(u32x4*)(hb + off + bj * HALF) = w;
                    s += ((o0[0] * o0[0] + o0[1] * o0[1]) + (o0[2] * o0[2] + o0[3] * o0[3])) + ((o1[0] * o1[0] + o1[1] * o1[1]) + (o1[2] * o1[2] + o1[3] * o1[3])); }
                s += __shfl_xor(s, 16); s += __shfl_xor(s, 32); if (fq == 0) rss[(size_t)row * 32 + u.pn * 4 + wc] = s;
                if (m & 1) asm volatile("" ::: "memory"); }
    }
};
template <class Epi, class Sched, bool ALIGN_EPI = false, bool SP2 = false>
__device__ __forceinline__ void gemm_phase(PG8_LAS unsigned char* lds, const Gemm g, const Sched& S, const Epi& E) {
    const int tid = opaque_tid(), wid = __builtin_amdgcn_readfirstlane(tid >> 6), lane = tid & 63, wr = wid >> 2, wc = wid & 3, fr = lane & 15, fq = lane >> 4;
    const int K = g.K, nt = K / BK;
    unsigned voffA[2], voffB[2];
#pragma unroll
    for (int i = 0; i < 2; ++i) { int R, C; stage_rc(tid * 16 + i * 8192, R, C); const int Rb = Epi::PERM ? ((R & ~31) + perm32(R & 31)) : R;
        voffA[i] = (unsigned)(R * K + C) * 2u; voffB[i] = (unsigned)(Rb * K + C) * 2u; }
    const size_t kstep = (size_t)(BK * 2);
    const size_t hstep = (size_t)HALF * K * 2;
    const size_t tstep = 2 * hstep;
    const unsigned ldsw = (unsigned)wid * 1024u;
    const int aoff = lds_byte(wr * 64 + fr, fq * 8), boff = lds_byte(wc * 32 + fr, fq * 8);
#define PG8_SA(b, h) (((b) * 2 + (h)) * HTB)
#define PG8_SB(b, h) ((4 + (b) * 2 + (h)) * HTB)
#define PG8_STAGE(bufoff, gbase, voff) do { _Pragma("unroll") for (int _i = 0; _i < 2; ++_i) \
        __builtin_amdgcn_global_load_lds((const unsigned*)((const char*)(gbase) + (voff)[_i]), (PG8_LAS unsigned*)(lds + (bufoff) + ldsw + _i * 8192), 16, 0, 0); } while (0)
#define PG8_LDA(dst, b, h) do { _Pragma("unroll") for (int m = 0; m < 4; ++m) _Pragma("unroll") for (int k = 0; k < 2; ++k) dst[m][k] = *(const PG8_LAS bf16x8*)(lds + PG8_SA(b, h) + aoff + m * 2048 + k * 1024); } while (0)
#define PG8_LDB(dst, b, h) do { _Pragma("unroll") for (int n = 0; n < 2; ++n) _Pragma("unroll") for (int k = 0; k < 2; ++k) dst[n][k] = *(const PG8_LAS bf16x8*)(lds + PG8_SB(b, h) + boff + n * 2048 + k * 1024); } while (0)
#define PG8_MMA(ai, bj, At, Bt) do { __builtin_amdgcn_s_setprio(1); _Pragma("unroll") for (int m = 0; m < 4; ++m) _Pragma("unroll") for (int n = 0; n < 2; ++n) _Pragma("unroll") for (int k = 0; k < 2; ++k) \
        acc[ai][bj][m][n] = __builtin_amdgcn_mfma_f32_16x16x32_bf16(Bt[n][k], At[m][k], acc[ai][bj][m][n], 0, 0, 0); __builtin_amdgcn_s_setprio(0); } while (0)
#define PG8_WAIT_V(n) asm volatile("s_waitcnt vmcnt(" #n ")" ::: "memory")
#define PG8_WAIT_L(n) asm volatile("s_waitcnt lgkmcnt(" #n ")" ::: "memory")
#define PG8_BAR __builtin_amdgcn_s_barrier()
#define PG8_SCHED __builtin_amdgcn_sched_barrier(0)
    Unit cur, nxt; int ui = 0;
    if (!S.next(0, cur)) return;
    f32x4 acc[2][2][4][2];
#pragma unroll
    for (int a = 0; a < 2; ++a)
#pragma unroll
        for (int b = 0; b < 2; ++b)
#pragma unroll
            for (int m = 0; m < 4; ++m)
#pragma unroll
                for (int n = 0; n < 2; ++n) acc[a][b][m][n] = (f32x4){0.f, 0.f, 0.f, 0.f};
    bf16x8 At[4][2], B0[2][2], B1[2][2];
    const char* cA = (const char*)g.A + (size_t)cur.pm * tstep; const char* cB = (const char*)g.Bt + (size_t)cur.pn * tstep;
    S.a_ready(cur);
    if constexpr (SP2) {
        PG8_STAGE(PG8_SB(0, 0), cB, voffB); PG8_STAGE(PG8_SB(0, 1), cB + hstep, voffB); PG8_STAGE(PG8_SA(0, 0), cA, voffA); PG8_STAGE(PG8_SA(0, 1), cA + hstep, voffA);
        if (wr == 1) PG8_BAR;
        PG8_WAIT_V(2); PG8_BAR;
        PG8_STAGE(PG8_SB(1, 0), cB + kstep, voffB); PG8_STAGE(PG8_SA(1, 0), cA + kstep, voffA); PG8_STAGE(PG8_SB(1, 1), cB + hstep + kstep, voffB);
        PG8_WAIT_V(6); PG8_BAR;
    } else {
        PG8_STAGE(PG8_SB(0, 0), cB, voffB); PG8_STAGE(PG8_SA(0, 0), cA, voffA); PG8_STAGE(PG8_SB(0, 1), cB + hstep, voffB); PG8_STAGE(PG8_SA(0, 1), cA + hstep, voffA);
        if (wr == 1) PG8_BAR;
        PG8_WAIT_V(4); PG8_BAR;
        PG8_STAGE(PG8_SB(1, 0), cB + kstep, voffB); PG8_STAGE(PG8_SA(1, 0), cA + kstep, voffA); PG8_STAGE(PG8_SB(1, 1), cB + hstep + kstep, voffB);
        PG8_WAIT_V(6); PG8_BAR;
    }
    for (;;) {
        const bool has_next = S.next(ui + 1, nxt);
        const char* nA = has_next ? (const char*)g.A + (size_t)nxt.pm * tstep : cA; const char* nB = has_next ? (const char*)g.Bt + (size_t)nxt.pn * tstep : cB;
        for (int t = 0; t < nt; t += 2) {
            const bool last = (t == nt - 2);
            const char* a1 = cA + (size_t)(t + 1) * kstep;
            const char* a2 = last ? nA : cA + (size_t)(t + 2) * kstep; const char* b2 = last ? nB : cB + (size_t)(t + 2) * kstep;
            const char* a3 = a2 + kstep; const char* b3 = b2 + kstep;
            if (last && has_next) S.a_ready(nxt);
            if constexpr (SP2) {
            PG8_LDB(B0, 0, 0); PG8_LDB(B1, 0, 1); PG8_SCHED; PG8_LDA(At, 0, 0); PG8_STAGE(PG8_SA(1, 1), a1 + hstep, voffA);
            PG8_WAIT_V(8); PG8_WAIT_L(0); PG8_BAR; PG8_MMA(0, 0, At, B0); PG8_MMA(0, 1, At, B1); PG8_BAR; PG8_SCHED;
            PG8_LDA(At, 0, 1); PG8_STAGE(PG8_SB(0, 0), b2, voffB); PG8_STAGE(PG8_SB(0, 1), b2 + hstep, voffB); PG8_STAGE(PG8_SA(0, 0), a2, voffA);
            PG8_WAIT_V(8); PG8_WAIT_L(0); PG8_BAR; PG8_MMA(1, 0, At, B0); PG8_MMA(1, 1, At, B1); PG8_BAR; PG8_SCHED;
            PG8_LDB(B0, 1, 0); PG8_LDB(B1, 1, 1); PG8_SCHED; PG8_LDA(At, 1, 0); PG8_STAGE(PG8_SA(0, 1), a2 + hstep, voffA);
            PG8_WAIT_V(8); PG8_WAIT_L(0); PG8_BAR; PG8_MMA(0, 0, At, B0); PG8_MMA(0, 1, At, B1); PG8_BAR; PG8_SCHED;
            PG8_LDA(At, 1, 1); PG8_STAGE(PG8_SB(1, 0), b3, voffB); PG8_STAGE(PG8_SB(1, 1), b3 + hstep, voffB); PG8_STAGE(PG8_SA(1, 0), a3, voffA);
            PG8_WAIT_V(8); PG8_WAIT_L(0); PG8_BAR; PG8_MMA(1, 0, At, B0); PG8_MMA(1, 1, At, B1); PG8_BAR; PG8_SCHED;
            } else {
            PG8_LDB(B0, 0, 0); PG8_SCHED; PG8_LDA(At, 0, 0); PG8_STAGE(PG8_SA(1, 1), a1 + hstep, voffA);
            PG8_WAIT_L(8); PG8_BAR; PG8_WAIT_L(0); PG8_MMA(0, 0, At, B0); PG8_BAR; PG8_SCHED;
            PG8_LDB(B1, 0, 1); PG8_STAGE(PG8_SB(0, 0), b2, voffB);
            PG8_BAR; PG8_WAIT_L(0); PG8_MMA(0, 1, At, B1); PG8_BAR;
            PG8_LDA(At, 0, 1); PG8_STAGE(PG8_SA(0, 0), a2, voffA);
            PG8_BAR; PG8_WAIT_L(0); PG8_MMA(1, 0, At, B0); PG8_BAR; PG8_SCHED;
            PG8_STAGE(PG8_SB(0, 1), b2 + hstep, voffB);
            PG8_WAIT_V(6); PG8_BAR; PG8_MMA(1, 1, At, B1); PG8_BAR;
            PG8_LDB(B0, 1, 0); PG8_SCHED; PG8_LDA(At, 1, 0); PG8_STAGE(PG8_SA(0, 1), a2 + hstep, voffA);
            PG8_WAIT_L(8); PG8_BAR; PG8_WAIT_L(0); PG8_MMA(0, 0, At, B0); PG8_BAR; PG8_SCHED;
            PG8_LDB(B1, 1, 1); PG8_STAGE(PG8_SB(1, 0), b3, voffB);
            PG8_BAR; PG8_WAIT_L(0); PG8_MMA(0, 1, At, B1); PG8_BAR;
            PG8_LDA(At, 1, 1); PG8_STAGE(PG8_SA(1, 0), a3, voffA);
            PG8_BAR; PG8_WAIT_L(0); PG8_MMA(1, 0, At, B0); PG8_BAR; PG8_SCHED;
            PG8_STAGE(PG8_SB(1, 1), b3 + hstep, voffB);
            PG8_WAIT_V(6); PG8_BAR; PG8_MMA(1, 1, At, B1); PG8_BAR;
            }
        }
        if constexpr (ALIGN_EPI) { if (wr == 0) PG8_BAR; }
        if constexpr (!Epi::AFTER_DRAIN) { E(acc, cur, wr, wc, fr, fq);
#if PROBE == 8
            if constexpr (Epi::IDEMPOTENT) E(acc, cur, wr, wc, fr, fq);
#endif
            S.done(cur); }
        if (!has_next) break;
#pragma unroll
        for (int a = 0; a < 2; ++a)
#pragma unroll
            for (int b = 0; b < 2; ++b)
#pragma unroll
                for (int m = 0; m < 4; ++m)
#pragma unroll
                    for (int n = 0; n < 2; ++n) acc[a][b][m][n] = (f32x4){0.f, 0.f, 0.f, 0.f};
        cur = nxt; cA = nA; cB = nB; ++ui;
        if constexpr (ALIGN_EPI) { if (wr == 1) PG8_BAR; }
    }
    PG8_WAIT_V(0);
    if constexpr (!ALIGN_EPI) { if (wr == 0) PG8_BAR; }
    PG8_BAR;
    if constexpr (Epi::AFTER_DRAIN) { E.fused(acc, cur, wr, wc, fr, fq, lds, wid, lane); S.done(cur); }
#undef PG8_SA
#undef PG8_SB
#undef PG8_STAGE
#undef PG8_LDA
#undef PG8_LDB
#undef PG8_MMA
#undef PG8_WAIT_V
#undef PG8_WAIT_L
#undef PG8_BAR
#undef PG8_SCHED
}
}
namespace att {
constexpr int D = 128, LDQ = 4096, LDK = 128, LDO = 2048, LDG = 4096;
constexpr float THR = 8.f; constexpr bool WSKIP = false;
typedef unsigned u32x4_t __attribute__((ext_vector_type(4)));
typedef short bf16x8_t __attribute__((ext_vector_type(8)));
__device__ __forceinline__ bf16x8_t ka_frag(unsigned lo, unsigned up, int hi) {
    u32x4_t w;
    w.x = 0x3f803f80u; w.y = 0x3f80u | (((lo & 0xffffu) ^ 0x8000u) << 16); w.z = ((lo >> 16) ^ 0x8000u) | (((up & 0xffffu) ^ 0x8000u) << 16); w.w = 0u;
    if (hi) { w.x = 0u; w.y = 0u; w.z = 0u; }
    return __builtin_bit_cast(bf16x8_t, w);
}
__device__ __forceinline__ bf16x8_t qa_frag(unsigned lo, unsigned up, int hi) {
    u32x4_t w;
    w.x = lo; w.y = (up & 0xffffu) | 0x3f800000u; w.z = 0x3f803f80u; w.w = 0u;
    if (hi) { w.x = 0u; w.y = 0u; w.z = 0u; }
    return __builtin_bit_cast(bf16x8_t, w);
}
constexpr float SCALE = 0.08838834764831845f;
constexpr int NW = 8, QBLK = 32, KVBLK = 64, QB = NW * QBLK;
constexpr int SHM_V = KVBLK * D * 2, SHM_K = KVBLK * D * 2;
constexpr int ATT_LDS_BYTES = 2 * SHM_V + 2 * SHM_K + NW * 64 * 4;

using bf16 = __hip_bfloat16;
typedef short bf16x8 __attribute__((ext_vector_type(8)));
typedef short s16x4 __attribute__((ext_vector_type(4)));
typedef float f32x16 __attribute__((ext_vector_type(16)));
typedef float f32x4 __attribute__((ext_vector_type(4)));
typedef unsigned u32x4 __attribute__((ext_vector_type(4)));
template <class A, class Bt> struct same_t { static constexpr bool v = false; };
template <class A> struct same_t<A, A> { static constexpr bool v = true; };

#define KSWZ(row, colB) ((row) * 256 + ((colB) ^ (((row) & 7) << 4)))
#define SBAR() __builtin_amdgcn_sched_barrier(0)
__device__ __forceinline__ int v_st(int k, int c) { const int kk = (k & ~0xC) | ((k & 4) << 1) | ((k & 8) >> 1); return ((kk >> 3) * 4 + (c >> 5)) * 512 + ((kk & 7) * 32 + (c & 31)) * 2; }
__device__ __forceinline__ int v_rd_base(int lane) { return ((lane & 3) << 3) | (((lane >> 2) & 3) << 6) | (((lane >> 4) & 1) << 5) | (((lane >> 5) & 1) << 8); }
constexpr int v_rd_off(int d0, int ks, int half) { return d0 * 512 + ks * 4096 + half * 2048; }
__device__ __forceinline__ int crow(int r, int hi) { return (r & 3) + 8 * (r >> 2) + 4 * hi; }
__device__ __forceinline__ unsigned cvtpk(float lo, float hi) {
    unsigned r; asm volatile("v_cvt_pk_bf16_f32 %0, %1, %2" : "=v"(r) : "v"(lo), "v"(hi)); return r;
}
__device__ __forceinline__ bf16x8 pack8(f32x4 a, f32x4 b) {
    u32x4 w = {cvtpk(a[0], a[1]), cvtpk(a[2], a[3]), cvtpk(b[0], b[1]), cvtpk(b[2], b[3])};
    return *reinterpret_cast<bf16x8*>(&w);
}
template <class T> __device__ __forceinline__ bf16x8 load8(const T* p) {
    if constexpr (same_t<T, float>::v) { return pack8(*(const f32x4*)p, *(const f32x4*)(p + 4)); }
    else { return *reinterpret_cast<const bf16x8*>(p); }
}
__device__ __forceinline__ void mask_tile(f32x16& p0, f32x16& p1, int dq, unsigned W) {
    const float NEG = -__builtin_inff();
#pragma unroll
    for (int r = 0; r < 16; ++r) {
        const int c = (r & 3) + 8 * (r >> 2);
        if ((unsigned)(dq - c) >= W) p0[r] = NEG;
        if ((unsigned)(dq - c - 32) >= W) p1[r] = NEG;
    }
}
__device__ __forceinline__ void partialSM(f32x16& p0, f32x16& p1, float& m_reg, float& mn, float& alpha) {
    float pmax = p0[0]; for (int r = 1; r < 16; ++r) pmax = fmaxf(pmax, p0[r]); for (int r = 0; r < 16; ++r) pmax = fmaxf(pmax, p1[r]);
    { auto rr = __builtin_amdgcn_permlane32_swap(__float_as_uint(pmax), __float_as_uint(pmax), false, false);
      pmax = fmaxf(__uint_as_float(rr[0]), __uint_as_float(rr[1])); }
    constexpr float C2 = 1.4426950408889634f * SCALE;
    if (__builtin_expect(__all((pmax - m_reg) * SCALE <= THR), 1)) { mn = m_reg; alpha = 1.f; }
    else { mn = fmaxf(m_reg, pmax); alpha = __builtin_amdgcn_exp2f((m_reg - mn) * C2); m_reg = mn; }
    const float mnL = -mn * C2;
    for (int r = 0; r < 16; ++r) p0[r] = fmaf(p0[r], C2, mnL); for (int r = 0; r < 16; ++r) p1[r] = fmaf(p1[r], C2, mnL);
    for (int r = 0; r < 16; ++r) p0[r] = __builtin_amdgcn_exp2f(p0[r]);
}
__device__ __forceinline__ void finishSM(f32x16& p0, f32x16& p1, float alpha, float& l_reg, bf16x8& pa0, bf16x8& pa1, bf16x8& pa2, bf16x8& pa3) {
    for (int r = 0; r < 16; ++r) p1[r] = __builtin_amdgcn_exp2f(p1[r]);
    float ps = 0; for (int r = 0; r < 16; ++r) ps += p0[r]; for (int r = 0; r < 16; ++r) ps += p1[r];
    { auto rr = __builtin_amdgcn_permlane32_swap(__float_as_uint(ps), __float_as_uint(ps), false, false);
      ps = __uint_as_float(rr[0]) + __uint_as_float(rr[1]); }
    l_reg = l_reg * alpha + ps;
#define PK4(P, B_, OUT) do { unsigned a0 = cvtpk(P[B_+0], P[B_+1]), a1 = cvtpk(P[B_+2], P[B_+3]);                          \
        unsigned b0 = cvtpk(P[B_+4], P[B_+5]), b1 = cvtpk(P[B_+6], P[B_+7]);                                             \
        auto r0 = __builtin_amdgcn_permlane32_swap(a0, b0, false, false); auto r1 = __builtin_amdgcn_permlane32_swap(a1, b1, false, false); \
        u32x4 w = {r0[0], r1[0], r0[1], r1[1]}; OUT = *reinterpret_cast<bf16x8*>(&w); } while (0)
    PK4(p0, 0, pa0); PK4(p0, 8, pa1); PK4(p1, 0, pa2); PK4(p1, 8, pa3);
#undef PK4
}
template <int KB, bool SK>
__device__ __forceinline__ void qkt(f32x16& p0, f32x16& p1, const char* K_lds, int r32, int hi, const bf16x8* qr, bool act, unsigned long long qa, unsigned long long c) {
    if (SK && !act) { const float NEG = -__builtin_inff();
#pragma unroll
        for (int r = 0; r < 16; ++r) { p0[r] = NEG; p1[r] = NEG; } return; }
    p0 = f32x16{}; p1 = f32x16{};
    const char* kb[4];
#pragma unroll
    for (int dd = 0; dd < 4; ++dd) kb[dd] = K_lds + KB * SHM_K + KSWZ(r32, (dd * 16 + hi * 8) * 2);
#pragma unroll
    for (int d0 = 0; d0 < 8; ++d0) { const char* a = kb[d0 & 3] + (d0 >> 2) * 128;
        bf16x8 b0 = *reinterpret_cast<const bf16x8*>(a);
        bf16x8 b1 = *reinterpret_cast<const bf16x8*>(a + 32 * 256);
        p0 = __builtin_amdgcn_mfma_f32_32x32x16_bf16(b0, qr[d0], p0, 0, 0, 0);
        p1 = __builtin_amdgcn_mfma_f32_32x32x16_bf16(b1, qr[d0], p1, 0, 0, 0); }
    { unsigned ql = (unsigned)qa, qu = (unsigned)(qa >> 32); asm volatile("" : "+v"(ql), "+v"(qu));
      const bf16x8 qaf = qa_frag(ql, qu, hi);
      const unsigned cl = (unsigned)c, cu = (unsigned)(c >> 32);
      auto r0 = __builtin_amdgcn_permlane32_swap(cl, cl, false, false); auto r1 = __builtin_amdgcn_permlane32_swap(cu, cu, false, false);
      p0 = __builtin_amdgcn_mfma_f32_32x32x16_bf16(ka_frag(r0[0], r1[0], hi), qaf, p0, 0, 0, 0);
      p1 = __builtin_amdgcn_mfma_f32_32x32x16_bf16(ka_frag(r0[1], r1[1], hi), qaf, p1, 0, 0, 0); }
}
template <int VB, bool SK>
__device__ __forceinline__ void pv_tile(f32x16* o, int vb0, bf16x8 pa0, bf16x8 pa1, bf16x8 pa2, bf16x8 pa3, bool act) {
    if (SK && !act) return;
#define TRRD(dst, off) asm volatile("ds_read_b64_tr_b16 %0, %1 offset:%2" : "=&v"(dst) : "v"(vb0), "i"(off) : "memory")
#define PV_D0(d0) do { s16x4 l0, l1, l2, l3, h0, h1, h2, h3; constexpr int b_ = VB * SHM_V + v_rd_off(d0, 0, 0);     \
        TRRD(l0, b_); TRRD(h0, b_ + 2048); TRRD(l1, b_ + 4096); TRRD(h1, b_ + 6144); TRRD(l2, b_ + 8192); TRRD(h2, b_ + 10240); TRRD(l3, b_ + 12288); TRRD(h3, b_ + 14336); \
        asm volatile("s_waitcnt lgkmcnt(0)" ::: "memory"); SBAR();                 \
        o[d0] = __builtin_amdgcn_mfma_f32_32x32x16_bf16(pa0, (bf16x8){l0[0], l0[1], l0[2], l0[3], h0[0], h0[1], h0[2], h0[3]}, o[d0], 0, 0, 0);   \
        o[d0] = __builtin_amdgcn_mfma_f32_32x32x16_bf16(pa1, (bf16x8){l1[0], l1[1], l1[2], l1[3], h1[0], h1[1], h1[2], h1[3]}, o[d0], 0, 0, 0);   \
        o[d0] = __builtin_amdgcn_mfma_f32_32x32x16_bf16(pa2, (bf16x8){l2[0], l2[1], l2[2], l2[3], h2[0], h2[1], h2[2], h2[3]}, o[d0], 0, 0, 0);   \
        o[d0] = __builtin_amdgcn_mfma_f32_32x32x16_bf16(pa3, (bf16x8){l3[0], l3[1], l3[2], l3[3], h3[0], h3[1], h3[2], h3[3]}, o[d0], 0, 0, 0); } while (0)
    PV_D0(0); PV_D0(1); PV_D0(2); PV_D0(3);
#undef PV_D0
#undef TRRD
}

template <class TIn, class TOut> struct BlockRef { const TIn* Q; const TIn* K; const TIn* V; TOut* O; const unsigned short* G; const unsigned long long* CA; int P0; };
template <class TIn> struct Seam {
    bf16x8 qr[8];
    bf16x8 st_v0, st_v1, st_k0, st_k1; f32x4 sf0, sf1, sf2, sf3;
    unsigned long long ca, qa;
    f32x4 tq[16];
};
__device__ __forceinline__ int swa_jlo(int P0, int W) { const int lowk = P0 - W + 1; return lowk > 0 ? lowk / KVBLK : 0; }
#define ROW(p, k0, rr) ((p) + (size_t)((k0) + (rr)) * LDK + sc)
#define VMW() asm volatile("s_waitcnt vmcnt(0)" ::: "memory")
#define VMWN(n) asm volatile("s_waitcnt vmcnt(%0)" :: "i"(n) : "memory")
#define SLOAD_H(Kp, Vp, CAp, k0) do { S.st_v0 = load8<TIn>(ROW(Vp, k0, sr)); S.st_v1 = load8<TIn>(ROW(Vp, k0, 32 + sr));              \
                         S.st_k0 = load8<TIn>(ROW(Kp, k0, sr)); S.st_k1 = load8<TIn>(ROW(Kp, k0, 32 + sr)); S.ca = (CAp)[(k0) + lane]; } while (0)
#define SWRITE_HK(bf) do { *(bf16x8*)(K_lds + (bf) * SHM_K + kws) = S.st_k0; *(bf16x8*)(K_lds + (bf) * SHM_K + kws + 32 * 256) = S.st_k1; } while (0)
#define SWRITE_HV(bf) do { *(bf16x8*)(V_lds + (bf) * SHM_V + vst0) = S.st_v0; *(bf16x8*)(V_lds + (bf) * SHM_V + vst1) = S.st_v1; } while (0)
#define SWRITE_H(bf) do { SWRITE_HV(bf); SWRITE_HK(bf); } while (0)
#define SLOAD_F(p, k0) do { S.sf0 = *(const f32x4*)ROW(p, k0, sr); S.sf1 = *(const f32x4*)(ROW(p, k0, sr) + 4);                \
                            S.sf2 = *(const f32x4*)ROW(p, k0, 32 + sr); S.sf3 = *(const f32x4*)(ROW(p, k0, 32 + sr) + 4); } while (0)
#define SWRITE_KF(bf) do { *(bf16x8*)(K_lds + (bf) * SHM_K + kws) = pack8(S.sf0, S.sf1); *(bf16x8*)(K_lds + (bf) * SHM_K + kws + 32 * 256) = pack8(S.sf2, S.sf3); } while (0)
#define SWRITE_VF(bf) do { *(bf16x8*)(V_lds + (bf) * SHM_V + vst0) = pack8(S.sf0, S.sf1); *(bf16x8*)(V_lds + (bf) * SHM_V + vst1) = pack8(S.sf2, S.sf3); } while (0)
template <class TIn, class TOut>
__device__ __forceinline__ void causal_swa_prime(const BlockRef<TIn, TOut>& cur, int W, char* lds, Seam<TIn>& S) {
    constexpr bool F32 = same_t<TIn, float>::v;
    const int tid = opaque_tid(), wid = __builtin_amdgcn_readfirstlane(tid >> 6), lane = tid & 63, r32 = lane & 31, hi = lane >> 5;
    const int sr = tid >> 4, sc = (tid & 15) * 8, kws = KSWZ(sr, sc * 2); char* K_lds = lds + 2 * SHM_V;
    const int kb0 = swa_jlo(cur.P0, W) * KVBLK;
    for (int d0 = 0; d0 < 8; ++d0) S.qr[d0] = load8<TIn>(cur.Q + (size_t)(wid * QBLK + r32) * LDQ + d0 * 16 + hi * 8);
    S.qa = cur.CA[cur.P0 + wid * QBLK + r32];
    if constexpr (F32) { SLOAD_F((const float*)cur.K, kb0); VMW(); SWRITE_KF(0); SBAR(); SLOAD_F((const float*)cur.V, kb0); }
    else { SLOAD_H(cur.K, cur.V, cur.CA, kb0); VMW(); SWRITE_HK(0); }
    __syncthreads();
}
template <class TIn, class TOut>
__device__ __forceinline__ void causal_swa_block(const BlockRef<TIn, TOut>& cur, const BlockRef<TIn, TOut>& nxt, int skv, int W, char* lds, Seam<TIn>& S) {
    constexpr bool F32 = same_t<TIn, float>::v;
    const int tid = opaque_tid(), wid = __builtin_amdgcn_readfirstlane(tid >> 6), lane = tid & 63, r32 = lane & 31, hi = lane >> 5;
    const int j_lo = swa_jlo(cur.P0, W);
    int j_hi = (cur.P0 + QB - 1) / KVBLK + 1; if (j_hi > skv / KVBLK) j_hi = skv / KVBLK;
    const int NT = j_hi - j_lo;
    const int kbn = swa_jlo(nxt.P0, W) * KVBLK;
    const int qlo = cur.P0 + wid * QBLK, qm = qlo + r32 - 4 * hi;
    char* V_lds = lds; char* K_lds = lds + 2 * SHM_V;
    float* ws = (float*)(lds + 2 * SHM_V + 2 * SHM_K) + wid * 64; float* li_l = ws, * al_l = ws + 32;
    float m_reg = -1e30f, l_reg = 0; f32x16 o[4] = {};
    const int sr = tid >> 4, sc = (tid & 15) * 8, vst0 = v_st(sr, sc), vst1 = v_st(32 + sr, sc), kws = KSWZ(sr, sc * 2);
    const int vb0 = (int)(uintptr_t)V_lds + v_rd_base(lane);
    const TIn* Kh = cur.K; const TIn* Vh = cur.V; const unsigned long long* CAh = cur.CA;
#define RESC(a) do { if (__any((a) < 1.f)) { if (hi == 0) al_l[r32] = (a); asm volatile("s_waitcnt lgkmcnt(0)" ::: "memory");              \
                     for (int d_ = 0; d_ < 4; ++d_) for (int r = 0; r < 16; ++r) o[d_][r] *= al_l[crow(r, hi)]; } } while (0)
#define KBASE(t) ((j_lo + (t)) * KVBLK)
#define ACT(t) (KBASE(t) <= qlo + QBLK - 1 && KBASE(t) + KVBLK - 1 >= qlo - W + 1)
#define MASKT(P0_, P1_, t) do { const int kb_ = KBASE(t); if ((!SK || ACT(t)) && (kb_ + KVBLK - 1 > qlo || kb_ <= qlo + QBLK - 1 - W)) mask_tile(P0_, P1_, qm - kb_, (unsigned)W); } while (0)
    constexpr int NQL = F32 ? 16 : 8;
    constexpr bool SK = WSKIP && !F32;
#define SEAM_K0() do { VMWN(NQL); if constexpr (F32) { SWRITE_KF(0); SBAR(); SLOAD_F((const float*)nxt.V, kbn); } else { SWRITE_HK(0); } SBAR(); } while (0)
    f32x16 pA0, pA1, pB0, pB1; float mnA, mnB, alA, alB; bf16x8 pa0, pa1, pa2, pa3;
    if constexpr (F32) { VMW(); SWRITE_VF(0); SBAR(); } else { SWRITE_HV(0); SBAR(); }
    const unsigned long long qa_ = S.qa, hc = S.ca;
    if (NT > 1) { if constexpr (F32) SLOAD_F((const float*)Kh, KBASE(1)); else SLOAD_H(Kh, Vh, CAh, KBASE(1)); }
    SBAR(); qkt<0, SK>(pA0, pA1, K_lds, r32, hi, S.qr, ACT(0), qa_, hc);
    if constexpr (F32) { if (NT > 1) { VMW(); SWRITE_KF(1); SBAR(); SLOAD_F((const float*)Vh, KBASE(1)); } }
    MASKT(pA0, pA1, 0); partialSM(pA0, pA1, m_reg, mnA, alA);
    if (NT > 1) { VMW(); if constexpr (F32) { SWRITE_VF(1); SBAR(); if (NT > 2) SLOAD_F((const float*)Kh, KBASE(2)); } else SWRITE_H(1); }
    __syncthreads();
#define HALF_STEP(PX0, PX1, mnX, alX, PY0, PY1, alY, t, KB, VB, SB) do {                                                      \
        { const unsigned long long c_ = S.ca; SBAR(); qkt<KB, SK>(PX0, PX1, K_lds, r32, hi, S.qr, ACT(t), qa_, c_); }                                             \
        finishSM(PY0, PY1, alY, l_reg, pa0, pa1, pa2, pa3); SBAR();                                                           \
        if ((t) + 1 < NT) { if constexpr (F32) { VMW(); SWRITE_KF(SB); SBAR(); SLOAD_F((const float*)Vh, KBASE((t) + 1)); }  \
                            else { SLOAD_H(Kh, Vh, CAh, KBASE((t) + 1)); } SBAR(); }                                               \
        pv_tile<VB, SK>(o, vb0, pa0, pa1, pa2, pa3, ACT((t) - 1)); MASKT(PX0, PX1, (t)); partialSM(PX0, PX1, m_reg, mnX, alX);                                        \
        __syncthreads();                                                                                                      \
        if ((t) + 1 < NT) { VMW(); if constexpr (F32) { SWRITE_VF(SB); SBAR(); if ((t) + 2 < NT) SLOAD_F((const float*)Kh, KBASE((t) + 2)); } \
                            else { SWRITE_H(SB); } }                                                                          \
        RESC(alX); __syncthreads(); } while (0)
    for (int t = 1; t + 1 < NT; t += 2) {
        HALF_STEP(pB0, pB1, mnB, alB, pA0, pA1, alA, t, 1, 0, 0);
        HALF_STEP(pA0, pA1, mnA, alA, pB0, pB1, alB, t + 1, 0, 1, 1);
    }
    const bool even = (NT & 1) == 0;
    if (even) { const unsigned long long c_ = S.ca; SBAR(); qkt<1, SK>(pB0, pB1, K_lds, r32, hi, S.qr, ACT(NT - 1), qa_, c_); SBAR(); }
#define QROW(e) (nxt.Q + (size_t)(wid * QBLK + r32) * D + ((e) >> 1) * 16 + hi * 8 + ((e) & 1) * 4)
    if constexpr (F32) { SLOAD_F((const float*)nxt.K, kbn); SBAR();
#pragma unroll
        for (int e = 0; e < 8; ++e) S.tq[e] = *(const f32x4*)QROW(e); }
    else { SLOAD_H(nxt.K, nxt.V, nxt.CA, kbn); SBAR();
#pragma unroll
        for (int d0 = 0; d0 < 8; ++d0) S.qr[d0] = load8<TIn>(nxt.Q + (size_t)(wid * QBLK + r32) * LDQ + d0 * 16 + hi * 8);
        S.qa = nxt.CA[nxt.P0 + wid * QBLK + r32]; }
    SBAR();
    finishSM(pA0, pA1, alA, l_reg, pa0, pa1, pa2, pa3); SBAR();
    if constexpr (F32) {
#pragma unroll
        for (int e = 8; e < 16; ++e) S.tq[e] = *(const f32x4*)QROW(e); SBAR(); }
#undef QROW
    pv_tile<0, SK>(o, vb0, pa0, pa1, pa2, pa3, ACT(even ? NT - 2 : NT - 1));
    if (even) { MASKT(pB0, pB1, NT - 1); partialSM(pB0, pB1, m_reg, mnB, alB); __syncthreads(); RESC(alB);
        finishSM(pB0, pB1, alB, l_reg, pa0, pa1, pa2, pa3); SBAR(); pv_tile<1, SK>(o, vb0, pa0, pa1, pa2, pa3, ACT(NT - 1)); }
    SBAR(); SEAM_K0();
    if (hi == 0) li_l[r32] = l_reg; asm volatile("s_waitcnt lgkmcnt(0)" ::: "memory");
    float rli[16];
#pragma unroll
    for (int r = 0; r < 16; ++r) rli[r] = __builtin_amdgcn_rcpf(li_l[crow(r, hi)]);
    TOut* Ow = cur.O + (size_t)(wid * QBLK) * LDO; const unsigned short* Gw = cur.G + (size_t)(wid * QBLK) * LDG;
#pragma unroll
    for (int r = 0; r < 16; ++r) { const int orow = crow(r, hi);
#pragma unroll
        for (int d0 = 0; d0 < 4; ++d0) { const float v = o[d0][r] * rli[r];
            if constexpr (same_t<TOut, float>::v) { Ow[(size_t)orow * LDO + d0 * 32 + r32] = v; }
            else { const float vn = __shfl_xor(v, 1);
                   if ((r32 & 1) == 0) { const unsigned g2 = *(const unsigned*)(Gw + (size_t)orow * LDG + d0 * 32 + r32);
                       *(unsigned*)(Ow + (size_t)orow * LDO + d0 * 32 + r32) = cvtpk(v * __uint_as_float(g2 << 16), vn * __uint_as_float(g2 & 0xffff0000u)); } } } }
    if constexpr (F32) {
#pragma unroll
        for (int d0 = 0; d0 < 8; ++d0) S.qr[d0] = pack8(S.tq[2 * d0], S.tq[2 * d0 + 1]); }
    __syncthreads();
#undef RESC
#undef KBASE
#undef ACT
#undef MASKT
#undef SEAM_K0
#undef HALF_STEP
}
#undef ROW
#undef VMW
#undef VMWN
#undef SLOAD_H
#undef SWRITE_HK
#undef SWRITE_HV
#undef SWRITE_H
#undef SLOAD_F
#undef SWRITE_KF
#undef SWRITE_VF

__host__ __device__ inline int swa_nx(int nqb, int nramp) { return (nramp + 1) / 2 + (nqb - nramp); }
struct SwaItem { int bh, qb0, qb1; };
__device__ __forceinline__ SwaItem swa_decode(int L, int nqb, int nx) {
    SwaItem it; const int xcd = L & 7, k = L >> 3, gi = k / nx, r = k - gi * nx;
    it.bh = gi * 8 + xcd; const int x = r;
    it.qb0 = x; it.qb1 = nqb - 1 - x;
    return it;
}
struct AttnT { const bf16* Q; const bf16* K; const bf16* V; bf16* O; const unsigned short* G; const unsigned long long* CA; };
__device__ __forceinline__ BlockRef<bf16, bf16> swa_ref(const SwaItem& it, int pass, const AttnT& T, int seq, int nh) {
    const int qb = pass ? it.qb1 : it.qb0, b = it.bh / nh, h = it.bh % nh; const size_t tok0 = (size_t)b * seq;
    BlockRef<bf16, bf16> r;
    r.Q = T.Q + (tok0 + (size_t)qb * QB) * LDQ + h * D; r.O = T.O + (tok0 + (size_t)qb * QB) * LDO + h * D; r.G = T.G + (tok0 + (size_t)qb * QB) * LDG + h * D;
    r.K = T.K + (size_t)it.bh * seq * D; r.V = T.V + (size_t)it.bh * seq * D; r.CA = T.CA + (size_t)it.bh * seq; r.P0 = qb * QB;
    return r;
}
__device__ __forceinline__ void attn_phase(char* lds, const AttnT& T, int nb, int nh, int seq) {
    const int W = 1 << 30, nqb = seq / QB, nx = nqb / 2, total = nx * nb * nh, stride = gridDim.x;
    int L = blockIdx.x; if (L >= total) return;
    SwaItem it = swa_decode(L, nqb, nx); int pass = 0;
    BlockRef<bf16, bf16> cur = swa_ref(it, 0, T, seq, nh);
    Seam<bf16> S;
    causal_swa_prime<bf16, bf16>(cur, W, lds, S);
    for (;;) {
        const bool more_pass = pass == 0 && it.qb1 != it.qb0, more_item = L + stride < total, last = !more_pass && !more_item;
        SwaItem itn = it; int passn = pass + 1, Ln = L;
        if (!more_pass) { passn = 0; Ln = more_item ? L + stride : L; itn = swa_decode(Ln, nqb, nx); }
        const BlockRef<bf16, bf16> nxt = last ? cur : swa_ref(itn, passn, T, seq, nh);
        causal_swa_block<bf16, bf16>(cur, nxt, seq, W, lds, S);
        if (last) break;
        cur = nxt; it = itn; pass = passn; L = Ln;
    }
}
#undef KSWZ
#undef SBAR
}
constexpr int DM = 2048, NB = 4, SEQ = 4096, MT = NB * SEQ, FF = 5632, FF2 = 2 * FF, NH = 16, HD = 128, CH = 128, NG = 16;
constexpr float EPS = 1e-6f;
constexpr int NWAVES = 8, NTHREADS = NWAVES * 64;
constexpr size_t MiB = 1u << 20;
constexpr size_t WS_BAR = 0, BAR_ZERO_BYTES = 16384;
constexpr size_t WS_LOGF = 1 * MiB;
constexpr size_t WS_CA = 2 * MiB;
constexpr size_t WS_WSB = 4 * MiB;
constexpr size_t WS_WF = 5 * MiB;
constexpr size_t WS_W_AIN = 6 * MiB;
constexpr size_t WS_W_AOUT = WS_W_AIN + 32 * MiB;
constexpr size_t WS_W_KV = WS_W_AOUT + 16 * MiB;
constexpr size_t WS_W_QG = WS_W_KV + 16 * MiB;
constexpr size_t WS_W_BOUT = WS_W_QG + 32 * MiB;
constexpr size_t WS_W_UP = WS_W_BOUT + 16 * MiB;
constexpr size_t WS_W_DN = WS_W_UP + 176 * MiB;
constexpr size_t WS_XN = WS_W_DN + 88 * MiB;
constexpr size_t WS_XN2 = WS_XN + 64 * MiB;
constexpr size_t WS_KV = WS_XN2 + 64 * MiB;
constexpr size_t WS_BIG = WS_KV + 128 * MiB;
constexpr size_t WS_ACT = WS_BIG + 352 * MiB;
constexpr size_t WS_SSP = WS_ACT + 176 * MiB;
constexpr size_t WS_END = WS_SSP + 2 * MiB;
constexpr int LDS_BYTES = 147456, MISC_OFF = LDS_BYTES - 64;

typedef unsigned short bf16_t;
typedef float f32x4 __attribute__((ext_vector_type(4)));
typedef unsigned u32x4 __attribute__((ext_vector_type(4)));
typedef unsigned u32x2 __attribute__((ext_vector_type(2)));
typedef short bf16x8 __attribute__((ext_vector_type(8)));
#define LAS __attribute__((address_space(3)))
__device__ __forceinline__ unsigned pk2(float lo, float hi) { return pg8::cvt_pk_bf16(lo, hi); }
__device__ __forceinline__ float bf_lo(unsigned w) { return __uint_as_float(w << 16); }
__device__ __forceinline__ float bf_hi(unsigned w) { return __uint_as_float(w & 0xffff0000u); }
__device__ __forceinline__ float wave_sum(float v) {
#pragma unroll
    for (int o = 1; o < 64; o <<= 1) v += __shfl_xor(v, o);
    return v;
}
struct Args { const float* in[21]; float* out; unsigned char* ws; };
#define XB_TMO      128
#define XB_XCNT(j)  (256  + 64 * (j))
#define XB_XSUB(j)  (1280 + 64 * (j))
#define XB_XGEN(j)  (2304 + 64 * (j))
#define XB_TOP      3328
#define XB_TOPGEN   3392
#define XCD_BAR_WORDS 3456
#define XB_SPIN_CAP (1u << 18)

__device__ __forceinline__ unsigned xb_ld(unsigned* p)              { return __hip_atomic_load(p, __ATOMIC_RELAXED, __HIP_MEMORY_SCOPE_AGENT); }
__device__ __forceinline__ unsigned xb_add(unsigned* p, unsigned v) { return __hip_atomic_fetch_add(p, v, __ATOMIC_RELAXED, __HIP_MEMORY_SCOPE_AGENT); }
__device__ __forceinline__ unsigned xb_xcc_id() { return (unsigned)__builtin_amdgcn_s_getreg((3 << 11) | 20) & 0xFu; }
#define XB_SPIN(cond, bar) do { unsigned _sp = 0; while (cond) { __builtin_amdgcn_s_sleep(1); \
    if ((++_sp & 255u) == 0u) { if (xb_ld(&(bar)[XB_TMO])) break; if (_sp > XB_SPIN_CAP) { atomicAdd(&(bar)[XB_TMO], 1u); break; } } } } while (0)

struct XcdBarrier {
    unsigned* bar; unsigned x;
    volatile LAS unsigned* st;
};

__device__ __forceinline__ XcdBarrier xcd_barrier_post(unsigned* bar, volatile LAS unsigned* st) {
    XcdBarrier b; b.bar = bar; b.x = xb_xcc_id(); b.st = st;
    if (threadIdx.x == 0) (void)xb_add(&bar[XB_XCNT(b.x)], 1u);
    return b;
}
__device__ __forceinline__ void xcd_barrier_complete(unsigned* bar, unsigned x, unsigned& nloc, unsigned& nx) {
    const unsigned G = gridDim.x * gridDim.y * gridDim.z;
    unsigned sum, cnt, mine, sp = 0u;
    for (;;) {
        sum = 0u; cnt = 0u; mine = 0u;
#pragma unroll
        for (unsigned j = 0; j < 16; ++j) { const unsigned c = xb_ld(&bar[XB_XCNT(j)]); sum += c; cnt += (c > 0u) ? 1u : 0u; mine = (j == x) ? c : mine; }
        if (sum == G) break;
        __builtin_amdgcn_s_sleep(1);
        if ((++sp & 255u) == 0u) { if (xb_ld(&bar[XB_TMO])) break; if (sp > XB_SPIN_CAP) { atomicAdd(&bar[XB_TMO], 1u); break; } }
    }
    nloc = mine > 0u ? mine : 1u; nx = cnt > 0u ? cnt : 1u;
}

__device__ __forceinline__ void xcd_barrier(const XcdBarrier& b) {
    asm volatile("s_waitcnt vmcnt(0)" ::: "memory");
    __syncthreads();
    if (threadIdx.x == 0) {
        unsigned* bar = b.bar;
        __builtin_amdgcn_s_waitcnt(0);
        unsigned nloc = b.st[0], nx = b.st[1];
        if (nloc == 0u) { xcd_barrier_complete(bar, b.x, nloc, nx); b.st[0] = nloc; b.st[1] = nx; }
        const unsigned old = xb_add(&bar[XB_XSUB(b.x)], 1u);
        const unsigned gen = old / nloc;
        if (old + 1u == (gen + 1u) * nloc) {
            __builtin_amdgcn_fence(__ATOMIC_RELEASE, "agent");
            asm volatile("s_waitcnt vmcnt(0)" ::: "memory");
            const unsigned og = xb_add(&bar[XB_TOP], 1u);
            const unsigned tg = og / nx;
            if (og + 1u == (tg + 1u) * nx) xb_add(&bar[XB_TOPGEN], 1u);
            else XB_SPIN(xb_ld(&bar[XB_TOPGEN]) == tg, bar);
            __builtin_amdgcn_fence(__ATOMIC_ACQUIRE, "agent");
            xb_add(&bar[XB_XGEN(b.x)], 1u);
            asm volatile("s_waitcnt vmcnt(0)" ::: "memory");
        } else {
            XB_SPIN(xb_ld(&bar[XB_XGEN(b.x)]) == gen, bar);
            __builtin_amdgcn_fence(__ATOMIC_ACQUIRE, "agent");
            asm volatile("s_waitcnt vmcnt(0)" ::: "memory");
        }
    }
    __syncthreads();
}


__device__ __forceinline__ int up_row(int n) { return n < FF ? (n >> 7) * 256 + (n & 127) : ((n - FF) >> 7) * 256 + 128 + ((n - FF) & 127); }
constexpr int TR_LDS_PER_WAVE = 64 * 65 * 4;
__device__ __forceinline__ void transpose_item(const float* W, int K, int ld, int ncols, const float* gk, bf16_t* WT, int mode, LAS float* scr, int item, int lane) {
    const int nblk = ncols / 64, kb = item / nblk, nb = item % nblk, k0 = 64 * kb, n0 = 64 * nb, kr = lane >> 4, n4 = (lane & 15) * 4;
    f32x4 v[16];
#pragma unroll
    for (int i = 0; i < 16; ++i) v[i] = *(const f32x4*)(W + (size_t)(k0 + 4 * i + kr) * ld + n0 + n4);
#pragma unroll
    for (int i = 0; i < 16; ++i) { const int kk = 4 * i + kr; const float g = gk ? gk[k0 + kk] : 1.f; LAS float* d = scr + kk * 65 + n4; d[0] = v[i].x * g; d[1] = v[i].y * g; d[2] = v[i].z * g; d[3] = v[i].w * g; }
    asm volatile("s_waitcnt lgkmcnt(0)" ::: "memory");
    const int c = lane & 7; const int r0 = mode ? up_row(n0) : n0;
#pragma unroll
    for (int j = 0; j < 8; ++j) { const int n = (lane >> 3) + 8 * j; const LAS float* p = scr + (8 * c) * 65 + n;
        u32x4 o; o.x = pk2(p[0 * 65], p[1 * 65]); o.y = pk2(p[2 * 65], p[3 * 65]); o.z = pk2(p[4 * 65], p[5 * 65]); o.w = pk2(p[6 * 65], p[7 * 65]);
        *(u32x4*)(WT + (size_t)(r0 + n) * K + k0 + 8 * c) = o; }
    asm volatile("s_waitcnt lgkmcnt(0)" ::: "memory");
}
template <bool F32OUT>
__device__ __forceinline__ void norm_rows(const float* src, const float* g, void* dst, int gw, int NGW, int lane) {
    for (int m = gw; m < MT; m += NGW) {
        const f32x4* xr = (const f32x4*)(src + (size_t)m * DM) + lane; f32x4 v[8]; float s = 0.f;
#pragma unroll
        for (int j = 0; j < 8; ++j) { v[j] = xr[64 * j]; s += (v[j].x * v[j].x + v[j].y * v[j].y) + (v[j].z * v[j].z + v[j].w * v[j].w); }
        const float r = 1.0f / sqrtf(wave_sum(s) * (1.0f / DM) + EPS);
        const f32x4* gr = (const f32x4*)g + lane;
        if constexpr (F32OUT) { f32x4* o = (f32x4*)((float*)dst + (size_t)m * DM) + lane;
#pragma unroll
            for (int j = 0; j < 8; ++j) o[64 * j] = (v[j] * r) * gr[64 * j]; }
        else { u32x2* o = (u32x2*)((bf16_t*)dst + (size_t)m * DM) + lane;
#pragma unroll
            for (int j = 0; j < 8; ++j) { const f32x4 y = (v[j] * r) * gr[64 * j]; u32x2 w; w.x = pk2(y.x, y.y); w.y = pk2(y.z, y.w); o[64 * j] = w; } }
    }
}
__device__ __forceinline__ void headnorm_rows(bf16_t* buf, int ld, const float* gain, int gw, int NGW, int lane) {
    const f32x4 g0 = *(const f32x4*)(gain + (lane & 15) * 8), g1 = *(const f32x4*)(gain + (lane & 15) * 8 + 4);
    for (int m = gw; m < MT; m += NGW) {
        u32x4* p = (u32x4*)(buf + (size_t)m * ld) + lane; u32x4 w[4];
#pragma unroll
        for (int j = 0; j < 4; ++j) w[j] = p[64 * j];
#pragma unroll
        for (int j = 0; j < 4; ++j) {
            float x[8] = {bf_lo(w[j].x), bf_hi(w[j].x), bf_lo(w[j].y), bf_hi(w[j].y), bf_lo(w[j].z), bf_hi(w[j].z), bf_lo(w[j].w), bf_hi(w[j].w)};
            float s = 0.f;
#pragma unroll
            for (int e = 0; e < 8; ++e) s += x[e] * x[e];
            s += __shfl_xor(s, 1); s += __shfl_xor(s, 2); s += __shfl_xor(s, 4); s += __shfl_xor(s, 8);
            const float r = 1.0f / sqrtf(s * (1.0f / HD) + EPS);
            u32x4 o; o.x = pk2(x[0] * r * g0.x, x[1] * r * g0.y); o.y = pk2(x[2] * r * g0.z, x[3] * r * g0.w); o.z = pk2(x[4] * r * g1.x, x[5] * r * g1.y); o.w = pk2(x[6] * r * g1.z, x[7] * r * g1.w);
            p[64 * j] = o; }
    }
}
__device__ __forceinline__ void fgate_rows(const float* h, const bf16_t* wfh, const bf16_t* wfl, const float* bf, float* logf, int gw, int NGW, int lane) {
    const int fr = lane & 15, fq = lane >> 4;
    for (int rg = gw; rg < MT / 16; rg += NGW) {
        const float* hrow = h + (size_t)(rg * 16 + fr) * DM + 8 * fq; const bf16_t* wh = wfh + fr * DM + 8 * fq; const bf16_t* wl = wfl + fr * DM + 8 * fq;
        f32x4 acc = {0.f, 0.f, 0.f, 0.f}; float ssq = 0.f;
#pragma unroll 4
        for (int ks = 0; ks < DM / 32; ++ks) {
            const f32x4 a0 = *(const f32x4*)(hrow + 32 * ks), a1 = *(const f32x4*)(hrow + 32 * ks + 4);
            ssq += (a0.x * a0.x + a0.y * a0.y) + (a0.z * a0.z + a0.w * a0.w) + (a1.x * a1.x + a1.y * a1.y) + (a1.z * a1.z + a1.w * a1.w);
            u32x4 hi; hi.x = pk2(a0.x, a0.y); hi.y = pk2(a0.z, a0.w); hi.z = pk2(a1.x, a1.y); hi.w = pk2(a1.z, a1.w);
            u32x4 lo; lo.x = pk2(a0.x - bf_lo(hi.x), a0.y - bf_hi(hi.x)); lo.y = pk2(a0.z - bf_lo(hi.y), a0.w - bf_hi(hi.y)); lo.z = pk2(a1.x - bf_lo(hi.z), a1.y - bf_hi(hi.z)); lo.w = pk2(a1.z - bf_lo(hi.w), a1.w - bf_hi(hi.w));
            const bf16x8 whv = *(const bf16x8*)(wh + 32 * ks), wlv = *(const bf16x8*)(wl + 32 * ks);
            const bf16x8 hv = __builtin_bit_cast(bf16x8, hi), lv = __builtin_bit_cast(bf16x8, lo);
            acc = __builtin_amdgcn_mfma_f32_16x16x32_bf16(whv, hv, acc, 0, 0, 0);
            acc = __builtin_amdgcn_mfma_f32_16x16x32_bf16(wlv, hv, acc, 0, 0, 0);
            acc = __builtin_amdgcn_mfma_f32_16x16x32_bf16(whv, lv, acc, 0, 0, 0);
        }
        ssq += __shfl_xor(ssq, 16); ssq += __shfl_xor(ssq, 32);
        const float r = 1.0f / sqrtf(ssq * (1.0f / DM) + EPS);
        const f32x4 b = *(const f32x4*)(bf + 4 * fq); f32x4 o;
#pragma unroll
        for (int e = 0; e < 4; ++e) { const float f = acc[e] * r + b[e]; o[e] = fminf(f, 0.f) - log1pf(expf(-fabsf(f))); }
        *(f32x4*)(logf + (size_t)(rg * 16 + fr) * 16 + 4 * fq) = o;
    }
}
__device__ __forceinline__ void scan_seq(const float* logf, unsigned long long* CA, int seq, int lane) {
    const int b = seq >> 4, hh = seq & 15;
    const float* lf = logf + ((size_t)b * SEQ + (size_t)lane * 64) * 16 + hh;
    float v[64];
#pragma unroll
    for (int i = 0; i < 64; ++i) v[i] = lf[i * 16];
#pragma unroll
    for (int i = 1; i < 64; ++i) v[i] += v[i - 1];
    const float tot = v[63]; float t = tot;
#pragma unroll
    for (int o = 1; o < 64; o <<= 1) { const float y = __shfl_up(t, o); if (lane >= o) t += y; }
    const float excl = t - tot;
    unsigned long long* out = CA + (size_t)seq * SEQ + lane * 64;
#pragma unroll
    for (int i = 0; i < 64; ++i) { const float c = (excl + v[i]) * 11.313708498984761f;
        const unsigned h1 = pk2(c, 0.f) & 0xffffu; const float r1 = c - bf_lo(h1);
        const unsigned h2 = pk2(r1, 0.f) & 0xffffu; const float r2 = r1 - bf_lo(h2);
        const unsigned h3 = pk2(r2, 0.f) & 0xffffu;
        out[i] = (unsigned long long)(h1 | (h2 << 16)) | ((unsigned long long)h3 << 32); }
}
__device__ __forceinline__ void spatial_phase(LAS unsigned char* ldsp, const bf16_t* Z, const float* ssp, const bf16_t* wsb, const float* vnorm, const float* bs, bf16_t* GATED, int wave, int lane) {
    const int fr = lane & 15, fq = lane >> 4;
    for (int item = blockIdx.x; item < (MT / CH) * NG; item += gridDim.x) {
        const int ch = item >> 4, g = item & 15, row0 = ch * CH, cw = g * 128 + wave * 16;
        LAS float* rvs = (LAS float*)ldsp;
        __syncthreads();
        { const int t_ = wave * 64 + lane; if (t_ < CH) { const f32x4* p = (const f32x4*)(ssp + (size_t)(row0 + t_) * 32); float sq = 0.f;
#pragma unroll
            for (int q = 0; q < 8; ++q) { const f32x4 v = p[q]; sq += (v.x + v.y) + (v.z + v.w); }
            rvs[t_] = 1.0f / sqrtf(sq * (1.0f / DM) + EPS); } }
        __syncthreads();
        LAS unsigned* VS = (LAS unsigned*)(ldsp + 1024);
        { const int t_ = wave * 64 + lane, srow = t_ >> 2, c0 = (t_ & 3) * 32; const float rv = rvs[srow];
          const u32x4* gp = (const u32x4*)(Z + (size_t)(row0 + srow) * 4096 + 2048 + g * 128 + c0); u32x4 q[4];
#pragma unroll
          for (int jj = 0; jj < 4; ++jj) q[jj] = gp[jj];
#pragma unroll
          for (int jj = 0; jj < 4; ++jj) { LAS unsigned* d = VS + srow * 65 + (c0 >> 1) + jj * 4;
#pragma unroll
              for (int e = 0; e < 4; ++e) d[e] = pk2(bf_lo(q[jj][e]) * rv, bf_hi(q[jj][e]) * rv); } }
        __syncthreads();
        bf16x8 vf[4];
        { const LAS unsigned short* vs16 = (const LAS unsigned short*)VS + wave * 16 + fr;
#pragma unroll
          for (int ks = 0; ks < 4; ++ks) { unsigned hv[8];
#pragma unroll
              for (int i = 0; i < 8; ++i) hv[i] = vs16[(32 * ks + 8 * fq + i) * 130];
              u32x4 w; w.x = hv[0] | (hv[1] << 16); w.y = hv[2] | (hv[3] << 16); w.z = hv[4] | (hv[5] << 16); w.w = hv[6] | (hv[7] << 16); vf[ks] = __builtin_bit_cast(bf16x8, w); } }
        f32x4 acc[8];
#pragma unroll
        for (int m = 0; m < 8; ++m) { acc[m] = (f32x4){0.f, 0.f, 0.f, 0.f};
#pragma unroll
            for (int ks = 0; ks < 4; ++ks) if (32 * ks <= 16 * m + 15) {
                const bf16x8 wf = *(const bf16x8*)(wsb + ((size_t)(g * 128 + 16 * m + fr) * 128 + 32 * ks + 8 * fq));
                acc[m] = __builtin_amdgcn_mfma_f32_16x16x32_bf16(vf[ks], wf, acc[m], 0, 0, 0); } }
        const f32x4 vn = *(const f32x4*)(vnorm + cw + 4 * fq);
#pragma unroll
        for (int m = 0; m < 8; ++m) { const int t = 16 * m + fr; const size_t row = (size_t)(row0 + t); const float bias = bs[g * 128 + t];
            const u32x2 uu = *(const u32x2*)(Z + row * 4096 + cw + 4 * fq);
            const float o0 = bf_lo(uu.x) * (acc[m][0] * vn[0] + bias), o1 = bf_hi(uu.x) * (acc[m][1] * vn[1] + bias), o2 = bf_lo(uu.y) * (acc[m][2] * vn[2] + bias), o3 = bf_hi(uu.y) * (acc[m][3] * vn[3] + bias);
            u32x2 w; w.x = pk2(o0, o1); w.y = pk2(o2, o3); *(u32x2*)(GATED + row * DM + cw + 4 * fq) = w; }
    }
}
__device__ __forceinline__ void conv_phase(const bf16_t* BIG, const float* cw, const float* cb, bf16_t* ACT) {
    constexpr int NQ = FF / 8, RS = 32, NTASK = NQ * (MT / RS);
    const int tid_ = opaque_tid();
    for (int T = blockIdx.x * NTHREADS + tid_; T < NTASK; T += gridDim.x * NTHREADS) {
        const int q = T % NQ, strip = T / NQ, j0 = 8 * q, pg = (q >> 4) * 256 + (q & 15) * 8, row0 = strip * RS;
        float wg[3][8], wv[3][8], bg[8], bv[8];
#pragma unroll
        for (int k = 0; k < 3; ++k)
#pragma unroll
            for (int e = 0; e < 8; ++e) { wg[k][e] = cw[(size_t)k * FF2 + j0 + e]; wv[k][e] = cw[(size_t)k * FF2 + FF + j0 + e]; }
#pragma unroll
        for (int e = 0; e < 8; ++e) { bg[e] = cb[j0 + e]; bv[e] = cb[FF + j0 + e]; }
        const bf16_t* src = BIG + (size_t)row0 * FF2 + pg; bf16_t* dst = ACT + (size_t)row0 * FF + j0;
        u32x4 g2 = {0u, 0u, 0u, 0u}, g1 = g2, v2 = g2, v1 = g2;
        if ((row0 & (SEQ - 1)) != 0) { g2 = *(const u32x4*)(src - 2 * (size_t)FF2); v2 = *(const u32x4*)(src - 2 * (size_t)FF2 + 128); g1 = *(const u32x4*)(src - (size_t)FF2); v1 = *(const u32x4*)(src - (size_t)FF2 + 128); }
        for (int i0 = 0; i0 < RS; i0 += 8) {
            u32x4 gc[8], vc[8];
#pragma unroll
            for (int i = 0; i < 8; ++i) { gc[i] = *(const u32x4*)(src + (size_t)(i0 + i) * FF2); vc[i] = *(const u32x4*)(src + (size_t)(i0 + i) * FF2 + 128); }
#pragma unroll
            for (int i = 0; i < 8; ++i) { u32x4 o;
#pragma unroll
                for (int p = 0; p < 4; ++p) {
                    const float ga = wg[0][2 * p] * bf_lo(g2[p]) + wg[1][2 * p] * bf_lo(g1[p]) + wg[2][2 * p] * bf_lo(gc[i][p]) + bg[2 * p];
                    const float gb = wg[0][2 * p + 1] * bf_hi(g2[p]) + wg[1][2 * p + 1] * bf_hi(g1[p]) + wg[2][2 * p + 1] * bf_hi(gc[i][p]) + bg[2 * p + 1];
                    const float va = wv[0][2 * p] * bf_lo(v2[p]) + wv[1][2 * p] * bf_lo(v1[p]) + wv[2][2 * p] * bf_lo(vc[i][p]) + bv[2 * p];
                    const float vb = wv[0][2 * p + 1] * bf_hi(v2[p]) + wv[1][2 * p + 1] * bf_hi(v1[p]) + wv[2][2 * p + 1] * bf_hi(vc[i][p]) + bv[2 * p + 1];
                    const float sa = ga * __builtin_amdgcn_rcpf(1.0f + __builtin_amdgcn_exp2f(-1.4426950408889634f * ga)), sb = gb * __builtin_amdgcn_rcpf(1.0f + __builtin_amdgcn_exp2f(-1.4426950408889634f * gb));
                    o[p] = pk2(sa * va, sb * vb); }
                *(u32x4*)(dst + (size_t)(i0 + i) * FF) = o; g2 = g1; g1 = gc[i]; v2 = v1; v1 = vc[i]; }
        }
    }
}

typedef const Args __attribute__((address_space(4))) CArgs;
__device__ __forceinline__ CArgs* kargs() { CArgs* p = (CArgs*)__builtin_amdgcn_kernarg_segment_ptr(); asm volatile("" : "+s"(p)); return p; }
#define PTRS \
    CArgs* ap_ = kargs(); unsigned char* ws = ap_->ws; float* h = ap_->out; (void)ws; (void)h; \
    const float* x = ap_->in[0]; const float* a_norm = ap_->in[1]; const float* a_w_in = ap_->in[2]; const float* a_v_norm = ap_->in[3]; const float* a_w_s = ap_->in[4]; const float* a_b_s = ap_->in[5]; \
    const float* a_w_out = ap_->in[6]; const float* kv_norm = ap_->in[7]; const float* w_kvf = ap_->in[8]; const float* b_f = ap_->in[9]; const float* k_norm = ap_->in[10]; const float* b_norm = ap_->in[11]; \
    const float* b_w_qg = ap_->in[12]; const float* q_norm = ap_->in[13]; const float* b_w_out = ap_->in[14]; const float* f_norm = ap_->in[15]; const float* f_w_up = ap_->in[16]; const float* f_conv_w = ap_->in[17]; \
    const float* f_conv_b = ap_->in[18]; const float* f_w_down = ap_->in[19]; const float* final_norm = ap_->in[20]; \
    (void)x; (void)a_norm; (void)a_w_in; (void)a_v_norm; (void)a_w_s; (void)a_b_s; (void)a_w_out; (void)kv_norm; (void)w_kvf; (void)b_f; (void)k_norm; (void)b_norm; (void)b_w_qg; (void)q_norm; (void)b_w_out; \
    (void)f_norm; (void)f_w_up; (void)f_conv_w; (void)f_conv_b; (void)f_w_down; (void)final_norm; \
    float* VSS = (float*)(ws + WS_SSP); float* LOGF = (float*)(ws + WS_LOGF); unsigned long long* CA = (unsigned long long*)(ws + WS_CA); \
    bf16_t* WSB = (bf16_t*)(ws + WS_WSB); bf16_t* WFH = (bf16_t*)(ws + WS_WF); bf16_t* WFL = WFH + 16 * DM; \
    bf16_t* W_AIN = (bf16_t*)(ws + WS_W_AIN); bf16_t* W_AOUT = (bf16_t*)(ws + WS_W_AOUT); bf16_t* W_KV = (bf16_t*)(ws + WS_W_KV); bf16_t* W_QG = (bf16_t*)(ws + WS_W_QG); \
    bf16_t* W_BOUT = (bf16_t*)(ws + WS_W_BOUT); bf16_t* W_UP = (bf16_t*)(ws + WS_W_UP); bf16_t* W_DN = (bf16_t*)(ws + WS_W_DN); \
    bf16_t* HB = (bf16_t*)(ws + WS_XN); float* RSS = (float*)(ws + WS_XN2); bf16_t* KVB = (bf16_t*)(ws + WS_KV); bf16_t* BIG = (bf16_t*)(ws + WS_BIG); bf16_t* ACT = (bf16_t*)(ws + WS_ACT); \
    (void)VSS; (void)LOGF; (void)CA; (void)WSB; (void)WFH; (void)WFL; (void)W_AIN; (void)W_AOUT; (void)W_KV; (void)W_QG; (void)W_BOUT; (void)W_UP; (void)W_DN; (void)HB; (void)RSS; (void)KVB; (void)BIG; (void)ACT;
typedef pg8::EpiBf<1, true> EPI_A1; typedef pg8::EpiBf<0, true, true> EPI_KV; typedef pg8::EpiBf<2, true> EPI_QG; typedef pg8::EpiBf<0, true> EPI_UP;
#define GEMM_PHASE(EPI, Aptr, Bptr, NN, KK, ...) do { pg8::Gemm g_{Aptr, Bptr, MT, NN, KK}; pg8::StaticOrder S_; S_.init(MT, NN, G, (int)blockIdx.x); EPI E_{__VA_ARGS__}; \
    pg8::gemm_phase<EPI, pg8::StaticOrder, true, true>(ldsp, g_, S_, E_); } while (0)

__global__ void __launch_bounds__(NTHREADS, 2) fwd_megakernel(Args a) {
    extern __shared__ __attribute__((aligned(16))) unsigned char lds[];
    cg::grid_group grid = cg::this_grid();
#define GSYNC_CG() do { asm volatile("s_waitcnt vmcnt(0)" ::: "memory"); grid.sync(); } while (0)
#define GSYNC() xcd_barrier(xbar)
    const int wave = __builtin_amdgcn_readfirstlane(threadIdx.x >> 6);
    const int G = gridDim.x, gw = blockIdx.x * NWAVES + wave, NGW = G * NWAVES;
    LAS unsigned char* ldsp = (LAS unsigned char*)lds;
    if (threadIdx.x < 16) ((LAS unsigned*)(ldsp + MISC_OFF))[threadIdx.x] = 0u;
    __syncthreads();
    const XcdBarrier xbar = xcd_barrier_post((unsigned*)(kargs()->ws + WS_BAR), (volatile LAS unsigned*)(ldsp + MISC_OFF));

    {
        PTRS
        const int tid = opaque_tid(), lane = tid & 63;
        const int gt = blockIdx.x * NTHREADS + tid, NGT = G * NTHREADS;
        for (int i = gt; i < 2 * NG * CH * CH / 8; i += NGT) {
            const int e0 = i * 8, s0 = e0 & 127, t = (e0 >> 7) & 127; const f32x4 w0 = *(const f32x4*)(a_w_s + e0), w1 = *(const f32x4*)(a_w_s + e0 + 4);
            float y[8] = {w0.x, w0.y, w0.z, w0.w, w1.x, w1.y, w1.z, w1.w};
#pragma unroll
            for (int e = 0; e < 8; ++e) if (s0 + e > t) y[e] = 0.f;
            u32x4 o; o.x = pk2(y[0], y[1]); o.y = pk2(y[2], y[3]); o.z = pk2(y[4], y[5]); o.w = pk2(y[6], y[7]); *(u32x4*)(WSB + e0) = o; }
        for (int i = gt; i < 16 * DM; i += NGT) { const int n = i / DM, k = i % DM; const float w = kv_norm[k] * w_kvf[(size_t)k * 4112 + 4096 + n];
            const unsigned hi = pk2(w, 0.f) & 0xffffu; WFH[i] = (bf16_t)hi; WFL[i] = (bf16_t)(pk2(w - bf_lo(hi), 0.f) & 0xffffu); }
        LAS float* scr = (LAS float*)(ldsp + wave * TR_LDS_PER_WAVE);
        for (int it = gw; it < 48128 * (PROBE == 4 ? 2 : 1); it += NGW) {
            int r = it % 48128, K = DM, ld, ncols, mode = 0; const float* W; const float* g = nullptr; bf16_t* WT;
            if (r < 4096) { const int l = r >> 11; r &= 2047; W = a_w_in + (size_t)l * DM * 4096; g = a_norm + l * DM; WT = W_AIN + (size_t)l * 4096 * DM; ld = 4096; ncols = 4096; }
            else if ((r -= 4096) < 2048) { const int l = r >> 10; r &= 1023; W = a_w_out + (size_t)l * DM * DM; WT = W_AOUT + (size_t)l * DM * DM; ld = DM; ncols = DM; }
            else if ((r -= 2048) < 2048) { W = w_kvf; g = kv_norm; WT = W_KV; ld = 4112; ncols = 4096; }
            else if ((r -= 2048) < 4096) { const int l = r >> 11; r &= 2047; W = b_w_qg + (size_t)l * DM * 4096; g = b_norm + l * DM; WT = W_QG + (size_t)l * 4096 * DM; ld = 4096; ncols = 4096; }
            else if ((r -= 4096) < 2048) { const int l = r >> 10; r &= 1023; W = b_w_out + (size_t)l * DM * DM; WT = W_BOUT + (size_t)l * DM * DM; ld = DM; ncols = DM; }
            else if ((r -= 2048) < 22528) { const int l = r / 5632; r -= l * 5632; W = f_w_up + (size_t)l * DM * FF2; g = f_norm + l * DM; WT = W_UP + (size_t)l * FF2 * DM; ld = FF2; ncols = FF2; mode = 1; }
            else { r -= 22528; const int l = r / 2816; r -= l * 2816; W = f_w_down + (size_t)l * FF * DM; WT = W_DN + (size_t)l * DM * FF; K = FF; ld = DM; ncols = DM; }
            transpose_item(W, K, ld, ncols, g, WT, mode, scr, r, lane);
        }
        for (int m = gw; m < MT; m += NGW) {
            const f32x4* xr = (const f32x4*)(x + (size_t)m * DM) + lane; u32x2* o = (u32x2*)(HB + (size_t)m * DM) + lane; float sq = 0.f;
#pragma unroll
            for (int j = 0; j < 8; ++j) { const f32x4 v = xr[64 * j]; sq += (v.x * v.x + v.y * v.y) + (v.z * v.z + v.w * v.w); u32x2 w; w.x = pk2(v.x, v.y); w.y = pk2(v.z, v.w); o[64 * j] = w; }
            sq = wave_sum(sq); if (lane < 32) RSS[(size_t)m * 32 + lane] = lane == 0 ? sq : 0.f;
        }
    }
    GSYNC_CG();

    for (int l = 0; l < 4; ++l) {
        if (l < 2) {
            { PTRS GEMM_PHASE(EPI_A1, HB, W_AIN + (size_t)l * 4096 * DM, 4096, DM, BIG, 4096, 8, VSS, RSS); }
            GSYNC();
            for (int rep_ = 0; rep_ < (PROBE == 6 ? 2 : 1); ++rep_) { if (rep_) GSYNC();
            { PTRS const int lane = opaque_tid() & 63;
              spatial_phase(ldsp, BIG, VSS, WSB + (size_t)l * NG * CH * CH, a_v_norm + (size_t)l * DM, a_b_s + (size_t)l * NG * CH, ACT, wave, lane); } }
            GSYNC();
        } else {
            const int j = l - 2;
            if (j == 0) { PTRS const int lane = opaque_tid() & 63; fgate_rows(h, WFH, WFL, b_f, LOGF, gw, NGW, lane);
                          GEMM_PHASE(EPI_KV, HB, W_KV, 4096, DM, KVB, 4096, 1 << 30, nullptr, RSS); }
            { PTRS GEMM_PHASE(EPI_QG, HB, W_QG + (size_t)j * 4096 * DM, 4096, DM, BIG, 4096, 8, nullptr, RSS); }
            GSYNC();
            { PTRS const int lane = opaque_tid() & 63;
              if (j == 0) { if (blockIdx.x < 8) scan_seq(LOGF, CA, blockIdx.x * 8 + wave, lane); headnorm_rows(KVB, 2048, k_norm, gw, NGW, lane); }
              headnorm_rows(BIG, 4096, q_norm + (size_t)j * HD, gw, NGW, lane); }
            GSYNC();
            for (int rep_ = 0; rep_ < (PROBE == 2 ? 2 : 1); ++rep_) {
            { PTRS att::AttnT T{(const att::bf16*)BIG, (const att::bf16*)KVB, (const att::bf16*)(KVB + (size_t)MT * 2048), (att::bf16*)ACT, BIG + 2048, CA};
              att::attn_phase((char*)lds, T, NB, NH, SEQ); }
            GSYNC(); }
        }
        { PTRS const bf16_t* Wt = l < 2 ? W_AOUT + (size_t)l * DM * DM : W_BOUT + (size_t)(l - 2) * DM * DM;
          GEMM_PHASE(pg8::EpiRes, ACT, Wt, DM, DM, l == 0 ? x : (const float*)h, h, HB, RSS, DM); }
        GSYNC();
        { PTRS GEMM_PHASE(EPI_UP, HB, W_UP + (size_t)l * FF2 * DM, FF2, DM, BIG, FF2, 1 << 30, nullptr, RSS); }
        GSYNC();
#if PROBE == 1
        { PTRS GEMM_PHASE(EPI_UP, HB, W_UP + (size_t)l * FF2 * DM, FF2, DM, BIG, FF2, 1 << 30, nullptr, RSS); }
        GSYNC();
#endif
        { PTRS conv_phase(BIG, f_conv_w + (size_t)l * 3 * FF2, f_conv_b + (size_t)l * FF2, ACT); }
        GSYNC();
#if PROBE == 3
        { PTRS conv_phase(BIG, f_conv_w + (size_t)l * 3 * FF2, f_conv_b + (size_t)l * FF2, ACT); }
        GSYNC();
#endif
        { PTRS GEMM_PHASE(pg8::EpiRes, ACT, W_DN + (size_t)l * DM * FF, DM, FF, h, h, HB, RSS, DM); }
        GSYNC();
    }
#if PROBE == 7
    for (int rep_ = 0; rep_ < 20; ++rep_) GSYNC();
#endif
    { PTRS const int lane = opaque_tid() & 63; norm_rows<true>(h, final_norm, h, gw, NGW, lane); }
}

extern "C" void kernel_launch(void* const* d_in, const int* in_sizes, int n_in, void* d_out, int out_size, void* d_ws, size_t ws_size, hipStream_t stream) {
    static int grid = 0;
    if (grid == 0) {
        if (n_in != 21 || out_size != MT * DM || ws_size < WS_END) { fprintf(stderr, "kernel_launch: unexpected shapes (n_in %d out %d ws %zu, need ws >= %zu)\n", n_in, out_size, ws_size, (size_t)WS_END); grid = -1; return; }
        int dev = 0, cus = 0, per_cu = 0;
        (void)hipGetDevice(&dev); (void)hipDeviceGetAttribute(&cus, hipDeviceAttributeMultiprocessorCount, dev);
        (void)hipFuncSetAttribute((const void*)fwd_megakernel, hipFuncAttributeMaxDynamicSharedMemorySize, LDS_BYTES);
        (void)hipOccupancyMaxActiveBlocksPerMultiprocessor(&per_cu, (const void*)fwd_megakernel, NTHREADS, LDS_BYTES);
        if (per_cu < 1) { fprintf(stderr, "kernel_launch: occupancy query says %d blocks per CU\n", per_cu); per_cu = 1; }
        grid = cus * 1;
        (void)hipGetLastError();
    }
    if (grid < 0) return;
    (void)hipMemsetAsync((char*)d_ws + WS_BAR, 0, BAR_ZERO_BYTES, stream);
    Args a{};
    for (int i = 0; i < 21; ++i) a.in[i] = (const float*)d_in[i];
    a.out = (float*)d_out; a.ws = (unsigned char*)d_ws;
    void* args[] = {&a};
    hipError_t e = hipLaunchCooperativeKernel((const void*)fwd_megakernel, dim3(grid), dim3(NTHREADS), args, LDS_BYTES, stream);
    if (e != hipSuccess) fprintf(stderr, "cooperative launch failed: %s (grid %d)\n", hipGetErrorString(e), grid);
}
```

```cpp
#include <hip/hip_runtime.h>
#include <hip/hip_cooperative_groups.h>
#include <hip/hip_bf16.h>
#include <cstdio>
#include <cstdint>
namespace cg = cooperative_groups;
#ifndef PROBE
#define PROBE 0
#endif
__device__ __forceinline__ int opaque_tid() { int t = threadIdx.x; asm volatile("" : "+v"(t)); return t; }
namespace pg8 {
#define PG8_LAS __attribute__((address_space(3)))
typedef unsigned short bf16_t;
typedef short bf16x8 __attribute__((ext_vector_type(8)));
typedef float f32x4 __attribute__((ext_vector_type(4)));
typedef unsigned u32x4 __attribute__((ext_vector_type(4)));
constexpr int BM = 256, BK = 64, HALF = 128, HTB = HALF * BK * 2  , STAGE_BYTES = 8 * HTB, NXCD = 8, WGM = 8;

__host__ __device__ __forceinline__ int lds_byte(int r, int c) { const int st = (r >> 4) * 2 + (c >> 5), rr = r & 15, cc = c & 31, ob = rr * 64 + cc * 2; return st * 1024 + (ob ^ (((ob >> 9) & 1) << 5)); }
__host__ __device__ __forceinline__ void stage_rc(int b, int& R, int& C) { const int st = b / 1024, sb = b % 1024, swz = sb ^ (((sb >> 9) & 1) << 5); R = (st >> 1) * 16 + swz / 64; C = (st & 1) * 32 + (swz % 64) / 2; }
__host__ __device__ __forceinline__ int perm32(int rho) { const int n = rho >> 4, i = rho & 15; return 8 * (i >> 2) + 4 * n + (i & 3); }

struct Unit { int pm, pn; };
struct Gemm { const bf16_t* A; const bf16_t* Bt; int M, N, K; };

struct StaticOrder {
    int nM, nN, nwg, G, c;
    __host__ __device__ void init(int M, int N, int G_, int c_) { nM = M / BM; nN = N / BM; nwg = nM * nN; G = G_; c = c_; }
    __host__ __device__ bool next(int i, Unit& u) const {
        const long L = (long)i * G + c; if (L >= nwg) return false;
        int wgid = (int)L; { const int q = nwg / NXCD, r = nwg % NXCD, xcd = wgid % NXCD, off = wgid / NXCD; wgid = (xcd < r ? xcd * (q + 1) : r * (q + 1) + (xcd - r) * q) + off; }
        const int nig = WGM * nN, gid = wgid / nig, fm = gid * WGM, gsz = (nM - fm) < WGM ? (nM - fm) : WGM;
        u.pm = fm + ((wgid % nig) % gsz); u.pn = (wgid % nig) / gsz; return true;
    }
    __device__ __forceinline__ void a_ready(const Unit&) const {}
    __device__ __forceinline__ void done(const Unit&) const {}
};

__device__ __forceinline__ unsigned cvt_pk_bf16(float lo, float hi) { unsigned r; asm volatile("v_cvt_pk_bf16_f32 %0, %1, %2" : "=v"(r) : "v"(lo), "v"(hi)); return r; }
typedef float f32x2 __attribute__((ext_vector_type(2)));
__device__ __forceinline__ f32x2 gelu_pk(f32x2 v) {
    const f32x2 av = __builtin_elementwise_abs(v), d = av * 0.2316418882f + 1.0f;
    f32x2 t; t.x = __builtin_amdgcn_rcpf(d.x); t.y = __builtin_amdgcn_rcpf(d.y);
    f32x2 q = t * 0.5307027145f + (-0.7265760135f); q = q * t + 0.7107068705f; q = q * t + (-0.142248368f); q = q * t + 0.127414796f; q = q * t;
    const f32x2 s = (v * v) * (-0.72134752044f);
    f32x2 e; e.x = __builtin_amdgcn_exp2f(s.x); e.y = __builtin_amdgcn_exp2f(s.y);
    const f32x2 m = v * (q * e), r = v - m;
    f32x2 o; o.x = v.x < 0.f ? m.x : r.x; o.y = v.y < 0.f ? m.y : r.y; return o;
}
constexpr float RS_INV = 1.0f / 2048.0f, RS_EPS = 1e-6f;
template <int MODE, bool RSCALE, bool HEADMAJOR = false, bool HN = false> struct EpiBf {
    static constexpr bool PERM = true, AFTER_DRAIN = false, IDEMPOTENT = true;
    bf16_t* O; int ldc; int split_pn; float* ss; const float* rs; const float* hgain; PG8_LAS float* xs;
    __device__ __forceinline__ void operator()(const f32x4 (&acc)[2][2][4][2], const Unit& u, int wr, int wc, int fr, int fq) const {
        const int row0 = u.pm * BM + wr * 64 + fr, col0 = u.pn * BM + wc * 32 + 8 * fq;
        const bool up = u.pn >= split_pn;
        float rr[2][4];
#pragma unroll
        for (int ai = 0; ai < 2; ++ai)
#pragma unroll
            for (int m = 0; m < 4; ++m) { rr[ai][m] = 1.f;
                if (RSCALE) { const f32x4* p = (const f32x4*)(rs + (size_t)(row0 + ai * HALF + m * 16) * 32 + fq * 8); const f32x4 a = p[0], b = p[1];
                    float t = ((a[0] + a[1]) + (a[2] + a[3])) + ((b[0] + b[1]) + (b[2] + b[3])); t += __shfl_xor(t, 16); t += __shfl_xor(t, 32); rr[ai][m] = 1.0f / sqrtf(t * RS_INV + RS_EPS); } }
        f32x4 hg0 = {1.f, 1.f, 1.f, 1.f}, hg1 = hg0; const bool hn = HN && u.pn < 8;
        if (HN) { if (hn) {
#pragma unroll
            for (int ai = 0; ai < 2; ++ai)
#pragma unroll
                for (int m = 0; m < 4; ++m)
#pragma unroll
                    for (int bj = 0; bj < 2; ++bj) { const f32x4 v0 = acc[ai][bj][m][0] * rr[ai][m], v1 = acc[ai][bj][m][1] * rr[ai][m];
                        float t = ((v0[0] * v0[0] + v0[1] * v0[1]) + (v0[2] * v0[2] + v0[3] * v0[3])) + ((v1[0] * v1[0] + v1[1] * v1[1]) + (v1[2] * v1[2] + v1[3] * v1[3]));
                        t += __shfl_xor(t, 16); t += __shfl_xor(t, 32);
                        if (fq == 0) xs[(ai * HALF + wr * 64 + m * 16 + fr) * 8 + bj * 4 + wc] = t; }
            asm volatile("s_waitcnt lgkmcnt(0)" ::: "memory"); __builtin_amdgcn_s_barrier(); asm volatile("" ::: "memory");
            hg0 = *(const f32x4*)(hgain + wc * 32 + 8 * fq); hg1 = *(const f32x4*)(hgain + wc * 32 + 8 * fq + 4);
        } }
#pragma unroll
        for (int ai = 0; ai < 2; ++ai)
#pragma unroll
            for (int m = 0; m < 4; ++m) { const int row = row0 + ai * HALF + m * 16; float s = 0.f; float hnr[2] = {1.f, 1.f};
                if (HN) { if (hn) { const PG8_LAS f32x4* xp = (const PG8_LAS f32x4*)(xs + (ai * HALF + wr * 64 + m * 16 + fr) * 8); const f32x4 a = xp[0], b = xp[1];
                    hnr[0] = 1.0f / sqrtf(((a[0] + a[1]) + (a[2] + a[3])) * (1.0f / 128.0f) + RS_EPS); hnr[1] = 1.0f / sqrtf(((b[0] + b[1]) + (b[2] + b[3])) * (1.0f / 128.0f) + RS_EPS); } }
                bf16_t* rowp = HEADMAJOR ? O + (u.pn >= 8 ? (size_t)16384 * 2048 : (size_t)0) + ((size_t)((row >> 12) * 16 + 2 * (u.pn & 7)) * 4096 + (row & 4095)) * 128 + wc * 32 + 8 * fq
                                         : O + (size_t)row * ldc + col0;
#pragma unroll
                for (int bj = 0; bj < 2; ++bj) { f32x4 v0 = acc[ai][bj][m][0], v1 = acc[ai][bj][m][1];
                    if (RSCALE) { v0 = v0 * rr[ai][m]; v1 = v1 * rr[ai][m]; }
                    if (HN) { if (hn) { v0 = (v0 * hnr[bj]) * hg0; v1 = (v1 * hnr[bj]) * hg1; } }
                    if (MODE == 1) { f32x2 a = gelu_pk((f32x2){v0[0], v0[1]}), b = gelu_pk((f32x2){v0[2], v0[3]}), c = gelu_pk((f32x2){v1[0], v1[1]}), d = gelu_pk((f32x2){v1[2], v1[3]});
                        v0 = (f32x4){a.x, a.y, b.x, b.y}; v1 = (f32x4){c.x, c.y, d.x, d.y};
                        s += (v0[0] * v0[0] + v0[1] * v0[1]) + (v0[2] * v0[2] + v0[3] * v0[3]) + (v1[0] * v1[0] + v1[1] * v1[1]) + (v1[2] * v1[2] + v1[3] * v1[3]); }
                    if (MODE == 2) { if (up) {
#pragma unroll
                        for (int e = 0; e < 4; ++e) { v0[e] = __builtin_amdgcn_rcpf(1.0f + __builtin_amdgcn_exp2f(-1.4426950408889634f * v0[e])); v1[e] = __builtin_amdgcn_rcpf(1.0f + __builtin_amdgcn_exp2f(-1.4426950408889634f * v1[e])); } } }
                    u32x4 w; w.x = cvt_pk_bf16(v0[0], v0[1]); w.y = cvt_pk_bf16(v0[2], v0[3]); w.z = cvt_pk_bf16(v1[0], v1[1]); w.w = cvt_pk_bf16(v1[2], v1[3]);
                    *(u32x4*)(rowp + (HEADMAJOR ? (size_t)bj * 4096 * 128 : (size_t)bj * HALF)) = w; }
                if (MODE == 1) { if (up) { s += __shfl_xor(s, 16); s += __shfl_xor(s, 32); if (fq == 0) ss[(size_t)row * 32 + (u.pn - split_pn) * 4 + wc] = s; } } }
    }
};
struct EpiRes {
    static constexpr bool PERM = true, AFTER_DRAIN = false, IDEMPOTENT = false;
    const float* base; float* out; bf16_t* hb; float* rss; int ldc;
    __device__ __forceinline__ void operator()(const f32x4 (&acc)[2][2][4][2], const Unit& u, int wr, int wc, int fr, int fq) const {
        const int row0 = u.pm * BM + wr * 64 + fr, col0 = u.pn * BM + wc * 32 + 8 * fq;
#pragma unroll
        for (int ai = 0; ai < 2; ++ai)
#pragma unroll
            for (int m = 0; m < 4; ++m) { const int row = row0 + ai * HALF + m * 16; const size_t off = (size_t)row * ldc + col0; f32x4 b[2][2]; float s = 0.f;
#pragma unroll
                for (int bj = 0; bj < 2; ++bj)
#pragma unroll
                    for (int n = 0; n < 2; ++n) b[bj][n] = *(const f32x4*)(base + off + bj * HALF + n * 4);
#pragma unroll
                for (int bj = 0; bj < 2; ++bj) { const f32x4 o0 = b[bj][0] + acc[ai][bj][m][0], o1 = b[bj][1] + acc[ai][bj][m][1];
                    *(f32x4*)(out + off + bj * HALF) = o0; *(f32x4*)(out + off + bj * HALF + 4) = o1;
                    u32x4 w; w.x = cvt_pk_bf16(o0[0], o0[1]); w.y = cvt_pk_bf16(o0[2], o0[3]); w.z = cvt_pk_bf16(o1[0], o1[1]); w.w = cvt_pk_bf16(o1[2], o1[3]);
                    *(u32x4*)(hb + off + bj * HALF) = w;
                    s += ((o0[0] * o0[0] + o0[1] * o0[1]) + (o0[2] * o0[2] + o0[3] * o0[3])) + ((o1[0] * o1[0] + o1[1] * o1[1]) + (o1[2] * o1[2] + o1[3] * o1[3])); }
                s += __shfl_xor(s, 16); s += __shfl_xor(s, 32); if (fq == 0) rss[(size_t)row * 32 + u.pn * 4 + wc] = s;
                if (m & 1) asm volatile("" ::: "memory"); }
    }
};
template <class Epi, class Sched, bool ALIGN_EPI = false, bool SP2 = false>
__device__ __forceinline__ void gemm_phase(PG8_LAS unsigned char* lds, const Gemm g, const Sched& S, const Epi& E) {
    const int tid = opaque_tid(), wid = __builtin_amdgcn_readfirstlane(tid >> 6), lane = tid & 63, wr = wid >> 2, wc = wid & 3, fr = lane & 15, fq = lane >> 4;
    const int K = g.K, nt = K / BK;
    unsigned voffA[2], voffB[2];
#pragma unroll
    for (int i = 0; i < 2; ++i) { int R, C; stage_rc(tid * 16 + i * 8192, R, C); const int Rb = Epi::PERM ? ((R & ~31) + perm32(R & 31)) : R;
        voffA[i] = (unsigned)(R * K + C) * 2u; voffB[i] = (unsigned)(Rb * K + C) * 2u; }
    const size_t kstep = (size_t)(BK * 2);
    const size_t hstep = (size_t)HALF * K * 2;
    const size_t tstep = 2 * hstep;
    const unsigned ldsw = (unsigned)wid * 1024u;
    const int aoff = lds_byte(wr * 64 + fr, fq * 8), boff = lds_byte(wc * 32 + fr, fq * 8);
#define PG8_SA(b, h) (((b) * 2 + (h)) * HTB)
#define PG8_SB(b, h) ((4 + (b) * 2 + (h)) * HTB)
#define PG8_STAGE(bufoff, gbase, voff) do { _Pragma("unroll") for (int _i = 0; _i < 2; ++_i) \
        __builtin_amdgcn_global_load_lds((const unsigned*)((const char*)(gbase) + (voff)[_i]), (PG8_LAS unsigned*)(lds + (bufoff) + ldsw + _i * 8192), 16, 0, 0); } while (0)
#define PG8_LDA(dst, b, h) do { _Pragma("unroll") for (int m = 0; m < 4; ++m) _Pragma("unroll") for (int k = 0; k < 2; ++k) dst[m][k] = *(const PG8_LAS bf16x8*)(lds + PG8_SA(b, h) + aoff + m * 2048 + k * 1024); } while (0)
#define PG8_LDB(dst, b, h) do { _Pragma("unroll") for (int n = 0; n < 2; ++n) _Pragma("unroll") for (int k = 0; k < 2; ++k) dst[n][k] = *(const PG8_LAS bf16x8*)(lds + PG8_SB(b, h) + boff + n * 2048 + k * 1024); } while (0)
#define PG8_MMA(ai, bj, At, Bt) do { __builtin_amdgcn_s_setprio(1); _Pragma("unroll") for (int m = 0; m < 4; ++m) _Pragma("unroll") for (int n = 0; n < 2; ++n) _Pragma("unroll") for (int k = 0; k < 2; ++k) \
        acc[ai][bj][m][n] = __builtin_amdgcn_mfma_f32_16x16x32_bf16(Bt[n][k], At[m][k], acc[ai][bj][m][n], 0, 0, 0); __builtin_amdgcn_s_setprio(0); } while (0)
#define PG8_WAIT_V(n) asm volatile("s_waitcnt vmcnt(" #n ")" ::: "memory")
#define PG8_WAIT_L(n) asm volatile("s_waitcnt lgkmcnt(" #n ")" ::: "memory")
#define PG8_BAR __builtin_amdgcn_s_barrier()
#define PG8_SCHED __builtin_amdgcn_sched_barrier(0)
    Unit cur, nxt; int ui = 0;
    if (!S.next(0, cur)) return;
    f32x4 acc[2][2][4][2];
#pragma unroll
    for (int a = 0; a < 2; ++a)
#pragma unroll
        for (int b = 0; b < 2; ++b)
#pragma unroll
            for (int m = 0; m < 4; ++m)
#pragma unroll
                for (int n = 0; n < 2; ++n) acc[a][b][m][n] = (f32x4){0.f, 0.f, 0.f, 0.f};
    bf16x8 At[4][2], B0[2][2], B1[2][2];
    const char* cA = (const char*)g.A + (size_t)cur.pm * tstep; const char* cB = (const char*)g.Bt + (size_t)cur.pn * tstep;
    S.a_ready(cur);
    if constexpr (SP2) {
        PG8_STAGE(PG8_SB(0, 0), cB, voffB); PG8_STAGE(PG8_SB(0, 1), cB + hstep, voffB); PG8_STAGE(PG8_SA(0, 0), cA, voffA); PG8_STAGE(PG8_SA(0, 1), cA + hstep, voffA);
        if (wr == 1) PG8_BAR;
        PG8_WAIT_V(2); PG8_BAR;
        PG8_STAGE(PG8_SB(1, 0), cB + kstep, voffB); PG8_STAGE(PG8_SA(1, 0), cA + kstep, voffA); PG8_STAGE(PG8_SB(1, 1), cB + hstep + kstep, voffB);
        PG8_WAIT_V(6); PG8_BAR;
    } else {
        PG8_STAGE(PG8_SB(0, 0), cB, voffB); PG8_STAGE(PG8_SA(0, 0), cA, voffA); PG8_STAGE(PG8_SB(0, 1), cB + hstep, voffB); PG8_STAGE(PG8_SA(0, 1), cA + hstep, voffA);
        if (wr == 1) PG8_BAR;
        PG8_WAIT_V(4); PG8_BAR;
        PG8_STAGE(PG8_SB(1, 0), cB + kstep, voffB); PG8_STAGE(PG8_SA(1, 0), cA + kstep, voffA); PG8_STAGE(PG8_SB(1, 1), cB + hstep + kstep, voffB);
        PG8_WAIT_V(6); PG8_BAR;
    }
    for (;;) {
        const bool has_next = S.next(ui + 1, nxt);
        const char* nA = has_next ? (const char*)g.A + (size_t)nxt.pm * tstep : cA; const char* nB = has_next ? (const char*)g.Bt + (size_t)nxt.pn * tstep : cB;
        for (int t = 0; t < nt; t += 2) {
            const bool last = (t == nt - 2);
            const char* a1 = cA + (size_t)(t + 1) * kstep;
            const char* a2 = last ? nA : cA + (size_t)(t + 2) * kstep; const char* b2 = last ? nB : cB + (size_t)(t + 2) * kstep;
            const char* a3 = a2 + kstep; const char* b3 = b2 + kstep;
            if (last && has_next) S.a_ready(nxt);
            if constexpr (SP2) {
            PG8_LDB(B0, 0, 0); PG8_LDB(B1, 0, 1); PG8_SCHED; PG8_LDA(At, 0, 0); PG8_STAGE(PG8_SA(1, 1), a1 + hstep, voffA);
            PG8_WAIT_V(8); PG8_WAIT_L(0); PG8_BAR; PG8_MMA(0, 0, At, B0); PG8_MMA(0, 1, At, B1); PG8_BAR; PG8_SCHED;
            PG8_LDA(At, 0, 1); PG8_STAGE(PG8_SB(0, 0), b2, voffB); PG8_STAGE(PG8_SB(0, 1), b2 + hstep, voffB); PG8_STAGE(PG8_SA(0, 0), a2, voffA);
            PG8_WAIT_V(8); PG8_WAIT_L(0); PG8_BAR; PG8_MMA(1, 0, At, B0); PG8_MMA(1, 1, At, B1); PG8_BAR; PG8_SCHED;
            PG8_LDB(B0, 1, 0); PG8_LDB(B1, 1, 1); PG8_SCHED; PG8_LDA(At, 1, 0); PG8_STAGE(PG8_SA(0, 1), a2 + hstep, voffA);
            PG8_WAIT_V(8); PG8_WAIT_L(0); PG8_BAR; PG8_MMA(0, 0, At, B0); PG8_MMA(0, 1, At, B1); PG8_BAR; PG8_SCHED;
            PG8_LDA(At, 1, 1); PG8_STAGE(PG8_SB(1, 0), b3, voffB); PG8_STAGE(PG8_SB(1, 1), b3 + hstep, voffB); PG8_STAGE(PG8_SA(1, 0), a3, voffA);
            PG8_WAIT_V(8); PG8_WAIT_L(0); PG8_BAR; PG8_MMA(1, 0, At, B0); PG8_MMA(1, 1, At, B1); PG8_BAR; PG8_SCHED;
            } else {
            PG8_LDB(B0, 0, 0); PG8_SCHED; PG8_LDA(At, 0, 0); PG8_STAGE(PG8_SA(1, 1), a1 + hstep, voffA);
            PG8_WAIT_L(8); PG8_BAR; PG8_WAIT_L(0); PG8_MMA(0, 0, At, B0); PG8_BAR; PG8_SCHED;
            PG8_LDB(B1, 0, 1); PG8_STAGE(PG8_SB(0, 0), b2, voffB);
            PG8_BAR; PG8_WAIT_L(0); PG8_MMA(0, 1, At, B1); PG8_BAR;
            PG8_LDA(At, 0, 1); PG8_STAGE(PG8_SA(0, 0), a2, voffA);
            PG8_BAR; PG8_WAIT_L(0); PG8_MMA(1, 0, At, B0); PG8_BAR; PG8_SCHED;
            PG8_STAGE(PG8_SB(0, 1), b2 + hstep, voffB);
            PG8_WAIT_V(6); PG8_BAR; PG8_MMA(1, 1, At, B1); PG8_BAR;
            PG8_LDB(B0, 1, 0); PG8_SCHED; PG8_LDA(At, 1, 0); PG8_STAGE(PG8_SA(0, 1), a2 + hstep, voffA);
            PG8_WAIT_L(8); PG8_BAR; PG8_WAIT_L(0); PG8_MMA(0, 0, At, B0); PG8_BAR; PG8_SCHED;
            PG8_LDB(B1, 1, 1); PG8_STAGE(PG8_SB(1, 0), b3, voffB);
            PG8_BAR; PG8_WAIT_L(0); PG8_MMA(0, 1, At, B1); PG8_BAR;
            PG8_LDA(At, 1, 1); PG8_STAGE(PG8_SA(1, 0), a3, voffA);
            PG8_BAR; PG8_WAIT_L(0); PG8_MMA(1, 0, At, B0); PG8_BAR; PG8_SCHED;
            PG8_STAGE(PG8_SB(1, 1), b3 + hstep, voffB);
            PG8_WAIT_V(6); PG8_BAR; PG8_MMA(1, 1, At, B1); PG8_BAR;
            }
        }
        if constexpr (ALIGN_EPI) { if (wr == 0) PG8_BAR; }
        if constexpr (!Epi::AFTER_DRAIN) { E(acc, cur, wr, wc, fr, fq);
#if PROBE == 8
            if constexpr (Epi::IDEMPOTENT) E(acc, cur, wr, wc, fr, fq);
#endif
            S.done(cur); }
        if (!has_next) break;
#pragma unroll
        for (int a = 0; a < 2; ++a)
#pragma unroll
            for (int b = 0; b < 2; ++b)
#pragma unroll
                for (int m = 0; m < 4; ++m)
#pragma unroll
                    for (int n = 0; n < 2; ++n) acc[a][b][m][n] = (f32x4){0.f, 0.f, 0.f, 0.f};
        cur = nxt; cA = nA; cB = nB; ++ui;
        if constexpr (ALIGN_EPI) { if (wr == 1) PG8_BAR; }
    }
    PG8_WAIT_V(0);
    if constexpr (!ALIGN_EPI) { if (wr == 0) PG8_BAR; }
    PG8_BAR;
    if constexpr (Epi::AFTER_DRAIN) { E.fused(acc, cur, wr, wc, fr, fq, lds, wid, lane); S.done(cur); }
#undef PG8_SA
#undef PG8_SB
#undef PG8_STAGE
#undef PG8_LDA
#undef PG8_LDB
#undef PG8_MMA
#undef PG8_WAIT_V
#undef PG8_WAIT_L
#undef PG8_BAR
#undef PG8_SCHED
}
}
namespace att {
constexpr int D = 128, LDQ = 4096, LDK = 128, LDO = 2048, LDG = 4096;
constexpr float THR = 8.f; constexpr bool WSKIP = false;
typedef unsigned u32x4_t __attribute__((ext_vector_type(4)));
typedef short bf16x8_t __attribute__((ext_vector_type(8)));
__device__ __forceinline__ bf16x8_t ka_frag(unsigned lo, unsigned up, int hi) {
    u32x4_t w;
    w.x = 0x3f803f80u; w.y = 0x3f80u | (((lo & 0xffffu) ^ 0x8000u) << 16); w.z = ((lo >> 16) ^ 0x8000u) | (((up & 0xffffu) ^ 0x8000u) << 16); w.w = 0u;
    if (hi) { w.x = 0u; w.y = 0u; w.z = 0u; }
    return __builtin_bit_cast(bf16x8_t, w);
}
__device__ __forceinline__ bf16x8_t qa_frag(unsigned lo, unsigned up, int hi) {
    u32x4_t w;
    w.x = lo; w.y = (up & 0xffffu) | 0x3f800000u; w.z = 0x3f803f80u; w.w = 0u;
    if (hi) { w.x = 0u; w.y = 0u; w.z = 0u; }
    return __builtin_bit_cast(bf16x8_t, w);
}
constexpr float SCALE = 0.08838834764831845f;
constexpr int NW = 8, QBLK = 32, KVBLK = 64, QB = NW * QBLK;
constexpr int SHM_V = KVBLK * D * 2, SHM_K = KVBLK * D * 2;
constexpr int ATT_LDS_BYTES = 2 * SHM_V + 2 * SHM_K + NW * 64 * 4;

using bf16 = __hip_bfloat16;
typedef short bf16x8 __attribute__((ext_vector_type(8)));
typedef short s16x4 __attribute__((ext_vector_type(4)));
typedef float f32x16 __attribute__((ext_vector_type(16)));
typedef float f32x4 __attribute__((ext_vector_type(4)));
typedef unsigned u32x4 __attribute__((ext_vector_type(4)));
template <class A, class Bt> struct same_t { static constexpr bool v = false; };
template <class A> struct same_t<A, A> { static constexpr bool v = true; };

#define KSWZ(row, colB) ((row) * 256 + ((colB) ^ (((row) & 7) << 4)))
#define SBAR() __builtin_amdgcn_sched_barrier(0)
__device__ __forceinline__ int v_st(int k, int c) { const int kk = (k & ~0xC) | ((k & 4) << 1) | ((k & 8) >> 1); return ((kk >> 3) * 4 + (c >> 5)) * 512 + ((kk & 7) * 32 + (c & 31)) * 2; }
__device__ __forceinline__ int v_rd_base(int lane) { return ((lane & 3) << 3) | (((lane >> 2) & 3) << 6) | (((lane >> 4) & 1) << 5) | (((lane >> 5) & 1) << 8); }
constexpr int v_rd_off(int d0, int ks, int half) { return d0 * 512 + ks * 4096 + half * 2048; }
__device__ __forceinline__ int crow(int r, int hi) { return (r & 3) + 8 * (r >> 2) + 4 * hi; }
__device__ __forceinline__ unsigned cvtpk(float lo, float hi) {
    unsigned r; asm volatile("v_cvt_pk_bf16_f32 %0, %1, %2" : "=v"(r) : "v"(lo), "v"(hi)); return r;
}
__device__ __forceinline__ bf16x8 pack8(f32x4 a, f32x4 b) {
    u32x4 w = {cvtpk(a[0], a[1]), cvtpk(a[2], a[3]), cvtpk(b[0], b[1]), cvtpk(b[2], b[3])};
    return *reinterpret_cast<bf16x8*>(&w);
}
template <class T> __device__ __forceinline__ bf16x8 load8(const T* p) {
    if constexpr (same_t<T, float>::v) { return pack8(*(const f32x4*)p, *(const f32x4*)(p + 4)); }
    else { return *reinterpret_cast<const bf16x8*>(p); }
}
__device__ __forceinline__ void mask_tile(f32x16& p0, f32x16& p1, int dq, unsigned W) {
    const float NEG = -__builtin_inff();
#pragma unroll
    for (int r = 0; r < 16; ++r) {
        const int c = (r & 3) + 8 * (r >> 2);
        if ((unsigned)(dq - c) >= W) p0[r] = NEG;
        if ((unsigned)(dq - c - 32) >= W) p1[r] = NEG;
    }
}
__device__ __forceinline__ void partialSM(f32x16& p0, f32x16& p1, float& m_reg, float& mn, float& alpha) {
    float pmax = p0[0]; for (int r = 1; r < 16; ++r) pmax = fmaxf(pmax, p0[r]); for (int r = 0; r < 16; ++r) pmax = fmaxf(pmax, p1[r]);
    { auto rr = __builtin_amdgcn_permlane32_swap(__float_as_uint(pmax), __float_as_uint(pmax), false, false);
      pmax = fmaxf(__uint_as_float(rr[0]), __uint_as_float(rr[1])); }
    constexpr float C2 = 1.4426950408889634f * SCALE;
    if (__builtin_expect(__all((pmax - m_reg) * SCALE <= THR), 1)) { mn = m_reg; alpha = 1.f; }
    else { mn = fmaxf(m_reg, pmax); alpha = __builtin_amdgcn_exp2f((m_reg - mn) * C2); m_reg = mn; }
    const float mnL = -mn * C2;
    for (int r = 0; r < 16; ++r) p0[r] = fmaf(p0[r], C2, mnL); for (int r = 0; r < 16; ++r) p1[r] = fmaf(p1[r], C2, mnL);
    for (int r = 0; r < 16; ++r) p0[r] = __builtin_amdgcn_exp2f(p0[r]);
}
__device__ __forceinline__ void finishSM(f32x16& p0, f32x16& p1, float alpha, float& l_reg, bf16x8& pa0, bf16x8& pa1, bf16x8& pa2, bf16x8& pa3) {
    for (int r = 0; r < 16; ++r) p1[r] = __builtin_amdgcn_exp2f(p1[r]);
    float ps = 0; for (int r = 0; r < 16; ++r) ps += p0[r]; for (int r = 0; r < 16; ++r) ps += p1[r];
    { auto rr = __builtin_amdgcn_permlane32_swap(__float_as_uint(ps), __float_as_uint(ps), false, false);
      ps = __uint_as_float(rr[0]) + __uint_as_float(rr[1]); }
    l_reg = l_reg * alpha + ps;
#define PK4(P, B_, OUT) do { unsigned a0 = cvtpk(P[B_+0], P[B_+1]), a1 = cvtpk(P[B_+2], P[B_+3]);                          \
        unsigned b0 = cvtpk(P[B_+4], P[B_+5]), b1 = cvtpk(P[B_+6], P[B_+7]);                                             \
        auto r0 = __builtin_amdgcn_permlane32_swap(a0, b0, false, false); auto r1 = __builtin_amdgcn_permlane32_swap(a1, b1, false, false); \
        u32x4 w = {r0[0], r1[0], r0[1], r1[1]}; OUT = *reinterpret_cast<bf16x8*>(&w); } while (0)
    PK4(p0, 0, pa0); PK4(p0, 8, pa1); PK4(p1, 0, pa2); PK4(p1, 8, pa3);
#undef PK4
}
template <int KB, bool SK>
__device__ __forceinline__ void qkt(f32x16& p0, f32x16& p1, const char* K_lds, int r32, int hi, const bf16x8* qr, bool act, unsigned long long qa, unsigned long long c) {
    if (SK && !act) { const float NEG = -__builtin_inff();
#pragma unroll
        for (int r = 0; r < 16; ++r) { p0[r] = NEG; p1[r] = NEG; } return; }
    p0 = f32x16{}; p1 = f32x16{};
    const char* kb[4];
#pragma unroll
    for (int dd = 0; dd < 4; ++dd) kb[dd] = K_lds + KB * SHM_K + KSWZ(r32, (dd * 16 + hi * 8) * 2);
#pragma unroll
    for (int d0 = 0; d0 < 8; ++d0) { const char* a = kb[d0 & 3] + (d0 >> 2) * 128;
        bf16x8 b0 = *reinterpret_cast<const bf16x8*>(a);
        bf16x8 b1 = *reinterpret_cast<const bf16x8*>(a + 32 * 256);
        p0 = __builtin_amdgcn_mfma_f32_32x32x16_bf16(b0, qr[d0], p0, 0, 0, 0);
        p1 = __builtin_amdgcn_mfma_f32_32x32x16_bf16(b1, qr[d0], p1, 0, 0, 0); }
    { unsigned ql = (unsigned)qa, qu = (unsigned)(qa >> 32); asm volatile("" : "+v"(ql), "+v"(qu));
      const bf16x8 qaf = qa_frag(ql, qu, hi);
      const unsigned cl = (unsigned)c, cu = (unsigned)(c >> 32);
      auto r0 = __builtin_amdgcn_permlane32_swap(cl, cl, false, false); auto r1 = __builtin_amdgcn_permlane32_swap(cu, cu, false, false);
      p0 = __builtin_amdgcn_mfma_f32_32x32x16_bf16(ka_frag(r0[0], r1[0], hi), qaf, p0, 0, 0, 0);
      p1 = __builtin_amdgcn_mfma_f32_32x32x16_bf16(ka_frag(r0[1], r1[1], hi), qaf, p1, 0, 0, 0); }
}
template <int VB, bool SK>
__device__ __forceinline__ void pv_tile(f32x16* o, int vb0, bf16x8 pa0, bf16x8 pa1, bf16x8 pa2, bf16x8 pa3, bool act) {
    if (SK && !act) return;
#define TRRD(dst, off) asm volatile("ds_read_b64_tr_b16 %0, %1 offset:%2" : "=&v"(dst) : "v"(vb0), "i"(off) : "memory")
#define PV_D0(d0) do { s16x4 l0, l1, l2, l3, h0, h1, h2, h3; constexpr int b_ = VB * SHM_V + v_rd_off(d0, 0, 0);     \
        TRRD(l0, b_); TRRD(h0, b_ + 2048); TRRD(l1, b_ + 4096); TRRD(h1, b_ + 6144); TRRD(l2, b_ + 8192); TRRD(h2, b_ + 10240); TRRD(l3, b_ + 12288); TRRD(h3, b_ + 14336); \
        asm volatile("s_waitcnt lgkmcnt(0)" ::: "memory"); SBAR();                 \
        o[d0] = __builtin_amdgcn_mfma_f32_32x32x16_bf16(pa0, (bf16x8){l0[0], l0[1], l0[2], l0[3], h0[0], h0[1], h0[2], h0[3]}, o[d0], 0, 0, 0);   \
        o[d0] = __builtin_amdgcn_mfma_f32_32x32x16_bf16(pa1, (bf16x8){l1[0], l1[1], l1[2], l1[3], h1[0], h1[1], h1[2], h1[3]}, o[d0], 0, 0, 0);   \
        o[d0] = __builtin_amdgcn_mfma_f32_32x32x16_bf16(pa2, (bf16x8){l2[0], l2[1], l2[2], l2[3], h2[0], h2[1], h2[2], h2[3]}, o[d0], 0, 0, 0);   \
        o[d0] = __builtin_amdgcn_mfma_f32_32x32x16_bf16(pa3, (bf16x8){l3[0], l3[1], l3[2], l3[3], h3[0], h3[1], h3[2], h3[3]}, o[d0], 0, 0, 0); } while (0)
    PV_D0(0); PV_D0(1); PV_D0(2); PV_D0(3);
#undef PV_D0
#undef TRRD
}

template <class TIn, class TOut> struct BlockRef { const TIn* Q; const TIn* K; const TIn* V; TOut* O; const unsigned short* G; const unsigned long long* CA; int P0; };
template <class TIn> struct Seam {
    bf16x8 qr[8];
    bf16x8 st_v0, st_v1, st_k0, st_k1; f32x4 sf0, sf1, sf2, sf3;
    unsigned long long ca, qa;
    f32x4 tq[16];
};
__device__ __forceinline__ int swa_jlo(int P0, int W) { const int lowk = P0 - W + 1; return lowk > 0 ? lowk / KVBLK : 0; }
#define ROW(p, k0, rr) ((p) + (size_t)((k0) + (rr)) * LDK + sc)
#define VMW() asm volatile("s_waitcnt vmcnt(0)" ::: "memory")
#define VMWN(n) asm volatile("s_waitcnt vmcnt(%0)" :: "i"(n) : "memory")
#define SLOAD_H(Kp, Vp, CAp, k0) do { S.st_v0 = load8<TIn>(ROW(Vp, k0, sr)); S.st_v1 = load8<TIn>(ROW(Vp, k0, 32 + sr));              \
                         S.st_k0 = load8<TIn>(ROW(Kp, k0, sr)); S.st_k1 = load8<TIn>(ROW(Kp, k0, 32 + sr)); S.ca = (CAp)[(k0) + lane]; } while (0)
#define SWRITE_HK(bf) do { *(bf16x8*)(K_lds + (bf) * SHM_K + kws) = S.st_k0; *(bf16x8*)(K_lds + (bf) * SHM_K + kws + 32 * 256) = S.st_k1; } while (0)
#define SWRITE_HV(bf) do { *(bf16x8*)(V_lds + (bf) * SHM_V + vst0) = S.st_v0; *(bf16x8*)(V_lds + (bf) * SHM_V + vst1) = S.st_v1; } while (0)
#define SWRITE_H(bf) do { SWRITE_HV(bf); SWRITE_HK(bf); } while (0)
#define SLOAD_F(p, k0) do { S.sf0 = *(const f32x4*)ROW(p, k0, sr); S.sf1 = *(const f32x4*)(ROW(p, k0, sr) + 4);                \
                            S.sf2 = *(const f32x4*)ROW(p, k0, 32 + sr); S.sf3 = *(const f32x4*)(ROW(p, k0, 32 + sr) + 4); } while (0)
#define SWRITE_KF(bf) do { *(bf16x8*)(K_lds + (bf) * SHM_K + kws) = pack8(S.sf0, S.sf1); *(bf16x8*)(K_lds + (bf) * SHM_K + kws + 32 * 256) = pack8(S.sf2, S.sf3); } while (0)
#define SWRITE_VF(bf) do { *(bf16x8*)(V_lds + (bf) * SHM_V + vst0) = pack8(S.sf0, S.sf1); *(bf16x8*)(V_lds + (bf) * SHM_V + vst1) = pack8(S.sf2, S.sf3); } while (0)
template <class TIn, class TOut>
__device__ __forceinline__ void causal_swa_prime(const BlockRef<TIn, TOut>& cur, int W, char* lds, Seam<TIn>& S) {
    constexpr bool F32 = same_t<TIn, float>::v;
    const int tid = opaque_tid(), wid = __builtin_amdgcn_readfirstlane(tid >> 6), lane = tid & 63, r32 = lane & 31, hi = lane >> 5;
    const int sr = tid >> 4, sc = (tid & 15) * 8, kws = KSWZ(sr, sc * 2); char* K_lds = lds + 2 * SHM_V;
    const int kb0 = swa_jlo(cur.P0, W) * KVBLK;
    for (int d0 = 0; d0 < 8; ++d0) S.qr[d0] = load8<TIn>(cur.Q + (size_t)(wid * QBLK + r32) * LDQ + d0 * 16 + hi * 8);
    S.qa = cur.CA[cur.P0 + wid * QBLK + r32];
    if constexpr (F32) { SLOAD_F((const float*)cur.K, kb0); VMW(); SWRITE_KF(0); SBAR(); SLOAD_F((const float*)cur.V, kb0); }
    else { SLOAD_H(cur.K, cur.V, cur.CA, kb0); VMW(); SWRITE_HK(0); }
    __syncthreads();
}
template <class TIn, class TOut>
__device__ __forceinline__ void causal_swa_block(const BlockRef<TIn, TOut>& cur, const BlockRef<TIn, TOut>& nxt, int skv, int W, char* lds, Seam<TIn>& S) {
    constexpr bool F32 = same_t<TIn, float>::v;
    const int tid = opaque_tid(), wid = __builtin_amdgcn_readfirstlane(tid >> 6), lane = tid & 63, r32 = lane & 31, hi = lane >> 5;
    const int j_lo = swa_jlo(cur.P0, W);
    int j_hi = (cur.P0 + QB - 1) / KVBLK + 1; if (j_hi > skv / KVBLK) j_hi = skv / KVBLK;
    const int NT = j_hi - j_lo;
    const int kbn = swa_jlo(nxt.P0, W) * KVBLK;
    const int qlo = cur.P0 + wid * QBLK, qm = qlo + r32 - 4 * hi;
    char* V_lds = lds; char* K_lds = lds + 2 * SHM_V;
    float* ws = (float*)(lds + 2 * SHM_V + 2 * SHM_K) + wid * 64; float* li_l = ws, * al_l = ws + 32;
    float m_reg = -1e30f, l_reg = 0; f32x16 o[4] = {};
    const int sr = tid >> 4, sc = (tid & 15) * 8, vst0 = v_st(sr, sc), vst1 = v_st(32 + sr, sc), kws = KSWZ(sr, sc * 2);
    const int vb0 = (int)(uintptr_t)V_lds + v_rd_base(lane);
    const TIn* Kh = cur.K; const TIn* Vh = cur.V; const unsigned long long* CAh = cur.CA;
#define RESC(a) do { if (__any((a) < 1.f)) { if (hi == 0) al_l[r32] = (a); asm volatile("s_waitcnt lgkmcnt(0)" ::: "memory");              \
                     for (int d_ = 0; d_ < 4; ++d_) for (int r = 0; r < 16; ++r) o[d_][r] *= al_l[crow(r, hi)]; } } while (0)
#define KBASE(t) ((j_lo + (t)) * KVBLK)
#define ACT(t) (KBASE(t) <= qlo + QBLK - 1 && KBASE(t) + KVBLK - 1 >= qlo - W + 1)
#define MASKT(P0_, P1_, t) do { const int kb_ = KBASE(t); if ((!SK || ACT(t)) && (kb_ + KVBLK - 1 > qlo || kb_ <= qlo + QBLK - 1 - W)) mask_tile(P0_, P1_, qm - kb_, (unsigned)W); } while (0)
    constexpr int NQL = F32 ? 16 : 8;
    constexpr bool SK = WSKIP && !F32;
#define SEAM_K0() do { VMWN(NQL); if constexpr (F32) { SWRITE_KF(0); SBAR(); SLOAD_F((const float*)nxt.V, kbn); } else { SWRITE_HK(0); } SBAR(); } while (0)
    f32x16 pA0, pA1, pB0, pB1; float mnA, mnB, alA, alB; bf16x8 pa0, pa1, pa2, pa3;
    if constexpr (F32) { VMW(); SWRITE_VF(0); SBAR(); } else { SWRITE_HV(0); SBAR(); }
    const unsigned long long qa_ = S.qa, hc = S.ca;
    if (NT > 1) { if constexpr (F32) SLOAD_F((const float*)Kh, KBASE(1)); else SLOAD_H(Kh, Vh, CAh, KBASE(1)); }
    SBAR(); qkt<0, SK>(pA0, pA1, K_lds, r32, hi, S.qr, ACT(0), qa_, hc);
    if constexpr (F32) { if (NT > 1) { VMW(); SWRITE_KF(1); SBAR(); SLOAD_F((const float*)Vh, KBASE(1)); } }
    MASKT(pA0, pA1, 0); partialSM(pA0, pA1, m_reg, mnA, alA);
    if (NT > 1) { VMW(); if constexpr (F32) { SWRITE_VF(1); SBAR(); if (NT > 2) SLOAD_F((const float*)Kh, KBASE(2)); } else SWRITE_H(1); }
    __syncthreads();
#define HALF_STEP(PX0, PX1, mnX, alX, PY0, PY1, alY, t, KB, VB, SB) do {                                                      \
        { const unsigned long long c_ = S.ca; SBAR(); qkt<KB, SK>(PX0, PX1, K_lds, r32, hi, S.qr, ACT(t), qa_, c_); }                                             \
        finishSM(PY0, PY1, alY, l_reg, pa0, pa1, pa2, pa3); SBAR();                                                           \
        if ((t) + 1 < NT) { if constexpr (F32) { VMW(); SWRITE_KF(SB); SBAR(); SLOAD_F((const float*)Vh, KBASE((t) + 1)); }  \
                            else { SLOAD_H(Kh, Vh, CAh, KBASE((t) + 1)); } SBAR(); }                                               \
        pv_tile<VB, SK>(o, vb0, pa0, pa1, pa2, pa3, ACT((t) - 1)); MASKT(PX0, PX1, (t)); partialSM(PX0, PX1, m_reg, mnX, alX);                                        \
        __syncthreads();                                                                                                      \
        if ((t) + 1 < NT) { VMW(); if constexpr (F32) { SWRITE_VF(SB); SBAR(); if ((t) + 2 < NT) SLOAD_F((const float*)Kh, KBASE((t) + 2)); } \
                            else { SWRITE_H(SB); } }                                                                          \
        RESC(alX); __syncthreads(); } while (0)
    for (int t = 1; t + 1 < NT; t += 2) {
        HALF_STEP(pB0, pB1, mnB, alB, pA0, pA1, alA, t, 1, 0, 0);
        HALF_STEP(pA0, pA1, mnA, alA, pB0, pB1, alB, t + 1, 0, 1, 1);
    }
    const bool even = (NT & 1) == 0;
    if (even) { const unsigned long long c_ = S.ca; SBAR(); qkt<1, SK>(pB0, pB1, K_lds, r32, hi, S.qr, ACT(NT - 1), qa_, c_); SBAR(); }
#define QROW(e) (nxt.Q + (size_t)(wid * QBLK + r32) * D + ((e) >> 1) * 16 + hi * 8 + ((e) & 1) * 4)
    if constexpr (F32) { SLOAD_F((const float*)nxt.K, kbn); SBAR();
#pragma unroll
        for (int e = 0; e < 8; ++e) S.tq[e] = *(const f32x4*)QROW(e); }
    else { SLOAD_H(nxt.K, nxt.V, nxt.CA, kbn); SBAR();
#pragma unroll
        for (int d0 = 0; d0 < 8; ++d0) S.qr[d0] = load8<TIn>(nxt.Q + (size_t)(wid * QBLK + r32) * LDQ + d0 * 16 + hi * 8);
        S.qa = nxt.CA[nxt.P0 + wid * QBLK + r32]; }
    SBAR();
    finishSM(pA0, pA1, alA, l_reg, pa0, pa1, pa2, pa3); SBAR();
    if constexpr (F32) {
#pragma unroll
        for (int e = 8; e < 16; ++e) S.tq[e] = *(const f32x4*)QROW(e); SBAR(); }
#undef QROW
    pv_tile<0, SK>(o, vb0, pa0, pa1, pa2, pa3, ACT(even ? NT - 2 : NT - 1));
    if (even) { MASKT(pB0, pB1, NT - 1); partialSM(pB0, pB1, m_reg, mnB, alB); __syncthreads(); RESC(alB);
        finishSM(pB0, pB1, alB, l_reg, pa0, pa1, pa2, pa3); SBAR(); pv_tile<1, SK>(o, vb0, pa0, pa1, pa2, pa3, ACT(NT - 1)); }
    SBAR(); SEAM_K0();
    if (hi == 0) li_l[r32] = l_reg; asm volatile("s_waitcnt lgkmcnt(0)" ::: "memory");
    float rli[16];
#pragma unroll
    for (int r = 0; r < 16; ++r) rli[r] = __builtin_amdgcn_rcpf(li_l[crow(r, hi)]);
    TOut* Ow = cur.O + (size_t)(wid * QBLK) * LDO; const unsigned short* Gw = cur.G + (size_t)(wid * QBLK) * LDG;
#pragma unroll
    for (int r = 0; r < 16; ++r) { const int orow = crow(r, hi);
#pragma unroll
        for (int d0 = 0; d0 < 4; ++d0) { const float v = o[d0][r] * rli[r];
            if constexpr (same_t<TOut, float>::v) { Ow[(size_t)orow * LDO + d0 * 32 + r32] = v; }
            else { const float vn = __shfl_xor(v, 1);
                   if ((r32 & 1) == 0) { const unsigned g2 = *(const unsigned*)(Gw + (size_t)orow * LDG + d0 * 32 + r32);
                       *(unsigned*)(Ow + (size_t)orow * LDO + d0 * 32 + r32) = cvtpk(v * __uint_as_float(g2 << 16), vn * __uint_as_float(g2 & 0xffff0000u)); } } } }
    if constexpr (F32) {
#pragma unroll
        for (int d0 = 0; d0 < 8; ++d0) S.qr[d0] = pack8(S.tq[2 * d0], S.tq[2 * d0 + 1]); }
    __syncthreads();
#undef RESC
#undef KBASE
#undef ACT
#undef MASKT
#undef SEAM_K0
#undef HALF_STEP
}
#undef ROW
#undef VMW
#undef VMWN
#undef SLOAD_H
#undef SWRITE_HK
#undef SWRITE_HV
#undef SWRITE_H
#undef SLOAD_F
#undef SWRITE_KF
#undef SWRITE_VF

__host__ __device__ inline int swa_nx(int nqb, int nramp) { return (nramp + 1) / 2 + (nqb - nramp); }
struct SwaItem { int bh, qb0, qb1; };
__device__ __forceinline__ SwaItem swa_decode(int L, int nqb, int nx) {
    SwaItem it; const int xcd = L & 7, k = L >> 3, gi = k / nx, r = k - gi * nx;
    it.bh = gi * 8 + xcd; const int x = r;
    it.qb0 = x; it.qb1 = nqb - 1 - x;
    return it;
}
struct AttnT { const bf16* Q; const bf16* K; const bf16* V; bf16* O; const unsigned short* G; const unsigned long long* CA; };
__device__ __forceinline__ BlockRef<bf16, bf16> swa_ref(const SwaItem& it, int pass, const AttnT& T, int seq, int nh) {
    const int qb = pass ? it.qb1 : it.qb0, b = it.bh / nh, h = it.bh % nh; const size_t tok0 = (size_t)b * seq;
    BlockRef<bf16, bf16> r;
    r.Q = T.Q + (tok0 + (size_t)qb * QB) * LDQ + h * D; r.O = T.O + (tok0 + (size_t)qb * QB) * LDO + h * D; r.G = T.G + (tok0 + (size_t)qb * QB) * LDG + h * D;
    r.K = T.K + (size_t)it.bh * seq * D; r.V = T.V + (size_t)it.bh * seq * D; r.CA = T.CA + (size_t)it.bh * seq; r.P0 = qb * QB;
    return r;
}
__device__ __forceinline__ void attn_phase(char* lds, const AttnT& T, int nb, int nh, int seq) {
    const int W = 1 << 30, nqb = seq / QB, nx = nqb / 2, total = nx * nb * nh, stride = gridDim.x;
    int L = blockIdx.x; if (L >= total) return;
    SwaItem it = swa_decode(L, nqb, nx); int pass = 0;
    BlockRef<bf16, bf16> cur = swa_ref(it, 0, T, seq, nh);
    Seam<bf16> S;
    causal_swa_prime<bf16, bf16>(cur, W, lds, S);
    for (;;) {
        const bool more_pass = pass == 0 && it.qb1 != it.qb0, more_item = L + stride < total, last = !more_pass && !more_item;
        SwaItem itn = it; int passn = pass + 1, Ln = L;
        if (!more_pass) { passn = 0; Ln = more_item ? L + stride : L; itn = swa_decode(Ln, nqb, nx); }
        const BlockRef<bf16, bf16> nxt = last ? cur : swa_ref(itn, passn, T, seq, nh);
        causal_swa_block<bf16, bf16>(cur, nxt, seq, W, lds, S);
        if (last) break;
        cur = nxt; it = itn; pass = passn; L = Ln;
    }
}
#undef KSWZ
#undef SBAR
}
constexpr int DM = 2048, NB = 4, SEQ = 4096, MT = NB * SEQ, FF = 5632, FF2 = 2 * FF, NH = 16, HD = 128, CH = 128, NG = 16;
constexpr float EPS = 1e-6f;
constexpr int NWAVES = 8, NTHREADS = NWAVES * 64;
constexpr size_t MiB = 1u << 20;
constexpr size_t WS_BAR = 0, BAR_ZERO_BYTES = 16384;
constexpr size_t WS_LOGF = 1 * MiB;
constexpr size_t WS_CA = 2 * MiB;
constexpr size_t WS_WSB = 4 * MiB;
constexpr size_t WS_WF = 5 * MiB;
constexpr size_t WS_W_AIN = 6 * MiB;
constexpr size_t WS_W_AOUT = WS_W_AIN + 32 * MiB;
constexpr size_t WS_W_KV = WS_W_AOUT + 16 * MiB;
constexpr size_t WS_W_QG = WS_W_KV + 16 * MiB;
constexpr size_t WS_W_BOUT = WS_W_QG + 32 * MiB;
constexpr size_t WS_W_UP = WS_W_BOUT + 16 * MiB;
constexpr size_t WS_W_DN = WS_W_UP + 176 * MiB;
constexpr size_t WS_XN = WS_W_DN + 88 * MiB;
constexpr size_t WS_XN2 = WS_XN + 64 * MiB;
constexpr size_t WS_KV = WS_XN2 + 64 * MiB;
constexpr size_t WS_BIG = WS_KV + 128 * MiB;
constexpr size_t WS_ACT = WS_BIG + 352 * MiB;
constexpr size_t WS_SSP = WS_ACT + 176 * MiB;
constexpr size_t WS_END = WS_SSP + 2 * MiB;
constexpr int LDS_BYTES = 147456, MISC_OFF = LDS_BYTES - 64, XS_OFF = 131072;

typedef unsigned short bf16_t;
typedef float f32x4 __attribute__((ext_vector_type(4)));
typedef unsigned u32x4 __attribute__((ext_vector_type(4)));
typedef unsigned u32x2 __attribute__((ext_vector_type(2)));
typedef short bf16x8 __attribute__((ext_vector_type(8)));
#define LAS __attribute__((address_space(3)))
__device__ __forceinline__ unsigned pk2(float lo, float hi) { return pg8::cvt_pk_bf16(lo, hi); }
__device__ __forceinline__ float bf_lo(unsigned w) { return __uint_as_float(w << 16); }
__device__ __forceinline__ float bf_hi(unsigned w) { return __uint_as_float(w & 0xffff0000u); }
__device__ __forceinline__ float wave_sum(float v) {
#pragma unroll
    for (int o = 1; o < 64; o <<= 1) v += __shfl_xor(v, o);
    return v;
}
struct Args { const float* in[21]; float* out; unsigned char* ws; };
#define XB_TMO      128
#define XB_XCNT(j)  (256  + 64 * (j))
#define XB_XSUB(j)  (1280 + 64 * (j))
#define XB_XGEN(j)  (2304 + 64 * (j))
#define XB_TOP      3328
#define XB_TOPGEN   3392
#define XCD_BAR_WORDS 3456
#define XB_SPIN_CAP (1u << 18)

__device__ __forceinline__ unsigned xb_ld(unsigned* p)              { return __hip_atomic_load(p, __ATOMIC_RELAXED, __HIP_MEMORY_SCOPE_AGENT); }
__device__ __forceinline__ unsigned xb_add(unsigned* p, unsigned v) { return __hip_atomic_fetch_add(p, v, __ATOMIC_RELAXED, __HIP_MEMORY_SCOPE_AGENT); }
__device__ __forceinline__ unsigned xb_xcc_id() { return (unsigned)__builtin_amdgcn_s_getreg((3 << 11) | 20) & 0xFu; }
#define XB_SPIN(cond, bar) do { unsigned _sp = 0; while (cond) { __builtin_amdgcn_s_sleep(1); \
    if ((++_sp & 255u) == 0u) { if (xb_ld(&(bar)[XB_TMO])) break; if (_sp > XB_SPIN_CAP) { atomicAdd(&(bar)[XB_TMO], 1u); break; } } } } while (0)

struct XcdBarrier {
    unsigned* bar; unsigned x;
    volatile LAS unsigned* st;
};

__device__ __forceinline__ XcdBarrier xcd_barrier_post(unsigned* bar, volatile LAS unsigned* st) {
    XcdBarrier b; b.bar = bar; b.x = xb_xcc_id(); b.st = st;
    if (threadIdx.x == 0) (void)xb_add(&bar[XB_XCNT(b.x)], 1u);
    return b;
}
__device__ __forceinline__ void xcd_barrier_complete(unsigned* bar, unsigned x, unsigned& nloc, unsigned& nx) {
    const unsigned G = gridDim.x * gridDim.y * gridDim.z;
    unsigned sum, cnt, mine, sp = 0u;
    for (;;) {
        sum = 0u; cnt = 0u; mine = 0u;
#pragma unroll
        for (unsigned j = 0; j < 16; ++j) { const unsigned c = xb_ld(&bar[XB_XCNT(j)]); sum += c; cnt += (c > 0u) ? 1u : 0u; mine = (j == x) ? c : mine; }
        if (sum == G) break;
        __builtin_amdgcn_s_sleep(1);
        if ((++sp & 255u) == 0u) { if (xb_ld(&bar[XB_TMO])) break; if (sp > XB_SPIN_CAP) { atomicAdd(&bar[XB_TMO], 1u); break; } }
    }
    nloc = mine > 0u ? mine : 1u; nx = cnt > 0u ? cnt : 1u;
}

__device__ __forceinline__ void xcd_barrier(const XcdBarrier& b) {
    asm volatile("s_waitcnt vmcnt(0)" ::: "memory");
    __syncthreads();
    if (threadIdx.x == 0) {
        unsigned* bar = b.bar;
        __builtin_amdgcn_s_waitcnt(0);
        unsigned nloc = b.st[0], nx = b.st[1];
        if (nloc == 0u) { xcd_barrier_complete(bar, b.x, nloc, nx); b.st[0] = nloc; b.st[1] = nx; }
        const unsigned old = xb_add(&bar[XB_XSUB(b.x)], 1u);
        const unsigned gen = old / nloc;
        if (old + 1u == (gen + 1u) * nloc) {
            __builtin_amdgcn_fence(__ATOMIC_RELEASE, "agent");
            asm volatile("s_waitcnt vmcnt(0)" ::: "memory");
            const unsigned og = xb_add(&bar[XB_TOP], 1u);
            const unsigned tg = og / nx;
            if (og + 1u == (tg + 1u) * nx) xb_add(&bar[XB_TOPGEN], 1u);
            else XB_SPIN(xb_ld(&bar[XB_TOPGEN]) == tg, bar);
            __builtin_amdgcn_fence(__ATOMIC_ACQUIRE, "agent");
            xb_add(&bar[XB_XGEN(b.x)], 1u);
            asm volatile("s_waitcnt vmcnt(0)" ::: "memory");
        } else {
            XB_SPIN(xb_ld(&bar[XB_XGEN(b.x)]) == gen, bar);
            __builtin_amdgcn_fence(__ATOMIC_ACQUIRE, "agent");
            asm volatile("s_waitcnt vmcnt(0)" ::: "memory");
        }
    }
    __syncthreads();
}


__device__ __forceinline__ int up_row(int n) { return n < FF ? (n >> 7) * 256 + (n & 127) : ((n - FF) >> 7) * 256 + 128 + ((n - FF) & 127); }
constexpr int TR_LDS_PER_WAVE = 64 * 65 * 4;
__device__ __forceinline__ void transpose_item(const float* W, int K, int ld, int ncols, const float* gk, bf16_t* WT, int mode, LAS float* scr, int item, int lane) {
    const int nblk = ncols / 64, kb = item / nblk, nb = item % nblk, k0 = 64 * kb, n0 = 64 * nb, kr = lane >> 4, n4 = (lane & 15) * 4;
    f32x4 v[16];
#pragma unroll
    for (int i = 0; i < 16; ++i) v[i] = *(const f32x4*)(W + (size_t)(k0 + 4 * i + kr) * ld + n0 + n4);
#pragma unroll
    for (int i = 0; i < 16; ++i) { const int kk = 4 * i + kr; const float g = gk ? gk[k0 + kk] : 1.f; LAS float* d = scr + kk * 65 + n4; d[0] = v[i].x * g; d[1] = v[i].y * g; d[2] = v[i].z * g; d[3] = v[i].w * g; }
    asm volatile("s_waitcnt lgkmcnt(0)" ::: "memory");
    const int c = lane & 7; const int r0 = mode ? up_row(n0) : n0;
#pragma unroll
    for (int j = 0; j < 8; ++j) { const int n = (lane >> 3) + 8 * j; const LAS float* p = scr + (8 * c) * 65 + n;
        u32x4 o; o.x = pk2(p[0 * 65], p[1 * 65]); o.y = pk2(p[2 * 65], p[3 * 65]); o.z = pk2(p[4 * 65], p[5 * 65]); o.w = pk2(p[6 * 65], p[7 * 65]);
        *(u32x4*)(WT + (size_t)(r0 + n) * K + k0 + 8 * c) = o; }
    asm volatile("s_waitcnt lgkmcnt(0)" ::: "memory");
}
template <bool F32OUT>
__device__ __forceinline__ void norm_rows(const float* src, const float* g, void* dst, int gw, int NGW, int lane) {
    for (int m = gw; m < MT; m += NGW) {
        const f32x4* xr = (const f32x4*)(src + (size_t)m * DM) + lane; f32x4 v[8]; float s = 0.f;
#pragma unroll
        for (int j = 0; j < 8; ++j) { v[j] = xr[64 * j]; s += (v[j].x * v[j].x + v[j].y * v[j].y) + (v[j].z * v[j].z + v[j].w * v[j].w); }
        const float r = 1.0f / sqrtf(wave_sum(s) * (1.0f / DM) + EPS);
        const f32x4* gr = (const f32x4*)g + lane;
        if constexpr (F32OUT) { f32x4* o = (f32x4*)((float*)dst + (size_t)m * DM) + lane;
#pragma unroll
            for (int j = 0; j < 8; ++j) o[64 * j] = (v[j] * r) * gr[64 * j]; }
        else { u32x2* o = (u32x2*)((bf16_t*)dst + (size_t)m * DM) + lane;
#pragma unroll
            for (int j = 0; j < 8; ++j) { const f32x4 y = (v[j] * r) * gr[64 * j]; u32x2 w; w.x = pk2(y.x, y.y); w.y = pk2(y.z, y.w); o[64 * j] = w; } }
    }
}
__device__ __forceinline__ void headnorm_rows(bf16_t* buf, int ld, const float* gain, int gw, int NGW, int lane) {
    const f32x4 g0 = *(const f32x4*)(gain + (lane & 15) * 8), g1 = *(const f32x4*)(gain + (lane & 15) * 8 + 4);
    for (int m = gw; m < MT; m += NGW) {
        u32x4* p = (u32x4*)(buf + (size_t)m * ld) + lane; u32x4 w[4];
#pragma unroll
        for (int j = 0; j < 4; ++j) w[j] = p[64 * j];
#pragma unroll
        for (int j = 0; j < 4; ++j) {
            float x[8] = {bf_lo(w[j].x), bf_hi(w[j].x), bf_lo(w[j].y), bf_hi(w[j].y), bf_lo(w[j].z), bf_hi(w[j].z), bf_lo(w[j].w), bf_hi(w[j].w)};
            float s = 0.f;
#pragma unroll
            for (int e = 0; e < 8; ++e) s += x[e] * x[e];
            s += __shfl_xor(s, 1); s += __shfl_xor(s, 2); s += __shfl_xor(s, 4); s += __shfl_xor(s, 8);
            const float r = 1.0f / sqrtf(s * (1.0f / HD) + EPS);
            u32x4 o; o.x = pk2(x[0] * r * g0.x, x[1] * r * g0.y); o.y = pk2(x[2] * r * g0.z, x[3] * r * g0.w); o.z = pk2(x[4] * r * g1.x, x[5] * r * g1.y); o.w = pk2(x[6] * r * g1.z, x[7] * r * g1.w);
            p[64 * j] = o; }
    }
}
__device__ __forceinline__ void fgate_rows(const float* h, const bf16_t* wfh, const bf16_t* wfl, const float* bf, float* logf, int gw, int NGW, int lane) {
    const int fr = lane & 15, fq = lane >> 4;
    for (int rg = gw; rg < MT / 16; rg += NGW) {
        const float* hrow = h + (size_t)(rg * 16 + fr) * DM + 8 * fq; const bf16_t* wh = wfh + fr * DM + 8 * fq; const bf16_t* wl = wfl + fr * DM + 8 * fq;
        f32x4 acc = {0.f, 0.f, 0.f, 0.f}; float ssq = 0.f;
#pragma unroll 4
        for (int ks = 0; ks < DM / 32; ++ks) {
            const f32x4 a0 = *(const f32x4*)(hrow + 32 * ks), a1 = *(const f32x4*)(hrow + 32 * ks + 4);
            ssq += (a0.x * a0.x + a0.y * a0.y) + (a0.z * a0.z + a0.w * a0.w) + (a1.x * a1.x + a1.y * a1.y) + (a1.z * a1.z + a1.w * a1.w);
            u32x4 hi; hi.x = pk2(a0.x, a0.y); hi.y = pk2(a0.z, a0.w); hi.z = pk2(a1.x, a1.y); hi.w = pk2(a1.z, a1.w);
            u32x4 lo; lo.x = pk2(a0.x - bf_lo(hi.x), a0.y - bf_hi(hi.x)); lo.y = pk2(a0.z - bf_lo(hi.y), a0.w - bf_hi(hi.y)); lo.z = pk2(a1.x - bf_lo(hi.z), a1.y - bf_hi(hi.z)); lo.w = pk2(a1.z - bf_lo(hi.w), a1.w - bf_hi(hi.w));
            const bf16x8 whv = *(const bf16x8*)(wh + 32 * ks), wlv = *(const bf16x8*)(wl + 32 * ks);
            const bf16x8 hv = __builtin_bit_cast(bf16x8, hi), lv = __builtin_bit_cast(bf16x8, lo);
            acc = __builtin_amdgcn_mfma_f32_16x16x32_bf16(whv, hv, acc, 0, 0, 0);
            acc = __builtin_amdgcn_mfma_f32_16x16x32_bf16(wlv, hv, acc, 0, 0, 0);
            acc = __builtin_amdgcn_mfma_f32_16x16x32_bf16(whv, lv, acc, 0, 0, 0);
        }
        ssq += __shfl_xor(ssq, 16); ssq += __shfl_xor(ssq, 32);
        const float r = 1.0f / sqrtf(ssq * (1.0f / DM) + EPS);
        const f32x4 b = *(const f32x4*)(bf + 4 * fq); f32x4 o;
#pragma unroll
        for (int e = 0; e < 4; ++e) { const float f = acc[e] * r + b[e]; o[e] = fminf(f, 0.f) - log1pf(expf(-fabsf(f))); }
        *(f32x4*)(logf + (size_t)(rg * 16 + fr) * 16 + 4 * fq) = o;
    }
}
__device__ __forceinline__ void scan_seq(const float* logf, unsigned long long* CA, int seq, int lane) {
    const int b = seq >> 4, hh = seq & 15;
    const float* lf = logf + ((size_t)b * SEQ + (size_t)lane * 64) * 16 + hh;
    float v[64];
#pragma unroll
    for (int i = 0; i < 64; ++i) v[i] = lf[i * 16];
#pragma unroll
    for (int i = 1; i < 64; ++i) v[i] += v[i - 1];
    const float tot = v[63]; float t = tot;
#pragma unroll
    for (int o = 1; o < 64; o <<= 1) { const float y = __shfl_up(t, o); if (lane >= o) t += y; }
    const float excl = t - tot;
    unsigned long long* out = CA + (size_t)seq * SEQ + lane * 64;
#pragma unroll
    for (int i = 0; i < 64; ++i) { const float c = (excl + v[i]) * 11.313708498984761f;
        const unsigned h1 = pk2(c, 0.f) & 0xffffu; const float r1 = c - bf_lo(h1);
        const unsigned h2 = pk2(r1, 0.f) & 0xffffu; const float r2 = r1 - bf_lo(h2);
        const unsigned h3 = pk2(r2, 0.f) & 0xffffu;
        out[i] = (unsigned long long)(h1 | (h2 << 16)) | ((unsigned long long)h3 << 32); }
}
__device__ __forceinline__ void spatial_phase(LAS unsigned char* ldsp, const bf16_t* Z, const float* ssp, const bf16_t* wsb, const float* vnorm, const float* bs, bf16_t* GATED, int wave, int lane) {
    const int fr = lane & 15, fq = lane >> 4;
    for (int item = blockIdx.x; item < (MT / CH) * NG; item += gridDim.x) {
        const int ch = item >> 4, g = item & 15, row0 = ch * CH, cw = g * 128 + wave * 16;
        LAS float* rvs = (LAS float*)ldsp;
        __syncthreads();
        { const int t_ = wave * 64 + lane; if (t_ < CH) { const f32x4* p = (const f32x4*)(ssp + (size_t)(row0 + t_) * 32); float sq = 0.f;
#pragma unroll
            for (int q = 0; q < 8; ++q) { const f32x4 v = p[q]; sq += (v.x + v.y) + (v.z + v.w); }
            rvs[t_] = 1.0f / sqrtf(sq * (1.0f / DM) + EPS); } }
        __syncthreads();
        LAS unsigned* VS = (LAS unsigned*)(ldsp + 1024);
        { const int t_ = wave * 64 + lane, srow = t_ >> 2, c0 = (t_ & 3) * 32; const float rv = rvs[srow];
          const u32x4* gp = (const u32x4*)(Z + (size_t)(row0 + srow) * 4096 + 2048 + g * 128 + c0); u32x4 q[4];
#pragma unroll
          for (int jj = 0; jj < 4; ++jj) q[jj] = gp[jj];
#pragma unroll
          for (int jj = 0; jj < 4; ++jj) { LAS unsigned* d = VS + srow * 65 + (c0 >> 1) + jj * 4;
#pragma unroll
              for (int e = 0; e < 4; ++e) d[e] = pk2(bf_lo(q[jj][e]) * rv, bf_hi(q[jj][e]) * rv); } }
        __syncthreads();
        bf16x8 vf[4];
        { const LAS unsigned short* vs16 = (const LAS unsigned short*)VS + wave * 16 + fr;
#pragma unroll
          for (int ks = 0; ks < 4; ++ks) { unsigned hv[8];
#pragma unroll
              for (int i = 0; i < 8; ++i) hv[i] = vs16[(32 * ks + 8 * fq + i) * 130];
              u32x4 w; w.x = hv[0] | (hv[1] << 16); w.y = hv[2] | (hv[3] << 16); w.z = hv[4] | (hv[5] << 16); w.w = hv[6] | (hv[7] << 16); vf[ks] = __builtin_bit_cast(bf16x8, w); } }
        f32x4 acc[8];
#pragma unroll
        for (int m = 0; m < 8; ++m) { acc[m] = (f32x4){0.f, 0.f, 0.f, 0.f};
#pragma unroll
            for (int ks = 0; ks < 4; ++ks) if (32 * ks <= 16 * m + 15) {
                const bf16x8 wf = *(const bf16x8*)(wsb + ((size_t)(g * 128 + 16 * m + fr) * 128 + 32 * ks + 8 * fq));
                acc[m] = __builtin_amdgcn_mfma_f32_16x16x32_bf16(vf[ks], wf, acc[m], 0, 0, 0); } }
        const f32x4 vn = *(const f32x4*)(vnorm + cw + 4 * fq);
#pragma unroll
        for (int m = 0; m < 8; ++m) { const int t = 16 * m + fr; const size_t row = (size_t)(row0 + t); const float bias = bs[g * 128 + t];
            const u32x2 uu = *(const u32x2*)(Z + row * 4096 + cw + 4 * fq);
            const float o0 = bf_lo(uu.x) * (acc[m][0] * vn[0] + bias), o1 = bf_hi(uu.x) * (acc[m][1] * vn[1] + bias), o2 = bf_lo(uu.y) * (acc[m][2] * vn[2] + bias), o3 = bf_hi(uu.y) * (acc[m][3] * vn[3] + bias);
            u32x2 w; w.x = pk2(o0, o1); w.y = pk2(o2, o3); *(u32x2*)(GATED + row * DM + cw + 4 * fq) = w; }
    }
}
__device__ __forceinline__ void conv_phase(const bf16_t* BIG, const float* cw, const float* cb, bf16_t* ACT) {
    constexpr int NQ = FF / 8, RS = 32, NTASK = NQ * (MT / RS);
    const int tid_ = opaque_tid();
    for (int T = blockIdx.x * NTHREADS + tid_; T < NTASK; T += gridDim.x * NTHREADS) {
        const int q = T % NQ, strip = T / NQ, j0 = 8 * q, pg = (q >> 4) * 256 + (q & 15) * 8, row0 = strip * RS;
        float wg[3][8], wv[3][8], bg[8], bv[8];
#pragma unroll
        for (int k = 0; k < 3; ++k)
#pragma unroll
            for (int e = 0; e < 8; ++e) { wg[k][e] = cw[(size_t)k * FF2 + j0 + e]; wv[k][e] = cw[(size_t)k * FF2 + FF + j0 + e]; }
#pragma unroll
        for (int e = 0; e < 8; ++e) { bg[e] = cb[j0 + e]; bv[e] = cb[FF + j0 + e]; }
        const bf16_t* src = BIG + (size_t)row0 * FF2 + pg; bf16_t* dst = ACT + (size_t)row0 * FF + j0;
        u32x4 g2 = {0u, 0u, 0u, 0u}, g1 = g2, v2 = g2, v1 = g2;
        if ((row0 & (SEQ - 1)) != 0) { g2 = *(const u32x4*)(src - 2 * (size_t)FF2); v2 = *(const u32x4*)(src - 2 * (size_t)FF2 + 128); g1 = *(const u32x4*)(src - (size_t)FF2); v1 = *(const u32x4*)(src - (size_t)FF2 + 128); }
        for (int i0 = 0; i0 < RS; i0 += 8) {
            u32x4 gc[8], vc[8];
#pragma unroll
            for (int i = 0; i < 8; ++i) { gc[i] = *(const u32x4*)(src + (size_t)(i0 + i) * FF2); vc[i] = *(const u32x4*)(src + (size_t)(i0 + i) * FF2 + 128); }
#pragma unroll
            for (int i = 0; i < 8; ++i) { u32x4 o;
#pragma unroll
                for (int p = 0; p < 4; ++p) {
                    const float ga = wg[0][2 * p] * bf_lo(g2[p]) + wg[1][2 * p] * bf_lo(g1[p]) + wg[2][2 * p] * bf_lo(gc[i][p]) + bg[2 * p];
                    const float gb = wg[0][2 * p + 1] * bf_hi(g2[p]) + wg[1][2 * p + 1] * bf_hi(g1[p]) + wg[2][2 * p + 1] * bf_hi(gc[i][p]) + bg[2 * p + 1];
                    const float va = wv[0][2 * p] * bf_lo(v2[p]) + wv[1][2 * p] * bf_lo(v1[p]) + wv[2][2 * p] * bf_lo(vc[i][p]) + bv[2 * p];
                    const float vb = wv[0][2 * p + 1] * bf_hi(v2[p]) + wv[1][2 * p + 1] * bf_hi(v1[p]) + wv[2][2 * p + 1] * bf_hi(vc[i][p]) + bv[2 * p + 1];
                    const float sa = ga * __builtin_amdgcn_rcpf(1.0f + __builtin_amdgcn_exp2f(-1.4426950408889634f * ga)), sb = gb * __builtin_amdgcn_rcpf(1.0f + __builtin_amdgcn_exp2f(-1.4426950408889634f * gb));
                    o[p] = pk2(sa * va, sb * vb); }
                *(u32x4*)(dst + (size_t)(i0 + i) * FF) = o; g2 = g1; g1 = gc[i]; v2 = v1; v1 = vc[i]; }
        }
    }
}

typedef const Args __attribute__((address_space(4))) CArgs;
__device__ __forceinline__ CArgs* kargs() { CArgs* p = (CArgs*)__builtin_amdgcn_kernarg_segment_ptr(); asm volatile("" : "+s"(p)); return p; }
#define PTRS \
    CArgs* ap_ = kargs(); unsigned char* ws = ap_->ws; float* h = ap_->out; (void)ws; (void)h; \
    const float* x = ap_->in[0]; const float* a_norm = ap_->in[1]; const float* a_w_in = ap_->in[2]; const float* a_v_norm = ap_->in[3]; const float* a_w_s = ap_->in[4]; const float* a_b_s = ap_->in[5]; \
    const float* a_w_out = ap_->in[6]; const float* kv_norm = ap_->in[7]; const float* w_kvf = ap_->in[8]; const float* b_f = ap_->in[9]; const float* k_norm = ap_->in[10]; const float* b_norm = ap_->in[11]; \
    const float* b_w_qg = ap_->in[12]; const float* q_norm = ap_->in[13]; const float* b_w_out = ap_->in[14]; const float* f_norm = ap_->in[15]; const float* f_w_up = ap_->in[16]; const float* f_conv_w = ap_->in[17]; \
    const float* f_conv_b = ap_->in[18]; const float* f_w_down = ap_->in[19]; const float* final_norm = ap_->in[20]; \
    (void)x; (void)a_norm; (void)a_w_in; (void)a_v_norm; (void)a_w_s; (void)a_b_s; (void)a_w_out; (void)kv_norm; (void)w_kvf; (void)b_f; (void)k_norm; (void)b_norm; (void)b_w_qg; (void)q_norm; (void)b_w_out; \
    (void)f_norm; (void)f_w_up; (void)f_conv_w; (void)f_conv_b; (void)f_w_down; (void)final_norm; \
    float* VSS = (float*)(ws + WS_SSP); float* LOGF = (float*)(ws + WS_LOGF); unsigned long long* CA = (unsigned long long*)(ws + WS_CA); \
    bf16_t* WSB = (bf16_t*)(ws + WS_WSB); bf16_t* WFH = (bf16_t*)(ws + WS_WF); bf16_t* WFL = WFH + 16 * DM; \
    bf16_t* W_AIN = (bf16_t*)(ws + WS_W_AIN); bf16_t* W_AOUT = (bf16_t*)(ws + WS_W_AOUT); bf16_t* W_KV = (bf16_t*)(ws + WS_W_KV); bf16_t* W_QG = (bf16_t*)(ws + WS_W_QG); \
    bf16_t* W_BOUT = (bf16_t*)(ws + WS_W_BOUT); bf16_t* W_UP = (bf16_t*)(ws + WS_W_UP); bf16_t* W_DN = (bf16_t*)(ws + WS_W_DN); \
    bf16_t* HB = (bf16_t*)(ws + WS_XN); float* RSS = (float*)(ws + WS_XN2); bf16_t* KVB = (bf16_t*)(ws + WS_KV); bf16_t* BIG = (bf16_t*)(ws + WS_BIG); bf16_t* ACT = (bf16_t*)(ws + WS_ACT); \
    (void)VSS; (void)LOGF; (void)CA; (void)WSB; (void)WFH; (void)WFL; (void)W_AIN; (void)W_AOUT; (void)W_KV; (void)W_QG; (void)W_BOUT; (void)W_UP; (void)W_DN; (void)HB; (void)RSS; (void)KVB; (void)BIG; (void)ACT;
typedef pg8::EpiBf<1, true> EPI_A1; typedef pg8::EpiBf<0, true, true, true> EPI_KV; typedef pg8::EpiBf<2, true, false, true> EPI_QG; typedef pg8::EpiBf<0, true> EPI_UP;
#define GEMM_PHASE(EPI, Aptr, Bptr, NN, KK, ...) do { pg8::Gemm g_{Aptr, Bptr, MT, NN, KK}; pg8::StaticOrder S_; S_.init(MT, NN, G, (int)blockIdx.x); EPI E_{__VA_ARGS__}; \
    pg8::gemm_phase<EPI, pg8::StaticOrder, true, true>(ldsp, g_, S_, E_); } while (0)

__global__ void __launch_bounds__(NTHREADS, 2) fwd_megakernel(Args a) {
    extern __shared__ __attribute__((aligned(16))) unsigned char lds[];
    cg::grid_group grid = cg::this_grid();
#define GSYNC_CG() do { asm volatile("s_waitcnt vmcnt(0)" ::: "memory"); grid.sync(); } while (0)
#define GSYNC() xcd_barrier(xbar)
    const int wave = __builtin_amdgcn_readfirstlane(threadIdx.x >> 6);
    const int G = gridDim.x, gw = blockIdx.x * NWAVES + wave, NGW = G * NWAVES;
    LAS unsigned char* ldsp = (LAS unsigned char*)lds;
    if (threadIdx.x < 16) ((LAS unsigned*)(ldsp + MISC_OFF))[threadIdx.x] = 0u;
    __syncthreads();
    const XcdBarrier xbar = xcd_barrier_post((unsigned*)(kargs()->ws + WS_BAR), (volatile LAS unsigned*)(ldsp + MISC_OFF));

    {
        PTRS
        const int tid = opaque_tid(), lane = tid & 63;
        const int gt = blockIdx.x * NTHREADS + tid, NGT = G * NTHREADS;
        for (int i = gt; i < 2 * NG * CH * CH / 8; i += NGT) {
            const int e0 = i * 8, s0 = e0 & 127, t = (e0 >> 7) & 127; const f32x4 w0 = *(const f32x4*)(a_w_s + e0), w1 = *(const f32x4*)(a_w_s + e0 + 4);
            float y[8] = {w0.x, w0.y, w0.z, w0.w, w1.x, w1.y, w1.z, w1.w};
#pragma unroll
            for (int e = 0; e < 8; ++e) if (s0 + e > t) y[e] = 0.f;
            u32x4 o; o.x = pk2(y[0], y[1]); o.y = pk2(y[2], y[3]); o.z = pk2(y[4], y[5]); o.w = pk2(y[6], y[7]); *(u32x4*)(WSB + e0) = o; }
        for (int i = gt; i < 16 * DM; i += NGT) { const int n = i / DM, k = i % DM; const float w = kv_norm[k] * w_kvf[(size_t)k * 4112 + 4096 + n];
            const unsigned hi = pk2(w, 0.f) & 0xffffu; WFH[i] = (bf16_t)hi; WFL[i] = (bf16_t)(pk2(w - bf_lo(hi), 0.f) & 0xffffu); }
        LAS float* scr = (LAS float*)(ldsp + wave * TR_LDS_PER_WAVE);
        for (int it = gw; it < 48128 * (PROBE == 4 ? 2 : 1); it += NGW) {
            int r = it % 48128, K = DM, ld, ncols, mode = 0; const float* W; const float* g = nullptr; bf16_t* WT;
            if (r < 4096) { const int l = r >> 11; r &= 2047; W = a_w_in + (size_t)l * DM * 4096; g = a_norm + l * DM; WT = W_AIN + (size_t)l * 4096 * DM; ld = 4096; ncols = 4096; }
            else if ((r -= 4096) < 2048) { const int l = r >> 10; r &= 1023; W = a_w_out + (size_t)l * DM * DM; WT = W_AOUT + (size_t)l * DM * DM; ld = DM; ncols = DM; }
            else if ((r -= 2048) < 2048) { W = w_kvf; g = kv_norm; WT = W_KV; ld = 4112; ncols = 4096; }
            else if ((r -= 2048) < 4096) { const int l = r >> 11; r &= 2047; W = b_w_qg + (size_t)l * DM * 4096; g = b_norm + l * DM; WT = W_QG + (size_t)l * 4096 * DM; ld = 4096; ncols = 4096; }
            else if ((r -= 4096) < 2048) { const int l = r >> 10; r &= 1023; W = b_w_out + (size_t)l * DM * DM; WT = W_BOUT + (size_t)l * DM * DM; ld = DM; ncols = DM; }
            else if ((r -= 2048) < 22528) { const int l = r / 5632; r -= l * 5632; W = f_w_up + (size_t)l * DM * FF2; g = f_norm + l * DM; WT = W_UP + (size_t)l * FF2 * DM; ld = FF2; ncols = FF2; mode = 1; }
            else { r -= 22528; const int l = r / 2816; r -= l * 2816; W = f_w_down + (size_t)l * FF * DM; WT = W_DN + (size_t)l * DM * FF; K = FF; ld = DM; ncols = DM; }
            transpose_item(W, K, ld, ncols, g, WT, mode, scr, r, lane);
        }
        for (int m = gw; m < MT; m += NGW) {
            const f32x4* xr = (const f32x4*)(x + (size_t)m * DM) + lane; u32x2* o = (u32x2*)(HB + (size_t)m * DM) + lane; float sq = 0.f;
#pragma unroll
            for (int j = 0; j < 8; ++j) { const f32x4 v = xr[64 * j]; sq += (v.x * v.x + v.y * v.y) + (v.z * v.z + v.w * v.w); u32x2 w; w.x = pk2(v.x, v.y); w.y = pk2(v.z, v.w); o[64 * j] = w; }
            sq = wave_sum(sq); if (lane < 32) RSS[(size_t)m * 32 + lane] = lane == 0 ? sq : 0.f;
        }
    }
    GSYNC_CG();

    for (int l = 0; l < 4; ++l) {
        if (l < 2) {
            { PTRS GEMM_PHASE(EPI_A1, HB, W_AIN + (size_t)l * 4096 * DM, 4096, DM, BIG, 4096, 8, VSS, RSS, nullptr, nullptr); }
            GSYNC();
            for (int rep_ = 0; rep_ < (PROBE == 6 ? 2 : 1); ++rep_) { if (rep_) GSYNC();
            { PTRS const int lane = opaque_tid() & 63;
              spatial_phase(ldsp, BIG, VSS, WSB + (size_t)l * NG * CH * CH, a_v_norm + (size_t)l * DM, a_b_s + (size_t)l * NG * CH, ACT, wave, lane); } }
            GSYNC();
        } else {
            const int j = l - 2;
            if (j == 0) { PTRS const int lane = opaque_tid() & 63; fgate_rows(h, WFH, WFL, b_f, LOGF, gw, NGW, lane);
                          GEMM_PHASE(EPI_KV, HB, W_KV, 4096, DM, KVB, 4096, 1 << 30, nullptr, RSS, k_norm, (LAS float*)(ldsp + XS_OFF)); }
            { PTRS GEMM_PHASE(EPI_QG, HB, W_QG + (size_t)j * 4096 * DM, 4096, DM, BIG, 4096, 8, nullptr, RSS, q_norm + (size_t)j * HD, (LAS float*)(ldsp + XS_OFF)); }
            GSYNC();
            if (j == 0) { { PTRS const int lane = opaque_tid() & 63; if (blockIdx.x < 8) scan_seq(LOGF, CA, blockIdx.x * 8 + wave, lane); }
                          GSYNC(); }
            for (int rep_ = 0; rep_ < (PROBE == 2 ? 2 : 1); ++rep_) {
            { PTRS att::AttnT T{(const att::bf16*)BIG, (const att::bf16*)KVB, (const att::bf16*)(KVB + (size_t)MT * 2048), (att::bf16*)ACT, BIG + 2048, CA};
              att::attn_phase((char*)lds, T, NB, NH, SEQ); }
            GSYNC(); }
        }
        { PTRS const bf16_t* Wt = l < 2 ? W_AOUT + (size_t)l * DM * DM : W_BOUT + (size_t)(l - 2) * DM * DM;
          GEMM_PHASE(pg8::EpiRes, ACT, Wt, DM, DM, l == 0 ? x : (const float*)h, h, HB, RSS, DM); }
        GSYNC();
        { PTRS GEMM_PHASE(EPI_UP, HB, W_UP + (size_t)l * FF2 * DM, FF2, DM, BIG, FF2, 1 << 30, nullptr, RSS, nullptr, nullptr); }
        GSYNC();
#if PROBE == 1
        { PTRS GEMM_PHASE(EPI_UP, HB, W_UP + (size_t)l * FF2 * DM, FF2, DM, BIG, FF2, 1 << 30, nullptr, RSS, nullptr, nullptr); }
        GSYNC();
#endif
        { PTRS conv_phase(BIG, f_conv_w + (size_t)l * 3 * FF2, f_conv_b + (size_t)l * FF2, ACT); }
        GSYNC();
#if PROBE == 3
        { PTRS conv_phase(BIG, f_conv_w + (size_t)l * 3 * FF2, f_conv_b + (size_t)l * FF2, ACT); }
        GSYNC();
#endif
        { PTRS GEMM_PHASE(pg8::EpiRes, ACT, W_DN + (size_t)l * DM * FF, DM, FF, h, h, HB, RSS, DM); }
        GSYNC();
    }
#if PROBE == 7
    for (int rep_ = 0; rep_ < 20; ++rep_) GSYNC();
#endif
    { PTRS const int lane = opaque_tid() & 63; norm_rows<true>(h, final_norm, h, gw, NGW, lane); }
}

extern "C" void kernel_launch(void* const* d_in, const int* in_sizes, int n_in, void* d_out, int out_size, void* d_ws, size_t ws_size, hipStream_t stream) {
    static int grid = 0;
    if (grid == 0) {
        if (n_in != 21 || out_size != MT * DM || ws_size < WS_END) { fprintf(stderr, "kernel_launch: unexpected shapes (n_in %d out %d ws %zu, need ws >= %zu)\n", n_in, out_size, ws_size, (size_t)WS_END); grid = -1; return; }
        int dev = 0, cus = 0, per_cu = 0;
        (void)hipGetDevice(&dev); (void)hipDeviceGetAttribute(&cus, hipDeviceAttributeMultiprocessorCount, dev);
        (void)hipFuncSetAttribute((const void*)fwd_megakernel, hipFuncAttributeMaxDynamicSharedMemorySize, LDS_BYTES);
        (void)hipOccupancyMaxActiveBlocksPerMultiprocessor(&per_cu, (const void*)fwd_megakernel, NTHREADS, LDS_BYTES);
        if (per_cu < 1) { fprintf(stderr, "kernel_launch: occupancy query says %d blocks per CU\n", per_cu); per_cu = 1; }
        grid = cus * 1;
        (void)hipGetLastError();
    }
    if (grid < 0) return;
    (void)hipMemsetAsync((char*)d_ws + WS_BAR, 0, BAR_ZERO_BYTES, stream);
    Args a{};
    for (int i = 0; i < 21; ++i) a.in[i] = (const float*)d_in[i];
    a.out = (float*)d_out; a.ws = (unsigned char*)d_ws;
    void* args[] = {&a};
    hipError_t e = hipLaunchCooperativeKernel((const void*)fwd_megakernel, dim3(grid), dim3(NTHREADS), args, LDS_BYTES, stream);
    if (e != hipSuccess) fprintf(stderr, "cooperative launch failed: %s (grid %d)\n", hipGetErrorString(e), grid);
}
```

```cpp
#include <hip/hip_runtime.h>
#include <hip/hip_cooperative_groups.h>
#include <hip/hip_bf16.h>
#include <cstdio>
#include <cstdint>
namespace cg = cooperative_groups;
#ifndef PROBE
#define PROBE 0
#endif
__device__ __forceinline__ int opaque_tid() { int t = threadIdx.x; asm volatile("" : "+v"(t)); return t; }
namespace pg8 {
#define PG8_LAS __attribute__((address_space(3)))
typedef unsigned short bf16_t;
typedef short bf16x8 __attribute__((ext_vector_type(8)));
typedef float f32x4 __attribute__((ext_vector_type(4)));
typedef unsigned u32x4 __attribute__((ext_vector_type(4)));
constexpr int BM = 256, BK = 64, HALF = 128, HTB = HALF * BK * 2  , STAGE_BYTES = 8 * HTB, NXCD = 8, WGM = 8;

__host__ __device__ __forceinline__ int lds_byte(int r, int c) { const int st = (r >> 4) * 2 + (c >> 5), rr = r & 15, cc = c & 31, ob = rr * 64 + cc * 2; return st * 1024 + (ob ^ (((ob >> 9) & 1) << 5)); }
__host__ __device__ __forceinline__ void stage_rc(int b, int& R, int& C) { const int st = b / 1024, sb = b % 1024, swz = sb ^ (((sb >> 9) & 1) << 5); R = (st >> 1) * 16 + swz / 64; C = (st & 1) * 32 + (swz % 64) / 2; }
__host__ __device__ __forceinline__ int perm32(int rho) { const int n = rho >> 4, i = rho & 15; return 8 * (i >> 2) + 4 * n + (i & 3); }

struct Unit { int pm, pn; };
struct Gemm { const bf16_t* A; const bf16_t* Bt; int M, N, K; };

struct StaticOrder {
    int nM, nN, nwg, G, c;
    __host__ __device__ void init(int M, int N, int G_, int c_) { nM = M / BM; nN = N / BM; nwg = nM * nN; G = G_; c = c_; }
    __host__ __device__ bool next(int i, Unit& u) const {
        const long L = (long)i * G + c; if (L >= nwg) return false;
        int wgid = (int)L; { const int q = nwg / NXCD, r = nwg % NXCD, xcd = wgid % NXCD, off = wgid / NXCD; wgid = (xcd < r ? xcd * (q + 1) : r * (q + 1) + (xcd - r) * q) + off; }
        const int nig = WGM * nN, gid = wgid / nig, fm = gid * WGM, gsz = (nM - fm) < WGM ? (nM - fm) : WGM;
        u.pm = fm + ((wgid % nig) % gsz); u.pn = (wgid % nig) / gsz; return true;
    }
    __device__ __forceinline__ void a_ready(const Unit&) const {}
    __device__ __forceinline__ void done(const Unit&) const {}
};

__device__ __forceinline__ unsigned cvt_pk_bf16(float lo, float hi) { unsigned r; asm volatile("v_cvt_pk_bf16_f32 %0, %1, %2" : "=v"(r) : "v"(lo), "v"(hi)); return r; }
typedef float f32x2 __attribute__((ext_vector_type(2)));
__device__ __forceinline__ f32x2 gelu_pk(f32x2 v) {
    const f32x2 av = __builtin_elementwise_abs(v), d = av * 0.2316418882f + 1.0f;
    f32x2 t; t.x = __builtin_amdgcn_rcpf(d.x); t.y = __builtin_amdgcn_rcpf(d.y);
    f32x2 q = t * 0.5307027145f + (-0.7265760135f); q = q * t + 0.7107068705f; q = q * t + (-0.142248368f); q = q * t + 0.127414796f; q = q * t;
    const f32x2 s = (v * v) * (-0.72134752044f);
    f32x2 e; e.x = __builtin_amdgcn_exp2f(s.x); e.y = __builtin_amdgcn_exp2f(s.y);
    const f32x2 m = v * (q * e), r = v - m;
    f32x2 o; o.x = v.x < 0.f ? m.x : r.x; o.y = v.y < 0.f ? m.y : r.y; return o;
}
constexpr float RS_INV = 1.0f / 2048.0f, RS_EPS = 1e-6f;
template <int MODE, bool RSCALE, bool HEADMAJOR = false, bool HN = false> struct EpiBf {
    static constexpr bool PERM = true, AFTER_DRAIN = false, IDEMPOTENT = true;
    bf16_t* O; int ldc; int split_pn; float* ss; const float* rs; const float* hgain; PG8_LAS float* xs;
    __device__ __forceinline__ void operator()(const f32x4 (&acc)[2][2][4][2], const Unit& u, int wr, int wc, int fr, int fq) const {
        const int row0 = u.pm * BM + wr * 64 + fr, col0 = u.pn * BM + wc * 32 + 8 * fq;
        const bool up = u.pn >= split_pn;
        float rr[2][4];
#pragma unroll
        for (int ai = 0; ai < 2; ++ai)
#pragma unroll
            for (int m = 0; m < 4; ++m) { rr[ai][m] = 1.f;
                if (RSCALE) { const f32x4* p = (const f32x4*)(rs + (size_t)(row0 + ai * HALF + m * 16) * 32 + fq * 8); const f32x4 a = p[0], b = p[1];
                    float t = ((a[0] + a[1]) + (a[2] + a[3])) + ((b[0] + b[1]) + (b[2] + b[3])); t += __shfl_xor(t, 16); t += __shfl_xor(t, 32); rr[ai][m] = 1.0f / sqrtf(t * RS_INV + RS_EPS); } }
        f32x4 hg0 = {1.f, 1.f, 1.f, 1.f}, hg1 = hg0; const bool hn = HN && u.pn < 8;
        if (HN) { if (hn) {
#pragma unroll
            for (int ai = 0; ai < 2; ++ai)
#pragma unroll
                for (int m = 0; m < 4; ++m)
#pragma unroll
                    for (int bj = 0; bj < 2; ++bj) { const f32x4 v0 = acc[ai][bj][m][0] * rr[ai][m], v1 = acc[ai][bj][m][1] * rr[ai][m];
                        float t = ((v0[0] * v0[0] + v0[1] * v0[1]) + (v0[2] * v0[2] + v0[3] * v0[3])) + ((v1[0] * v1[0] + v1[1] * v1[1]) + (v1[2] * v1[2] + v1[3] * v1[3]));
                        t += __shfl_xor(t, 16); t += __shfl_xor(t, 32);
                        if (fq == 0) xs[(ai * HALF + wr * 64 + m * 16 + fr) * 8 + bj * 4 + wc] = t; }
            asm volatile("s_waitcnt lgkmcnt(0)" ::: "memory"); __builtin_amdgcn_s_barrier(); asm volatile("" ::: "memory");
            hg0 = *(const f32x4*)(hgain + wc * 32 + 8 * fq); hg1 = *(const f32x4*)(hgain + wc * 32 + 8 * fq + 4);
        } }
#pragma unroll
        for (int ai = 0; ai < 2; ++ai)
#pragma unroll
            for (int m = 0; m < 4; ++m) { const int row = row0 + ai * HALF + m * 16; float s = 0.f; float hnr[2] = {1.f, 1.f};
                if (HN) { if (hn) { const PG8_LAS f32x4* xp = (const PG8_LAS f32x4*)(xs + (ai * HALF + wr * 64 + m * 16 + fr) * 8); const f32x4 a = xp[0], b = xp[1];
                    hnr[0] = 1.0f / sqrtf(((a[0] + a[1]) + (a[2] + a[3])) * (1.0f / 128.0f) + RS_EPS); hnr[1] = 1.0f / sqrtf(((b[0] + b[1]) + (b[2] + b[3])) * (1.0f / 128.0f) + RS_EPS); } }
                bf16_t* rowp = HEADMAJOR ? O + (u.pn >= 8 ? (size_t)16384 * 2048 : (size_t)0) + ((size_t)((row >> 12) * 16 + 2 * (u.pn & 7)) * 4096 + (row & 4095)) * 128 + wc * 32 + 8 * fq
                                         : O + (size_t)row * ldc + col0;
#pragma unroll
                for (int bj = 0; bj < 2; ++bj) { f32x4 v0 = acc[ai][bj][m][0], v1 = acc[ai][bj][m][1];
                    if (RSCALE) { v0 = v0 * rr[ai][m]; v1 = v1 * rr[ai][m]; }
                    if (HN) { if (hn) { v0 = (v0 * hnr[bj]) * hg0; v1 = (v1 * hnr[bj]) * hg1; } }
                    if (MODE == 1) { f32x2 a = gelu_pk((f32x2){v0[0], v0[1]}), b = gelu_pk((f32x2){v0[2], v0[3]}), c = gelu_pk((f32x2){v1[0], v1[1]}), d = gelu_pk((f32x2){v1[2], v1[3]});
                        v0 = (f32x4){a.x, a.y, b.x, b.y}; v1 = (f32x4){c.x, c.y, d.x, d.y};
                        s += (v0[0] * v0[0] + v0[1] * v0[1]) + (v0[2] * v0[2] + v0[3] * v0[3]) + (v1[0] * v1[0] + v1[1] * v1[1]) + (v1[2] * v1[2] + v1[3] * v1[3]); }
                    if (MODE == 2) { if (up) {
#pragma unroll
                        for (int e = 0; e < 4; ++e) { v0[e] = __builtin_amdgcn_rcpf(1.0f + __builtin_amdgcn_exp2f(-1.4426950408889634f * v0[e])); v1[e] = __builtin_amdgcn_rcpf(1.0f + __builtin_amdgcn_exp2f(-1.4426950408889634f * v1[e])); } } }
                    u32x4 w; w.x = cvt_pk_bf16(v0[0], v0[1]); w.y = cvt_pk_bf16(v0[2], v0[3]); w.z = cvt_pk_bf16(v1[0], v1[1]); w.w = cvt_pk_bf16(v1[2], v1[3]);
                    *(u32x4*)(rowp + (HEADMAJOR ? (size_t)bj * 4096 * 128 : (size_t)bj * HALF)) = w; }
                if (MODE == 1) { if (up) { s += __shfl_xor(s, 16); s += __shfl_xor(s, 32); if (fq == 0) ss[(size_t)row * 32 + (u.pn - split_pn) * 4 + wc] = s; } } }
    }
};
struct EpiRes {
    static constexpr bool PERM = true, AFTER_DRAIN = false, IDEMPOTENT = false;
    const float* base; float* out; bf16_t* hb; float* rss; int ldc;
    __device__ __forceinline__ void operator()(const f32x4 (&acc)[2][2][4][2], const Unit& u, int wr, int wc, int fr, int fq) const {
        const int row0 = u.pm * BM + wr * 64 + fr, col0 = u.pn * BM + wc * 32 + 8 * fq;
#pragma unroll
        for (int ai = 0; ai < 2; ++ai)
#pragma unroll
            for (int m = 0; m < 4; ++m) { const int row = row0 + ai * HALF + m * 16; const size_t off = (size_t)row * ldc + col0; f32x4 b[2][2]; float s = 0.f;
#pragma unroll
                for (int bj = 0; bj < 2; ++bj)
#pragma unroll
                    for (int n = 0; n < 2; ++n) b[bj][n] = *(const f32x4*)(base + off + bj * HALF + n * 4);
#pragma unroll
                for (int bj = 0; bj < 2; ++bj) { const f32x4 o0 = b[bj][0] + acc[ai][bj][m][0], o1 = b[bj][1] + acc[ai][bj][m][1];
                    *(f32x4*)(out + off + bj * HALF) = o0; *(f32x4*)(out + off + bj * HALF + 4) = o1;
                    u32x4 w; w.x = cvt_pk_bf16(o0[0], o0[1]); w.y = cvt_pk_bf16(o0[2], o0[3]); w.z = cvt_pk_bf16(o1[0], o1[1]); w.w = cvt_pk_bf16(o1[2], o1[3]);
                    *(u32x4*)(hb + off + bj * HALF) = w;
                    s += ((o0[0] * o0[0] + o0[1] * o0[1]) + (o0[2] * o0[2] + o0[3] * o0[3])) + ((o1[0] * o1[0] + o1[1] * o1[1]) + (o1[2] * o1[2] + o1[3] * o1[3])); }
                s += __shfl_xor(s, 16); s += __shfl_xor(s, 32); if (fq == 0) rss[(size_t)row * 32 + u.pn * 4 + wc] = s;
                if (m & 1) asm volatile("" ::: "memory"); }
    }
};
template <class Epi, class Sched, bool ALIGN_EPI = false, bool SP2 = false>
__device__ __forceinline__ void gemm_phase(PG8_LAS unsigned char* lds, const Gemm g, const Sched& S, const Epi& E) {
    const int tid = opaque_tid(), wid = __builtin_amdgcn_readfirstlane(tid >> 6), lane = tid & 63, wr = wid >> 2, wc = wid & 3, fr = lane & 15, fq = lane >> 4;
    const int K = g.K, nt = K / BK;
    unsigned voffA[2], voffB[2];
#pragma unroll
    for (int i = 0; i < 2; ++i) { int R, C; stage_rc(tid * 16 + i * 8192, R, C); const int Rb = Epi::PERM ? ((R & ~31) + perm32(R & 31)) : R;
        voffA[i] = (unsigned)(R * K + C) * 2u; voffB[i] = (unsigned)(Rb * K + C) * 2u; }
    const size_t kstep = (size_t)(BK * 2);
    const size_t hstep = (size_t)HALF * K * 2;
    const size_t tstep = 2 * hstep;
    const unsigned ldsw = (unsigned)wid * 1024u;
    const int aoff = lds_byte(wr * 64 + fr, fq * 8), boff = lds_byte(wc * 32 + fr, fq * 8);
#define PG8_SA(b, h) (((b) * 2 + (h)) * HTB)
#define PG8_SB(b, h) ((4 + (b) * 2 + (h)) * HTB)
#define PG8_STAGE(bufoff, gbase, voff) do { _Pragma("unroll") for (int _i = 0; _i < 2; ++_i) \
        __builtin_amdgcn_global_load_lds((const unsigned*)((const char*)(gbase) + (voff)[_i]), (PG8_LAS unsigned*)(lds + (bufoff) + ldsw + _i * 8192), 16, 0, 0); } while (0)
#define PG8_LDA(dst, b, h) do { _Pragma("unroll") for (int m = 0; m < 4; ++m) _Pragma("unroll") for (int k = 0; k < 2; ++k) dst[m][k] = *(const PG8_LAS bf16x8*)(lds + PG8_SA(b, h) + aoff + m * 2048 + k * 1024); } while (0)
#define PG8_LDB(dst, b, h) do { _Pragma("unroll") for (int n = 0; n < 2; ++n) _Pragma("unroll") for (int k = 0; k < 2; ++k) dst[n][k] = *(const PG8_LAS bf16x8*)(lds + PG8_SB(b, h) + boff + n * 2048 + k * 1024); } while (0)
#define PG8_MMA(ai, bj, At, Bt) do { __builtin_amdgcn_s_setprio(1); _Pragma("unroll") for (int m = 0; m < 4; ++m) _Pragma("unroll") for (int n = 0; n < 2; ++n) _Pragma("unroll") for (int k = 0; k < 2; ++k) \
        acc[ai][bj][m][n] = __builtin_amdgcn_mfma_f32_16x16x32_bf16(Bt[n][k], At[m][k], acc[ai][bj][m][n], 0, 0, 0); __builtin_amdgcn_s_setprio(0); } while (0)
#define PG8_WAIT_V(n) asm volatile("s_waitcnt vmcnt(" #n ")" ::: "memory")
#define PG8_WAIT_L(n) asm volatile("s_waitcnt lgkmcnt(" #n ")" ::: "memory")
#define PG8_BAR __builtin_amdgcn_s_barrier()
#define PG8_SCHED __builtin_amdgcn_sched_barrier(0)
    Unit cur, nxt; int ui = 0;
    if (!S.next(0, cur)) return;
    f32x4 acc[2][2][4][2];
#pragma unroll
    for (int a = 0; a < 2; ++a)
#pragma unroll
        for (int b = 0; b < 2; ++b)
#pragma unroll
            for (int m = 0; m < 4; ++m)
#pragma unroll
                for (int n = 0; n < 2; ++n) acc[a][b][m][n] = (f32x4){0.f, 0.f, 0.f, 0.f};
    bf16x8 At[4][2], B0[2][2], B1[2][2];
    const char* cA = (const char*)g.A + (size_t)cur.pm * tstep; const char* cB = (const char*)g.Bt + (size_t)cur.pn * tstep;
    S.a_ready(cur);
    if constexpr (SP2) {
        PG8_STAGE(PG8_SB(0, 0), cB, voffB); PG8_STAGE(PG8_SB(0, 1), cB + hstep, voffB); PG8_STAGE(PG8_SA(0, 0), cA, voffA); PG8_STAGE(PG8_SA(0, 1), cA + hstep, voffA);
        if (wr == 1) PG8_BAR;
        PG8_WAIT_V(2); PG8_BAR;
        PG8_STAGE(PG8_SB(1, 0), cB + kstep, voffB); PG8_STAGE(PG8_SA(1, 0), cA + kstep, voffA); PG8_STAGE(PG8_SB(1, 1), cB + hstep + kstep, voffB);
        PG8_WAIT_V(6); PG8_BAR;
    } else {
        PG8_STAGE(PG8_SB(0, 0), cB, voffB); PG8_STAGE(PG8_SA(0, 0), cA, voffA); PG8_STAGE(PG8_SB(0, 1), cB + hstep, voffB); PG8_STAGE(PG8_SA(0, 1), cA + hstep, voffA);
        if (wr == 1) PG8_BAR;
        PG8_WAIT_V(4); PG8_BAR;
        PG8_STAGE(PG8_SB(1, 0), cB + kstep, voffB); PG8_STAGE(PG8_SA(1, 0), cA + kstep, voffA); PG8_STAGE(PG8_SB(1, 1), cB + hstep + kstep, voffB);
        PG8_WAIT_V(6); PG8_BAR;
    }
    for (;;) {
        const bool has_next = S.next(ui + 1, nxt);
        const char* nA = has_next ? (const char*)g.A + (size_t)nxt.pm * tstep : cA; const char* nB = has_next ? (const char*)g.Bt + (size_t)nxt.pn * tstep : cB;
        for (int t = 0; t < nt; t += 2) {
            const bool last = (t == nt - 2);
            const char* a1 = cA + (size_t)(t + 1) * kstep;
            const char* a2 = last ? nA : cA + (size_t)(t + 2) * kstep; const char* b2 = last ? nB : cB + (size_t)(t + 2) * kstep;
            const char* a3 = a2 + kstep; const char* b3 = b2 + kstep;
            if (last && has_next) S.a_ready(nxt);
            if constexpr (SP2) {
            PG8_LDB(B0, 0, 0); PG8_LDB(B1, 0, 1); PG8_SCHED; PG8_LDA(At, 0, 0); PG8_STAGE(PG8_SA(1, 1), a1 + hstep, voffA);
            PG8_WAIT_V(8); PG8_WAIT_L(0); PG8_BAR; PG8_MMA(0, 0, At, B0); PG8_MMA(0, 1, At, B1); PG8_BAR; PG8_SCHED;
            PG8_LDA(At, 0, 1); PG8_STAGE(PG8_SB(0, 0), b2, voffB); PG8_STAGE(PG8_SB(0, 1), b2 + hstep, voffB); PG8_STAGE(PG8_SA(0, 0), a2, voffA);
            PG8_WAIT_V(8); PG8_WAIT_L(0); PG8_BAR; PG8_MMA(1, 0, At, B0); PG8_MMA(1, 1, At, B1); PG8_BAR; PG8_SCHED;
            PG8_LDB(B0, 1, 0); PG8_LDB(B1, 1, 1); PG8_SCHED; PG8_LDA(At, 1, 0); PG8_STAGE(PG8_SA(0, 1), a2 + hstep, voffA);
            PG8_WAIT_V(8); PG8_WAIT_L(0); PG8_BAR; PG8_MMA(0, 0, At, B0); PG8_MMA(0, 1, At, B1); PG8_BAR; PG8_SCHED;
            PG8_LDA(At, 1, 1); PG8_STAGE(PG8_SB(1, 0), b3, voffB); PG8_STAGE(PG8_SB(1, 1), b3 + hstep, voffB); PG8_STAGE(PG8_SA(1, 0), a3, voffA);
            PG8_WAIT_V(8); PG8_WAIT_L(0); PG8_BAR; PG8_MMA(1, 0, At, B0); PG8_MMA(1, 1, At, B1); PG8_BAR; PG8_SCHED;
            } else {
            PG8_LDB(B0, 0, 0); PG8_SCHED; PG8_LDA(At, 0, 0); PG8_STAGE(PG8_SA(1, 1), a1 + hstep, voffA);
            PG8_WAIT_L(8); PG8_BAR; PG8_WAIT_L(0); PG8_MMA(0, 0, At, B0); PG8_BAR; PG8_SCHED;
            PG8_LDB(B1, 0, 1); PG8_STAGE(PG8_SB(0, 0), b2, voffB);
            PG8_BAR; PG8_WAIT_L(0); PG8_MMA(0, 1, At, B1); PG8_BAR;
            PG8_LDA(At, 0, 1); PG8_STAGE(PG8_SA(0, 0), a2, voffA);
            PG8_BAR; PG8_WAIT_L(0); PG8_MMA(1, 0, At, B0); PG8_BAR; PG8_SCHED;
            PG8_STAGE(PG8_SB(0, 1), b2 + hstep, voffB);
            PG8_WAIT_V(6); PG8_BAR; PG8_MMA(1, 1, At, B1); PG8_BAR;
            PG8_LDB(B0, 1, 0); PG8_SCHED; PG8_LDA(At, 1, 0); PG8_STAGE(PG8_SA(0, 1), a2 + hstep, voffA);
            PG8_WAIT_L(8); PG8_BAR; PG8_WAIT_L(0); PG8_MMA(0, 0, At, B0); PG8_BAR; PG8_SCHED;
            PG8_LDB(B1, 1, 1); PG8_STAGE(PG8_SB(1, 0), b3, voffB);
            PG8_BAR; PG8_WAIT_L(0); PG8_MMA(0, 1, At, B1); PG8_BAR;
            PG8_LDA(At, 1, 1); PG8_STAGE(PG8_SA(1, 0), a3, voffA);
            PG8_BAR; PG8_WAIT_L(0); PG8_MMA(1, 0, At, B0); PG8_BAR; PG8_SCHED;
            PG8_STAGE(PG8_SB(1, 1), b3 + hstep, voffB);
            PG8_WAIT_V(6); PG8_BAR; PG8_MMA(1, 1, At, B1); PG8_BAR;
            }
        }
        if constexpr (ALIGN_EPI) { if (wr == 0) PG8_BAR; }
        if constexpr (!Epi::AFTER_DRAIN) { E(acc, cur, wr, wc, fr, fq);
#if PROBE == 8
            if constexpr (Epi::IDEMPOTENT) E(acc, cur, wr, wc, fr, fq);
#endif
            S.done(cur); }
        if (!has_next) break;
#pragma unroll
        for (int a = 0; a < 2; ++a)
#pragma unroll
            for (int b = 0; b < 2; ++b)
#pragma unroll
                for (int m = 0; m < 4; ++m)
#pragma unroll
                    for (int n = 0; n < 2; ++n) acc[a][b][m][n] = (f32x4){0.f, 0.f, 0.f, 0.f};
        cur = nxt; cA = nA; cB = nB; ++ui;
        if constexpr (ALIGN_EPI) { if (wr == 1) PG8_BAR; }
    }
    PG8_WAIT_V(0);
    if constexpr (!ALIGN_EPI) { if (wr == 0) PG8_BAR; }
    PG8_BAR;
    if constexpr (Epi::AFTER_DRAIN) { E.fused(acc, cur, wr, wc, fr, fq, lds, wid, lane); S.done(cur); }
#undef PG8_SA
#undef PG8_SB
#undef PG8_STAGE
#undef PG8_LDA
#undef PG8_LDB
#undef PG8_MMA
#undef PG8_WAIT_V
#undef PG8_WAIT_L
#undef PG8_BAR
#undef PG8_SCHED
}
}
namespace att {
constexpr int D = 128, LDQ = 4096, LDK = 128, LDO = 2048, LDG = 4096;
constexpr float THR = 8.f; constexpr bool WSKIP = false;
typedef unsigned u32x4_t __attribute__((ext_vector_type(4)));
typedef short bf16x8_t __attribute__((ext_vector_type(8)));
__device__ __forceinline__ bf16x8_t ka_frag(unsigned lo, unsigned up, int hi) {
    u32x4_t w;
    w.x = 0x3f803f80u; w.y = 0x3f80u | (((lo & 0xffffu) ^ 0x8000u) << 16); w.z = ((lo >> 16) ^ 0x8000u) | (((up & 0xffffu) ^ 0x8000u) << 16); w.w = 0u;
    if (hi) { w.x = 0u; w.y = 0u; w.z = 0u; }
    return __builtin_bit_cast(bf16x8_t, w);
}
__device__ __forceinline__ bf16x8_t qa_frag(unsigned lo, unsigned up, int hi) {
    u32x4_t w;
    w.x = lo; w.y = (up & 0xffffu) | 0x3f800000u; w.z = 0x3f803f80u; w.w = 0u;
    if (hi) { w.x = 0u; w.y = 0u; w.z = 0u; }
    return __builtin_bit_cast(bf16x8_t, w);
}
constexpr float SCALE = 0.08838834764831845f;
constexpr int NW = 8, QBLK = 32, KVBLK = 64, QB = NW * QBLK;
constexpr int SHM_V = KVBLK * D * 2, SHM_K = KVBLK * D * 2;
constexpr int ATT_LDS_BYTES = 2 * SHM_V + 2 * SHM_K + NW * 64 * 4;

using bf16 = __hip_bfloat16;
typedef short bf16x8 __attribute__((ext_vector_type(8)));
typedef short s16x4 __attribute__((ext_vector_type(4)));
typedef float f32x16 __attribute__((ext_vector_type(16)));
typedef float f32x4 __attribute__((ext_vector_type(4)));
typedef unsigned u32x4 __attribute__((ext_vector_type(4)));
template <class A, class Bt> struct same_t { static constexpr bool v = false; };
template <class A> struct same_t<A, A> { static constexpr bool v = true; };

#define KSWZ(row, colB) ((row) * 256 + ((colB) ^ (((row) & 7) << 4)))
#define SBAR() __builtin_amdgcn_sched_barrier(0)
__device__ __forceinline__ int v_st(int k, int c) { const int kk = (k & ~0xC) | ((k & 4) << 1) | ((k & 8) >> 1); return ((kk >> 3) * 4 + (c >> 5)) * 512 + ((kk & 7) * 32 + (c & 31)) * 2; }
__device__ __forceinline__ int v_rd_base(int lane) { return ((lane & 3) << 3) | (((lane >> 2) & 3) << 6) | (((lane >> 4) & 1) << 5) | (((lane >> 5) & 1) << 8); }
constexpr int v_rd_off(int d0, int ks, int half) { return d0 * 512 + ks * 4096 + half * 2048; }
__device__ __forceinline__ int crow(int r, int hi) { return (r & 3) + 8 * (r >> 2) + 4 * hi; }
__device__ __forceinline__ unsigned cvtpk(float lo, float hi) {
    unsigned r; asm volatile("v_cvt_pk_bf16_f32 %0, %1, %2" : "=v"(r) : "v"(lo), "v"(hi)); return r;
}
__device__ __forceinline__ bf16x8 pack8(f32x4 a, f32x4 b) {
    u32x4 w = {cvtpk(a[0], a[1]), cvtpk(a[2], a[3]), cvtpk(b[0], b[1]), cvtpk(b[2], b[3])};
    return *reinterpret_cast<bf16x8*>(&w);
}
template <class T> __device__ __forceinline__ bf16x8 load8(const T* p) {
    if constexpr (same_t<T, float>::v) { return pack8(*(const f32x4*)p, *(const f32x4*)(p + 4)); }
    else { return *reinterpret_cast<const bf16x8*>(p); }
}
__device__ __forceinline__ void mask_tile(f32x16& p0, f32x16& p1, int dq, unsigned W) {
    const float NEG = -__builtin_inff();
#pragma unroll
    for (int r = 0; r < 16; ++r) {
        const int c = (r & 3) + 8 * (r >> 2);
        if ((unsigned)(dq - c) >= W) p0[r] = NEG;
        if ((unsigned)(dq - c - 32) >= W) p1[r] = NEG;
    }
}
__device__ __forceinline__ void partialSM(f32x16& p0, f32x16& p1, float& m_reg, float& mn, float& alpha) {
    float pmax = p0[0]; for (int r = 1; r < 16; ++r) pmax = fmaxf(pmax, p0[r]); for (int r = 0; r < 16; ++r) pmax = fmaxf(pmax, p1[r]);
    { auto rr = __builtin_amdgcn_permlane32_swap(__float_as_uint(pmax), __float_as_uint(pmax), false, false);
      pmax = fmaxf(__uint_as_float(rr[0]), __uint_as_float(rr[1])); }
    constexpr float C2 = 1.4426950408889634f * SCALE;
    if (__builtin_expect(__all((pmax - m_reg) * SCALE <= THR), 1)) { mn = m_reg; alpha = 1.f; }
    else { mn = fmaxf(m_reg, pmax); alpha = __builtin_amdgcn_exp2f((m_reg - mn) * C2); m_reg = mn; }
    const float mnL = -mn * C2;
    for (int r = 0; r < 16; ++r) p0[r] = fmaf(p0[r], C2, mnL); for (int r = 0; r < 16; ++r) p1[r] = fmaf(p1[r], C2, mnL);
    for (int r = 0; r < 16; ++r) p0[r] = __builtin_amdgcn_exp2f(p0[r]);
}
__device__ __forceinline__ void finishSM(f32x16& p0, f32x16& p1, float alpha, float& l_reg, bf16x8& pa0, bf16x8& pa1, bf16x8& pa2, bf16x8& pa3) {
    for (int r = 0; r < 16; ++r) p1[r] = __builtin_amdgcn_exp2f(p1[r]);
    float ps = 0; for (int r = 0; r < 16; ++r) ps += p0[r]; for (int r = 0; r < 16; ++r) ps += p1[r];
    { auto rr = __builtin_amdgcn_permlane32_swap(__float_as_uint(ps), __float_as_uint(ps), false, false);
      ps = __uint_as_float(rr[0]) + __uint_as_float(rr[1]); }
    l_reg = l_reg * alpha + ps;
#define PK4(P, B_, OUT) do { unsigned a0 = cvtpk(P[B_+0], P[B_+1]), a1 = cvtpk(P[B_+2], P[B_+3]);                          \
        unsigned b0 = cvtpk(P[B_+4], P[B_+5]), b1 = cvtpk(P[B_+6], P[B_+7]);                                             \
        auto r0 = __builtin_amdgcn_permlane32_swap(a0, b0, false, false); auto r1 = __builtin_amdgcn_permlane32_swap(a1, b1, false, false); \
        u32x4 w = {r0[0], r1[0], r0[1], r1[1]}; OUT = *reinterpret_cast<bf16x8*>(&w); } while (0)
    PK4(p0, 0, pa0); PK4(p0, 8, pa1); PK4(p1, 0, pa2); PK4(p1, 8, pa3);
#undef PK4
}
template <int KB, bool SK>
__device__ __forceinline__ void qkt(f32x16& p0, f32x16& p1, const char* K_lds, int r32, int hi, const bf16x8* qr, bool act, unsigned long long qa, unsigned long long c) {
    if (SK && !act) { const float NEG = -__builtin_inff();
#pragma unroll
        for (int r = 0; r < 16; ++r) { p0[r] = NEG; p1[r] = NEG; } return; }
    p0 = f32x16{}; p1 = f32x16{};
    const char* kb[4];
#pragma unroll
    for (int dd = 0; dd < 4; ++dd) kb[dd] = K_lds + KB * SHM_K + KSWZ(r32, (dd * 16 + hi * 8) * 2);
#pragma unroll
    for (int d0 = 0; d0 < 8; ++d0) { const char* a = kb[d0 & 3] + (d0 >> 2) * 128;
        bf16x8 b0 = *reinterpret_cast<const bf16x8*>(a);
        bf16x8 b1 = *reinterpret_cast<const bf16x8*>(a + 32 * 256);
        p0 = __builtin_amdgcn_mfma_f32_32x32x16_bf16(b0, qr[d0], p0, 0, 0, 0);
        p1 = __builtin_amdgcn_mfma_f32_32x32x16_bf16(b1, qr[d0], p1, 0, 0, 0); }
    { unsigned ql = (unsigned)qa, qu = (unsigned)(qa >> 32); asm volatile("" : "+v"(ql), "+v"(qu));
      const bf16x8 qaf = qa_frag(ql, qu, hi);
      const unsigned cl = (unsigned)c, cu = (unsigned)(c >> 32);
      auto r0 = __builtin_amdgcn_permlane32_swap(cl, cl, false, false); auto r1 = __builtin_amdgcn_permlane32_swap(cu, cu, false, false);
      p0 = __builtin_amdgcn_mfma_f32_32x32x16_bf16(ka_frag(r0[0], r1[0], hi), qaf, p0, 0, 0, 0);
      p1 = __builtin_amdgcn_mfma_f32_32x32x16_bf16(ka_frag(r0[1], r1[1], hi), qaf, p1, 0, 0, 0); }
}
template <int VB, bool SK>
__device__ __forceinline__ void pv_tile(f32x16* o, int vb0, bf16x8 pa0, bf16x8 pa1, bf16x8 pa2, bf16x8 pa3, bool act) {
    if (SK && !act) return;
#define TRRD(dst, off) asm volatile("ds_read_b64_tr_b16 %0, %1 offset:%2" : "=&v"(dst) : "v"(vb0), "i"(off) : "memory")
#define PV_D0(d0) do { s16x4 l0, l1, l2, l3, h0, h1, h2, h3; constexpr int b_ = VB * SHM_V + v_rd_off(d0, 0, 0);     \
        TRRD(l0, b_); TRRD(h0, b_ + 2048); TRRD(l1, b_ + 4096); TRRD(h1, b_ + 6144); TRRD(l2, b_ + 8192); TRRD(h2, b_ + 10240); TRRD(l3, b_ + 12288); TRRD(h3, b_ + 14336); \
        asm volatile("s_waitcnt lgkmcnt(0)" ::: "memory"); SBAR();                 \
        o[d0] = __builtin_amdgcn_mfma_f32_32x32x16_bf16(pa0, (bf16x8){l0[0], l0[1], l0[2], l0[3], h0[0], h0[1], h0[2], h0[3]}, o[d0], 0, 0, 0);   \
        o[d0] = __builtin_amdgcn_mfma_f32_32x32x16_bf16(pa1, (bf16x8){l1[0], l1[1], l1[2], l1[3], h1[0], h1[1], h1[2], h1[3]}, o[d0], 0, 0, 0);   \
        o[d0] = __builtin_amdgcn_mfma_f32_32x32x16_bf16(pa2, (bf16x8){l2[0], l2[1], l2[2], l2[3], h2[0], h2[1], h2[2], h2[3]}, o[d0], 0, 0, 0);   \
        o[d0] = __builtin_amdgcn_mfma_f32_32x32x16_bf16(pa3, (bf16x8){l3[0], l3[1], l3[2], l3[3], h3[0], h3[1], h3[2], h3[3]}, o[d0], 0, 0, 0); } while (0)
    PV_D0(0); PV_D0(1); PV_D0(2); PV_D0(3);
#undef PV_D0
#undef TRRD
}

template <class TIn, class TOut> struct BlockRef { const TIn* Q; const TIn* K; const TIn* V; TOut* O; const unsigned short* G; const unsigned long long* CA; int P0; };
template <class TIn> struct Seam {
    bf16x8 qr[8];
    bf16x8 st_v0, st_v1, st_k0, st_k1; f32x4 sf0, sf1, sf2, sf3;
    unsigned long long ca, qa;
    f32x4 tq[16];
};
__device__ __forceinline__ int swa_jlo(int P0, int W) { const int lowk = P0 - W + 1; return lowk > 0 ? lowk / KVBLK : 0; }
#define ROW(p, k0, rr) ((p) + (size_t)((k0) + (rr)) * LDK + sc)
#define VMW() asm volatile("s_waitcnt vmcnt(0)" ::: "memory")
#define VMWN(n) asm volatile("s_waitcnt vmcnt(%0)" :: "i"(n) : "memory")
#define SLOAD_H(Kp, Vp, CAp, k0) do { S.st_v0 = load8<TIn>(ROW(Vp, k0, sr)); S.st_v1 = load8<TIn>(ROW(Vp, k0, 32 + sr));              \
                         S.st_k0 = load8<TIn>(ROW(Kp, k0, sr)); S.st_k1 = load8<TIn>(ROW(Kp, k0, 32 + sr)); S.ca = (CAp)[(k0) + lane]; } while (0)
#define SWRITE_HK(bf) do { *(bf16x8*)(K_lds + (bf) * SHM_K + kws) = S.st_k0; *(bf16x8*)(K_lds + (bf) * SHM_K + kws + 32 * 256) = S.st_k1; } while (0)
#define SWRITE_HV(bf) do { *(bf16x8*)(V_lds + (bf) * SHM_V + vst0) = S.st_v0; *(bf16x8*)(V_lds + (bf) * SHM_V + vst1) = S.st_v1; } while (0)
#define SWRITE_H(bf) do { SWRITE_HV(bf); SWRITE_HK(bf); } while (0)
#define SLOAD_F(p, k0) do { S.sf0 = *(const f32x4*)ROW(p, k0, sr); S.sf1 = *(const f32x4*)(ROW(p, k0, sr) + 4);                \
                            S.sf2 = *(const f32x4*)ROW(p, k0, 32 + sr); S.sf3 = *(const f32x4*)(ROW(p, k0, 32 + sr) + 4); } while (0)
#define SWRITE_KF(bf) do { *(bf16x8*)(K_lds + (bf) * SHM_K + kws) = pack8(S.sf0, S.sf1); *(bf16x8*)(K_lds + (bf) * SHM_K + kws + 32 * 256) = pack8(S.sf2, S.sf3); } while (0)
#define SWRITE_VF(bf) do { *(bf16x8*)(V_lds + (bf) * SHM_V + vst0) = pack8(S.sf0, S.sf1); *(bf16x8*)(V_lds + (bf) * SHM_V + vst1) = pack8(S.sf2, S.sf3); } while (0)
template <class TIn, class TOut>
__device__ __forceinline__ void causal_swa_prime(const BlockRef<TIn, TOut>& cur, int W, char* lds, Seam<TIn>& S) {
    constexpr bool F32 = same_t<TIn, float>::v;
    const int tid = opaque_tid(), wid = __builtin_amdgcn_readfirstlane(tid >> 6), lane = tid & 63, r32 = lane & 31, hi = lane >> 5;
    const int sr = tid >> 4, sc = (tid & 15) * 8, kws = KSWZ(sr, sc * 2); char* K_lds = lds + 2 * SHM_V;
    const int kb0 = swa_jlo(cur.P0, W) * KVBLK;
    for (int d0 = 0; d0 < 8; ++d0) S.qr[d0] = load8<TIn>(cur.Q + (size_t)(wid * QBLK + r32) * LDQ + d0 * 16 + hi * 8);
    S.qa = cur.CA[cur.P0 + wid * QBLK + r32];
    if constexpr (F32) { SLOAD_F((const float*)cur.K, kb0); VMW(); SWRITE_KF(0); SBAR(); SLOAD_F((const float*)cur.V, kb0); }
    else { SLOAD_H(cur.K, cur.V, cur.CA, kb0); VMW(); SWRITE_HK(0); }
    __syncthreads();
}
template <class TIn, class TOut>
__device__ __forceinline__ void causal_swa_block(const BlockRef<TIn, TOut>& cur, const BlockRef<TIn, TOut>& nxt, int skv, int W, char* lds, Seam<TIn>& S) {
    constexpr bool F32 = same_t<TIn, float>::v;
    const int tid = opaque_tid(), wid = __builtin_amdgcn_readfirstlane(tid >> 6), lane = tid & 63, r32 = lane & 31, hi = lane >> 5;
    const int j_lo = swa_jlo(cur.P0, W);
    int j_hi = (cur.P0 + QB - 1) / KVBLK + 1; if (j_hi > skv / KVBLK) j_hi = skv / KVBLK;
    const int NT = j_hi - j_lo;
    const int kbn = swa_jlo(nxt.P0, W) * KVBLK;
    const int qlo = cur.P0 + wid * QBLK, qm = qlo + r32 - 4 * hi;
    char* V_lds = lds; char* K_lds = lds + 2 * SHM_V;
    float* ws = (float*)(lds + 2 * SHM_V + 2 * SHM_K) + wid * 64; float* li_l = ws, * al_l = ws + 32;
    float m_reg = -1e30f, l_reg = 0; f32x16 o[4] = {};
    const int sr = tid >> 4, sc = (tid & 15) * 8, vst0 = v_st(sr, sc), vst1 = v_st(32 + sr, sc), kws = KSWZ(sr, sc * 2);
    const int vb0 = (int)(uintptr_t)V_lds + v_rd_base(lane);
    const TIn* Kh = cur.K; const TIn* Vh = cur.V; const unsigned long long* CAh = cur.CA;
#define RESC(a) do { if (__any((a) < 1.f)) { if (hi == 0) al_l[r32] = (a); asm volatile("s_waitcnt lgkmcnt(0)" ::: "memory");              \
                     for (int d_ = 0; d_ < 4; ++d_) for (int r = 0; r < 16; ++r) o[d_][r] *= al_l[crow(r, hi)]; } } while (0)
#define KBASE(t) ((j_lo + (t)) * KVBLK)
#define ACT(t) (KBASE(t) <= qlo + QBLK - 1 && KBASE(t) + KVBLK - 1 >= qlo - W + 1)
#define MASKT(P0_, P1_, t) do { const int kb_ = KBASE(t); if ((!SK || ACT(t)) && (kb_ + KVBLK - 1 > qlo || kb_ <= qlo + QBLK - 1 - W)) mask_tile(P0_, P1_, qm - kb_, (unsigned)W); } while (0)
    constexpr int NQL = F32 ? 16 : 8;
    constexpr bool SK = WSKIP && !F32;
#define SEAM_K0() do { VMWN(NQL); if constexpr (F32) { SWRITE_KF(0); SBAR(); SLOAD_F((const float*)nxt.V, kbn); } else { SWRITE_HK(0); } SBAR(); } while (0)
    f32x16 pA0, pA1, pB0, pB1; float mnA, mnB, alA, alB; bf16x8 pa0, pa1, pa2, pa3;
    if constexpr (F32) { VMW(); SWRITE_VF(0); SBAR(); } else { SWRITE_HV(0); SBAR(); }
    const unsigned long long qa_ = S.qa, hc = S.ca;
    if (NT > 1) { if constexpr (F32) SLOAD_F((const float*)Kh, KBASE(1)); else SLOAD_H(Kh, Vh, CAh, KBASE(1)); }
    SBAR(); qkt<0, SK>(pA0, pA1, K_lds, r32, hi, S.qr, ACT(0), qa_, hc);
    if constexpr (F32) { if (NT > 1) { VMW(); SWRITE_KF(1); SBAR(); SLOAD_F((const float*)Vh, KBASE(1)); } }
    MASKT(pA0, pA1, 0); partialSM(pA0, pA1, m_reg, mnA, alA);
    if (NT > 1) { VMW(); if constexpr (F32) { SWRITE_VF(1); SBAR(); if (NT > 2) SLOAD_F((const float*)Kh, KBASE(2)); } else SWRITE_H(1); }
    __syncthreads();
#define HALF_STEP(PX0, PX1, mnX, alX, PY0, PY1, alY, t, KB, VB, SB) do {                                                      \
        { const unsigned long long c_ = S.ca; SBAR(); qkt<KB, SK>(PX0, PX1, K_lds, r32, hi, S.qr, ACT(t), qa_, c_); }                                             \
        finishSM(PY0, PY1, alY, l_reg, pa0, pa1, pa2, pa3); SBAR();                                                           \
        if ((t) + 1 < NT) { if constexpr (F32) { VMW(); SWRITE_KF(SB); SBAR(); SLOAD_F((const float*)Vh, KBASE((t) + 1)); }  \
                            else { SLOAD_H(Kh, Vh, CAh, KBASE((t) + 1)); } SBAR(); }                                               \
        pv_tile<VB, SK>(o, vb0, pa0, pa1, pa2, pa3, ACT((t) - 1)); MASKT(PX0, PX1, (t)); partialSM(PX0, PX1, m_reg, mnX, alX);                                        \
        __syncthreads();                                                                                                      \
        if ((t) + 1 < NT) { VMW(); if constexpr (F32) { SWRITE_VF(SB); SBAR(); if ((t) + 2 < NT) SLOAD_F((const float*)Kh, KBASE((t) + 2)); } \
                            else { SWRITE_H(SB); } }                                                                          \
        RESC(alX); __syncthreads(); } while (0)
    for (int t = 1; t + 1 < NT; t += 2) {
        HALF_STEP(pB0, pB1, mnB, alB, pA0, pA1, alA, t, 1, 0, 0);
        HALF_STEP(pA0, pA1, mnA, alA, pB0, pB1, alB, t + 1, 0, 1, 1);
    }
    const bool even = (NT & 1) == 0;
    if (even) { const unsigned long long c_ = S.ca; SBAR(); qkt<1, SK>(pB0, pB1, K_lds, r32, hi, S.qr, ACT(NT - 1), qa_, c_); SBAR(); }
#define QROW(e) (nxt.Q + (size_t)(wid * QBLK + r32) * D + ((e) >> 1) * 16 + hi * 8 + ((e) & 1) * 4)
    if constexpr (F32) { SLOAD_F((const float*)nxt.K, kbn); SBAR();
#pragma unroll
        for (int e = 0; e < 8; ++e) S.tq[e] = *(const f32x4*)QROW(e); }
    else { SLOAD_H(nxt.K, nxt.V, nxt.CA, kbn); SBAR();
#pragma unroll
        for (int d0 = 0; d0 < 8; ++d0) S.qr[d0] = load8<TIn>(nxt.Q + (size_t)(wid * QBLK + r32) * LDQ + d0 * 16 + hi * 8);
        S.qa = nxt.CA[nxt.P0 + wid * QBLK + r32]; }
    SBAR();
    finishSM(pA0, pA1, alA, l_reg, pa0, pa1, pa2, pa3); SBAR();
    if constexpr (F32) {
#pragma unroll
        for (int e = 8; e < 16; ++e) S.tq[e] = *(const f32x4*)QROW(e); SBAR(); }
#undef QROW
    pv_tile<0, SK>(o, vb0, pa0, pa1, pa2, pa3, ACT(even ? NT - 2 : NT - 1));
    if (even) { MASKT(pB0, pB1, NT - 1); partialSM(pB0, pB1, m_reg, mnB, alB); __syncthreads(); RESC(alB);
        finishSM(pB0, pB1, alB, l_reg, pa0, pa1, pa2, pa3); SBAR(); pv_tile<1, SK>(o, vb0, pa0, pa1, pa2, pa3, ACT(NT - 1)); }
    SBAR(); SEAM_K0();
    if (hi == 0) li_l[r32] = l_reg; asm volatile("s_waitcnt lgkmcnt(0)" ::: "memory");
    float rli[16];
#pragma unroll
    for (int r = 0; r < 16; ++r) rli[r] = __builtin_amdgcn_rcpf(li_l[crow(r, hi)]);
    TOut* Ow = cur.O + (size_t)(wid * QBLK) * LDO; const unsigned short* Gw = cur.G + (size_t)(wid * QBLK) * LDG;
#pragma unroll
    for (int r = 0; r < 16; ++r) { const int orow = crow(r, hi);
#pragma unroll
        for (int d0 = 0; d0 < 4; ++d0) { const float v = o[d0][r] * rli[r];
            if constexpr (same_t<TOut, float>::v) { Ow[(size_t)orow * LDO + d0 * 32 + r32] = v; }
            else { const float vn = __shfl_xor(v, 1);
                   if ((r32 & 1) == 0) { const unsigned g2 = *(const unsigned*)(Gw + (size_t)orow * LDG + d0 * 32 + r32);
                       *(unsigned*)(Ow + (size_t)orow * LDO + d0 * 32 + r32) = cvtpk(v * __uint_as_float(g2 << 16), vn * __uint_as_float(g2 & 0xffff0000u)); } } } }
    if constexpr (F32) {
#pragma unroll
        for (int d0 = 0; d0 < 8; ++d0) S.qr[d0] = pack8(S.tq[2 * d0], S.tq[2 * d0 + 1]); }
    __syncthreads();
#undef RESC
#undef KBASE
#undef ACT
#undef MASKT
#undef SEAM_K0
#undef HALF_STEP
}
#undef ROW
#undef VMW
#undef VMWN
#undef SLOAD_H
#undef SWRITE_HK
#undef SWRITE_HV
#undef SWRITE_H
#undef SLOAD_F
#undef SWRITE_KF
#undef SWRITE_VF

__host__ __device__ inline int swa_nx(int nqb, int nramp) { return (nramp + 1) / 2 + (nqb - nramp); }
struct SwaItem { int bh, qb0, qb1; };
__device__ __forceinline__ SwaItem swa_decode(int L, int nqb, int nx) {
    SwaItem it; const int xcd = L & 7, k = L >> 3, gi = k / nx, r = k - gi * nx;
    it.bh = gi * 8 + xcd; const int x = r;
    it.qb0 = x; it.qb1 = nqb - 1 - x;
    return it;
}
struct AttnT { const bf16* Q; const bf16* K; const bf16* V; bf16* O; const unsigned short* G; const unsigned long long* CA; };
__device__ __forceinline__ BlockRef<bf16, bf16> swa_ref(const SwaItem& it, int pass, const AttnT& T, int seq, int nh) {
    const int qb = pass ? it.qb1 : it.qb0, b = it.bh / nh, h = it.bh % nh; const size_t tok0 = (size_t)b * seq;
    BlockRef<bf16, bf16> r;
    r.Q = T.Q + (tok0 + (size_t)qb * QB) * LDQ + h * D; r.O = T.O + (tok0 + (size_t)qb * QB) * LDO + h * D; r.G = T.G + (tok0 + (size_t)qb * QB) * LDG + h * D;
    r.K = T.K + (size_t)it.bh * seq * D; r.V = T.V + (size_t)it.bh * seq * D; r.CA = T.CA + (size_t)it.bh * seq; r.P0 = qb * QB;
    return r;
}
__device__ __forceinline__ void attn_phase(char* lds, const AttnT& T, int nb, int nh, int seq) {
    const int W = 1 << 30, nqb = seq / QB, nx = nqb / 2, total = nx * nb * nh, stride = gridDim.x;
    int L = blockIdx.x; if (L >= total) return;
    SwaItem it = swa_decode(L, nqb, nx); int pass = 0;
    BlockRef<bf16, bf16> cur = swa_ref(it, 0, T, seq, nh);
    Seam<bf16> S;
    causal_swa_prime<bf16, bf16>(cur, W, lds, S);
    for (;;) {
        const bool more_pass = pass == 0 && it.qb1 != it.qb0, more_item = L + stride < total, last = !more_pass && !more_item;
        SwaItem itn = it; int passn = pass + 1, Ln = L;
        if (!more_pass) { passn = 0; Ln = more_item ? L + stride : L; itn = swa_decode(Ln, nqb, nx); }
        const BlockRef<bf16, bf16> nxt = last ? cur : swa_ref(itn, passn, T, seq, nh);
        causal_swa_block<bf16, bf16>(cur, nxt, seq, W, lds, S);
        if (last) break;
        cur = nxt; it = itn; pass = passn; L = Ln;
    }
}
#undef KSWZ
#undef SBAR
}
constexpr int DM = 2048, NB = 4, SEQ = 4096, MT = NB * SEQ, FF = 5632, FF2 = 2 * FF, NH = 16, HD = 128, CH = 128, NG = 16;
constexpr float EPS = 1e-6f;
constexpr int NWAVES = 8, NTHREADS = NWAVES * 64;
constexpr size_t MiB = 1u << 20;
constexpr size_t WS_BAR = 0, BAR_ZERO_BYTES = 16384;
constexpr size_t WS_LOGF = 1 * MiB;
constexpr size_t WS_CA = 2 * MiB;
constexpr size_t WS_WSB = 4 * MiB;
constexpr size_t WS_WF = 5 * MiB;
constexpr size_t WS_W_AIN = 6 * MiB;
constexpr size_t WS_W_AOUT = WS_W_AIN + 32 * MiB;
constexpr size_t WS_W_KV = WS_W_AOUT + 16 * MiB;
constexpr size_t WS_W_QG = WS_W_KV + 16 * MiB;
constexpr size_t WS_W_BOUT = WS_W_QG + 32 * MiB;
constexpr size_t WS_W_UP = WS_W_BOUT + 16 * MiB;
constexpr size_t WS_W_DN = WS_W_UP + 176 * MiB;
constexpr size_t WS_XN = WS_W_DN + 88 * MiB;
constexpr size_t WS_XN2 = WS_XN + 64 * MiB;
constexpr size_t WS_KV = WS_XN2 + 64 * MiB;
constexpr size_t WS_BIG = WS_KV + 128 * MiB;
constexpr size_t WS_ACT = WS_BIG + 352 * MiB;
constexpr size_t WS_SSP = WS_ACT + 176 * MiB;
constexpr size_t WS_END = WS_SSP + 2 * MiB;
constexpr int LDS_BYTES = 147456, MISC_OFF = LDS_BYTES - 64, XS_OFF = 131072;

typedef unsigned short bf16_t;
typedef float f32x4 __attribute__((ext_vector_type(4)));
typedef unsigned u32x4 __attribute__((ext_vector_type(4)));
typedef unsigned u32x2 __attribute__((ext_vector_type(2)));
typedef short bf16x8 __attribute__((ext_vector_type(8)));
#define LAS __attribute__((address_space(3)))
__device__ __forceinline__ unsigned pk2(float lo, float hi) { return pg8::cvt_pk_bf16(lo, hi); }
__device__ __forceinline__ float bf_lo(unsigned w) { return __uint_as_float(w << 16); }
__device__ __forceinline__ float bf_hi(unsigned w) { return __uint_as_float(w & 0xffff0000u); }
__device__ __forceinline__ float wave_sum(float v) {
#pragma unroll
    for (int o = 1; o < 64; o <<= 1) v += __shfl_xor(v, o);
    return v;
}
struct Args { const float* in[21]; float* out; unsigned char* ws; };
#define XB_TMO      128
#define XB_XCNT(j)  (256  + 64 * (j))
#define XB_XSUB(j)  (1280 + 64 * (j))
#define XB_XGEN(j)  (2304 + 64 * (j))
#define XB_TOP      3328
#define XB_TOPGEN   3392
#define XCD_BAR_WORDS 3456
#define XB_SPIN_CAP (1u << 18)

__device__ __forceinline__ unsigned xb_ld(unsigned* p)              { return __hip_atomic_load(p, __ATOMIC_RELAXED, __HIP_MEMORY_SCOPE_AGENT); }
__device__ __forceinline__ unsigned xb_add(unsigned* p, unsigned v) { return __hip_atomic_fetch_add(p, v, __ATOMIC_RELAXED, __HIP_MEMORY_SCOPE_AGENT); }
__device__ __forceinline__ unsigned xb_xcc_id() { return (unsigned)__builtin_amdgcn_s_getreg((3 << 11) | 20) & 0xFu; }
#define XB_SPIN(cond, bar) do { unsigned _sp = 0; while (cond) { __builtin_amdgcn_s_sleep(1); \
    if ((++_sp & 255u) == 0u) { if (xb_ld(&(bar)[XB_TMO])) break; if (_sp > XB_SPIN_CAP) { atomicAdd(&(bar)[XB_TMO], 1u); break; } } } } while (0)

struct XcdBarrier {
    unsigned* bar; unsigned x;
    volatile LAS unsigned* st;
};

__device__ __forceinline__ XcdBarrier xcd_barrier_post(unsigned* bar, volatile LAS unsigned* st) {
    XcdBarrier b; b.bar = bar; b.x = xb_xcc_id(); b.st = st;
    if (threadIdx.x == 0) (void)xb_add(&bar[XB_XCNT(b.x)], 1u);
    return b;
}
__device__ __forceinline__ void xcd_barrier_complete(unsigned* bar, unsigned x, unsigned& nloc, unsigned& nx) {
    const unsigned G = gridDim.x * gridDim.y * gridDim.z;
    unsigned sum, cnt, mine, sp = 0u;
    for (;;) {
        sum = 0u; cnt = 0u; mine = 0u;
#pragma unroll
        for (unsigned j = 0; j < 16; ++j) { const unsigned c = xb_ld(&bar[XB_XCNT(j)]); sum += c; cnt += (c > 0u) ? 1u : 0u; mine = (j == x) ? c : mine; }
        if (sum == G) break;
        __builtin_amdgcn_s_sleep(1);
        if ((++sp & 255u) == 0u) { if (xb_ld(&bar[XB_TMO])) break; if (sp > XB_SPIN_CAP) { atomicAdd(&bar[XB_TMO], 1u); break; } }
    }
    nloc = mine > 0u ? mine : 1u; nx = cnt > 0u ? cnt : 1u;
}

__device__ __forceinline__ void xcd_barrier(const XcdBarrier& b) {
    asm volatile("s_waitcnt vmcnt(0)" ::: "memory");
    __syncthreads();
    if (threadIdx.x == 0) {
        unsigned* bar = b.bar;
        __builtin_amdgcn_s_waitcnt(0);
        unsigned nloc = b.st[0], nx = b.st[1];
        if (nloc == 0u) { xcd_barrier_complete(bar, b.x, nloc, nx); b.st[0] = nloc; b.st[1] = nx; }
        const unsigned old = xb_add(&bar[XB_XSUB(b.x)], 1u);
        const unsigned gen = old / nloc;
        if (old + 1u == (gen + 1u) * nloc) {
            __builtin_amdgcn_fence(__ATOMIC_RELEASE, "agent");
            asm volatile("s_waitcnt vmcnt(0)" ::: "memory");
            const unsigned og = xb_add(&bar[XB_TOP], 1u);
            const unsigned tg = og / nx;
            if (og + 1u == (tg + 1u) * nx) xb_add(&bar[XB_TOPGEN], 1u);
            else XB_SPIN(xb_ld(&bar[XB_TOPGEN]) == tg, bar);
            __builtin_amdgcn_fence(__ATOMIC_ACQUIRE, "agent");
            xb_add(&bar[XB_XGEN(b.x)], 1u);
            asm volatile("s_waitcnt vmcnt(0)" ::: "memory");
        } else {
            XB_SPIN(xb_ld(&bar[XB_XGEN(b.x)]) == gen, bar);
            __builtin_amdgcn_fence(__ATOMIC_ACQUIRE, "agent");
            asm volatile("s_waitcnt vmcnt(0)" ::: "memory");
        }
    }
    __syncthreads();
}


__device__ __forceinline__ int up_row(int n) { return n < FF ? (n >> 7) * 256 + (n & 127) : ((n - FF) >> 7) * 256 + 128 + ((n - FF) & 127); }
constexpr int TR_LDS_PER_WAVE = 64 * 65 * 4;
__device__ __forceinline__ void transpose_item(const float* W, int K, int ld, int ncols, const float* gk, bf16_t* WT, int mode, LAS float* scr, int item, int lane) {
    const int nblk = ncols / 64, kb = item / nblk, nb = item % nblk, k0 = 64 * kb, n0 = 64 * nb, kr = lane >> 4, n4 = (lane & 15) * 4;
    f32x4 v[16];
#pragma unroll
    for (int i = 0; i < 16; ++i) v[i] = *(const f32x4*)(W + (size_t)(k0 + 4 * i + kr) * ld + n0 + n4);
#pragma unroll
    for (int i = 0; i < 16; ++i) { const int kk = 4 * i + kr; const float g = gk ? gk[k0 + kk] : 1.f; LAS float* d = scr + kk * 65 + n4; d[0] = v[i].x * g; d[1] = v[i].y * g; d[2] = v[i].z * g; d[3] = v[i].w * g; }
    asm volatile("s_waitcnt lgkmcnt(0)" ::: "memory");
    const int c = lane & 7; const int r0 = mode ? up_row(n0) : n0;
#pragma unroll
    for (int j = 0; j < 8; ++j) { const int n = (lane >> 3) + 8 * j; const LAS float* p = scr + (8 * c) * 65 + n;
        u32x4 o; o.x = pk2(p[0 * 65], p[1 * 65]); o.y = pk2(p[2 * 65], p[3 * 65]); o.z = pk2(p[4 * 65], p[5 * 65]); o.w = pk2(p[6 * 65], p[7 * 65]);
        *(u32x4*)(WT + (size_t)(r0 + n) * K + k0 + 8 * c) = o; }
    asm volatile("s_waitcnt lgkmcnt(0)" ::: "memory");
}
template <bool F32OUT>
__device__ __forceinline__ void norm_rows(const float* src, const float* g, void* dst, int gw, int NGW, int lane) {
    for (int m = gw; m < MT; m += NGW) {
        const f32x4* xr = (const f32x4*)(src + (size_t)m * DM) + lane; f32x4 v[8]; float s = 0.f;
#pragma unroll
        for (int j = 0; j < 8; ++j) { v[j] = xr[64 * j]; s += (v[j].x * v[j].x + v[j].y * v[j].y) + (v[j].z * v[j].z + v[j].w * v[j].w); }
        const float r = 1.0f / sqrtf(wave_sum(s) * (1.0f / DM) + EPS);
        const f32x4* gr = (const f32x4*)g + lane;
        if constexpr (F32OUT) { f32x4* o = (f32x4*)((float*)dst + (size_t)m * DM) + lane;
#pragma unroll
            for (int j = 0; j < 8; ++j) o[64 * j] = (v[j] * r) * gr[64 * j]; }
        else { u32x2* o = (u32x2*)((bf16_t*)dst + (size_t)m * DM) + lane;
#pragma unroll
            for (int j = 0; j < 8; ++j) { const f32x4 y = (v[j] * r) * gr[64 * j]; u32x2 w; w.x = pk2(y.x, y.y); w.y = pk2(y.z, y.w); o[64 * j] = w; } }
    }
}
__device__ __forceinline__ void headnorm_rows(bf16_t* buf, int ld, const float* gain, int gw, int NGW, int lane) {
    const f32x4 g0 = *(const f32x4*)(gain + (lane & 15) * 8), g1 = *(const f32x4*)(gain + (lane & 15) * 8 + 4);
    for (int m = gw; m < MT; m += NGW) {
        u32x4* p = (u32x4*)(buf + (size_t)m * ld) + lane; u32x4 w[4];
#pragma unroll
        for (int j = 0; j < 4; ++j) w[j] = p[64 * j];
#pragma unroll
        for (int j = 0; j < 4; ++j) {
            float x[8] = {bf_lo(w[j].x), bf_hi(w[j].x), bf_lo(w[j].y), bf_hi(w[j].y), bf_lo(w[j].z), bf_hi(w[j].z), bf_lo(w[j].w), bf_hi(w[j].w)};
            float s = 0.f;
#pragma unroll
            for (int e = 0; e < 8; ++e) s += x[e] * x[e];
            s += __shfl_xor(s, 1); s += __shfl_xor(s, 2); s += __shfl_xor(s, 4); s += __shfl_xor(s, 8);
            const float r = 1.0f / sqrtf(s * (1.0f / HD) + EPS);
            u32x4 o; o.x = pk2(x[0] * r * g0.x, x[1] * r * g0.y); o.y = pk2(x[2] * r * g0.z, x[3] * r * g0.w); o.z = pk2(x[4] * r * g1.x, x[5] * r * g1.y); o.w = pk2(x[6] * r * g1.z, x[7] * r * g1.w);
            p[64 * j] = o; }
    }
}
__device__ __forceinline__ void fgate_rows(const float* h, const bf16_t* wfh, const bf16_t* wfl, const float* bf, float* logf, int gw, int NGW, int lane) {
    const int fr = lane & 15, fq = lane >> 4;
    for (int rg = gw; rg < MT / 16; rg += NGW) {
        const float* hrow = h + (size_t)(rg * 16 + fr) * DM + 8 * fq; const bf16_t* wh = wfh + fr * DM + 8 * fq; const bf16_t* wl = wfl + fr * DM + 8 * fq;
        f32x4 acc = {0.f, 0.f, 0.f, 0.f}; float ssq = 0.f;
#pragma unroll 4
        for (int ks = 0; ks < DM / 32; ++ks) {
            const f32x4 a0 = *(const f32x4*)(hrow + 32 * ks), a1 = *(const f32x4*)(hrow + 32 * ks + 4);
            ssq += (a0.x * a0.x + a0.y * a0.y) + (a0.z * a0.z + a0.w * a0.w) + (a1.x * a1.x + a1.y * a1.y) + (a1.z * a1.z + a1.w * a1.w);
            u32x4 hi; hi.x = pk2(a0.x, a0.y); hi.y = pk2(a0.z, a0.w); hi.z = pk2(a1.x, a1.y); hi.w = pk2(a1.z, a1.w);
            u32x4 lo; lo.x = pk2(a0.x - bf_lo(hi.x), a0.y - bf_hi(hi.x)); lo.y = pk2(a0.z - bf_lo(hi.y), a0.w - bf_hi(hi.y)); lo.z = pk2(a1.x - bf_lo(hi.z), a1.y - bf_hi(hi.z)); lo.w = pk2(a1.z - bf_lo(hi.w), a1.w - bf_hi(hi.w));
            const bf16x8 whv = *(const bf16x8*)(wh + 32 * ks), wlv = *(const bf16x8*)(wl + 32 * ks);
            const bf16x8 hv = __builtin_bit_cast(bf16x8, hi), lv = __builtin_bit_cast(bf16x8, lo);
            acc = __builtin_amdgcn_mfma_f32_16x16x32_bf16(whv, hv, acc, 0, 0, 0);
            acc = __builtin_amdgcn_mfma_f32_16x16x32_bf16(wlv, hv, acc, 0, 0, 0);
            acc = __builtin_amdgcn_mfma_f32_16x16x32_bf16(whv, lv, acc, 0, 0, 0);
        }
        ssq += __shfl_xor(ssq, 16); ssq += __shfl_xor(ssq, 32);
        const float r = 1.0f / sqrtf(ssq * (1.0f / DM) + EPS);
        const f32x4 b = *(const f32x4*)(bf + 4 * fq); f32x4 o;
#pragma unroll
        for (int e = 0; e < 4; ++e) { const float f = acc[e] * r + b[e]; o[e] = fminf(f, 0.f) - log1pf(expf(-fabsf(f))); }
        *(f32x4*)(logf + (size_t)(rg * 16 + fr) * 16 + 4 * fq) = o;
    }
}
__device__ __forceinline__ void scan_seq(const float* logf, unsigned long long* CA, int seq, int lane) {
    const int b = seq >> 4, hh = seq & 15;
    const float* lf = logf + ((size_t)b * SEQ + (size_t)lane * 64) * 16 + hh;
    float v[64];
#pragma unroll
    for (int i = 0; i < 64; ++i) v[i] = lf[i * 16];
#pragma unroll
    for (int i = 1; i < 64; ++i) v[i] += v[i - 1];
    const float tot = v[63]; float t = tot;
#pragma unroll
    for (int o = 1; o < 64; o <<= 1) { const float y = __shfl_up(t, o); if (lane >= o) t += y; }
    const float excl = t - tot;
    unsigned long long* out = CA + (size_t)seq * SEQ + lane * 64;
#pragma unroll
    for (int i = 0; i < 64; ++i) { const float c = (excl + v[i]) * 11.313708498984761f;
        const unsigned h1 = pk2(c, 0.f) & 0xffffu; const float r1 = c - bf_lo(h1);
        const unsigned h2 = pk2(r1, 0.f) & 0xffffu; const float r2 = r1 - bf_lo(h2);
        const unsigned h3 = pk2(r2, 0.f) & 0xffffu;
        out[i] = (unsigned long long)(h1 | (h2 << 16)) | ((unsigned long long)h3 << 32); }
}
__device__ __forceinline__ void spatial_phase(LAS unsigned char* ldsp, const bf16_t* Z, const float* ssp, const bf16_t* wsb, const float* vnorm, const float* bs, bf16_t* GATED, int wave, int lane) {
    const int fr = lane & 15, fq = lane >> 4;
    for (int item = blockIdx.x; item < (MT / CH) * NG; item += gridDim.x) {
        const int ch = item >> 4, g = item & 15, row0 = ch * CH, cw = g * 128 + wave * 16;
        LAS float* rvs = (LAS float*)ldsp;
        __syncthreads();
        { const int t_ = wave * 64 + lane; if (t_ < CH) { const f32x4* p = (const f32x4*)(ssp + (size_t)(row0 + t_) * 32); float sq = 0.f;
#pragma unroll
            for (int q = 0; q < 8; ++q) { const f32x4 v = p[q]; sq += (v.x + v.y) + (v.z + v.w); }
            rvs[t_] = 1.0f / sqrtf(sq * (1.0f / DM) + EPS); } }
        __syncthreads();
        LAS unsigned* VS = (LAS unsigned*)(ldsp + 1024);
        { const int t_ = wave * 64 + lane, srow = t_ >> 2, c0 = (t_ & 3) * 32; const float rv = rvs[srow];
          const u32x4* gp = (const u32x4*)(Z + (size_t)(row0 + srow) * 4096 + 2048 + g * 128 + c0); u32x4 q[4];
#pragma unroll
          for (int jj = 0; jj < 4; ++jj) q[jj] = gp[jj];
#pragma unroll
          for (int jj = 0; jj < 4; ++jj) { LAS unsigned* d = VS + srow * 65 + (c0 >> 1) + jj * 4;
#pragma unroll
              for (int e = 0; e < 4; ++e) d[e] = pk2(bf_lo(q[jj][e]) * rv, bf_hi(q[jj][e]) * rv); } }
        __syncthreads();
        bf16x8 vf[4];
        { const LAS unsigned short* vs16 = (const LAS unsigned short*)VS + wave * 16 + fr;
#pragma unroll
          for (int ks = 0; ks < 4; ++ks) { unsigned hv[8];
#pragma unroll
              for (int i = 0; i < 8; ++i) hv[i] = vs16[(32 * ks + 8 * fq + i) * 130];
              u32x4 w; w.x = hv[0] | (hv[1] << 16); w.y = hv[2] | (hv[3] << 16); w.z = hv[4] | (hv[5] << 16); w.w = hv[6] | (hv[7] << 16); vf[ks] = __builtin_bit_cast(bf16x8, w); } }
        f32x4 acc[8];
#pragma unroll
        for (int m = 0; m < 8; ++m) { acc[m] = (f32x4){0.f, 0.f, 0.f, 0.f};
#pragma unroll
            for (int ks = 0; ks < 4; ++ks) if (32 * ks <= 16 * m + 15) {
                const bf16x8 wf = *(const bf16x8*)(wsb + ((size_t)(g * 128 + 16 * m + fr) * 128 + 32 * ks + 8 * fq));
                acc[m] = __builtin_amdgcn_mfma_f32_16x16x32_bf16(vf[ks], wf, acc[m], 0, 0, 0); } }
        const f32x4 vn = *(const f32x4*)(vnorm + cw + 4 * fq);
#pragma unroll
        for (int m = 0; m < 8; ++m) { const int t = 16 * m + fr; const size_t row = (size_t)(row0 + t); const float bias = bs[g * 128 + t];
            const u32x2 uu = *(const u32x2*)(Z + row * 4096 + cw + 4 * fq);
            const float o0 = bf_lo(uu.x) * (acc[m][0] * vn[0] + bias), o1 = bf_hi(uu.x) * (acc[m][1] * vn[1] + bias), o2 = bf_lo(uu.y) * (acc[m][2] * vn[2] + bias), o3 = bf_hi(uu.y) * (acc[m][3] * vn[3] + bias);
            u32x2 w; w.x = pk2(o0, o1); w.y = pk2(o2, o3); *(u32x2*)(GATED + row * DM + cw + 4 * fq) = w; }
    }
}
__device__ __forceinline__ void conv_phase(const bf16_t* BIG, const float* cw, const float* cb, bf16_t* ACT) {
    constexpr int NQ = FF / 8, RS = 32, NTASK = NQ * (MT / RS);
    const int tid_ = opaque_tid();
    for (int T = blockIdx.x * NTHREADS + tid_; T < NTASK; T += gridDim.x * NTHREADS) {
        const int qb = (NQ / 64 - 1) - T / (64 * (MT / RS)), rem = T % (64 * (MT / RS)), strip = rem >> 6, q = qb * 64 + (rem & 63), j0 = 8 * q, pg = (q >> 4) * 256 + (q & 15) * 8, row0 = strip * RS;
        float wg[3][8], wv[3][8], bg[8], bv[8];
#pragma unroll
        for (int k = 0; k < 3; ++k)
#pragma unroll
            for (int e = 0; e < 8; ++e) { wg[k][e] = cw[(size_t)k * FF2 + j0 + e]; wv[k][e] = cw[(size_t)k * FF2 + FF + j0 + e]; }
#pragma unroll
        for (int e = 0; e < 8; ++e) { bg[e] = cb[j0 + e]; bv[e] = cb[FF + j0 + e]; }
        const bf16_t* src = BIG + (size_t)row0 * FF2 + pg; bf16_t* dst = ACT + (size_t)row0 * FF + j0;
        u32x4 g2 = {0u, 0u, 0u, 0u}, g1 = g2, v2 = g2, v1 = g2;
        if ((row0 & (SEQ - 1)) != 0) { g2 = *(const u32x4*)(src - 2 * (size_t)FF2); v2 = *(const u32x4*)(src - 2 * (size_t)FF2 + 128); g1 = *(const u32x4*)(src - (size_t)FF2); v1 = *(const u32x4*)(src - (size_t)FF2 + 128); }
        for (int i0 = 0; i0 < RS; i0 += 8) {
            u32x4 gc[8], vc[8];
#pragma unroll
            for (int i = 0; i < 8; ++i) { gc[i] = *(const u32x4*)(src + (size_t)(i0 + i) * FF2); vc[i] = *(const u32x4*)(src + (size_t)(i0 + i) * FF2 + 128); }
#pragma unroll
            for (int i = 0; i < 8; ++i) { u32x4 o;
#pragma unroll
                for (int p = 0; p < 4; ++p) {
                    const float ga = wg[0][2 * p] * bf_lo(g2[p]) + wg[1][2 * p] * bf_lo(g1[p]) + wg[2][2 * p] * bf_lo(gc[i][p]) + bg[2 * p];
                    const float gb = wg[0][2 * p + 1] * bf_hi(g2[p]) + wg[1][2 * p + 1] * bf_hi(g1[p]) + wg[2][2 * p + 1] * bf_hi(gc[i][p]) + bg[2 * p + 1];
                    const float va = wv[0][2 * p] * bf_lo(v2[p]) + wv[1][2 * p] * bf_lo(v1[p]) + wv[2][2 * p] * bf_lo(vc[i][p]) + bv[2 * p];
                    const float vb = wv[0][2 * p + 1] * bf_hi(v2[p]) + wv[1][2 * p + 1] * bf_hi(v1[p]) + wv[2][2 * p + 1] * bf_hi(vc[i][p]) + bv[2 * p + 1];
                    const float sa = ga * __builtin_amdgcn_rcpf(1.0f + __builtin_amdgcn_exp2f(-1.4426950408889634f * ga)), sb = gb * __builtin_amdgcn_rcpf(1.0f + __builtin_amdgcn_exp2f(-1.4426950408889634f * gb));
                    o[p] = pk2(sa * va, sb * vb); }
                *(u32x4*)(dst + (size_t)(i0 + i) * FF) = o; g2 = g1; g1 = gc[i]; v2 = v1; v1 = vc[i]; }
        }
    }
}

typedef const Args __attribute__((address_space(4))) CArgs;
__device__ __forceinline__ CArgs* kargs() { CArgs* p = (CArgs*)__builtin_amdgcn_kernarg_segment_ptr(); asm volatile("" : "+s"(p)); return p; }
#define PTRS \
    CArgs* ap_ = kargs(); unsigned char* ws = ap_->ws; float* h = ap_->out; (void)ws; (void)h; \
    const float* x = ap_->in[0]; const float* a_norm = ap_->in[1]; const float* a_w_in = ap_->in[2]; const float* a_v_norm = ap_->in[3]; const float* a_w_s = ap_->in[4]; const float* a_b_s = ap_->in[5]; \
    const float* a_w_out = ap_->in[6]; const float* kv_norm = ap_->in[7]; const float* w_kvf = ap_->in[8]; const float* b_f = ap_->in[9]; const float* k_norm = ap_->in[10]; const float* b_norm = ap_->in[11]; \
    const float* b_w_qg = ap_->in[12]; const float* q_norm = ap_->in[13]; const float* b_w_out = ap_->in[14]; const float* f_norm = ap_->in[15]; const float* f_w_up = ap_->in[16]; const float* f_conv_w = ap_->in[17]; \
    const float* f_conv_b = ap_->in[18]; const float* f_w_down = ap_->in[19]; const float* final_norm = ap_->in[20]; \
    (void)x; (void)a_norm; (void)a_w_in; (void)a_v_norm; (void)a_w_s; (void)a_b_s; (void)a_w_out; (void)kv_norm; (void)w_kvf; (void)b_f; (void)k_norm; (void)b_norm; (void)b_w_qg; (void)q_norm; (void)b_w_out; \
    (void)f_norm; (void)f_w_up; (void)f_conv_w; (void)f_conv_b; (void)f_w_down; (void)final_norm; \
    float* VSS = (float*)(ws + WS_SSP); float* LOGF = (float*)(ws + WS_LOGF); unsigned long long* CA = (unsigned long long*)(ws + WS_CA); \
    bf16_t* WSB = (bf16_t*)(ws + WS_WSB); bf16_t* WFH = (bf16_t*)(ws + WS_WF); bf16_t* WFL = WFH + 16 * DM; \
    bf16_t* W_AIN = (bf16_t*)(ws + WS_W_AIN); bf16_t* W_AOUT = (bf16_t*)(ws + WS_W_AOUT); bf16_t* W_KV = (bf16_t*)(ws + WS_W_KV); bf16_t* W_QG = (bf16_t*)(ws + WS_W_QG); \
    bf16_t* W_BOUT = (bf16_t*)(ws + WS_W_BOUT); bf16_t* W_UP = (bf16_t*)(ws + WS_W_UP); bf16_t* W_DN = (bf16_t*)(ws + WS_W_DN); \
    bf16_t* HB = (bf16_t*)(ws + WS_XN); float* RSS = (float*)(ws + WS_XN2); bf16_t* KVB = (bf16_t*)(ws + WS_KV); bf16_t* BIG = (bf16_t*)(ws + WS_BIG); bf16_t* ACT = (bf16_t*)(ws + WS_ACT); \
    (void)VSS; (void)LOGF; (void)CA; (void)WSB; (void)WFH; (void)WFL; (void)W_AIN; (void)W_AOUT; (void)W_KV; (void)W_QG; (void)W_BOUT; (void)W_UP; (void)W_DN; (void)HB; (void)RSS; (void)KVB; (void)BIG; (void)ACT;
typedef pg8::EpiBf<1, true> EPI_A1; typedef pg8::EpiBf<0, true, true, true> EPI_KV; typedef pg8::EpiBf<2, true, false, true> EPI_QG; typedef pg8::EpiBf<0, true> EPI_UP;
#define GEMM_PHASE(EPI, Aptr, Bptr, NN, KK, ...) do { pg8::Gemm g_{Aptr, Bptr, MT, NN, KK}; pg8::StaticOrder S_; S_.init(MT, NN, G, (int)blockIdx.x); EPI E_{__VA_ARGS__}; \
    pg8::gemm_phase<EPI, pg8::StaticOrder, true, true>(ldsp, g_, S_, E_); } while (0)

__global__ void __launch_bounds__(NTHREADS, 2) fwd_megakernel(Args a) {
    extern __shared__ __attribute__((aligned(16))) unsigned char lds[];
    cg::grid_group grid = cg::this_grid();
#define GSYNC_CG() do { asm volatile("s_waitcnt vmcnt(0)" ::: "memory"); grid.sync(); } while (0)
#define GSYNC() xcd_barrier(xbar)
    const int wave = __builtin_amdgcn_readfirstlane(threadIdx.x >> 6);
    const int G = gridDim.x, gw = blockIdx.x * NWAVES + wave, NGW = G * NWAVES;
    LAS unsigned char* ldsp = (LAS unsigned char*)lds;
    if (threadIdx.x < 16) ((LAS unsigned*)(ldsp + MISC_OFF))[threadIdx.x] = 0u;
    __syncthreads();
    const XcdBarrier xbar = xcd_barrier_post((unsigned*)(kargs()->ws + WS_BAR), (volatile LAS unsigned*)(ldsp + MISC_OFF));

    {
        PTRS
        const int tid = opaque_tid(), lane = tid & 63;
        const int gt = blockIdx.x * NTHREADS + tid, NGT = G * NTHREADS;
        for (int i = gt; i < 2 * NG * CH * CH / 8; i += NGT) {
            const int e0 = i * 8, s0 = e0 & 127, t = (e0 >> 7) & 127; const f32x4 w0 = *(const f32x4*)(a_w_s + e0), w1 = *(const f32x4*)(a_w_s + e0 + 4);
            float y[8] = {w0.x, w0.y, w0.z, w0.w, w1.x, w1.y, w1.z, w1.w};
#pragma unroll
            for (int e = 0; e < 8; ++e) if (s0 + e > t) y[e] = 0.f;
            u32x4 o; o.x = pk2(y[0], y[1]); o.y = pk2(y[2], y[3]); o.z = pk2(y[4], y[5]); o.w = pk2(y[6], y[7]); *(u32x4*)(WSB + e0) = o; }
        for (int i = gt; i < 16 * DM; i += NGT) { const int n = i / DM, k = i % DM; const float w = kv_norm[k] * w_kvf[(size_t)k * 4112 + 4096 + n];
            const unsigned hi = pk2(w, 0.f) & 0xffffu; WFH[i] = (bf16_t)hi; WFL[i] = (bf16_t)(pk2(w - bf_lo(hi), 0.f) & 0xffffu); }
        LAS float* scr = (LAS float*)(ldsp + wave * TR_LDS_PER_WAVE);
        for (int it = gw; it < 48128 * (PROBE == 4 ? 2 : 1); it += NGW) {
            int r = it % 48128, K = DM, ld, ncols, mode = 0; const float* W; const float* g = nullptr; bf16_t* WT;
            if (r < 4096) { const int l = r >> 11; r &= 2047; W = a_w_in + (size_t)l * DM * 4096; g = a_norm + l * DM; WT = W_AIN + (size_t)l * 4096 * DM; ld = 4096; ncols = 4096; }
            else if ((r -= 4096) < 2048) { const int l = r >> 10; r &= 1023; W = a_w_out + (size_t)l * DM * DM; WT = W_AOUT + (size_t)l * DM * DM; ld = DM; ncols = DM; }
            else if ((r -= 2048) < 2048) { W = w_kvf; g = kv_norm; WT = W_KV; ld = 4112; ncols = 4096; }
            else if ((r -= 2048) < 4096) { const int l = r >> 11; r &= 2047; W = b_w_qg + (size_t)l * DM * 4096; g = b_norm + l * DM; WT = W_QG + (size_t)l * 4096 * DM; ld = 4096; ncols = 4096; }
            else if ((r -= 4096) < 2048) { const int l = r >> 10; r &= 1023; W = b_w_out + (size_t)l * DM * DM; WT = W_BOUT + (size_t)l * DM * DM; ld = DM; ncols = DM; }
            else if ((r -= 2048) < 22528) { const int l = r / 5632; r -= l * 5632; W = f_w_up + (size_t)l * DM * FF2; g = f_norm + l * DM; WT = W_UP + (size_t)l * FF2 * DM; ld = FF2; ncols = FF2; mode = 1; }
            else { r -= 22528; const int l = r / 2816; r -= l * 2816; W = f_w_down + (size_t)l * FF * DM; WT = W_DN + (size_t)l * DM * FF; K = FF; ld = DM; ncols = DM; }
            transpose_item(W, K, ld, ncols, g, WT, mode, scr, r, lane);
        }
        for (int m = gw; m < MT; m += NGW) {
            const f32x4* xr = (const f32x4*)(x + (size_t)m * DM) + lane; u32x2* o = (u32x2*)(HB + (size_t)m * DM) + lane; float sq = 0.f;
#pragma unroll
            for (int j = 0; j < 8; ++j) { const f32x4 v = xr[64 * j]; sq += (v.x * v.x + v.y * v.y) + (v.z * v.z + v.w * v.w); u32x2 w; w.x = pk2(v.x, v.y); w.y = pk2(v.z, v.w); o[64 * j] = w; }
            sq = wave_sum(sq); if (lane < 32) RSS[(size_t)m * 32 + lane] = lane == 0 ? sq : 0.f;
        }
    }
    GSYNC_CG();

    for (int l = 0; l < 4; ++l) {
        if (l < 2) {
            { PTRS GEMM_PHASE(EPI_A1, HB, W_AIN + (size_t)l * 4096 * DM, 4096, DM, BIG, 4096, 8, VSS, RSS, nullptr, nullptr); }
            GSYNC();
            for (int rep_ = 0; rep_ < (PROBE == 6 ? 2 : 1); ++rep_) { if (rep_) GSYNC();
            { PTRS const int lane = opaque_tid() & 63;
              spatial_phase(ldsp, BIG, VSS, WSB + (size_t)l * NG * CH * CH, a_v_norm + (size_t)l * DM, a_b_s + (size_t)l * NG * CH, ACT, wave, lane); } }
            GSYNC();
        } else {
            const int j = l - 2;
            if (j == 0) { PTRS const int lane = opaque_tid() & 63; fgate_rows(h, WFH, WFL, b_f, LOGF, gw, NGW, lane);
                          GEMM_PHASE(EPI_KV, HB, W_KV, 4096, DM, KVB, 4096, 1 << 30, nullptr, RSS, k_norm, (LAS float*)(ldsp + XS_OFF)); }
            { PTRS GEMM_PHASE(EPI_QG, HB, W_QG + (size_t)j * 4096 * DM, 4096, DM, BIG, 4096, 8, nullptr, RSS, q_norm + (size_t)j * HD, (LAS float*)(ldsp + XS_OFF)); }
            GSYNC();
            if (j == 0) { { PTRS const int lane = opaque_tid() & 63; if (blockIdx.x < 8) scan_seq(LOGF, CA, blockIdx.x * 8 + wave, lane); }
                          GSYNC(); }
            for (int rep_ = 0; rep_ < (PROBE == 2 ? 2 : 1); ++rep_) {
            { PTRS att::AttnT T{(const att::bf16*)BIG, (const att::bf16*)KVB, (const att::bf16*)(KVB + (size_t)MT * 2048), (att::bf16*)ACT, BIG + 2048, CA};
              att::attn_phase((char*)lds, T, NB, NH, SEQ); }
            GSYNC(); }
        }
        { PTRS const bf16_t* Wt = l < 2 ? W_AOUT + (size_t)l * DM * DM : W_BOUT + (size_t)(l - 2) * DM * DM;
          GEMM_PHASE(pg8::EpiRes, ACT, Wt, DM, DM, l == 0 ? x : (const float*)h, h, HB, RSS, DM); }
        GSYNC();
        { PTRS GEMM_PHASE(EPI_UP, HB, W_UP + (size_t)l * FF2 * DM, FF2, DM, BIG, FF2, 1 << 30, nullptr, RSS, nullptr, nullptr); }
        GSYNC();
#if PROBE == 1
        { PTRS GEMM_PHASE(EPI_UP, HB, W_UP + (size_t)l * FF2 * DM, FF2, DM, BIG, FF2, 1 << 30, nullptr, RSS, nullptr, nullptr); }
        GSYNC();
#endif
        { PTRS conv_phase(BIG, f_conv_w + (size_t)l * 3 * FF2, f_conv_b + (size_t)l * FF2, ACT); }
        GSYNC();
#if PROBE == 3
        { PTRS conv_phase(BIG, f_conv_w + (size_t)l * 3 * FF2, f_conv_b + (size_t)l * FF2, ACT); }
        GSYNC();
#endif
        { PTRS GEMM_PHASE(pg8::EpiRes, ACT, W_DN + (size_t)l * DM * FF, DM, FF, h, h, HB, RSS, DM); }
        GSYNC();
    }
#if PROBE == 7
    for (int rep_ = 0; rep_ < 20; ++rep_) GSYNC();
#endif
    { PTRS const int lane = opaque_tid() & 63; norm_rows<true>(h, final_norm, h, gw, NGW, lane); }
}

extern "C" void kernel_launch(void* const* d_in, const int* in_sizes, int n_in, void* d_out, int out_size, void* d_ws, size_t ws_size, hipStream_t stream) {
    static int grid = 0;
    if (grid == 0) {
        if (n_in != 21 || out_size != MT * DM || ws_size < WS_END) { fprintf(stderr, "kernel_launch: unexpected shapes (n_in %d out %d ws %zu, need ws >= %zu)\n", n_in, out_size, ws_size, (size_t)WS_END); grid = -1; return; }
        int dev = 0, cus = 0, per_cu = 0;
        (void)hipGetDevice(&dev); (void)hipDeviceGetAttribute(&cus, hipDeviceAttributeMultiprocessorCount, dev);
        (void)hipFuncSetAttribute((const void*)fwd_megakernel, hipFuncAttributeMaxDynamicSharedMemorySize, LDS_BYTES);
        (void)hipOccupancyMaxActiveBlocksPerMultiprocessor(&per_cu, (const void*)fwd_megakernel, NTHREADS, LDS_BYTES);
        if (per_cu < 1) { fprintf(stderr, "kernel_launch: occupancy query says %d blocks per CU\n", per_cu); per_cu = 1; }
        grid = cus * 1;
        (void)hipGetLastError();
    }
    if (grid < 0) return;
    (void)hipMemsetAsync((char*)d_ws + WS_BAR, 0, BAR_ZERO_BYTES, stream);
    Args a{};
    for (int i = 0; i < 21; ++i) a.in[i] = (const float*)d_in[i];
    a.out = (float*)d_out; a.ws = (unsigned char*)d_ws;
    void* args[] = {&a};
    hipError_t e = hipLaunchCooperativeKernel((const void*)fwd_megakernel, dim3(grid), dim3(NTHREADS), args, LDS_BYTES, stream);
    if (e != hipSuccess) fprintf(stderr, "cooperative launch failed: %s (grid %d)\n", hipGetErrorString(e), grid);
}
```

```cpp
#include <hip/hip_runtime.h>
#include <hip/hip_cooperative_groups.h>
#include <hip/hip_bf16.h>
#include <cstdio>
#include <cstdint>
namespace cg = cooperative_groups;
#ifndef PROBE
#define PROBE 0
#endif
__device__ __forceinline__ float lane_read(float v, int src_lane) { return __builtin_bit_cast(float, __builtin_amdgcn_ds_bpermute(src_lane << 2, __builtin_bit_cast(int, v))); }
__device__ __forceinline__ int opaque_tid() { int t = threadIdx.x; asm volatile("" : "+v"(t)); return t; }
namespace pg8 {
#define PG8_LAS __attribute__((address_space(3)))
typedef unsigned short bf16_t;
typedef short bf16x8 __attribute__((ext_vector_type(8)));
typedef float f32x4 __attribute__((ext_vector_type(4)));
typedef unsigned u32x4 __attribute__((ext_vector_type(4)));
constexpr int BM = 256, BK = 64, HALF = 128, HTB = HALF * BK * 2  , STAGE_BYTES = 8 * HTB, NXCD = 8, WGM = 8;

__host__ __device__ __forceinline__ int lds_byte(int r, int c) { const int st = (r >> 4) * 2 + (c >> 5), rr = r & 15, cc = c & 31, ob = rr * 64 + cc * 2; return st * 1024 + (ob ^ (((ob >> 9) & 1) << 5)); }
__host__ __device__ __forceinline__ void stage_rc(int b, int& R, int& C) { const int st = b / 1024, sb = b % 1024, swz = sb ^ (((sb >> 9) & 1) << 5); R = (st >> 1) * 16 + swz / 64; C = (st & 1) * 32 + (swz % 64) / 2; }
__host__ __device__ __forceinline__ int perm32(int rho) { const int n = rho >> 4, i = rho & 15; return 8 * (i >> 2) + 4 * n + (i & 3); }

struct Unit { int pm, pn; };
struct Gemm { const bf16_t* A; const bf16_t* Bt; int M, N, K; };

struct StaticOrder {
    int nM, nN, nwg, G, c;
    __host__ __device__ void init(int M, int N, int G_, int c_) { nM = M / BM; nN = N / BM; nwg = nM * nN; G = G_; c = c_; }
    __host__ __device__ bool next(int i, Unit& u) const {
        const long L = (long)i * G + c; if (L >= nwg) return false;
        int wgid = (int)L; { const int q = nwg / NXCD, r = nwg % NXCD, xcd = wgid % NXCD, off = wgid / NXCD; wgid = (xcd < r ? xcd * (q + 1) : r * (q + 1) + (xcd - r) * q) + off; }
        const int nig = WGM * nN, gid = wgid / nig, fm = gid * WGM, gsz = (nM - fm) < WGM ? (nM - fm) : WGM;
        u.pm = fm + ((wgid % nig) % gsz); u.pn = (wgid % nig) / gsz; return true;
    }
    __device__ __forceinline__ void a_ready(const Unit&) const {}
    __device__ __forceinline__ void done(const Unit&) const {}
};

__device__ __forceinline__ unsigned cvt_pk_bf16(float lo, float hi) { unsigned r; asm volatile("v_cvt_pk_bf16_f32 %0, %1, %2" : "=v"(r) : "v"(lo), "v"(hi)); return r; }
typedef float f32x2 __attribute__((ext_vector_type(2)));
__device__ __forceinline__ f32x2 gelu_pk(f32x2 v) {
    const f32x2 av = __builtin_elementwise_abs(v), d = av * 0.2316418882f + 1.0f;
    f32x2 t; t.x = __builtin_amdgcn_rcpf(d.x); t.y = __builtin_amdgcn_rcpf(d.y);
    f32x2 q = t * 0.5307027145f + (-0.7265760135f); q = q * t + 0.7107068705f; q = q * t + (-0.142248368f); q = q * t + 0.127414796f; q = q * t;
    const f32x2 s = (v * v) * (-0.72134752044f);
    f32x2 e; e.x = __builtin_amdgcn_exp2f(s.x); e.y = __builtin_amdgcn_exp2f(s.y);
    const f32x2 m = v * (q * e), r = v - m;
    f32x2 o; o.x = v.x < 0.f ? m.x : r.x; o.y = v.y < 0.f ? m.y : r.y; return o;
}
constexpr float RS_INV = 1.0f / 2048.0f, RS_EPS = 1e-6f;
template <int MODE, bool RSCALE, bool HEADMAJOR = false, bool HN = false> struct EpiBf {
    static constexpr bool PERM = true, AFTER_DRAIN = false, IDEMPOTENT = true;
    bf16_t* O; int ldc; int split_pn; float* ss; const float* rs; const float* hgain; PG8_LAS float* xs;
    __device__ __forceinline__ void operator()(const f32x4 (&acc)[2][2][4][2], const Unit& u, int wr, int wc, int fr, int fq) const {
        const int row0 = u.pm * BM + wr * 64 + fr, col0 = u.pn * BM + wc * 32 + 8 * fq;
        const bool up = u.pn >= split_pn;
        float rr[2][4];
#pragma unroll
        for (int ai = 0; ai < 2; ++ai)
#pragma unroll
            for (int m = 0; m < 4; ++m) { rr[ai][m] = 1.f;
                if (RSCALE) { const f32x4* p = (const f32x4*)(rs + (size_t)(row0 + ai * HALF + m * 16) * 32 + fq * 8); const f32x4 a = p[0], b = p[1];
                    float t = ((a[0] + a[1]) + (a[2] + a[3])) + ((b[0] + b[1]) + (b[2] + b[3])); t += lane_read(t, (fq * 16 + fr) ^ 16); t += lane_read(t, (fq * 16 + fr) ^ 32); rr[ai][m] = 1.0f / sqrtf(t * RS_INV + RS_EPS); } }
        f32x4 hg0 = {1.f, 1.f, 1.f, 1.f}, hg1 = hg0; const bool hn = HN && u.pn < 8;
        if (HN) { if (hn) {
#pragma unroll
            for (int ai = 0; ai < 2; ++ai)
#pragma unroll
                for (int m = 0; m < 4; ++m)
#pragma unroll
                    for (int bj = 0; bj < 2; ++bj) { const f32x4 v0 = acc[ai][bj][m][0] * rr[ai][m], v1 = acc[ai][bj][m][1] * rr[ai][m];
                        float t = ((v0[0] * v0[0] + v0[1] * v0[1]) + (v0[2] * v0[2] + v0[3] * v0[3])) + ((v1[0] * v1[0] + v1[1] * v1[1]) + (v1[2] * v1[2] + v1[3] * v1[3]));
                        t += lane_read(t, (fq * 16 + fr) ^ 16); t += lane_read(t, (fq * 16 + fr) ^ 32);
                        if (fq == 0) xs[(ai * HALF + wr * 64 + m * 16 + fr) * 8 + bj * 4 + wc] = t; }
            asm volatile("s_waitcnt lgkmcnt(0)" ::: "memory"); __builtin_amdgcn_s_barrier(); asm volatile("" ::: "memory");
            hg0 = *(const f32x4*)(hgain + wc * 32 + 8 * fq); hg1 = *(const f32x4*)(hgain + wc * 32 + 8 * fq + 4);
        } }
#pragma unroll
        for (int ai = 0; ai < 2; ++ai)
#pragma unroll
            for (int m = 0; m < 4; ++m) { const int row = row0 + ai * HALF + m * 16; float s = 0.f; float hnr[2] = {1.f, 1.f};
                if (HN) { if (hn) { const PG8_LAS f32x4* xp = (const PG8_LAS f32x4*)(xs + (ai * HALF + wr * 64 + m * 16 + fr) * 8); const f32x4 a = xp[0], b = xp[1];
                    hnr[0] = 1.0f / sqrtf(((a[0] + a[1]) + (a[2] + a[3])) * (1.0f / 128.0f) + RS_EPS); hnr[1] = 1.0f / sqrtf(((b[0] + b[1]) + (b[2] + b[3])) * (1.0f / 128.0f) + RS_EPS); } }
                bf16_t* rowp = HEADMAJOR ? O + (u.pn >= 8 ? (size_t)16384 * 2048 : (size_t)0) + ((size_t)((row >> 12) * 16 + 2 * (u.pn & 7)) * 4096 + (row & 4095)) * 128 + wc * 32 + 8 * fq
                                         : O + (size_t)row * ldc + col0;
#pragma unroll
                for (int bj = 0; bj < 2; ++bj) { f32x4 v0 = acc[ai][bj][m][0], v1 = acc[ai][bj][m][1];
                    if (RSCALE) { v0 = v0 * rr[ai][m]; v1 = v1 * rr[ai][m]; }
                    if (HN) { if (hn) { v0 = (v0 * hnr[bj]) * hg0; v1 = (v1 * hnr[bj]) * hg1; } }
                    if (MODE == 1) { f32x2 a = gelu_pk((f32x2){v0[0], v0[1]}), b = gelu_pk((f32x2){v0[2], v0[3]}), c = gelu_pk((f32x2){v1[0], v1[1]}), d = gelu_pk((f32x2){v1[2], v1[3]});
                        v0 = (f32x4){a.x, a.y, b.x, b.y}; v1 = (f32x4){c.x, c.y, d.x, d.y};
                        s += (v0[0] * v0[0] + v0[1] * v0[1]) + (v0[2] * v0[2] + v0[3] * v0[3]) + (v1[0] * v1[0] + v1[1] * v1[1]) + (v1[2] * v1[2] + v1[3] * v1[3]); }
                    if (MODE == 2) { if (up) {
#pragma unroll
                        for (int e = 0; e < 4; ++e) { v0[e] = __builtin_amdgcn_rcpf(1.0f + __builtin_amdgcn_exp2f(-1.4426950408889634f * v0[e])); v1[e] = __builtin_amdgcn_rcpf(1.0f + __builtin_amdgcn_exp2f(-1.4426950408889634f * v1[e])); } } }
                    u32x4 w; w.x = cvt_pk_bf16(v0[0], v0[1]); w.y = cvt_pk_bf16(v0[2], v0[3]); w.z = cvt_pk_bf16(v1[0], v1[1]); w.w = cvt_pk_bf16(v1[2], v1[3]);
                    *(u32x4*)(rowp + (HEADMAJOR ? (size_t)bj * 4096 * 128 : (size_t)bj * HALF)) = w; }
                if (MODE == 1) { if (up) { s += lane_read(s, (fq * 16 + fr) ^ 16); s += lane_read(s, (fq * 16 + fr) ^ 32); if (fq == 0) ss[(size_t)row * 32 + (u.pn - split_pn) * 4 + wc] = s; } } }
    }
};
struct EpiRes {
    static constexpr bool PERM = true, AFTER_DRAIN = false, IDEMPOTENT = false;
    bf16_t* hb; float* rss; int ldc;
    __device__ __forceinline__ void operator()(const f32x4 (&acc)[2][2][4][2], const Unit& u, int wr, int wc, int fr, int fq) const {
        const int row0 = u.pm * BM + wr * 64 + fr, col0 = u.pn * BM + wc * 32 + 8 * fq;
        u32x4 bn[2][2];
#pragma unroll
        for (int mm = 0; mm < 2; ++mm)
#pragma unroll
            for (int bj = 0; bj < 2; ++bj) bn[mm][bj] = *(const u32x4*)(hb + (size_t)(row0 + mm * 16) * ldc + col0 + bj * HALF);
#pragma unroll
        for (int c = 0; c < 4; ++c) { const int ai = c >> 1; u32x4 b[2][2];
#pragma unroll
            for (int mm = 0; mm < 2; ++mm)
#pragma unroll
                for (int bj = 0; bj < 2; ++bj) b[mm][bj] = bn[mm][bj];
            if (c < 3) { const int c1 = c + 1, ai1 = c1 >> 1;
#pragma unroll
                for (int mm = 0; mm < 2; ++mm)
#pragma unroll
                    for (int bj = 0; bj < 2; ++bj) bn[mm][bj] = *(const u32x4*)(hb + (size_t)(row0 + ai1 * HALF + (2 * (c1 & 1) + mm) * 16) * ldc + col0 + bj * HALF); }
#pragma unroll
            for (int mm = 0; mm < 2; ++mm) { const int m = 2 * (c & 1) + mm; const int row = row0 + ai * HALF + m * 16; const size_t off = (size_t)row * ldc + col0; float s = 0.f;
#pragma unroll
                for (int bj = 0; bj < 2; ++bj) { const u32x4 q = b[mm][bj];
                    const f32x4 o0 = (f32x4){__uint_as_float(q.x << 16), __uint_as_float(q.x & 0xffff0000u), __uint_as_float(q.y << 16), __uint_as_float(q.y & 0xffff0000u)} + acc[ai][bj][m][0];
                    const f32x4 o1 = (f32x4){__uint_as_float(q.z << 16), __uint_as_float(q.z & 0xffff0000u), __uint_as_float(q.w << 16), __uint_as_float(q.w & 0xffff0000u)} + acc[ai][bj][m][1];
                    u32x4 w; w.x = cvt_pk_bf16(o0[0], o0[1]); w.y = cvt_pk_bf16(o0[2], o0[3]); w.z = cvt_pk_bf16(o1[0], o1[1]); w.w = cvt_pk_bf16(o1[2], o1[3]);
                    *(u32x4*)(hb + off + bj * HALF) = w;
                    s += ((o0[0] * o0[0] + o0[1] * o0[1]) + (o0[2] * o0[2] + o0[3] * o0[3])) + ((o1[0] * o1[0] + o1[1] * o1[1]) + (o1[2] * o1[2] + o1[3] * o1[3])); }
                s += lane_read(s, (fq * 16 + fr) ^ 16); s += lane_read(s, (fq * 16 + fr) ^ 32); if (fq == 0) rss[(size_t)row * 32 + u.pn * 4 + wc] = s; } }
    }
};
template <class Epi, class Sched, bool ALIGN_EPI = false, bool SP2 = false>
__device__ __forceinline__ void gemm_phase(PG8_LAS unsigned char* lds, const Gemm g, const Sched& S, const Epi& E) {
    const int tid = opaque_tid(), wid = __builtin_amdgcn_readfirstlane(tid >> 6), lane = tid & 63, wr = wid >> 2, wc = wid & 3, fr = lane & 15, fq = lane >> 4;
    const int K = g.K, nt = K / BK;
    unsigned voffA[2], voffB[2];
#pragma unroll
    for (int i = 0; i < 2; ++i) { int R, C; stage_rc(tid * 16 + i * 8192, R, C); const int Rb = Epi::PERM ? ((R & ~31) + perm32(R & 31)) : R;
        voffA[i] = (unsigned)(R * K + C) * 2u; voffB[i] = (unsigned)(Rb * K + C) * 2u; }
    const size_t kstep = (size_t)(BK * 2);
    const size_t hstep = (size_t)HALF * K * 2;
    const size_t tstep = 2 * hstep;
    const unsigned ldsw = (unsigned)wid * 1024u;
    const int aoff = lds_byte(wr * 64 + fr, fq * 8), boff = lds_byte(wc * 32 + fr, fq * 8);
#define PG8_SA(b, h) (((b) * 2 + (h)) * HTB)
#define PG8_SB(b, h) ((4 + (b) * 2 + (h)) * HTB)
#define PG8_STAGE(bufoff, gbase, voff) do { _Pragma("unroll") for (int _i = 0; _i < 2; ++_i) \
        __builtin_amdgcn_global_load_lds((const unsigned*)((const char*)(gbase) + (voff)[_i]), (PG8_LAS unsigned*)(lds + (bufoff) + ldsw + _i * 8192), 16, 0, 0); } while (0)
#define PG8_LDA(dst, b, h) do { _Pragma("unroll") for (int m = 0; m < 4; ++m) _Pragma("unroll") for (int k = 0; k < 2; ++k) dst[m][k] = *(const PG8_LAS bf16x8*)(lds + PG8_SA(b, h) + aoff + m * 2048 + k * 1024); } while (0)
#define PG8_LDB(dst, b, h) do { _Pragma("unroll") for (int n = 0; n < 2; ++n) _Pragma("unroll") for (int k = 0; k < 2; ++k) dst[n][k] = *(const PG8_LAS bf16x8*)(lds + PG8_SB(b, h) + boff + n * 2048 + k * 1024); } while (0)
#define PG8_MMA(ai, bj, At, Bt) do { __builtin_amdgcn_s_setprio(1); _Pragma("unroll") for (int m = 0; m < 4; ++m) _Pragma("unroll") for (int n = 0; n < 2; ++n) _Pragma("unroll") for (int k = 0; k < 2; ++k) \
        acc[ai][bj][m][n] = __builtin_amdgcn_mfma_f32_16x16x32_bf16(Bt[n][k], At[m][k], acc[ai][bj][m][n], 0, 0, 0); __builtin_amdgcn_s_setprio(0); } while (0)
#define PG8_WAIT_V(n) asm volatile("s_waitcnt vmcnt(" #n ")" ::: "memory")
#define PG8_WAIT_L(n) asm volatile("s_waitcnt lgkmcnt(" #n ")" ::: "memory")
#define PG8_BAR __builtin_amdgcn_s_barrier()
#define PG8_SCHED __builtin_amdgcn_sched_barrier(0)
    Unit cur, nxt; int ui = 0;
    if (!S.next(0, cur)) return;
    f32x4 acc[2][2][4][2];
#pragma unroll
    for (int a = 0; a < 2; ++a)
#pragma unroll
        for (int b = 0; b < 2; ++b)
#pragma unroll
            for (int m = 0; m < 4; ++m)
#pragma unroll
                for (int n = 0; n < 2; ++n) acc[a][b][m][n] = (f32x4){0.f, 0.f, 0.f, 0.f};
    bf16x8 At[4][2], B0[2][2], B1[2][2];
    const char* cA = (const char*)g.A + (size_t)cur.pm * tstep; const char* cB = (const char*)g.Bt + (size_t)cur.pn * tstep;
    S.a_ready(cur);
    if constexpr (SP2) {
        PG8_STAGE(PG8_SB(0, 0), cB, voffB); PG8_STAGE(PG8_SB(0, 1), cB + hstep, voffB); PG8_STAGE(PG8_SA(0, 0), cA, voffA); PG8_STAGE(PG8_SA(0, 1), cA + hstep, voffA);
        if (wr == 1) PG8_BAR;
        PG8_WAIT_V(2); PG8_BAR;
        PG8_STAGE(PG8_SB(1, 0), cB + kstep, voffB); PG8_STAGE(PG8_SA(1, 0), cA + kstep, voffA); PG8_STAGE(PG8_SB(1, 1), cB + hstep + kstep, voffB);
        PG8_WAIT_V(6); PG8_BAR;
    } else {
        PG8_STAGE(PG8_SB(0, 0), cB, voffB); PG8_STAGE(PG8_SA(0, 0), cA, voffA); PG8_STAGE(PG8_SB(0, 1), cB + hstep, voffB); PG8_STAGE(PG8_SA(0, 1), cA + hstep, voffA);
        if (wr == 1) PG8_BAR;
        PG8_WAIT_V(4); PG8_BAR;
        PG8_STAGE(PG8_SB(1, 0), cB + kstep, voffB); PG8_STAGE(PG8_SA(1, 0), cA + kstep, voffA); PG8_STAGE(PG8_SB(1, 1), cB + hstep + kstep, voffB);
        PG8_WAIT_V(6); PG8_BAR;
    }
    for (;;) {
        const bool has_next = S.next(ui + 1, nxt);
        const char* nA = has_next ? (const char*)g.A + (size_t)nxt.pm * tstep : cA; const char* nB = has_next ? (const char*)g.Bt + (size_t)nxt.pn * tstep : cB;
        for (int t = 0; t < nt; t += 2) {
            const bool last = (t == nt - 2);
            const char* a1 = cA + (size_t)(t + 1) * kstep;
            const char* a2 = last ? nA : cA + (size_t)(t + 2) * kstep; const char* b2 = last ? nB : cB + (size_t)(t + 2) * kstep;
            const char* a3 = a2 + kstep; const char* b3 = b2 + kstep;
            if (last && has_next) S.a_ready(nxt);
            if constexpr (SP2) {
            PG8_LDB(B0, 0, 0); PG8_LDB(B1, 0, 1); PG8_SCHED; PG8_LDA(At, 0, 0); PG8_STAGE(PG8_SA(1, 1), a1 + hstep, voffA);
            PG8_WAIT_V(8); PG8_WAIT_L(0); PG8_BAR; PG8_MMA(0, 0, At, B0); PG8_MMA(0, 1, At, B1); PG8_BAR; PG8_SCHED;
            PG8_LDA(At, 0, 1); PG8_STAGE(PG8_SB(0, 0), b2, voffB); PG8_STAGE(PG8_SB(0, 1), b2 + hstep, voffB); PG8_STAGE(PG8_SA(0, 0), a2, voffA);
            PG8_WAIT_V(8); PG8_WAIT_L(0); PG8_BAR; PG8_MMA(1, 0, At, B0); PG8_MMA(1, 1, At, B1); PG8_BAR; PG8_SCHED;
            PG8_LDB(B0, 1, 0); PG8_LDB(B1, 1, 1); PG8_SCHED; PG8_LDA(At, 1, 0); PG8_STAGE(PG8_SA(0, 1), a2 + hstep, voffA);
            PG8_WAIT_V(8); PG8_WAIT_L(0); PG8_BAR; PG8_MMA(0, 0, At, B0); PG8_MMA(0, 1, At, B1); PG8_BAR; PG8_SCHED;
            PG8_LDA(At, 1, 1); PG8_STAGE(PG8_SB(1, 0), b3, voffB); PG8_STAGE(PG8_SB(1, 1), b3 + hstep, voffB); PG8_STAGE(PG8_SA(1, 0), a3, voffA);
            PG8_WAIT_V(8); PG8_WAIT_L(0); PG8_BAR; PG8_MMA(1, 0, At, B0); PG8_MMA(1, 1, At, B1); PG8_BAR; PG8_SCHED;
            } else {
            PG8_LDB(B0, 0, 0); PG8_SCHED; PG8_LDA(At, 0, 0); PG8_STAGE(PG8_SA(1, 1), a1 + hstep, voffA);
            PG8_WAIT_L(8); PG8_BAR; PG8_WAIT_L(0); PG8_MMA(0, 0, At, B0); PG8_BAR; PG8_SCHED;
            PG8_LDB(B1, 0, 1); PG8_STAGE(PG8_SB(0, 0), b2, voffB);
            PG8_BAR; PG8_WAIT_L(0); PG8_MMA(0, 1, At, B1); PG8_BAR;
            PG8_LDA(At, 0, 1); PG8_STAGE(PG8_SA(0, 0), a2, voffA);
            PG8_BAR; PG8_WAIT_L(0); PG8_MMA(1, 0, At, B0); PG8_BAR; PG8_SCHED;
            PG8_STAGE(PG8_SB(0, 1), b2 + hstep, voffB);
            PG8_WAIT_V(6); PG8_BAR; PG8_MMA(1, 1, At, B1); PG8_BAR;
            PG8_LDB(B0, 1, 0); PG8_SCHED; PG8_LDA(At, 1, 0); PG8_STAGE(PG8_SA(0, 1), a2 + hstep, voffA);
            PG8_WAIT_L(8); PG8_BAR; PG8_WAIT_L(0); PG8_MMA(0, 0, At, B0); PG8_BAR; PG8_SCHED;
            PG8_LDB(B1, 1, 1); PG8_STAGE(PG8_SB(1, 0), b3, voffB);
            PG8_BAR; PG8_WAIT_L(0); PG8_MMA(0, 1, At, B1); PG8_BAR;
            PG8_LDA(At, 1, 1); PG8_STAGE(PG8_SA(1, 0), a3, voffA);
            PG8_BAR; PG8_WAIT_L(0); PG8_MMA(1, 0, At, B0); PG8_BAR; PG8_SCHED;
            PG8_STAGE(PG8_SB(1, 1), b3 + hstep, voffB);
            PG8_WAIT_V(6); PG8_BAR; PG8_MMA(1, 1, At, B1); PG8_BAR;
            }
        }
        if constexpr (ALIGN_EPI) { if (wr == 0) PG8_BAR; }
        if constexpr (!Epi::AFTER_DRAIN) { E(acc, cur, wr, wc, fr, fq);
#if PROBE == 8
            if constexpr (Epi::IDEMPOTENT) E(acc, cur, wr, wc, fr, fq);
#endif
            S.done(cur); }
        if (!has_next) break;
#pragma unroll
        for (int a = 0; a < 2; ++a)
#pragma unroll
            for (int b = 0; b < 2; ++b)
#pragma unroll
                for (int m = 0; m < 4; ++m)
#pragma unroll
                    for (int n = 0; n < 2; ++n) acc[a][b][m][n] = (f32x4){0.f, 0.f, 0.f, 0.f};
        cur = nxt; cA = nA; cB = nB; ++ui;
        if constexpr (ALIGN_EPI) { if (wr == 1) PG8_BAR; }
    }
    PG8_WAIT_V(0);
    if constexpr (!ALIGN_EPI) { if (wr == 0) PG8_BAR; }
    PG8_BAR;
    if constexpr (Epi::AFTER_DRAIN) { E.fused(acc, cur, wr, wc, fr, fq, lds, wid, lane); S.done(cur); }
#undef PG8_SA
#undef PG8_SB
#undef PG8_STAGE
#undef PG8_LDA
#undef PG8_LDB
#undef PG8_MMA
#undef PG8_WAIT_V
#undef PG8_WAIT_L
#undef PG8_BAR
#undef PG8_SCHED
}
}
namespace att {
constexpr int D = 128, LDQ = 4096, LDK = 128, LDO = 2048, LDG = 4096;
constexpr float THR = 8.f; constexpr bool WSKIP = false;
typedef unsigned u32x4_t __attribute__((ext_vector_type(4)));
typedef short bf16x8_t __attribute__((ext_vector_type(8)));
__device__ __forceinline__ bf16x8_t ka_frag(unsigned lo, unsigned up, int hi) {
    u32x4_t w;
    w.x = 0x3f803f80u; w.y = 0x3f80u | (((lo & 0xffffu) ^ 0x8000u) << 16); w.z = ((lo >> 16) ^ 0x8000u) | (((up & 0xffffu) ^ 0x8000u) << 16); w.w = 0u;
    if (hi) { w.x = 0u; w.y = 0u; w.z = 0u; }
    return __builtin_bit_cast(bf16x8_t, w);
}
__device__ __forceinline__ bf16x8_t qa_frag(unsigned lo, unsigned up, int hi) {
    u32x4_t w;
    w.x = lo; w.y = (up & 0xffffu) | 0x3f800000u; w.z = 0x3f803f80u; w.w = 0u;
    if (hi) { w.x = 0u; w.y = 0u; w.z = 0u; }
    return __builtin_bit_cast(bf16x8_t, w);
}
constexpr float SCALE = 0.08838834764831845f;
constexpr int NW = 8, QBLK = 32, KVBLK = 64, QB = NW * QBLK;
constexpr int SHM_V = KVBLK * D * 2, SHM_K = KVBLK * D * 2;
constexpr int ATT_LDS_BYTES = 2 * SHM_V + 2 * SHM_K + NW * 64 * 4;

using bf16 = __hip_bfloat16;
typedef short bf16x8 __attribute__((ext_vector_type(8)));
typedef short s16x4 __attribute__((ext_vector_type(4)));
typedef float f32x16 __attribute__((ext_vector_type(16)));
typedef float f32x4 __attribute__((ext_vector_type(4)));
typedef unsigned u32x4 __attribute__((ext_vector_type(4)));
template <class A, class Bt> struct same_t { static constexpr bool v = false; };
template <class A> struct same_t<A, A> { static constexpr bool v = true; };

#define KSWZ(row, colB) ((row) * 256 + ((colB) ^ (((row) & 7) << 4)))
#define SBAR() __builtin_amdgcn_sched_barrier(0)
__device__ __forceinline__ int v_st(int k, int c) { const int kk = (k & ~0xC) | ((k & 4) << 1) | ((k & 8) >> 1); return ((kk >> 3) * 4 + (c >> 5)) * 512 + ((kk & 7) * 32 + (c & 31)) * 2; }
__device__ __forceinline__ int v_rd_base(int lane) { return ((lane & 3) << 3) | (((lane >> 2) & 3) << 6) | (((lane >> 4) & 1) << 5) | (((lane >> 5) & 1) << 8); }
constexpr int v_rd_off(int d0, int ks, int half) { return d0 * 512 + ks * 4096 + half * 2048; }
__device__ __forceinline__ int crow(int r, int hi) { return (r & 3) + 8 * (r >> 2) + 4 * hi; }
__device__ __forceinline__ unsigned cvtpk(float lo, float hi) {
    unsigned r; asm volatile("v_cvt_pk_bf16_f32 %0, %1, %2" : "=v"(r) : "v"(lo), "v"(hi)); return r;
}
__device__ __forceinline__ bf16x8 pack8(f32x4 a, f32x4 b) {
    u32x4 w = {cvtpk(a[0], a[1]), cvtpk(a[2], a[3]), cvtpk(b[0], b[1]), cvtpk(b[2], b[3])};
    return *reinterpret_cast<bf16x8*>(&w);
}
template <class T> __device__ __forceinline__ bf16x8 load8(const T* p) {
    if constexpr (same_t<T, float>::v) { return pack8(*(const f32x4*)p, *(const f32x4*)(p + 4)); }
    else { return *reinterpret_cast<const bf16x8*>(p); }
}
__device__ __forceinline__ void mask_tile(f32x16& p0, f32x16& p1, int dq, unsigned W) {
    const float NEG = -__builtin_inff();
#pragma unroll
    for (int r = 0; r < 16; ++r) {
        const int c = (r & 3) + 8 * (r >> 2);
        if ((unsigned)(dq - c) >= W) p0[r] = NEG;
        if ((unsigned)(dq - c - 32) >= W) p1[r] = NEG;
    }
}
__device__ __forceinline__ void partialSM(f32x16& p0, f32x16& p1, float& m_reg, float& mn, float& alpha) {
    float pmax = p0[0]; for (int r = 1; r < 16; ++r) pmax = fmaxf(pmax, p0[r]); for (int r = 0; r < 16; ++r) pmax = fmaxf(pmax, p1[r]);
    { auto rr = __builtin_amdgcn_permlane32_swap(__float_as_uint(pmax), __float_as_uint(pmax), false, false);
      pmax = fmaxf(__uint_as_float(rr[0]), __uint_as_float(rr[1])); }
    constexpr float C2 = 1.4426950408889634f * SCALE;
    if (__builtin_expect(__all((pmax - m_reg) * SCALE <= THR), 1)) { mn = m_reg; alpha = 1.f; }
    else { mn = fmaxf(m_reg, pmax); alpha = __builtin_amdgcn_exp2f((m_reg - mn) * C2); m_reg = mn; }
    const float mnL = -mn * C2;
    for (int r = 0; r < 16; ++r) p0[r] = fmaf(p0[r], C2, mnL); for (int r = 0; r < 16; ++r) p1[r] = fmaf(p1[r], C2, mnL);
    for (int r = 0; r < 16; ++r) p0[r] = __builtin_amdgcn_exp2f(p0[r]);
}
__device__ __forceinline__ void finishSM(f32x16& p0, f32x16& p1, float alpha, float& l_reg, bf16x8& pa0, bf16x8& pa1, bf16x8& pa2, bf16x8& pa3) {
    for (int r = 0; r < 16; ++r) p1[r] = __builtin_amdgcn_exp2f(p1[r]);
    float ps = 0; for (int r = 0; r < 16; ++r) ps += p0[r]; for (int r = 0; r < 16; ++r) ps += p1[r];
    { auto rr = __builtin_amdgcn_permlane32_swap(__float_as_uint(ps), __float_as_uint(ps), false, false);
      ps = __uint_as_float(rr[0]) + __uint_as_float(rr[1]); }
    l_reg = l_reg * alpha + ps;
#define PK4(P, B_, OUT) do { unsigned a0 = cvtpk(P[B_+0], P[B_+1]), a1 = cvtpk(P[B_+2], P[B_+3]);                          \
        unsigned b0 = cvtpk(P[B_+4], P[B_+5]), b1 = cvtpk(P[B_+6], P[B_+7]);                                             \
        auto r0 = __builtin_amdgcn_permlane32_swap(a0, b0, false, false); auto r1 = __builtin_amdgcn_permlane32_swap(a1, b1, false, false); \
        u32x4 w = {r0[0], r1[0], r0[1], r1[1]}; OUT = *reinterpret_cast<bf16x8*>(&w); } while (0)
    PK4(p0, 0, pa0); PK4(p0, 8, pa1); PK4(p1, 0, pa2); PK4(p1, 8, pa3);
#undef PK4
}
template <int KB, bool SK>
__device__ __forceinline__ void qkt(f32x16& p0, f32x16& p1, const char* K_lds, int r32, int hi, const bf16x8* qr, bool act, unsigned long long qa, unsigned long long c) {
    if (SK && !act) { const float NEG = -__builtin_inff();
#pragma unroll
        for (int r = 0; r < 16; ++r) { p0[r] = NEG; p1[r] = NEG; } return; }
    p0 = f32x16{}; p1 = f32x16{};
    const char* kb[4];
#pragma unroll
    for (int dd = 0; dd < 4; ++dd) kb[dd] = K_lds + KB * SHM_K + KSWZ(r32, (dd * 16 + hi * 8) * 2);
#pragma unroll
    for (int d0 = 0; d0 < 8; ++d0) { const char* a = kb[d0 & 3] + (d0 >> 2) * 128;
        bf16x8 b0 = *reinterpret_cast<const bf16x8*>(a);
        bf16x8 b1 = *reinterpret_cast<const bf16x8*>(a + 32 * 256);
        p0 = __builtin_amdgcn_mfma_f32_32x32x16_bf16(b0, qr[d0], p0, 0, 0, 0);
        p1 = __builtin_amdgcn_mfma_f32_32x32x16_bf16(b1, qr[d0], p1, 0, 0, 0); }
    { unsigned ql = (unsigned)qa, qu = (unsigned)(qa >> 32); asm volatile("" : "+v"(ql), "+v"(qu));
      const bf16x8 qaf = qa_frag(ql, qu, hi);
      const unsigned cl = (unsigned)c, cu = (unsigned)(c >> 32);
      auto r0 = __builtin_amdgcn_permlane32_swap(cl, cl, false, false); auto r1 = __builtin_amdgcn_permlane32_swap(cu, cu, false, false);
      p0 = __builtin_amdgcn_mfma_f32_32x32x16_bf16(ka_frag(r0[0], r1[0], hi), qaf, p0, 0, 0, 0);
      p1 = __builtin_amdgcn_mfma_f32_32x32x16_bf16(ka_frag(r0[1], r1[1], hi), qaf, p1, 0, 0, 0); }
}
template <int VB, bool SK>
__device__ __forceinline__ void pv_tile(f32x16* o, int vb0, bf16x8 pa0, bf16x8 pa1, bf16x8 pa2, bf16x8 pa3, bool act) {
    if (SK && !act) return;
#define TRRD(dst, off) asm volatile("ds_read_b64_tr_b16 %0, %1 offset:%2" : "=&v"(dst) : "v"(vb0), "i"(off) : "memory")
#define PV_D0(d0) do { s16x4 l0, l1, l2, l3, h0, h1, h2, h3; constexpr int b_ = VB * SHM_V + v_rd_off(d0, 0, 0);     \
        TRRD(l0, b_); TRRD(h0, b_ + 2048); TRRD(l1, b_ + 4096); TRRD(h1, b_ + 6144); TRRD(l2, b_ + 8192); TRRD(h2, b_ + 10240); TRRD(l3, b_ + 12288); TRRD(h3, b_ + 14336); \
        asm volatile("s_waitcnt lgkmcnt(0)" ::: "memory"); SBAR();                 \
        o[d0] = __builtin_amdgcn_mfma_f32_32x32x16_bf16(pa0, (bf16x8){l0[0], l0[1], l0[2], l0[3], h0[0], h0[1], h0[2], h0[3]}, o[d0], 0, 0, 0);   \
        o[d0] = __builtin_amdgcn_mfma_f32_32x32x16_bf16(pa1, (bf16x8){l1[0], l1[1], l1[2], l1[3], h1[0], h1[1], h1[2], h1[3]}, o[d0], 0, 0, 0);   \
        o[d0] = __builtin_amdgcn_mfma_f32_32x32x16_bf16(pa2, (bf16x8){l2[0], l2[1], l2[2], l2[3], h2[0], h2[1], h2[2], h2[3]}, o[d0], 0, 0, 0);   \
        o[d0] = __builtin_amdgcn_mfma_f32_32x32x16_bf16(pa3, (bf16x8){l3[0], l3[1], l3[2], l3[3], h3[0], h3[1], h3[2], h3[3]}, o[d0], 0, 0, 0); } while (0)
    PV_D0(0); PV_D0(1); PV_D0(2); PV_D0(3);
#undef PV_D0
#undef TRRD
}

template <class TIn, class TOut> struct BlockRef { const TIn* Q; const TIn* K; const TIn* V; TOut* O; const unsigned short* G; const unsigned long long* CA; int P0; };
template <class TIn> struct Seam {
    bf16x8 qr[8];
    bf16x8 st_v0, st_v1, st_k0, st_k1; f32x4 sf0, sf1, sf2, sf3;
    unsigned long long ca, qa;
    f32x4 tq[16];
};
__device__ __forceinline__ int swa_jlo(int P0, int W) { const int lowk = P0 - W + 1; return lowk > 0 ? lowk / KVBLK : 0; }
#define ROW(p, k0, rr) ((p) + (size_t)((k0) + (rr)) * LDK + sc)
#define VMW() asm volatile("s_waitcnt vmcnt(0)" ::: "memory")
#define VMWN(n) asm volatile("s_waitcnt vmcnt(%0)" :: "i"(n) : "memory")
#define SLOAD_H(Kp, Vp, CAp, k0) do { S.st_v0 = load8<TIn>(ROW(Vp, k0, sr)); S.st_v1 = load8<TIn>(ROW(Vp, k0, 32 + sr));              \
                         S.st_k0 = load8<TIn>(ROW(Kp, k0, sr)); S.st_k1 = load8<TIn>(ROW(Kp, k0, 32 + sr)); S.ca = (CAp)[(k0) + lane]; } while (0)
#define SWRITE_HK(bf) do { *(bf16x8*)(K_lds + (bf) * SHM_K + kws) = S.st_k0; *(bf16x8*)(K_lds + (bf) * SHM_K + kws + 32 * 256) = S.st_k1; } while (0)
#define SWRITE_HV(bf) do { *(bf16x8*)(V_lds + (bf) * SHM_V + vst0) = S.st_v0; *(bf16x8*)(V_lds + (bf) * SHM_V + vst1) = S.st_v1; } while (0)
#define SWRITE_H(bf) do { SWRITE_HV(bf); SWRITE_HK(bf); } while (0)
#define SLOAD_F(p, k0) do { S.sf0 = *(const f32x4*)ROW(p, k0, sr); S.sf1 = *(const f32x4*)(ROW(p, k0, sr) + 4);                \
                            S.sf2 = *(const f32x4*)ROW(p, k0, 32 + sr); S.sf3 = *(const f32x4*)(ROW(p, k0, 32 + sr) + 4); } while (0)
#define SWRITE_KF(bf) do { *(bf16x8*)(K_lds + (bf) * SHM_K + kws) = pack8(S.sf0, S.sf1); *(bf16x8*)(K_lds + (bf) * SHM_K + kws + 32 * 256) = pack8(S.sf2, S.sf3); } while (0)
#define SWRITE_VF(bf) do { *(bf16x8*)(V_lds + (bf) * SHM_V + vst0) = pack8(S.sf0, S.sf1); *(bf16x8*)(V_lds + (bf) * SHM_V + vst1) = pack8(S.sf2, S.sf3); } while (0)
template <class TIn, class TOut>
__device__ __forceinline__ void causal_swa_prime(const BlockRef<TIn, TOut>& cur, int W, char* lds, Seam<TIn>& S) {
    constexpr bool F32 = same_t<TIn, float>::v;
    const int tid = opaque_tid(), wid = __builtin_amdgcn_readfirstlane(tid >> 6), lane = tid & 63, r32 = lane & 31, hi = lane >> 5;
    const int sr = tid >> 4, sc = (tid & 15) * 8, kws = KSWZ(sr, sc * 2); char* K_lds = lds + 2 * SHM_V;
    const int kb0 = swa_jlo(cur.P0, W) * KVBLK;
    for (int d0 = 0; d0 < 8; ++d0) S.qr[d0] = load8<TIn>(cur.Q + (size_t)(wid * QBLK + r32) * LDQ + d0 * 16 + hi * 8);
    S.qa = cur.CA[cur.P0 + wid * QBLK + r32];
    if constexpr (F32) { SLOAD_F((const float*)cur.K, kb0); VMW(); SWRITE_KF(0); SBAR(); SLOAD_F((const float*)cur.V, kb0); }
    else { SLOAD_H(cur.K, cur.V, cur.CA, kb0); VMW(); SWRITE_HK(0); }
    __syncthreads();
}
template <class TIn, class TOut>
__device__ __forceinline__ void causal_swa_block(const BlockRef<TIn, TOut>& cur, const BlockRef<TIn, TOut>& nxt, int skv, int W, char* lds, Seam<TIn>& S) {
    constexpr bool F32 = same_t<TIn, float>::v;
    const int tid = opaque_tid(), wid = __builtin_amdgcn_readfirstlane(tid >> 6), lane = tid & 63, r32 = lane & 31, hi = lane >> 5;
    const int j_lo = swa_jlo(cur.P0, W);
    int j_hi = (cur.P0 + QB - 1) / KVBLK + 1; if (j_hi > skv / KVBLK) j_hi = skv / KVBLK;
    const int NT = j_hi - j_lo;
    const int kbn = swa_jlo(nxt.P0, W) * KVBLK;
    const int qlo = cur.P0 + wid * QBLK, qm = qlo + r32 - 4 * hi;
    char* V_lds = lds; char* K_lds = lds + 2 * SHM_V;
    float* ws = (float*)(lds + 2 * SHM_V + 2 * SHM_K) + wid * 64; float* li_l = ws, * al_l = ws + 32;
    float m_reg = -1e30f, l_reg = 0; f32x16 o[4] = {};
    const int sr = tid >> 4, sc = (tid & 15) * 8, vst0 = v_st(sr, sc), vst1 = v_st(32 + sr, sc), kws = KSWZ(sr, sc * 2);
    const int vb0 = (int)(uintptr_t)V_lds + v_rd_base(lane);
    const TIn* Kh = cur.K; const TIn* Vh = cur.V; const unsigned long long* CAh = cur.CA;
#define RESC(a) do { if (__any((a) < 1.f)) { if (hi == 0) al_l[r32] = (a); asm volatile("s_waitcnt lgkmcnt(0)" ::: "memory");              \
                     for (int d_ = 0; d_ < 4; ++d_) for (int r = 0; r < 16; ++r) o[d_][r] *= al_l[crow(r, hi)]; } } while (0)
#define KBASE(t) ((j_lo + (t)) * KVBLK)
#define ACT(t) (KBASE(t) <= qlo + QBLK - 1 && KBASE(t) + KVBLK - 1 >= qlo - W + 1)
#define MASKT(P0_, P1_, t) do { const int kb_ = KBASE(t); if ((!SK || ACT(t)) && (kb_ + KVBLK - 1 > qlo || kb_ <= qlo + QBLK - 1 - W)) mask_tile(P0_, P1_, qm - kb_, (unsigned)W); } while (0)
    constexpr int NQL = F32 ? 16 : 8;
    constexpr bool SK = WSKIP && !F32;
#define SEAM_K0() do { VMWN(NQL); if constexpr (F32) { SWRITE_KF(0); SBAR(); SLOAD_F((const float*)nxt.V, kbn); } else { SWRITE_HK(0); } SBAR(); } while (0)
    f32x16 pA0, pA1, pB0, pB1; float mnA, mnB, alA, alB; bf16x8 pa0, pa1, pa2, pa3;
    if constexpr (F32) { VMW(); SWRITE_VF(0); SBAR(); } else { SWRITE_HV(0); SBAR(); }
    const unsigned long long qa_ = S.qa, hc = S.ca;
    if (NT > 1) { if constexpr (F32) SLOAD_F((const float*)Kh, KBASE(1)); else SLOAD_H(Kh, Vh, CAh, KBASE(1)); }
    SBAR(); qkt<0, SK>(pA0, pA1, K_lds, r32, hi, S.qr, ACT(0), qa_, hc);
    if constexpr (F32) { if (NT > 1) { VMW(); SWRITE_KF(1); SBAR(); SLOAD_F((const float*)Vh, KBASE(1)); } }
    MASKT(pA0, pA1, 0); partialSM(pA0, pA1, m_reg, mnA, alA);
    if (NT > 1) { VMW(); if constexpr (F32) { SWRITE_VF(1); SBAR(); if (NT > 2) SLOAD_F((const float*)Kh, KBASE(2)); } else SWRITE_H(1); }
    __syncthreads();
#define HALF_STEP(PX0, PX1, mnX, alX, PY0, PY1, alY, t, KB, VB, SB) do {                                                      \
        { const unsigned long long c_ = S.ca; SBAR(); qkt<KB, SK>(PX0, PX1, K_lds, r32, hi, S.qr, ACT(t), qa_, c_); }                                             \
        finishSM(PY0, PY1, alY, l_reg, pa0, pa1, pa2, pa3); SBAR();                                                           \
        if ((t) + 1 < NT) { if constexpr (F32) { VMW(); SWRITE_KF(SB); SBAR(); SLOAD_F((const float*)Vh, KBASE((t) + 1)); }  \
                            else { SLOAD_H(Kh, Vh, CAh, KBASE((t) + 1)); } SBAR(); }                                               \
        pv_tile<VB, SK>(o, vb0, pa0, pa1, pa2, pa3, ACT((t) - 1)); MASKT(PX0, PX1, (t)); partialSM(PX0, PX1, m_reg, mnX, alX);                                        \
        __syncthreads();                                                                                                      \
        if ((t) + 1 < NT) { VMW(); if constexpr (F32) { SWRITE_VF(SB); SBAR(); if ((t) + 2 < NT) SLOAD_F((const float*)Kh, KBASE((t) + 2)); } \
                            else { SWRITE_H(SB); } }                                                                          \
        RESC(alX); __syncthreads(); } while (0)
    for (int t = 1; t + 1 < NT; t += 2) {
        HALF_STEP(pB0, pB1, mnB, alB, pA0, pA1, alA, t, 1, 0, 0);
        HALF_STEP(pA0, pA1, mnA, alA, pB0, pB1, alB, t + 1, 0, 1, 1);
    }
    const bool even = (NT & 1) == 0;
    if (even) { const unsigned long long c_ = S.ca; SBAR(); qkt<1, SK>(pB0, pB1, K_lds, r32, hi, S.qr, ACT(NT - 1), qa_, c_); SBAR(); }
#define QROW(e) (nxt.Q + (size_t)(wid * QBLK + r32) * D + ((e) >> 1) * 16 + hi * 8 + ((e) & 1) * 4)
    if constexpr (F32) { SLOAD_F((const float*)nxt.K, kbn); SBAR();
#pragma unroll
        for (int e = 0; e < 8; ++e) S.tq[e] = *(const f32x4*)QROW(e); }
    else { SLOAD_H(nxt.K, nxt.V, nxt.CA, kbn); SBAR();
#pragma unroll
        for (int d0 = 0; d0 < 8; ++d0) S.qr[d0] = load8<TIn>(nxt.Q + (size_t)(wid * QBLK + r32) * LDQ + d0 * 16 + hi * 8);
        S.qa = nxt.CA[nxt.P0 + wid * QBLK + r32]; }
    SBAR();
    finishSM(pA0, pA1, alA, l_reg, pa0, pa1, pa2, pa3); SBAR();
    if constexpr (F32) {
#pragma unroll
        for (int e = 8; e < 16; ++e) S.tq[e] = *(const f32x4*)QROW(e); SBAR(); }
#undef QROW
    pv_tile<0, SK>(o, vb0, pa0, pa1, pa2, pa3, ACT(even ? NT - 2 : NT - 1));
    if (even) { MASKT(pB0, pB1, NT - 1); partialSM(pB0, pB1, m_reg, mnB, alB); __syncthreads(); RESC(alB);
        finishSM(pB0, pB1, alB, l_reg, pa0, pa1, pa2, pa3); SBAR(); pv_tile<1, SK>(o, vb0, pa0, pa1, pa2, pa3, ACT(NT - 1)); }
    SBAR(); SEAM_K0();
    if (hi == 0) li_l[r32] = l_reg; asm volatile("s_waitcnt lgkmcnt(0)" ::: "memory");
    float rli[16];
#pragma unroll
    for (int r = 0; r < 16; ++r) rli[r] = __builtin_amdgcn_rcpf(li_l[crow(r, hi)]);
    TOut* Ow = cur.O + (size_t)(wid * QBLK) * LDO; const unsigned short* Gw = cur.G + (size_t)(wid * QBLK) * LDG;
#pragma unroll
    for (int r = 0; r < 16; ++r) { const int orow = crow(r, hi);
#pragma unroll
        for (int d0 = 0; d0 < 4; ++d0) { const float v = o[d0][r] * rli[r];
            if constexpr (same_t<TOut, float>::v) { Ow[(size_t)orow * LDO + d0 * 32 + r32] = v; }
            else { const float vn = __builtin_bit_cast(float, __builtin_amdgcn_mov_dpp(__builtin_bit_cast(int, v), 0xB1, 0xf, 0xf, true));
                   if ((r32 & 1) == 0) { const unsigned g2 = *(const unsigned*)(Gw + (size_t)orow * LDG + d0 * 32 + r32);
                       *(unsigned*)(Ow + (size_t)orow * LDO + d0 * 32 + r32) = cvtpk(v * __uint_as_float(g2 << 16), vn * __uint_as_float(g2 & 0xffff0000u)); } } } }
    if constexpr (F32) {
#pragma unroll
        for (int d0 = 0; d0 < 8; ++d0) S.qr[d0] = pack8(S.tq[2 * d0], S.tq[2 * d0 + 1]); }
    __syncthreads();
#undef RESC
#undef KBASE
#undef ACT
#undef MASKT
#undef SEAM_K0
#undef HALF_STEP
}
#undef ROW
#undef VMW
#undef VMWN
#undef SLOAD_H
#undef SWRITE_HK
#undef SWRITE_HV
#undef SWRITE_H
#undef SLOAD_F
#undef SWRITE_KF
#undef SWRITE_VF

__host__ __device__ inline int swa_nx(int nqb, int nramp) { return (nramp + 1) / 2 + (nqb - nramp); }
struct SwaItem { int bh, qb0, qb1; };
__device__ __forceinline__ SwaItem swa_decode(int L, int nqb, int nx) {
    SwaItem it; const int xcd = L & 7, k = L >> 3, gi = k / nx, r = k - gi * nx;
    it.bh = gi * 8 + xcd; const int x = r;
    it.qb0 = x; it.qb1 = nqb - 1 - x;
    return it;
}
struct AttnT { const bf16* Q; const bf16* K; const bf16* V; bf16* O; const unsigned short* G; const unsigned long long* CA; };
__device__ __forceinline__ BlockRef<bf16, bf16> swa_ref(const SwaItem& it, int pass, const AttnT& T, int seq, int nh) {
    const int qb = pass ? it.qb1 : it.qb0, b = it.bh / nh, h = it.bh % nh; const size_t tok0 = (size_t)b * seq;
    BlockRef<bf16, bf16> r;
    r.Q = T.Q + (tok0 + (size_t)qb * QB) * LDQ + h * D; r.O = T.O + (tok0 + (size_t)qb * QB) * LDO + h * D; r.G = T.G + (tok0 + (size_t)qb * QB) * LDG + h * D;
    r.K = T.K + (size_t)it.bh * seq * D; r.V = T.V + (size_t)it.bh * seq * D; r.CA = T.CA + (size_t)it.bh * seq; r.P0 = qb * QB;
    return r;
}
__device__ __forceinline__ void attn_phase(char* lds, const AttnT& T, int nb, int nh, int seq) {
    const int W = 1 << 30, nqb = seq / QB, nx = nqb / 2, total = nx * nb * nh, stride = gridDim.x;
    int L = blockIdx.x; if (L >= total) return;
    SwaItem it = swa_decode(L, nqb, nx); int pass = 0;
    BlockRef<bf16, bf16> cur = swa_ref(it, 0, T, seq, nh);
    Seam<bf16> S;
    causal_swa_prime<bf16, bf16>(cur, W, lds, S);
    for (;;) {
        const bool more_pass = pass == 0 && it.qb1 != it.qb0, more_item = L + stride < total, last = !more_pass && !more_item;
        SwaItem itn = it; int passn = pass + 1, Ln = L;
        if (!more_pass) { passn = 0; Ln = more_item ? L + stride : L; itn = swa_decode(Ln, nqb, nx); }
        const BlockRef<bf16, bf16> nxt = last ? cur : swa_ref(itn, passn, T, seq, nh);
        causal_swa_block<bf16, bf16>(cur, nxt, seq, W, lds, S);
        if (last) break;
        cur = nxt; it = itn; pass = passn; L = Ln;
    }
}
#undef KSWZ
#undef SBAR
}
constexpr int DM = 2048, NB = 4, SEQ = 4096, MT = NB * SEQ, FF = 5632, FF2 = 2 * FF, NH = 16, HD = 128, CH = 128, NG = 16;
constexpr float EPS = 1e-6f;
constexpr int NWAVES = 8, NTHREADS = NWAVES * 64;
constexpr size_t MiB = 1u << 20;
constexpr size_t WS_BAR = 0, BAR_ZERO_BYTES = 16384;
constexpr size_t WS_LOGF = 1 * MiB;
constexpr size_t WS_CA = 2 * MiB;
constexpr size_t WS_WSB = 4 * MiB;
constexpr size_t WS_WF = 5 * MiB;
constexpr size_t WS_W_AIN = 6 * MiB;
constexpr size_t WS_W_AOUT = WS_W_AIN + 32 * MiB;
constexpr size_t WS_W_KV = WS_W_AOUT + 16 * MiB;
constexpr size_t WS_W_QG = WS_W_KV + 16 * MiB;
constexpr size_t WS_W_BOUT = WS_W_QG + 32 * MiB;
constexpr size_t WS_W_UP = WS_W_BOUT + 16 * MiB;
constexpr size_t WS_W_DN = WS_W_UP + 176 * MiB;
constexpr size_t WS_XN = WS_W_DN + 88 * MiB;
constexpr size_t WS_XN2 = WS_XN + 64 * MiB;
constexpr size_t WS_KV = WS_XN2 + 64 * MiB;
constexpr size_t WS_BIG = WS_KV + 128 * MiB;
constexpr size_t WS_ACT = WS_BIG + 352 * MiB;
constexpr size_t WS_SSP = WS_ACT + 176 * MiB;
constexpr size_t WS_END = WS_SSP + 2 * MiB;
constexpr int LDS_BYTES = 147456, MISC_OFF = LDS_BYTES - 64, XS_OFF = 131072;

typedef unsigned short bf16_t;
typedef float f32x4 __attribute__((ext_vector_type(4)));
typedef unsigned u32x4 __attribute__((ext_vector_type(4)));
typedef unsigned u32x2 __attribute__((ext_vector_type(2)));
typedef short bf16x8 __attribute__((ext_vector_type(8)));
#define LAS __attribute__((address_space(3)))
__device__ __forceinline__ unsigned pk2(float lo, float hi) { return pg8::cvt_pk_bf16(lo, hi); }
__device__ __forceinline__ float bf_lo(unsigned w) { return __uint_as_float(w << 16); }
__device__ __forceinline__ float bf_hi(unsigned w) { return __uint_as_float(w & 0xffff0000u); }
__device__ __forceinline__ float wave_sum(float v, int lane) {
#pragma unroll
    for (int o = 1; o < 64; o <<= 1) v += lane_read(v, lane ^ o);
    return v;
}
struct Args { const float* in[21]; float* out; unsigned char* ws; };
#define XB_TMO      128
#define XB_XCNT(j)  (256  + 64 * (j))
#define XB_XSUB(j)  (1280 + 64 * (j))
#define XB_XGEN(j)  (2304 + 64 * (j))
#define XB_TOP      3328
#define XB_TOPGEN   3392
#define XCD_BAR_WORDS 3456
#define XB_SPIN_CAP (1u << 18)

__device__ __forceinline__ unsigned xb_ld(unsigned* p)              { return __hip_atomic_load(p, __ATOMIC_RELAXED, __HIP_MEMORY_SCOPE_AGENT); }
__device__ __forceinline__ unsigned xb_add(unsigned* p, unsigned v) { return __hip_atomic_fetch_add(p, v, __ATOMIC_RELAXED, __HIP_MEMORY_SCOPE_AGENT); }
__device__ __forceinline__ unsigned xb_xcc_id() { return (unsigned)__builtin_amdgcn_s_getreg((3 << 11) | 20) & 0xFu; }
#define XB_SPIN(cond, bar) do { unsigned _sp = 0; while (cond) { __builtin_amdgcn_s_sleep(1); \
    if ((++_sp & 255u) == 0u) { if (xb_ld(&(bar)[XB_TMO])) break; if (_sp > XB_SPIN_CAP) { atomicAdd(&(bar)[XB_TMO], 1u); break; } } } } while (0)

struct XcdBarrier {
    unsigned* bar; unsigned x;
    volatile LAS unsigned* st;
};

__device__ __forceinline__ XcdBarrier xcd_barrier_post(unsigned* bar, volatile LAS unsigned* st) {
    XcdBarrier b; b.bar = bar; b.x = xb_xcc_id(); b.st = st;
    if (threadIdx.x == 0) (void)xb_add(&bar[XB_XCNT(b.x)], 1u);
    return b;
}
__device__ __forceinline__ void xcd_barrier_complete(unsigned* bar, unsigned x, unsigned& nloc, unsigned& nx) {
    const unsigned G = gridDim.x * gridDim.y * gridDim.z;
    unsigned sum, cnt, mine, sp = 0u;
    for (;;) {
        sum = 0u; cnt = 0u; mine = 0u;
#pragma unroll
        for (unsigned j = 0; j < 16; ++j) { const unsigned c = xb_ld(&bar[XB_XCNT(j)]); sum += c; cnt += (c > 0u) ? 1u : 0u; mine = (j == x) ? c : mine; }
        if (sum == G) break;
        __builtin_amdgcn_s_sleep(1);
        if ((++sp & 255u) == 0u) { if (xb_ld(&bar[XB_TMO])) break; if (sp > XB_SPIN_CAP) { atomicAdd(&bar[XB_TMO], 1u); break; } }
    }
    nloc = mine > 0u ? mine : 1u; nx = cnt > 0u ? cnt : 1u;
}

__device__ __forceinline__ void xcd_barrier(const XcdBarrier& b) {
    asm volatile("s_waitcnt vmcnt(0)" ::: "memory");
    __syncthreads();
    if (threadIdx.x == 0) {
        unsigned* bar = b.bar;
        __builtin_amdgcn_s_waitcnt(0);
        unsigned nloc = b.st[0], nx = b.st[1];
        if (nloc == 0u) { xcd_barrier_complete(bar, b.x, nloc, nx); b.st[0] = nloc; b.st[1] = nx; }
        const unsigned old = xb_add(&bar[XB_XSUB(b.x)], 1u);
        const unsigned gen = old / nloc;
        if (old + 1u == (gen + 1u) * nloc) {
            __builtin_amdgcn_fence(__ATOMIC_RELEASE, "agent");
            asm volatile("s_waitcnt vmcnt(0)" ::: "memory");
            const unsigned og = xb_add(&bar[XB_TOP], 1u);
            const unsigned tg = og / nx;
            if (og + 1u == (tg + 1u) * nx) xb_add(&bar[XB_TOPGEN], 1u);
            else XB_SPIN(xb_ld(&bar[XB_TOPGEN]) == tg, bar);
            __builtin_amdgcn_fence(__ATOMIC_ACQUIRE, "agent");
            xb_add(&bar[XB_XGEN(b.x)], 1u);
            asm volatile("s_waitcnt vmcnt(0)" ::: "memory");
        } else {
            XB_SPIN(xb_ld(&bar[XB_XGEN(b.x)]) == gen, bar);
            __builtin_amdgcn_fence(__ATOMIC_ACQUIRE, "agent");
            asm volatile("s_waitcnt vmcnt(0)" ::: "memory");
        }
    }
    __syncthreads();
}


__device__ __forceinline__ int up_row(int n) { return n < FF ? (n >> 7) * 256 + (n & 127) : ((n - FF) >> 7) * 256 + 128 + ((n - FF) & 127); }
constexpr int TR_LDS_PER_WAVE = 64 * 65 * 4;
__device__ __forceinline__ void transpose_item(const float* W, int K, int ld, int ncols, const float* gk, bf16_t* WT, int mode, LAS float* scr, int item, int lane) {
    const int nblk = ncols / 64, kb = item / nblk, nb = item % nblk, k0 = 64 * kb, n0 = 64 * nb, kr = lane >> 4, n4 = (lane & 15) * 4;
    f32x4 v[16];
#pragma unroll
    for (int i = 0; i < 16; ++i) v[i] = *(const f32x4*)(W + (size_t)(k0 + 4 * i + kr) * ld + n0 + n4);
#pragma unroll
    for (int i = 0; i < 16; ++i) { const int kk = 4 * i + kr; const float g = gk ? gk[k0 + kk] : 1.f; LAS float* d = scr + kk * 65 + n4; d[0] = v[i].x * g; d[1] = v[i].y * g; d[2] = v[i].z * g; d[3] = v[i].w * g; }
    asm volatile("s_waitcnt lgkmcnt(0)" ::: "memory");
    const int c = lane & 7; const int r0 = mode ? up_row(n0) : n0;
#pragma unroll
    for (int j = 0; j < 8; ++j) { const int n = (lane >> 3) + 8 * j; const LAS float* p = scr + (8 * c) * 65 + n;
        u32x4 o; o.x = pk2(p[0 * 65], p[1 * 65]); o.y = pk2(p[2 * 65], p[3 * 65]); o.z = pk2(p[4 * 65], p[5 * 65]); o.w = pk2(p[6 * 65], p[7 * 65]);
        *(u32x4*)(WT + (size_t)(r0 + n) * K + k0 + 8 * c) = o; }
    asm volatile("s_waitcnt lgkmcnt(0)" ::: "memory");
}
__device__ __forceinline__ void fgate_rows(const bf16_t* hb, const float* rss, const bf16_t* wfh, const bf16_t* wfl, const float* bf, float* logf, int gw, int NGW, int lane) {
    const int fr = lane & 15, fq = lane >> 4;
    for (int rg = gw; rg < MT / 16; rg += NGW) {
        const bf16_t* hrow = hb + (size_t)(rg * 16 + fr) * DM + 8 * fq; const bf16_t* wh = wfh + fr * DM + 8 * fq; const bf16_t* wl = wfl + fr * DM + 8 * fq;
        const f32x4* rp = (const f32x4*)(rss + (size_t)(rg * 16 + fr) * 32 + fq * 8); const f32x4 ra = rp[0], rb = rp[1];
        float ssq = ((ra[0] + ra[1]) + (ra[2] + ra[3])) + ((rb[0] + rb[1]) + (rb[2] + rb[3])); ssq += lane_read(ssq, lane ^ 16); ssq += lane_read(ssq, lane ^ 32);
        f32x4 acc = {0.f, 0.f, 0.f, 0.f};
#pragma unroll 4
        for (int ks = 0; ks < DM / 32; ++ks) {
            const bf16x8 hv = *(const bf16x8*)(hrow + 32 * ks), whv = *(const bf16x8*)(wh + 32 * ks), wlv = *(const bf16x8*)(wl + 32 * ks);
            acc = __builtin_amdgcn_mfma_f32_16x16x32_bf16(whv, hv, acc, 0, 0, 0);
            acc = __builtin_amdgcn_mfma_f32_16x16x32_bf16(wlv, hv, acc, 0, 0, 0);
        }
        const float r = 1.0f / sqrtf(ssq * (1.0f / DM) + EPS);
        const f32x4 b = *(const f32x4*)(bf + 4 * fq); f32x4 o;
#pragma unroll
        for (int e = 0; e < 4; ++e) { const float f = acc[e] * r + b[e]; o[e] = fminf(f, 0.f) - log1pf(expf(-fabsf(f))); }
        *(f32x4*)(logf + (size_t)(rg * 16 + fr) * 16 + 4 * fq) = o;
    }
}
__device__ __forceinline__ void scan_seq(const float* logf, unsigned long long* CA, int seq, int lane) {
    const int b = seq >> 4, hh = seq & 15;
    const float* lf = logf + ((size_t)b * SEQ + (size_t)lane * 64) * 16 + hh;
    float v[64];
#pragma unroll
    for (int i = 0; i < 64; ++i) v[i] = lf[i * 16];
#pragma unroll
    for (int i = 1; i < 64; ++i) v[i] += v[i - 1];
    const float tot = v[63]; float t = tot;
#pragma unroll
    for (int o = 1; o < 64; o <<= 1) { const float y = lane_read(t, lane >= o ? lane - o : lane); if (lane >= o) t += y; }
    const float excl = t - tot;
    unsigned long long* out = CA + (size_t)seq * SEQ + lane * 64;
#pragma unroll
    for (int i = 0; i < 64; ++i) { const float c = (excl + v[i]) * 11.313708498984761f;
        const unsigned h1 = pk2(c, 0.f) & 0xffffu; const float r1 = c - bf_lo(h1);
        const unsigned h2 = pk2(r1, 0.f) & 0xffffu; const float r2 = r1 - bf_lo(h2);
        const unsigned h3 = pk2(r2, 0.f) & 0xffffu;
        out[i] = (unsigned long long)(h1 | (h2 << 16)) | ((unsigned long long)h3 << 32); }
}
__device__ __forceinline__ void spatial_phase(LAS unsigned char* ldsp, const bf16_t* Z, const float* ssp, const bf16_t* wsb, const float* vnorm, const float* bs, bf16_t* GATED, int wave, int lane) {
    const int fr = lane & 15, fq = lane >> 4;
    for (int item = blockIdx.x; item < (MT / CH) * NG; item += gridDim.x) {
        const int ch = item >> 4, g = item & 15, row0 = ch * CH, cw = g * 128 + wave * 16;
        LAS float* rvs = (LAS float*)ldsp;
        __syncthreads();
        { const int t_ = wave * 64 + lane; if (t_ < CH) { const f32x4* p = (const f32x4*)(ssp + (size_t)(row0 + t_) * 32); float sq = 0.f;
#pragma unroll
            for (int q = 0; q < 8; ++q) { const f32x4 v = p[q]; sq += (v.x + v.y) + (v.z + v.w); }
            rvs[t_] = 1.0f / sqrtf(sq * (1.0f / DM) + EPS); } }
        __syncthreads();
        LAS unsigned* VS = (LAS unsigned*)(ldsp + 1024);
        { const int t_ = wave * 64 + lane, srow = t_ >> 2, c0 = (t_ & 3) * 32; const float rv = rvs[srow];
          const u32x4* gp = (const u32x4*)(Z + (size_t)(row0 + srow) * 4096 + 2048 + g * 128 + c0); u32x4 q[4];
#pragma unroll
          for (int jj = 0; jj < 4; ++jj) q[jj] = gp[jj];
#pragma unroll
          for (int jj = 0; jj < 4; ++jj) { LAS unsigned* d = VS + srow * 65 + (c0 >> 1) + jj * 4;
#pragma unroll
              for (int e = 0; e < 4; ++e) d[e] = pk2(bf_lo(q[jj][e]) * rv, bf_hi(q[jj][e]) * rv); } }
        __syncthreads();
        bf16x8 vf[4];
        { const LAS unsigned short* vs16 = (const LAS unsigned short*)VS + wave * 16 + fr;
#pragma unroll
          for (int ks = 0; ks < 4; ++ks) { unsigned hv[8];
#pragma unroll
              for (int i = 0; i < 8; ++i) hv[i] = vs16[(32 * ks + 8 * fq + i) * 130];
              u32x4 w; w.x = hv[0] | (hv[1] << 16); w.y = hv[2] | (hv[3] << 16); w.z = hv[4] | (hv[5] << 16); w.w = hv[6] | (hv[7] << 16); vf[ks] = __builtin_bit_cast(bf16x8, w); } }
        f32x4 acc[8];
#pragma unroll
        for (int m = 0; m < 8; ++m) { acc[m] = (f32x4){0.f, 0.f, 0.f, 0.f};
#pragma unroll
            for (int ks = 0; ks < 4; ++ks) if (32 * ks <= 16 * m + 15) {
                const bf16x8 wf = *(const bf16x8*)(wsb + ((size_t)(g * 128 + 16 * m + fr) * 128 + 32 * ks + 8 * fq));
                acc[m] = __builtin_amdgcn_mfma_f32_16x16x32_bf16(vf[ks], wf, acc[m], 0, 0, 0); } }
        const f32x4 vn = *(const f32x4*)(vnorm + cw + 4 * fq);
#pragma unroll
        for (int m = 0; m < 8; ++m) { const int t = 16 * m + fr; const size_t row = (size_t)(row0 + t); const float bias = bs[g * 128 + t];
            const u32x2 uu = *(const u32x2*)(Z + row * 4096 + cw + 4 * fq);
            const float o0 = bf_lo(uu.x) * (acc[m][0] * vn[0] + bias), o1 = bf_hi(uu.x) * (acc[m][1] * vn[1] + bias), o2 = bf_lo(uu.y) * (acc[m][2] * vn[2] + bias), o3 = bf_hi(uu.y) * (acc[m][3] * vn[3] + bias);
            u32x2 w; w.x = pk2(o0, o1); w.y = pk2(o2, o3); *(u32x2*)(GATED + row * DM + cw + 4 * fq) = w; }
    }
}
__device__ __forceinline__ void conv_phase(const bf16_t* BIG, const float* cw, const float* cb, bf16_t* ACT) {
    constexpr int NQ = FF / 8, RS = 32, NTASK = NQ * (MT / RS);
    const int tid_ = opaque_tid();
    for (int T = blockIdx.x * NTHREADS + tid_; T < NTASK; T += gridDim.x * NTHREADS) {
        const int qb = (NQ / 64 - 1) - T / (64 * (MT / RS)), rem = T % (64 * (MT / RS)), strip = rem >> 6, q = qb * 64 + (rem & 63), j0 = 8 * q, pg = (q >> 4) * 256 + (q & 15) * 8, row0 = strip * RS;
        float wg[3][8], wv[3][8], bg[8], bv[8];
#pragma unroll
        for (int k = 0; k < 3; ++k)
#pragma unroll
            for (int e = 0; e < 8; ++e) { wg[k][e] = cw[(size_t)k * FF2 + j0 + e]; wv[k][e] = cw[(size_t)k * FF2 + FF + j0 + e]; }
#pragma unroll
        for (int e = 0; e < 8; ++e) { bg[e] = cb[j0 + e]; bv[e] = cb[FF + j0 + e]; }
        const bf16_t* src = BIG + (size_t)row0 * FF2 + pg; bf16_t* dst = ACT + (size_t)row0 * FF + j0;
        u32x4 g2 = {0u, 0u, 0u, 0u}, g1 = g2, v2 = g2, v1 = g2;
        if ((row0 & (SEQ - 1)) != 0) { g2 = *(const u32x4*)(src - 2 * (size_t)FF2); v2 = *(const u32x4*)(src - 2 * (size_t)FF2 + 128); g1 = *(const u32x4*)(src - (size_t)FF2); v1 = *(const u32x4*)(src - (size_t)FF2 + 128); }
        for (int i0 = 0; i0 < RS; i0 += 8) {
            u32x4 gc[8], vc[8];
#pragma unroll
            for (int i = 0; i < 8; ++i) { gc[i] = *(const u32x4*)(src + (size_t)(i0 + i) * FF2); vc[i] = *(const u32x4*)(src + (size_t)(i0 + i) * FF2 + 128); }
#pragma unroll
            for (int i = 0; i < 8; ++i) { u32x4 o;
#pragma unroll
                for (int p = 0; p < 4; ++p) {
                    const float ga = wg[0][2 * p] * bf_lo(g2[p]) + wg[1][2 * p] * bf_lo(g1[p]) + wg[2][2 * p] * bf_lo(gc[i][p]) + bg[2 * p];
                    const float gb = wg[0][2 * p + 1] * bf_hi(g2[p]) + wg[1][2 * p + 1] * bf_hi(g1[p]) + wg[2][2 * p + 1] * bf_hi(gc[i][p]) + bg[2 * p + 1];
                    const float va = wv[0][2 * p] * bf_lo(v2[p]) + wv[1][2 * p] * bf_lo(v1[p]) + wv[2][2 * p] * bf_lo(vc[i][p]) + bv[2 * p];
                    const float vb = wv[0][2 * p + 1] * bf_hi(v2[p]) + wv[1][2 * p + 1] * bf_hi(v1[p]) + wv[2][2 * p + 1] * bf_hi(vc[i][p]) + bv[2 * p + 1];
                    const float sa = ga * __builtin_amdgcn_rcpf(1.0f + __builtin_amdgcn_exp2f(-1.4426950408889634f * ga)), sb = gb * __builtin_amdgcn_rcpf(1.0f + __builtin_amdgcn_exp2f(-1.4426950408889634f * gb));
                    o[p] = pk2(sa * va, sb * vb); }
                *(u32x4*)(dst + (size_t)(i0 + i) * FF) = o; g2 = g1; g1 = gc[i]; v2 = v1; v1 = vc[i]; }
        }
    }
}

typedef const Args __attribute__((address_space(4))) CArgs;
__device__ __forceinline__ CArgs* kargs() { CArgs* p = (CArgs*)__builtin_amdgcn_kernarg_segment_ptr(); asm volatile("" : "+s"(p)); return p; }
#define PTRS \
    CArgs* ap_ = kargs(); unsigned char* ws = ap_->ws; float* h = ap_->out; (void)ws; (void)h; \
    const float* x = ap_->in[0]; const float* a_norm = ap_->in[1]; const float* a_w_in = ap_->in[2]; const float* a_v_norm = ap_->in[3]; const float* a_w_s = ap_->in[4]; const float* a_b_s = ap_->in[5]; \
    const float* a_w_out = ap_->in[6]; const float* kv_norm = ap_->in[7]; const float* w_kvf = ap_->in[8]; const float* b_f = ap_->in[9]; const float* k_norm = ap_->in[10]; const float* b_norm = ap_->in[11]; \
    const float* b_w_qg = ap_->in[12]; const float* q_norm = ap_->in[13]; const float* b_w_out = ap_->in[14]; const float* f_norm = ap_->in[15]; const float* f_w_up = ap_->in[16]; const float* f_conv_w = ap_->in[17]; \
    const float* f_conv_b = ap_->in[18]; const float* f_w_down = ap_->in[19]; const float* final_norm = ap_->in[20]; \
    (void)x; (void)a_norm; (void)a_w_in; (void)a_v_norm; (void)a_w_s; (void)a_b_s; (void)a_w_out; (void)kv_norm; (void)w_kvf; (void)b_f; (void)k_norm; (void)b_norm; (void)b_w_qg; (void)q_norm; (void)b_w_out; \
    (void)f_norm; (void)f_w_up; (void)f_conv_w; (void)f_conv_b; (void)f_w_down; (void)final_norm; \
    float* VSS = (float*)(ws + WS_SSP); float* LOGF = (float*)(ws + WS_LOGF); unsigned long long* CA = (unsigned long long*)(ws + WS_CA); \
    bf16_t* WSB = (bf16_t*)(ws + WS_WSB); bf16_t* WFH = (bf16_t*)(ws + WS_WF); bf16_t* WFL = WFH + 16 * DM; \
    bf16_t* W_AIN = (bf16_t*)(ws + WS_W_AIN); bf16_t* W_AOUT = (bf16_t*)(ws + WS_W_AOUT); bf16_t* W_KV = (bf16_t*)(ws + WS_W_KV); bf16_t* W_QG = (bf16_t*)(ws + WS_W_QG); \
    bf16_t* W_BOUT = (bf16_t*)(ws + WS_W_BOUT); bf16_t* W_UP = (bf16_t*)(ws + WS_W_UP); bf16_t* W_DN = (bf16_t*)(ws + WS_W_DN); \
    bf16_t* HB = (bf16_t*)(ws + WS_XN); float* RSS = (float*)(ws + WS_XN2); bf16_t* KVB = (bf16_t*)(ws + WS_KV); bf16_t* BIG = (bf16_t*)(ws + WS_BIG); bf16_t* ACT = (bf16_t*)(ws + WS_ACT); \
    (void)VSS; (void)LOGF; (void)CA; (void)WSB; (void)WFH; (void)WFL; (void)W_AIN; (void)W_AOUT; (void)W_KV; (void)W_QG; (void)W_BOUT; (void)W_UP; (void)W_DN; (void)HB; (void)RSS; (void)KVB; (void)BIG; (void)ACT;
typedef pg8::EpiBf<1, true> EPI_A1; typedef pg8::EpiBf<0, true, true, true> EPI_KV; typedef pg8::EpiBf<2, true, false, true> EPI_QG; typedef pg8::EpiBf<0, true> EPI_UP;
#define GEMM_PHASE(EPI, Aptr, Bptr, NN, KK, ...) do { pg8::Gemm g_{Aptr, Bptr, MT, NN, KK}; pg8::StaticOrder S_; S_.init(MT, NN, G, (int)blockIdx.x); EPI E_{__VA_ARGS__}; \
    pg8::gemm_phase<EPI, pg8::StaticOrder, true, true>(ldsp, g_, S_, E_); } while (0)

__global__ void __launch_bounds__(NTHREADS, 2) fwd_megakernel(Args a) {
    extern __shared__ __attribute__((aligned(16))) unsigned char lds[];
    cg::grid_group grid = cg::this_grid();
#define GSYNC_CG() do { asm volatile("s_waitcnt vmcnt(0)" ::: "memory"); grid.sync(); } while (0)
#define GSYNC() xcd_barrier(xbar)
    const int wave = __builtin_amdgcn_readfirstlane(threadIdx.x >> 6);
    const int G = gridDim.x, gw = blockIdx.x * NWAVES + wave, NGW = G * NWAVES;
    LAS unsigned char* ldsp = (LAS unsigned char*)lds;
    if (threadIdx.x < 16) ((LAS unsigned*)(ldsp + MISC_OFF))[threadIdx.x] = 0u;
    __syncthreads();
    const XcdBarrier xbar = xcd_barrier_post((unsigned*)(kargs()->ws + WS_BAR), (volatile LAS unsigned*)(ldsp + MISC_OFF));

    {
        PTRS
        const int tid = opaque_tid(), lane = tid & 63;
        const int gt = blockIdx.x * NTHREADS + tid, NGT = G * NTHREADS;
        for (int i = gt; i < 2 * NG * CH * CH / 8; i += NGT) {
            const int e0 = i * 8, s0 = e0 & 127, t = (e0 >> 7) & 127; const f32x4 w0 = *(const f32x4*)(a_w_s + e0), w1 = *(const f32x4*)(a_w_s + e0 + 4);
            float y[8] = {w0.x, w0.y, w0.z, w0.w, w1.x, w1.y, w1.z, w1.w};
#pragma unroll
            for (int e = 0; e < 8; ++e) if (s0 + e > t) y[e] = 0.f;
            u32x4 o; o.x = pk2(y[0], y[1]); o.y = pk2(y[2], y[3]); o.z = pk2(y[4], y[5]); o.w = pk2(y[6], y[7]); *(u32x4*)(WSB + e0) = o; }
        for (int i = gt; i < 16 * DM; i += NGT) { const int n = i / DM, k = i % DM; const float w = kv_norm[k] * w_kvf[(size_t)k * 4112 + 4096 + n];
            const unsigned hi = pk2(w, 0.f) & 0xffffu; WFH[i] = (bf16_t)hi; WFL[i] = (bf16_t)(pk2(w - bf_lo(hi), 0.f) & 0xffffu); }
        LAS float* scr = (LAS float*)(ldsp + wave * TR_LDS_PER_WAVE);
        for (int it = gw; it < 48128 * (PROBE == 4 ? 2 : 1); it += NGW) {
            int r = it % 48128, K = DM, ld, ncols, mode = 0; const float* W; const float* g = nullptr; bf16_t* WT;
            if (r < 4096) { const int l = r >> 11; r &= 2047; W = a_w_in + (size_t)l * DM * 4096; g = a_norm + l * DM; WT = W_AIN + (size_t)l * 4096 * DM; ld = 4096; ncols = 4096; }
            else if ((r -= 4096) < 2048) { const int l = r >> 10; r &= 1023; W = a_w_out + (size_t)l * DM * DM; WT = W_AOUT + (size_t)l * DM * DM; ld = DM; ncols = DM; }
            else if ((r -= 2048) < 2048) { W = w_kvf; g = kv_norm; WT = W_KV; ld = 4112; ncols = 4096; }
            else if ((r -= 2048) < 4096) { const int l = r >> 11; r &= 2047; W = b_w_qg + (size_t)l * DM * 4096; g = b_norm + l * DM; WT = W_QG + (size_t)l * 4096 * DM; ld = 4096; ncols = 4096; }
            else if ((r -= 4096) < 2048) { const int l = r >> 10; r &= 1023; W = b_w_out + (size_t)l * DM * DM; WT = W_BOUT + (size_t)l * DM * DM; ld = DM; ncols = DM; }
            else if ((r -= 2048) < 22528) { const int l = r / 5632; r -= l * 5632; W = f_w_up + (size_t)l * DM * FF2; g = f_norm + l * DM; WT = W_UP + (size_t)l * FF2 * DM; ld = FF2; ncols = FF2; mode = 1; }
            else { r -= 22528; const int l = r / 2816; r -= l * 2816; W = f_w_down + (size_t)l * FF * DM; WT = W_DN + (size_t)l * DM * FF; K = FF; ld = DM; ncols = DM; }
            transpose_item(W, K, ld, ncols, g, WT, mode, scr, r, lane);
        }
        for (int m = gw; m < MT; m += NGW) {
            const f32x4* xr = (const f32x4*)(x + (size_t)m * DM) + lane; u32x2* o = (u32x2*)(HB + (size_t)m * DM) + lane; float sq = 0.f;
#pragma unroll
            for (int j = 0; j < 8; ++j) { const f32x4 v = xr[64 * j]; sq += (v.x * v.x + v.y * v.y) + (v.z * v.z + v.w * v.w); u32x2 w; w.x = pk2(v.x, v.y); w.y = pk2(v.z, v.w); o[64 * j] = w; }
            sq = wave_sum(sq, lane); if (lane < 32) RSS[(size_t)m * 32 + lane] = lane == 0 ? sq : 0.f;
        }
    }
    GSYNC_CG();

    for (int l = 0; l < 4; ++l) {
        if (l < 2) {
            for (int rep_ = 0; rep_ < (PROBE == 10 ? 2 : 1); ++rep_) {
            { PTRS GEMM_PHASE(EPI_A1, HB, W_AIN + (size_t)l * 4096 * DM, 4096, DM, BIG, 4096, 8, VSS, RSS, nullptr, nullptr); }
            GSYNC(); }
            for (int rep_ = 0; rep_ < (PROBE == 6 ? 2 : 1); ++rep_) { if (rep_) GSYNC();
            { PTRS const int lane = opaque_tid() & 63;
              spatial_phase(ldsp, BIG, VSS, WSB + (size_t)l * NG * CH * CH, a_v_norm + (size_t)l * DM, a_b_s + (size_t)l * NG * CH, ACT, wave, lane); } }
            GSYNC();
        } else {
            const int j = l - 2;
            if (j == 0) { { PTRS const int lane = opaque_tid() & 63; fgate_rows(HB, RSS, WFH, WFL, b_f, LOGF, gw, NGW, lane); }
                          PTRS GEMM_PHASE(EPI_KV, HB, W_KV, 4096, DM, KVB, 4096, 1 << 30, nullptr, RSS, k_norm, (LAS float*)(ldsp + XS_OFF)); }
            { PTRS GEMM_PHASE(EPI_QG, HB, W_QG + (size_t)j * 4096 * DM, 4096, DM, BIG, 4096, 8, nullptr, RSS, q_norm + (size_t)j * HD, (LAS float*)(ldsp + XS_OFF)); }
            GSYNC();
            if (j == 0) { { PTRS const int lane = opaque_tid() & 63; if (blockIdx.x < 8) scan_seq(LOGF, CA, blockIdx.x * 8 + wave, lane); }
                          GSYNC(); }
            for (int rep_ = 0; rep_ < (PROBE == 2 ? 2 : 1); ++rep_) {
            { PTRS att::AttnT T{(const att::bf16*)BIG, (const att::bf16*)KVB, (const att::bf16*)(KVB + (size_t)MT * 2048), (att::bf16*)ACT, BIG + 2048, CA};
              att::attn_phase((char*)lds, T, NB, NH, SEQ); }
            GSYNC(); }
        }
        { PTRS const bf16_t* Wt = l < 2 ? W_AOUT + (size_t)l * DM * DM : W_BOUT + (size_t)(l - 2) * DM * DM;
          GEMM_PHASE(pg8::EpiRes, ACT, Wt, DM, DM, HB, RSS, DM);
        }
        GSYNC();
        { PTRS GEMM_PHASE(EPI_UP, HB, W_UP + (size_t)l * FF2 * DM, FF2, DM, BIG, FF2, 1 << 30, nullptr, RSS, nullptr, nullptr); }
        GSYNC();
#if PROBE == 1
        { PTRS GEMM_PHASE(EPI_UP, HB, W_UP + (size_t)l * FF2 * DM, FF2, DM, BIG, FF2, 1 << 30, nullptr, RSS, nullptr, nullptr); }
        GSYNC();
#endif
        { PTRS conv_phase(BIG, f_conv_w + (size_t)l * 3 * FF2, f_conv_b + (size_t)l * FF2, ACT); }
        GSYNC();
#if PROBE == 3
        { PTRS conv_phase(BIG, f_conv_w + (size_t)l * 3 * FF2, f_conv_b + (size_t)l * FF2, ACT); }
        GSYNC();
#endif
        { PTRS GEMM_PHASE(pg8::EpiRes, ACT, W_DN + (size_t)l * DM * FF, DM, FF, HB, RSS, DM);
        }
        GSYNC();
    }
#if PROBE == 7
    for (int rep_ = 0; rep_ < 20; ++rep_) GSYNC();
#endif
    { PTRS const int lane = opaque_tid() & 63;
      for (int m = gw; m < MT; m += NGW) {
          const float part = lane < 32 ? RSS[(size_t)m * 32 + lane] : 0.f; const float r = 1.0f / sqrtf(wave_sum(part, lane) * (1.0f / DM) + EPS);
          const u32x4* p = (const u32x4*)(HB + (size_t)m * DM) + lane; float* orow = h + (size_t)m * DM;
#pragma unroll
          for (int j = 0; j < 4; ++j) { const u32x4 w = p[64 * j]; const int c = (64 * j + lane) * 8; const f32x4 g0 = *(const f32x4*)(final_norm + c), g1 = *(const f32x4*)(final_norm + c + 4);
              f32x4 o0 = {bf_lo(w.x) * r * g0[0], bf_hi(w.x) * r * g0[1], bf_lo(w.y) * r * g0[2], bf_hi(w.y) * r * g0[3]}, o1 = {bf_lo(w.z) * r * g1[0], bf_hi(w.z) * r * g1[1], bf_lo(w.w) * r * g1[2], bf_hi(w.w) * r * g1[3]};
              *(f32x4*)(orow + c) = o0; *(f32x4*)(orow + c + 4) = o1; } } }
}

extern "C" void kernel_launch(void* const* d_in, const int* in_sizes, int n_in, void* d_out, int out_size, void* d_ws, size_t ws_size, hipStream_t stream) {
    static int grid = 0;
    if (grid == 0) {
        if (n_in != 21 || out_size != MT * DM || ws_size < WS_END) { fprintf(stderr, "kernel_launch: unexpected shapes (n_in %d out %d ws %zu, need ws >= %zu)\n", n_in, out_size, ws_size, (size_t)WS_END); grid = -1; return; }
        int dev = 0, cus = 0, per_cu = 0;
        (void)hipGetDevice(&dev); (void)hipDeviceGetAttribute(&cus, hipDeviceAttributeMultiprocessorCount, dev);
        (void)hipFuncSetAttribute((const void*)fwd_megakernel, hipFuncAttributeMaxDynamicSharedMemorySize, LDS_BYTES);
        (void)hipOccupancyMaxActiveBlocksPerMultiprocessor(&per_cu, (const void*)fwd_megakernel, NTHREADS, LDS_BYTES);
        if (per_cu < 1) { fprintf(stderr, "kernel_launch: occupancy query says %d blocks per CU\n", per_cu); per_cu = 1; }
        grid = cus * 1;
        (void)hipGetLastError();
    }
    if (grid < 0) return;
    (void)hipMemsetAsync((char*)d_ws + WS_BAR, 0, BAR_ZERO_BYTES, stream);
    Args a{};
    for (int i = 0; i < 21; ++i) a.in[i] = (const float*)d_in[i];
    a.out = (float*)d_out; a.ws = (unsigned char*)d_ws;
    void* args[] = {&a};
    hipError_t e = hipLaunchCooperativeKernel((const void*)fwd_megakernel, dim3(grid), dim3(NTHREADS), args, LDS_BYTES, stream);
    if (e != hipSuccess) fprintf(stderr, "cooperative launch failed: %s (grid %d)\n", hipGetErrorString(e), grid);
}
```

```cpp
#include <hip/hip_runtime.h>
#include <hip/hip_cooperative_groups.h>
#include <hip/hip_bf16.h>
#include <cstdio>
#include <cstdint>
namespace cg = cooperative_groups;
#ifndef PROBE
#define PROBE 0
#endif
__device__ __forceinline__ float lane_read(float v, int src_lane) { return __builtin_bit_cast(float, __builtin_amdgcn_ds_bpermute(src_lane << 2, __builtin_bit_cast(int, v))); }
__device__ __forceinline__ int opaque_tid() { int t = threadIdx.x; asm volatile("" : "+v"(t)); return t; }
namespace pg8 {
#define PG8_LAS __attribute__((address_space(3)))
typedef unsigned short bf16_t;
typedef short bf16x8 __attribute__((ext_vector_type(8)));
typedef float f32x4 __attribute__((ext_vector_type(4)));
typedef unsigned u32x4 __attribute__((ext_vector_type(4)));
constexpr int BM = 256, BK = 64, HALF = 128, HTB = HALF * BK * 2  , STAGE_BYTES = 8 * HTB, NXCD = 8, WGM = 8;

__host__ __device__ __forceinline__ int lds_byte(int r, int c) { const int st = (r >> 4) * 2 + (c >> 5), rr = r & 15, cc = c & 31, ob = rr * 64 + cc * 2; return st * 1024 + (ob ^ (((ob >> 9) & 1) << 5)); }
__host__ __device__ __forceinline__ void stage_rc(int b, int& R, int& C) { const int st = b / 1024, sb = b % 1024, swz = sb ^ (((sb >> 9) & 1) << 5); R = (st >> 1) * 16 + swz / 64; C = (st & 1) * 32 + (swz % 64) / 2; }
__host__ __device__ __forceinline__ int perm32(int rho) { const int n = rho >> 4, i = rho & 15; return 8 * (i >> 2) + 4 * n + (i & 3); }

struct Unit { int pm, pn; };
struct Gemm { const bf16_t* A; const bf16_t* Bt; int M, N, K; };

struct StaticOrder {
    int nM, nN, nwg, G, c;
    __host__ __device__ void init(int M, int N, int G_, int c_) { nM = M / BM; nN = N / BM; nwg = nM * nN; G = G_; c = c_; }
    __host__ __device__ bool next(int i, Unit& u) const {
        const long L = (long)i * G + c; if (L >= nwg) return false;
        int wgid = (int)L; { const int q = nwg / NXCD, r = nwg % NXCD, xcd = wgid % NXCD, off = wgid / NXCD; wgid = (xcd < r ? xcd * (q + 1) : r * (q + 1) + (xcd - r) * q) + off; }
        const int nig = WGM * nN, gid = wgid / nig, fm = gid * WGM, gsz = (nM - fm) < WGM ? (nM - fm) : WGM;
        u.pm = fm + ((wgid % nig) % gsz); u.pn = (wgid % nig) / gsz; return true;
    }
    __device__ __forceinline__ void a_ready(const Unit&) const {}
    __device__ __forceinline__ void done(const Unit&) const {}
};

__device__ __forceinline__ unsigned cvt_pk_bf16(float lo, float hi) { unsigned r; asm volatile("v_cvt_pk_bf16_f32 %0, %1, %2" : "=v"(r) : "v"(lo), "v"(hi)); return r; }
typedef float f32x2 __attribute__((ext_vector_type(2)));
__device__ __forceinline__ f32x2 gelu_pk(f32x2 v) {
    const f32x2 av = __builtin_elementwise_abs(v), d = av * 0.2316418882f + 1.0f;
    f32x2 t; t.x = __builtin_amdgcn_rcpf(d.x); t.y = __builtin_amdgcn_rcpf(d.y);
    f32x2 q = t * 0.5307027145f + (-0.7265760135f); q = q * t + 0.7107068705f; q = q * t + (-0.142248368f); q = q * t + 0.127414796f; q = q * t;
    const f32x2 s = (v * v) * (-0.72134752044f);
    f32x2 e; e.x = __builtin_amdgcn_exp2f(s.x); e.y = __builtin_amdgcn_exp2f(s.y);
    const f32x2 m = v * (q * e), r = v - m;
    f32x2 o; o.x = v.x < 0.f ? m.x : r.x; o.y = v.y < 0.f ? m.y : r.y; return o;
}
constexpr float RS_INV = 1.0f / 2048.0f, RS_EPS = 1e-6f;
template <int MODE, bool RSCALE, bool HEADMAJOR = false, bool HN = false> struct EpiBf {
    static constexpr bool PERM = true, AFTER_DRAIN = false, IDEMPOTENT = true;
    bf16_t* O; int ldc; int split_pn; float* ss; const float* rs; const float* hgain; PG8_LAS float* xs; PG8_LAS float* rrw;
    __device__ __forceinline__ void load_raw(const Unit& u, int ai, int wr, int fr, int fq, f32x4 (&raw)[4][2]) const {
#pragma unroll
        for (int m = 0; m < 4; ++m) { const f32x4* p = (const f32x4*)(rs + (size_t)(u.pm * BM + wr * 64 + fr + ai * HALF + m * 16) * 32 + fq * 8); raw[m][0] = p[0]; raw[m][1] = p[1]; }
    }
    __device__ __forceinline__ void reduce_raw(const f32x4 (&raw)[4][2], int ai, int wr, int wc, int fr, int fq) const {
#pragma unroll
        for (int m = 0; m < 4; ++m) { const f32x4 a = raw[m][0], b = raw[m][1];
            float t = ((a[0] + a[1]) + (a[2] + a[3])) + ((b[0] + b[1]) + (b[2] + b[3])); t += lane_read(t, (fq * 16 + fr) ^ 16); t += lane_read(t, (fq * 16 + fr) ^ 32);
            if (fq == 0) rrw[((wr * 4 + wc) * 8 + ai * 4 + m) * 16 + fr] = 1.0f / sqrtf(t * RS_INV + RS_EPS); }
    }
    __device__ __forceinline__ void init(const Unit& u, int wr, int wc, int fr, int fq) const {
        if (RSCALE) { f32x4 raw[4][2]; load_raw(u, 0, wr, fr, fq, raw); reduce_raw(raw, 0, wr, wc, fr, fq); load_raw(u, 1, wr, fr, fq, raw); reduce_raw(raw, 1, wr, wc, fr, fq); }
    }
    __device__ __forceinline__ void operator()(const f32x4 (&acc)[2][2][4][2], const Unit& u, const Unit& nxt, bool has_next, int wr, int wc, int fr, int fq) const {
        const int row0 = u.pm * BM + wr * 64 + fr, col0 = u.pn * BM + wc * 32 + 8 * fq;
        const bool up = u.pn >= split_pn;
        float rr[2][4]; f32x4 raw[4][2];
#pragma unroll
        for (int ai = 0; ai < 2; ++ai)
#pragma unroll
            for (int m = 0; m < 4; ++m) rr[ai][m] = RSCALE ? rrw[((wr * 4 + wc) * 8 + ai * 4 + m) * 16 + fr] : 1.f;
        if (RSCALE) asm volatile("s_waitcnt lgkmcnt(0)" ::: "memory");
        f32x4 hg0 = {1.f, 1.f, 1.f, 1.f}, hg1 = hg0; const bool hn = HN && u.pn < 8;
        if (HN) { if (hn) {
#pragma unroll
            for (int ai = 0; ai < 2; ++ai)
#pragma unroll
                for (int m = 0; m < 4; ++m)
#pragma unroll
                    for (int bj = 0; bj < 2; ++bj) { const f32x4 v0 = acc[ai][bj][m][0] * rr[ai][m], v1 = acc[ai][bj][m][1] * rr[ai][m];
                        float t = ((v0[0] * v0[0] + v0[1] * v0[1]) + (v0[2] * v0[2] + v0[3] * v0[3])) + ((v1[0] * v1[0] + v1[1] * v1[1]) + (v1[2] * v1[2] + v1[3] * v1[3]));
                        t += lane_read(t, (fq * 16 + fr) ^ 16); t += lane_read(t, (fq * 16 + fr) ^ 32);
                        if (fq == 0) xs[(ai * HALF + wr * 64 + m * 16 + fr) * 8 + bj * 4 + wc] = t; }
            asm volatile("s_waitcnt lgkmcnt(0)" ::: "memory"); __builtin_amdgcn_s_barrier(); asm volatile("" ::: "memory");
            hg0 = *(const f32x4*)(hgain + wc * 32 + 8 * fq); hg1 = *(const f32x4*)(hgain + wc * 32 + 8 * fq + 4);
        } }
#pragma unroll
        for (int ai = 0; ai < 2; ++ai) {
            if (RSCALE) { if (has_next) load_raw(nxt, ai, wr, fr, fq, raw); }
#pragma unroll
            for (int m = 0; m < 4; ++m) { const int row = row0 + ai * HALF + m * 16; float s = 0.f; float hnr[2] = {1.f, 1.f};
                if (HN) { if (hn) { const PG8_LAS f32x4* xp = (const PG8_LAS f32x4*)(xs + (ai * HALF + wr * 64 + m * 16 + fr) * 8); const f32x4 a = xp[0], b = xp[1];
                    hnr[0] = 1.0f / sqrtf(((a[0] + a[1]) + (a[2] + a[3])) * (1.0f / 128.0f) + RS_EPS); hnr[1] = 1.0f / sqrtf(((b[0] + b[1]) + (b[2] + b[3])) * (1.0f / 128.0f) + RS_EPS); } }
                bf16_t* rowp = HEADMAJOR ? O + (u.pn >= 8 ? (size_t)16384 * 2048 : (size_t)0) + ((size_t)((row >> 12) * 16 + 2 * (u.pn & 7)) * 4096 + (row & 4095)) * 128 + wc * 32 + 8 * fq
                                         : O + (size_t)row * ldc + col0;
#pragma unroll
                for (int bj = 0; bj < 2; ++bj) { f32x4 v0 = acc[ai][bj][m][0], v1 = acc[ai][bj][m][1];
                    if (RSCALE) { v0 = v0 * rr[ai][m]; v1 = v1 * rr[ai][m]; }
                    if (HN) { if (hn) { v0 = (v0 * hnr[bj]) * hg0; v1 = (v1 * hnr[bj]) * hg1; } }
                    if (MODE == 1) { f32x2 a = gelu_pk((f32x2){v0[0], v0[1]}), b = gelu_pk((f32x2){v0[2], v0[3]}), c = gelu_pk((f32x2){v1[0], v1[1]}), d = gelu_pk((f32x2){v1[2], v1[3]});
                        v0 = (f32x4){a.x, a.y, b.x, b.y}; v1 = (f32x4){c.x, c.y, d.x, d.y};
                        s += (v0[0] * v0[0] + v0[1] * v0[1]) + (v0[2] * v0[2] + v0[3] * v0[3]) + (v1[0] * v1[0] + v1[1] * v1[1]) + (v1[2] * v1[2] + v1[3] * v1[3]); }
                    if (MODE == 2) { if (up) {
#pragma unroll
                        for (int e = 0; e < 4; ++e) { v0[e] = __builtin_amdgcn_rcpf(1.0f + __builtin_amdgcn_exp2f(-1.4426950408889634f * v0[e])); v1[e] = __builtin_amdgcn_rcpf(1.0f + __builtin_amdgcn_exp2f(-1.4426950408889634f * v1[e])); } } }
                    u32x4 w; w.x = cvt_pk_bf16(v0[0], v0[1]); w.y = cvt_pk_bf16(v0[2], v0[3]); w.z = cvt_pk_bf16(v1[0], v1[1]); w.w = cvt_pk_bf16(v1[2], v1[3]);
                    *(u32x4*)(rowp + (HEADMAJOR ? (size_t)bj * 4096 * 128 : (size_t)bj * HALF)) = w; }
                if (MODE == 1) { if (up) { s += lane_read(s, (fq * 16 + fr) ^ 16); s += lane_read(s, (fq * 16 + fr) ^ 32); if (fq == 0) ss[(size_t)row * 32 + (u.pn - split_pn) * 4 + wc] = s; } } }
            if (RSCALE) { if (has_next) reduce_raw(raw, ai, wr, wc, fr, fq); } }
    }
};
struct EpiRes {
    static constexpr bool PERM = true, AFTER_DRAIN = false, IDEMPOTENT = false;
    bf16_t* hb; float* rss; int ldc;
    __device__ __forceinline__ void init(const Unit&, int, int, int, int) const {}
    __device__ __forceinline__ void operator()(const f32x4 (&acc)[2][2][4][2], const Unit& u, const Unit&, bool, int wr, int wc, int fr, int fq) const {
        const int row0 = u.pm * BM + wr * 64 + fr, col0 = u.pn * BM + wc * 32 + 8 * fq;
        u32x4 bn[2][2];
#pragma unroll
        for (int mm = 0; mm < 2; ++mm)
#pragma unroll
            for (int bj = 0; bj < 2; ++bj) bn[mm][bj] = *(const u32x4*)(hb + (size_t)(row0 + mm * 16) * ldc + col0 + bj * HALF);
#pragma unroll
        for (int c = 0; c < 4; ++c) { const int ai = c >> 1; u32x4 b[2][2];
#pragma unroll
            for (int mm = 0; mm < 2; ++mm)
#pragma unroll
                for (int bj = 0; bj < 2; ++bj) b[mm][bj] = bn[mm][bj];
            if (c < 3) { const int c1 = c + 1, ai1 = c1 >> 1;
#pragma unroll
                for (int mm = 0; mm < 2; ++mm)
#pragma unroll
                    for (int bj = 0; bj < 2; ++bj) bn[mm][bj] = *(const u32x4*)(hb + (size_t)(row0 + ai1 * HALF + (2 * (c1 & 1) + mm) * 16) * ldc + col0 + bj * HALF); }
#pragma unroll
            for (int mm = 0; mm < 2; ++mm) { const int m = 2 * (c & 1) + mm; const int row = row0 + ai * HALF + m * 16; const size_t off = (size_t)row * ldc + col0; float s = 0.f;
#pragma unroll
                for (int bj = 0; bj < 2; ++bj) { const u32x4 q = b[mm][bj];
                    const f32x4 o0 = (f32x4){__uint_as_float(q.x << 16), __uint_as_float(q.x & 0xffff0000u), __uint_as_float(q.y << 16), __uint_as_float(q.y & 0xffff0000u)} + acc[ai][bj][m][0];
                    const f32x4 o1 = (f32x4){__uint_as_float(q.z << 16), __uint_as_float(q.z & 0xffff0000u), __uint_as_float(q.w << 16), __uint_as_float(q.w & 0xffff0000u)} + acc[ai][bj][m][1];
                    u32x4 w; w.x = cvt_pk_bf16(o0[0], o0[1]); w.y = cvt_pk_bf16(o0[2], o0[3]); w.z = cvt_pk_bf16(o1[0], o1[1]); w.w = cvt_pk_bf16(o1[2], o1[3]);
                    *(u32x4*)(hb + off + bj * HALF) = w;
                    s += ((o0[0] * o0[0] + o0[1] * o0[1]) + (o0[2] * o0[2] + o0[3] * o0[3])) + ((o1[0] * o1[0] + o1[1] * o1[1]) + (o1[2] * o1[2] + o1[3] * o1[3])); }
                s += lane_read(s, (fq * 16 + fr) ^ 16); s += lane_read(s, (fq * 16 + fr) ^ 32); if (fq == 0) rss[(size_t)row * 32 + u.pn * 4 + wc] = s; } }
    }
};
template <class Epi, class Sched, bool ALIGN_EPI = false, bool SP2 = false>
__device__ __forceinline__ void gemm_phase(PG8_LAS unsigned char* lds, const Gemm g, const Sched& S, const Epi& E) {
    const int tid = opaque_tid(), wid = __builtin_amdgcn_readfirstlane(tid >> 6), lane = tid & 63, wr = wid >> 2, wc = wid & 3, fr = lane & 15, fq = lane >> 4;
    const int K = g.K, nt = K / BK;
    unsigned voffA[2], voffB[2];
#pragma unroll
    for (int i = 0; i < 2; ++i) { int R, C; stage_rc(tid * 16 + i * 8192, R, C); const int Rb = Epi::PERM ? ((R & ~31) + perm32(R & 31)) : R;
        voffA[i] = (unsigned)(R * K + C) * 2u; voffB[i] = (unsigned)(Rb * K + C) * 2u; }
    const size_t kstep = (size_t)(BK * 2);
    const size_t hstep = (size_t)HALF * K * 2;
    const size_t tstep = 2 * hstep;
    const unsigned ldsw = (unsigned)wid * 1024u;
    const int aoff = lds_byte(wr * 64 + fr, fq * 8), boff = lds_byte(wc * 32 + fr, fq * 8);
#define PG8_SA(b, h) (((b) * 2 + (h)) * HTB)
#define PG8_SB(b, h) ((4 + (b) * 2 + (h)) * HTB)
#define PG8_STAGE(bufoff, gbase, voff) do { _Pragma("unroll") for (int _i = 0; _i < 2; ++_i) \
        __builtin_amdgcn_global_load_lds((const unsigned*)((const char*)(gbase) + (voff)[_i]), (PG8_LAS unsigned*)(lds + (bufoff) + ldsw + _i * 8192), 16, 0, 0); } while (0)
#define PG8_LDA(dst, b, h) do { _Pragma("unroll") for (int m = 0; m < 4; ++m) _Pragma("unroll") for (int k = 0; k < 2; ++k) dst[m][k] = *(const PG8_LAS bf16x8*)(lds + PG8_SA(b, h) + aoff + m * 2048 + k * 1024); } while (0)
#define PG8_LDB(dst, b, h) do { _Pragma("unroll") for (int n = 0; n < 2; ++n) _Pragma("unroll") for (int k = 0; k < 2; ++k) dst[n][k] = *(const PG8_LAS bf16x8*)(lds + PG8_SB(b, h) + boff + n * 2048 + k * 1024); } while (0)
#define PG8_MMA(ai, bj, At, Bt) do { __builtin_amdgcn_s_setprio(1); _Pragma("unroll") for (int m = 0; m < 4; ++m) _Pragma("unroll") for (int n = 0; n < 2; ++n) _Pragma("unroll") for (int k = 0; k < 2; ++k) \
        acc[ai][bj][m][n] = __builtin_amdgcn_mfma_f32_16x16x32_bf16(Bt[n][k], At[m][k], acc[ai][bj][m][n], 0, 0, 0); __builtin_amdgcn_s_setprio(0); } while (0)
#define PG8_WAIT_V(n) asm volatile("s_waitcnt vmcnt(" #n ")" ::: "memory")
#define PG8_WAIT_L(n) asm volatile("s_waitcnt lgkmcnt(" #n ")" ::: "memory")
#define PG8_BAR __builtin_amdgcn_s_barrier()
#define PG8_SCHED __builtin_amdgcn_sched_barrier(0)
    Unit cur, nxt; int ui = 0;
    if (!S.next(0, cur)) return;
    E.init(cur, wr, wc, fr, fq);
    f32x4 acc[2][2][4][2];
#pragma unroll
    for (int a = 0; a < 2; ++a)
#pragma unroll
        for (int b = 0; b < 2; ++b)
#pragma unroll
            for (int m = 0; m < 4; ++m)
#pragma unroll
                for (int n = 0; n < 2; ++n) acc[a][b][m][n] = (f32x4){0.f, 0.f, 0.f, 0.f};
    bf16x8 At[4][2], B0[2][2], B1[2][2];
    const char* cA = (const char*)g.A + (size_t)cur.pm * tstep; const char* cB = (const char*)g.Bt + (size_t)cur.pn * tstep;
    S.a_ready(cur);
    if constexpr (SP2) {
        PG8_STAGE(PG8_SB(0, 0), cB, voffB); PG8_STAGE(PG8_SB(0, 1), cB + hstep, voffB); PG8_STAGE(PG8_SA(0, 0), cA, voffA); PG8_STAGE(PG8_SA(0, 1), cA + hstep, voffA);
        if (wr == 1) PG8_BAR;
        PG8_WAIT_V(2); PG8_BAR;
        PG8_STAGE(PG8_SB(1, 0), cB + kstep, voffB); PG8_STAGE(PG8_SA(1, 0), cA + kstep, voffA); PG8_STAGE(PG8_SB(1, 1), cB + hstep + kstep, voffB);
        PG8_WAIT_V(6); PG8_BAR;
    } else {
        PG8_STAGE(PG8_SB(0, 0), cB, voffB); PG8_STAGE(PG8_SA(0, 0), cA, voffA); PG8_STAGE(PG8_SB(0, 1), cB + hstep, voffB); PG8_STAGE(PG8_SA(0, 1), cA + hstep, voffA);
        if (wr == 1) PG8_BAR;
        PG8_WAIT_V(4); PG8_BAR;
        PG8_STAGE(PG8_SB(1, 0), cB + kstep, voffB); PG8_STAGE(PG8_SA(1, 0), cA + kstep, voffA); PG8_STAGE(PG8_SB(1, 1), cB + hstep + kstep, voffB);
        PG8_WAIT_V(6); PG8_BAR;
    }
    for (;;) {
        const bool has_next = S.next(ui + 1, nxt);
        const char* nA = has_next ? (const char*)g.A + (size_t)nxt.pm * tstep : cA; const char* nB = has_next ? (const char*)g.Bt + (size_t)nxt.pn * tstep : cB;
        for (int t = 0; t < nt; t += 2) {
            const bool last = (t == nt - 2);
            const char* a1 = cA + (size_t)(t + 1) * kstep;
            const char* a2 = last ? nA : cA + (size_t)(t + 2) * kstep; const char* b2 = last ? nB : cB + (size_t)(t + 2) * kstep;
            const char* a3 = a2 + kstep; const char* b3 = b2 + kstep;
            if (last && has_next) S.a_ready(nxt);
            if constexpr (SP2) {
            PG8_LDB(B0, 0, 0); PG8_LDB(B1, 0, 1); PG8_SCHED; PG8_LDA(At, 0, 0); PG8_STAGE(PG8_SA(1, 1), a1 + hstep, voffA);
            PG8_WAIT_V(8); PG8_WAIT_L(0); PG8_BAR; PG8_MMA(0, 0, At, B0); PG8_MMA(0, 1, At, B1); PG8_BAR; PG8_SCHED;
            PG8_LDA(At, 0, 1); PG8_STAGE(PG8_SB(0, 0), b2, voffB); PG8_STAGE(PG8_SB(0, 1), b2 + hstep, voffB); PG8_STAGE(PG8_SA(0, 0), a2, voffA);
            PG8_WAIT_V(8); PG8_WAIT_L(0); PG8_BAR; PG8_MMA(1, 0, At, B0); PG8_MMA(1, 1, At, B1); PG8_BAR; PG8_SCHED;
            PG8_LDB(B0, 1, 0); PG8_LDB(B1, 1, 1); PG8_SCHED; PG8_LDA(At, 1, 0); PG8_STAGE(PG8_SA(0, 1), a2 + hstep, voffA);
            PG8_WAIT_V(8); PG8_WAIT_L(0); PG8_BAR; PG8_MMA(0, 0, At, B0); PG8_MMA(0, 1, At, B1); PG8_BAR; PG8_SCHED;
            PG8_LDA(At, 1, 1); PG8_STAGE(PG8_SB(1, 0), b3, voffB); PG8_STAGE(PG8_SB(1, 1), b3 + hstep, voffB); PG8_STAGE(PG8_SA(1, 0), a3, voffA);
            PG8_WAIT_V(8); PG8_WAIT_L(0); PG8_BAR; PG8_MMA(1, 0, At, B0); PG8_MMA(1, 1, At, B1); PG8_BAR; PG8_SCHED;
            } else {
            PG8_LDB(B0, 0, 0); PG8_SCHED; PG8_LDA(At, 0, 0); PG8_STAGE(PG8_SA(1, 1), a1 + hstep, voffA);
            PG8_WAIT_L(8); PG8_BAR; PG8_WAIT_L(0); PG8_MMA(0, 0, At, B0); PG8_BAR; PG8_SCHED;
            PG8_LDB(B1, 0, 1); PG8_STAGE(PG8_SB(0, 0), b2, voffB);
            PG8_BAR; PG8_WAIT_L(0); PG8_MMA(0, 1, At, B1); PG8_BAR;
            PG8_LDA(At, 0, 1); PG8_STAGE(PG8_SA(0, 0), a2, voffA);
            PG8_BAR; PG8_WAIT_L(0); PG8_MMA(1, 0, At, B0); PG8_BAR; PG8_SCHED;
            PG8_STAGE(PG8_SB(0, 1), b2 + hstep, voffB);
            PG8_WAIT_V(6); PG8_BAR; PG8_MMA(1, 1, At, B1); PG8_BAR;
            PG8_LDB(B0, 1, 0); PG8_SCHED; PG8_LDA(At, 1, 0); PG8_STAGE(PG8_SA(0, 1), a2 + hstep, voffA);
            PG8_WAIT_L(8); PG8_BAR; PG8_WAIT_L(0); PG8_MMA(0, 0, At, B0); PG8_BAR; PG8_SCHED;
            PG8_LDB(B1, 1, 1); PG8_STAGE(PG8_SB(1, 0), b3, voffB);
            PG8_BAR; PG8_WAIT_L(0); PG8_MMA(0, 1, At, B1); PG8_BAR;
            PG8_LDA(At, 1, 1); PG8_STAGE(PG8_SA(1, 0), a3, voffA);
            PG8_BAR; PG8_WAIT_L(0); PG8_MMA(1, 0, At, B0); PG8_BAR; PG8_SCHED;
            PG8_STAGE(PG8_SB(1, 1), b3 + hstep, voffB);
            PG8_WAIT_V(6); PG8_BAR; PG8_MMA(1, 1, At, B1); PG8_BAR;
            }
        }
        if constexpr (ALIGN_EPI) { if (wr == 0) PG8_BAR; }
        if constexpr (!Epi::AFTER_DRAIN) { E(acc, cur, nxt, has_next, wr, wc, fr, fq); S.done(cur); }
        if (!has_next) break;
#pragma unroll
        for (int a = 0; a < 2; ++a)
#pragma unroll
            for (int b = 0; b < 2; ++b)
#pragma unroll
                for (int m = 0; m < 4; ++m)
#pragma unroll
                    for (int n = 0; n < 2; ++n) acc[a][b][m][n] = (f32x4){0.f, 0.f, 0.f, 0.f};
        cur = nxt; cA = nA; cB = nB; ++ui;
        if constexpr (ALIGN_EPI) { if (wr == 1) PG8_BAR; }
    }
    PG8_WAIT_V(0);
    if constexpr (!ALIGN_EPI) { if (wr == 0) PG8_BAR; }
    PG8_BAR;
    if constexpr (Epi::AFTER_DRAIN) { E.fused(acc, cur, wr, wc, fr, fq, lds, wid, lane); S.done(cur); }
#undef PG8_SA
#undef PG8_SB
#undef PG8_STAGE
#undef PG8_LDA
#undef PG8_LDB
#undef PG8_MMA
#undef PG8_WAIT_V
#undef PG8_WAIT_L
#undef PG8_BAR
#undef PG8_SCHED
}
}
namespace att {
constexpr int D = 128, LDQ = 4096, LDK = 128, LDO = 2048, LDG = 4096;
constexpr float THR = 8.f; constexpr bool WSKIP = false;
typedef unsigned u32x4_t __attribute__((ext_vector_type(4)));
typedef short bf16x8_t __attribute__((ext_vector_type(8)));
__device__ __forceinline__ bf16x8_t ka_frag(unsigned lo, unsigned up, int hi) {
    u32x4_t w;
    w.x = 0x3f803f80u; w.y = 0x3f80u | (((lo & 0xffffu) ^ 0x8000u) << 16); w.z = ((lo >> 16) ^ 0x8000u) | (((up & 0xffffu) ^ 0x8000u) << 16); w.w = 0u;
    if (hi) { w.x = 0u; w.y = 0u; w.z = 0u; }
    return __builtin_bit_cast(bf16x8_t, w);
}
__device__ __forceinline__ bf16x8_t qa_frag(unsigned lo, unsigned up, int hi) {
    u32x4_t w;
    w.x = lo; w.y = (up & 0xffffu) | 0x3f800000u; w.z = 0x3f803f80u; w.w = 0u;
    if (hi) { w.x = 0u; w.y = 0u; w.z = 0u; }
    return __builtin_bit_cast(bf16x8_t, w);
}
constexpr float SCALE = 0.08838834764831845f;
constexpr int NW = 8, QBLK = 32, KVBLK = 64, QB = NW * QBLK;
constexpr int SHM_V = KVBLK * D * 2, SHM_K = KVBLK * D * 2;
constexpr int ATT_LDS_BYTES = 2 * SHM_V + 2 * SHM_K + NW * 64 * 4;

using bf16 = __hip_bfloat16;
typedef short bf16x8 __attribute__((ext_vector_type(8)));
typedef short s16x4 __attribute__((ext_vector_type(4)));
typedef float f32x16 __attribute__((ext_vector_type(16)));
typedef float f32x4 __attribute__((ext_vector_type(4)));
typedef unsigned u32x4 __attribute__((ext_vector_type(4)));
template <class A, class Bt> struct same_t { static constexpr bool v = false; };
template <class A> struct same_t<A, A> { static constexpr bool v = true; };

#define KSWZ(row, colB) ((row) * 256 + ((colB) ^ (((row) & 7) << 4)))
#define SBAR() __builtin_amdgcn_sched_barrier(0)
__device__ __forceinline__ int v_st(int k, int c) { const int kk = (k & ~0xC) | ((k & 4) << 1) | ((k & 8) >> 1); return ((kk >> 3) * 4 + (c >> 5)) * 512 + ((kk & 7) * 32 + (c & 31)) * 2; }
__device__ __forceinline__ int v_rd_base(int lane) { return ((lane & 3) << 3) | (((lane >> 2) & 3) << 6) | (((lane >> 4) & 1) << 5) | (((lane >> 5) & 1) << 8); }
constexpr int v_rd_off(int d0, int ks, int half) { return d0 * 512 + ks * 4096 + half * 2048; }
__device__ __forceinline__ int crow(int r, int hi) { return (r & 3) + 8 * (r >> 2) + 4 * hi; }
__device__ __forceinline__ unsigned cvtpk(float lo, float hi) {
    unsigned r; asm volatile("v_cvt_pk_bf16_f32 %0, %1, %2" : "=v"(r) : "v"(lo), "v"(hi)); return r;
}
__device__ __forceinline__ bf16x8 pack8(f32x4 a, f32x4 b) {
    u32x4 w = {cvtpk(a[0], a[1]), cvtpk(a[2], a[3]), cvtpk(b[0], b[1]), cvtpk(b[2], b[3])};
    return *reinterpret_cast<bf16x8*>(&w);
}
template <class T> __device__ __forceinline__ bf16x8 load8(const T* p) {
    if constexpr (same_t<T, float>::v) { return pack8(*(const f32x4*)p, *(const f32x4*)(p + 4)); }
    else { return *reinterpret_cast<const bf16x8*>(p); }
}
__device__ __forceinline__ void mask_tile(f32x16& p0, f32x16& p1, int dq, unsigned W) {
    const float NEG = -__builtin_inff();
#pragma unroll
    for (int r = 0; r < 16; ++r) {
        const int c = (r & 3) + 8 * (r >> 2);
        if ((unsigned)(dq - c) >= W) p0[r] = NEG;
        if ((unsigned)(dq - c - 32) >= W) p1[r] = NEG;
    }
}
__device__ __forceinline__ void partialSM(f32x16& p0, f32x16& p1, float& m_reg, float& mn, float& alpha) {
    float pmax = p0[0]; for (int r = 1; r < 16; ++r) pmax = fmaxf(pmax, p0[r]); for (int r = 0; r < 16; ++r) pmax = fmaxf(pmax, p1[r]);
    { auto rr = __builtin_amdgcn_permlane32_swap(__float_as_uint(pmax), __float_as_uint(pmax), false, false);
      pmax = fmaxf(__uint_as_float(rr[0]), __uint_as_float(rr[1])); }
    constexpr float C2 = 1.4426950408889634f * SCALE;
    if (__builtin_expect(__all((pmax - m_reg) * SCALE <= THR), 1)) { mn = m_reg; alpha = 1.f; }
    else { mn = fmaxf(m_reg, pmax); alpha = __builtin_amdgcn_exp2f((m_reg - mn) * C2); m_reg = mn; }
    const float mnL = -mn * C2;
    for (int r = 0; r < 16; ++r) p0[r] = fmaf(p0[r], C2, mnL); for (int r = 0; r < 16; ++r) p1[r] = fmaf(p1[r], C2, mnL);
    for (int r = 0; r < 16; ++r) p0[r] = __builtin_amdgcn_exp2f(p0[r]);
}
__device__ __forceinline__ void finishSM(f32x16& p0, f32x16& p1, float alpha, float& l_reg, bf16x8& pa0, bf16x8& pa1, bf16x8& pa2, bf16x8& pa3) {
    for (int r = 0; r < 16; ++r) p1[r] = __builtin_amdgcn_exp2f(p1[r]);
    float ps = 0; for (int r = 0; r < 16; ++r) ps += p0[r]; for (int r = 0; r < 16; ++r) ps += p1[r];
    { auto rr = __builtin_amdgcn_permlane32_swap(__float_as_uint(ps), __float_as_uint(ps), false, false);
      ps = __uint_as_float(rr[0]) + __uint_as_float(rr[1]); }
    l_reg = l_reg * alpha + ps;
#define PK4(P, B_, OUT) do { unsigned a0 = cvtpk(P[B_+0], P[B_+1]), a1 = cvtpk(P[B_+2], P[B_+3]);                          \
        unsigned b0 = cvtpk(P[B_+4], P[B_+5]), b1 = cvtpk(P[B_+6], P[B_+7]);                                             \
        auto r0 = __builtin_amdgcn_permlane32_swap(a0, b0, false, false); auto r1 = __builtin_amdgcn_permlane32_swap(a1, b1, false, false); \
        u32x4 w = {r0[0], r1[0], r0[1], r1[1]}; OUT = *reinterpret_cast<bf16x8*>(&w); } while (0)
    PK4(p0, 0, pa0); PK4(p0, 8, pa1); PK4(p1, 0, pa2); PK4(p1, 8, pa3);
#undef PK4
}
template <int KB, bool SK>
__device__ __forceinline__ void qkt(f32x16& p0, f32x16& p1, const char* K_lds, int r32, int hi, const bf16x8* qr, bool act, unsigned long long qa, unsigned long long c) {
    if (SK && !act) { const float NEG = -__builtin_inff();
#pragma unroll
        for (int r = 0; r < 16; ++r) { p0[r] = NEG; p1[r] = NEG; } return; }
    p0 = f32x16{}; p1 = f32x16{};
    const char* kb[4];
#pragma unroll
    for (int dd = 0; dd < 4; ++dd) kb[dd] = K_lds + KB * SHM_K + KSWZ(r32, (dd * 16 + hi * 8) * 2);
#pragma unroll
    for (int d0 = 0; d0 < 8; ++d0) { const char* a = kb[d0 & 3] + (d0 >> 2) * 128;
        bf16x8 b0 = *reinterpret_cast<const bf16x8*>(a);
        bf16x8 b1 = *reinterpret_cast<const bf16x8*>(a + 32 * 256);
        p0 = __builtin_amdgcn_mfma_f32_32x32x16_bf16(b0, qr[d0], p0, 0, 0, 0);
        p1 = __builtin_amdgcn_mfma_f32_32x32x16_bf16(b1, qr[d0], p1, 0, 0, 0); }
    { unsigned ql = (unsigned)qa, qu = (unsigned)(qa >> 32); asm volatile("" : "+v"(ql), "+v"(qu));
      const bf16x8 qaf = qa_frag(ql, qu, hi);
      const unsigned cl = (unsigned)c, cu = (unsigned)(c >> 32);
      auto r0 = __builtin_amdgcn_permlane32_swap(cl, cl, false, false); auto r1 = __builtin_amdgcn_permlane32_swap(cu, cu, false, false);
      p0 = __builtin_amdgcn_mfma_f32_32x32x16_bf16(ka_frag(r0[0], r1[0], hi), qaf, p0, 0, 0, 0);
      p1 = __builtin_amdgcn_mfma_f32_32x32x16_bf16(ka_frag(r0[1], r1[1], hi), qaf, p1, 0, 0, 0); }
}
template <int VB, bool SK>
__device__ __forceinline__ void pv_tile(f32x16* o, int vb0, bf16x8 pa0, bf16x8 pa1, bf16x8 pa2, bf16x8 pa3, bool act) {
    if (SK && !act) return;
#define TRRD(dst, off) asm volatile("ds_read_b64_tr_b16 %0, %1 offset:%2" : "=&v"(dst) : "v"(vb0), "i"(off) : "memory")
#define PV_D0(d0) do { s16x4 l0, l1, l2, l3, h0, h1, h2, h3; constexpr int b_ = VB * SHM_V + v_rd_off(d0, 0, 0);     \
        TRRD(l0, b_); TRRD(h0, b_ + 2048); TRRD(l1, b_ + 4096); TRRD(h1, b_ + 6144); TRRD(l2, b_ + 8192); TRRD(h2, b_ + 10240); TRRD(l3, b_ + 12288); TRRD(h3, b_ + 14336); \
        asm volatile("s_waitcnt lgkmcnt(0)" ::: "memory"); SBAR();                 \
        o[d0] = __builtin_amdgcn_mfma_f32_32x32x16_bf16(pa0, (bf16x8){l0[0], l0[1], l0[2], l0[3], h0[0], h0[1], h0[2], h0[3]}, o[d0], 0, 0, 0);   \
        o[d0] = __builtin_amdgcn_mfma_f32_32x32x16_bf16(pa1, (bf16x8){l1[0], l1[1], l1[2], l1[3], h1[0], h1[1], h1[2], h1[3]}, o[d0], 0, 0, 0);   \
        o[d0] = __builtin_amdgcn_mfma_f32_32x32x16_bf16(pa2, (bf16x8){l2[0], l2[1], l2[2], l2[3], h2[0], h2[1], h2[2], h2[3]}, o[d0], 0, 0, 0);   \
        o[d0] = __builtin_amdgcn_mfma_f32_32x32x16_bf16(pa3, (bf16x8){l3[0], l3[1], l3[2], l3[3], h3[0], h3[1], h3[2], h3[3]}, o[d0], 0, 0, 0); } while (0)
    PV_D0(0); PV_D0(1); PV_D0(2); PV_D0(3);
#undef PV_D0
#undef TRRD
}

template <class TIn, class TOut> struct BlockRef { const TIn* Q; const TIn* K; const TIn* V; TOut* O; const unsigned short* G; const unsigned long long* CA; int P0; };
template <class TIn> struct Seam {
    bf16x8 qr[8];
    bf16x8 st_v0, st_v1, st_k0, st_k1; f32x4 sf0, sf1, sf2, sf3;
    unsigned long long ca, qa;
    f32x4 tq[16];
};
__device__ __forceinline__ int swa_jlo(int P0, int W) { const int lowk = P0 - W + 1; return lowk > 0 ? lowk / KVBLK : 0; }
#define ROW(p, k0, rr) ((p) + (size_t)((k0) + (rr)) * LDK + sc)
#define VMW() asm volatile("s_waitcnt vmcnt(0)" ::: "memory")
#define VMWN(n) asm volatile("s_waitcnt vmcnt(%0)" :: "i"(n) : "memory")
#define SLOAD_H(Kp, Vp, CAp, k0) do { S.st_v0 = load8<TIn>(ROW(Vp, k0, sr)); S.st_v1 = load8<TIn>(ROW(Vp, k0, 32 + sr));              \
                         S.st_k0 = load8<TIn>(ROW(Kp, k0, sr)); S.st_k1 = load8<TIn>(ROW(Kp, k0, 32 + sr)); S.ca = (CAp)[(k0) + lane]; } while (0)
#define SWRITE_HK(bf) do { *(bf16x8*)(K_lds + (bf) * SHM_K + kws) = S.st_k0; *(bf16x8*)(K_lds + (bf) * SHM_K + kws + 32 * 256) = S.st_k1; } while (0)
#define SWRITE_HV(bf) do { *(bf16x8*)(V_lds + (bf) * SHM_V + vst0) = S.st_v0; *(bf16x8*)(V_lds + (bf) * SHM_V + vst1) = S.st_v1; } while (0)
#define SWRITE_H(bf) do { SWRITE_HV(bf); SWRITE_HK(bf); } while (0)
#define SLOAD_F(p, k0) do { S.sf0 = *(const f32x4*)ROW(p, k0, sr); S.sf1 = *(const f32x4*)(ROW(p, k0, sr) + 4);                \
                            S.sf2 = *(const f32x4*)ROW(p, k0, 32 + sr); S.sf3 = *(const f32x4*)(ROW(p, k0, 32 + sr) + 4); } while (0)
#define SWRITE_KF(bf) do { *(bf16x8*)(K_lds + (bf) * SHM_K + kws) = pack8(S.sf0, S.sf1); *(bf16x8*)(K_lds + (bf) * SHM_K + kws + 32 * 256) = pack8(S.sf2, S.sf3); } while (0)
#define SWRITE_VF(bf) do { *(bf16x8*)(V_lds + (bf) * SHM_V + vst0) = pack8(S.sf0, S.sf1); *(bf16x8*)(V_lds + (bf) * SHM_V + vst1) = pack8(S.sf2, S.sf3); } while (0)
template <class TIn, class TOut>
__device__ __forceinline__ void causal_swa_prime(const BlockRef<TIn, TOut>& cur, int W, char* lds, Seam<TIn>& S) {
    constexpr bool F32 = same_t<TIn, float>::v;
    const int tid = opaque_tid(), wid = __builtin_amdgcn_readfirstlane(tid >> 6), lane = tid & 63, r32 = lane & 31, hi = lane >> 5;
    const int sr = tid >> 4, sc = (tid & 15) * 8, kws = KSWZ(sr, sc * 2); char* K_lds = lds + 2 * SHM_V;
    const int kb0 = swa_jlo(cur.P0, W) * KVBLK;
    for (int d0 = 0; d0 < 8; ++d0) S.qr[d0] = load8<TIn>(cur.Q + (size_t)(wid * QBLK + r32) * LDQ + d0 * 16 + hi * 8);
    S.qa = cur.CA[cur.P0 + wid * QBLK + r32];
    if constexpr (F32) { SLOAD_F((const float*)cur.K, kb0); VMW(); SWRITE_KF(0); SBAR(); SLOAD_F((const float*)cur.V, kb0); }
    else { SLOAD_H(cur.K, cur.V, cur.CA, kb0); VMW(); SWRITE_HK(0); }
    __syncthreads();
}
template <class TIn, class TOut>
__device__ __forceinline__ void causal_swa_block(const BlockRef<TIn, TOut>& cur, const BlockRef<TIn, TOut>& nxt, int skv, int W, char* lds, Seam<TIn>& S) {
    constexpr bool F32 = same_t<TIn, float>::v;
    const int tid = opaque_tid(), wid = __builtin_amdgcn_readfirstlane(tid >> 6), lane = tid & 63, r32 = lane & 31, hi = lane >> 5;
    const int j_lo = swa_jlo(cur.P0, W);
    int j_hi = (cur.P0 + QB - 1) / KVBLK + 1; if (j_hi > skv / KVBLK) j_hi = skv / KVBLK;
    const int NT = j_hi - j_lo;
    const int kbn = swa_jlo(nxt.P0, W) * KVBLK;
    const int qlo = cur.P0 + wid * QBLK, qm = qlo + r32 - 4 * hi;
    char* V_lds = lds; char* K_lds = lds + 2 * SHM_V;
    float* ws = (float*)(lds + 2 * SHM_V + 2 * SHM_K) + wid * 64; float* li_l = ws, * al_l = ws + 32;
    float m_reg = -1e30f, l_reg = 0; f32x16 o[4] = {};
    const int sr = tid >> 4, sc = (tid & 15) * 8, vst0 = v_st(sr, sc), vst1 = v_st(32 + sr, sc), kws = KSWZ(sr, sc * 2);
    const int vb0 = (int)(uintptr_t)V_lds + v_rd_base(lane);
    const TIn* Kh = cur.K; const TIn* Vh = cur.V; const unsigned long long* CAh = cur.CA;
#define RESC(a) do { if (__any((a) < 1.f)) { if (hi == 0) al_l[r32] = (a); asm volatile("s_waitcnt lgkmcnt(0)" ::: "memory");              \
                     for (int d_ = 0; d_ < 4; ++d_) for (int r = 0; r < 16; ++r) o[d_][r] *= al_l[crow(r, hi)]; } } while (0)
#define KBASE(t) ((j_lo + (t)) * KVBLK)
#define ACT(t) (KBASE(t) <= qlo + QBLK - 1 && KBASE(t) + KVBLK - 1 >= qlo - W + 1)
#define MASKT(P0_, P1_, t) do { const int kb_ = KBASE(t); if ((!SK || ACT(t)) && (kb_ + KVBLK - 1 > qlo || kb_ <= qlo + QBLK - 1 - W)) mask_tile(P0_, P1_, qm - kb_, (unsigned)W); } while (0)
    constexpr int NQL = F32 ? 16 : 8;
    constexpr bool SK = WSKIP && !F32;
#define SEAM_K0() do { VMWN(NQL); if constexpr (F32) { SWRITE_KF(0); SBAR(); SLOAD_F((const float*)nxt.V, kbn); } else { SWRITE_HK(0); } SBAR(); } while (0)
    f32x16 pA0, pA1, pB0, pB1; float mnA, mnB, alA, alB; bf16x8 pa0, pa1, pa2, pa3;
    if constexpr (F32) { VMW(); SWRITE_VF(0); SBAR(); } else { SWRITE_HV(0); SBAR(); }
    const unsigned long long qa_ = S.qa, hc = S.ca;
    if (NT > 1) { if constexpr (F32) SLOAD_F((const float*)Kh, KBASE(1)); else SLOAD_H(Kh, Vh, CAh, KBASE(1)); }
    SBAR(); qkt<0, SK>(pA0, pA1, K_lds, r32, hi, S.qr, ACT(0), qa_, hc);
    if constexpr (F32) { if (NT > 1) { VMW(); SWRITE_KF(1); SBAR(); SLOAD_F((const float*)Vh, KBASE(1)); } }
    MASKT(pA0, pA1, 0); partialSM(pA0, pA1, m_reg, mnA, alA);
    if (NT > 1) { VMW(); if constexpr (F32) { SWRITE_VF(1); SBAR(); if (NT > 2) SLOAD_F((const float*)Kh, KBASE(2)); } else SWRITE_H(1); }
    __syncthreads();
#define HALF_STEP(PX0, PX1, mnX, alX, PY0, PY1, alY, t, KB, VB, SB) do {                                                      \
        { const unsigned long long c_ = S.ca; SBAR(); qkt<KB, SK>(PX0, PX1, K_lds, r32, hi, S.qr, ACT(t), qa_, c_); }                                             \
        finishSM(PY0, PY1, alY, l_reg, pa0, pa1, pa2, pa3); SBAR();                                                           \
        if ((t) + 1 < NT) { if constexpr (F32) { VMW(); SWRITE_KF(SB); SBAR(); SLOAD_F((const float*)Vh, KBASE((t) + 1)); }  \
                            else { SLOAD_H(Kh, Vh, CAh, KBASE((t) + 1)); } SBAR(); }                                               \
        pv_tile<VB, SK>(o, vb0, pa0, pa1, pa2, pa3, ACT((t) - 1)); MASKT(PX0, PX1, (t)); partialSM(PX0, PX1, m_reg, mnX, alX);                                        \
        __syncthreads();                                                                                                      \
        if ((t) + 1 < NT) { VMW(); if constexpr (F32) { SWRITE_VF(SB); SBAR(); if ((t) + 2 < NT) SLOAD_F((const float*)Kh, KBASE((t) + 2)); } \
                            else { SWRITE_H(SB); } }                                                                          \
        RESC(alX); __syncthreads(); } while (0)
    for (int t = 1; t + 1 < NT; t += 2) {
        HALF_STEP(pB0, pB1, mnB, alB, pA0, pA1, alA, t, 1, 0, 0);
        HALF_STEP(pA0, pA1, mnA, alA, pB0, pB1, alB, t + 1, 0, 1, 1);
    }
    const bool even = (NT & 1) == 0;
    if (even) { const unsigned long long c_ = S.ca; SBAR(); qkt<1, SK>(pB0, pB1, K_lds, r32, hi, S.qr, ACT(NT - 1), qa_, c_); SBAR(); }
#define QROW(e) (nxt.Q + (size_t)(wid * QBLK + r32) * D + ((e) >> 1) * 16 + hi * 8 + ((e) & 1) * 4)
    if constexpr (F32) { SLOAD_F((const float*)nxt.K, kbn); SBAR();
#pragma unroll
        for (int e = 0; e < 8; ++e) S.tq[e] = *(const f32x4*)QROW(e); }
    else { SLOAD_H(nxt.K, nxt.V, nxt.CA, kbn); SBAR();
#pragma unroll
        for (int d0 = 0; d0 < 8; ++d0) S.qr[d0] = load8<TIn>(nxt.Q + (size_t)(wid * QBLK + r32) * LDQ + d0 * 16 + hi * 8);
        S.qa = nxt.CA[nxt.P0 + wid * QBLK + r32]; }
    SBAR();
    finishSM(pA0, pA1, alA, l_reg, pa0, pa1, pa2, pa3); SBAR();
    if constexpr (F32) {
#pragma unroll
        for (int e = 8; e < 16; ++e) S.tq[e] = *(const f32x4*)QROW(e); SBAR(); }
#undef QROW
    pv_tile<0, SK>(o, vb0, pa0, pa1, pa2, pa3, ACT(even ? NT - 2 : NT - 1));
    if (even) { MASKT(pB0, pB1, NT - 1); partialSM(pB0, pB1, m_reg, mnB, alB); __syncthreads(); RESC(alB);
        finishSM(pB0, pB1, alB, l_reg, pa0, pa1, pa2, pa3); SBAR(); pv_tile<1, SK>(o, vb0, pa0, pa1, pa2, pa3, ACT(NT - 1)); }
    SBAR(); SEAM_K0();
    if (hi == 0) li_l[r32] = l_reg; asm volatile("s_waitcnt lgkmcnt(0)" ::: "memory");
    float rli[16];
#pragma unroll
    for (int r = 0; r < 16; ++r) rli[r] = __builtin_amdgcn_rcpf(li_l[crow(r, hi)]);
    TOut* Ow = cur.O + (size_t)(wid * QBLK) * LDO; const unsigned short* Gw = cur.G + (size_t)(wid * QBLK) * LDG;
#pragma unroll
    for (int r = 0; r < 16; ++r) { const int orow = crow(r, hi);
#pragma unroll
        for (int d0 = 0; d0 < 4; ++d0) { const float v = o[d0][r] * rli[r];
            if constexpr (same_t<TOut, float>::v) { Ow[(size_t)orow * LDO + d0 * 32 + r32] = v; }
            else { const float vn = __builtin_bit_cast(float, __builtin_amdgcn_mov_dpp(__builtin_bit_cast(int, v), 0xB1, 0xf, 0xf, true));
                   if ((r32 & 1) == 0) { const unsigned g2 = *(const unsigned*)(Gw + (size_t)orow * LDG + d0 * 32 + r32);
                       *(unsigned*)(Ow + (size_t)orow * LDO + d0 * 32 + r32) = cvtpk(v * __uint_as_float(g2 << 16), vn * __uint_as_float(g2 & 0xffff0000u)); } } } }
    if constexpr (F32) {
#pragma unroll
        for (int d0 = 0; d0 < 8; ++d0) S.qr[d0] = pack8(S.tq[2 * d0], S.tq[2 * d0 + 1]); }
    __syncthreads();
#undef RESC
#undef KBASE
#undef ACT
#undef MASKT
#undef SEAM_K0
#undef HALF_STEP
}
#undef ROW
#undef VMW
#undef VMWN
#undef SLOAD_H
#undef SWRITE_HK
#undef SWRITE_HV
#undef SWRITE_H
#undef SLOAD_F
#undef SWRITE_KF
#undef SWRITE_VF

__host__ __device__ inline int swa_nx(int nqb, int nramp) { return (nramp + 1) / 2 + (nqb - nramp); }
struct SwaItem { int bh, qb0, qb1; };
__device__ __forceinline__ SwaItem swa_decode(int L, int nqb, int nx) {
    SwaItem it; const int xcd = L & 7, k = L >> 3, gi = k / nx, r = k - gi * nx;
    it.bh = gi * 8 + xcd; const int x = r;
    it.qb0 = nqb - 1 - x; it.qb1 = x;
    return it;
}
struct AttnT { const bf16* Q; const bf16* K; const bf16* V; bf16* O; const unsigned short* G; const unsigned long long* CA; };
__device__ __forceinline__ BlockRef<bf16, bf16> swa_ref(const SwaItem& it, int pass, const AttnT& T, int seq, int nh) {
    const int qb = pass ? it.qb1 : it.qb0, b = it.bh / nh, h = it.bh % nh; const size_t tok0 = (size_t)b * seq;
    BlockRef<bf16, bf16> r;
    r.Q = T.Q + (tok0 + (size_t)qb * QB) * LDQ + h * D; r.O = T.O + (tok0 + (size_t)qb * QB) * LDO + h * D; r.G = T.G + (tok0 + (size_t)qb * QB) * LDG + h * D;
    r.K = T.K + (size_t)it.bh * seq * D; r.V = T.V + (size_t)it.bh * seq * D; r.CA = T.CA + (size_t)it.bh * seq; r.P0 = qb * QB;
    return r;
}
__device__ __forceinline__ void attn_phase(char* lds, const AttnT& T, int nb, int nh, int seq) {
    const int W = 1 << 30, nqb = seq / QB, nx = nqb / 2, total = nx * nb * nh, stride = gridDim.x;
    int L = blockIdx.x; if (L >= total) return;
    SwaItem it = swa_decode(L, nqb, nx); int pass = 0;
    BlockRef<bf16, bf16> cur = swa_ref(it, 0, T, seq, nh);
    Seam<bf16> S;
    causal_swa_prime<bf16, bf16>(cur, W, lds, S);
    for (;;) {
        const bool more_pass = pass == 0 && it.qb1 != it.qb0, more_item = L + stride < total, last = !more_pass && !more_item;
        SwaItem itn = it; int passn = pass + 1, Ln = L;
        if (!more_pass) { passn = 0; Ln = more_item ? L + stride : L; itn = swa_decode(Ln, nqb, nx); }
        const BlockRef<bf16, bf16> nxt = last ? cur : swa_ref(itn, passn, T, seq, nh);
        causal_swa_block<bf16, bf16>(cur, nxt, seq, W, lds, S);
        if (last) break;
        cur = nxt; it = itn; pass = passn; L = Ln;
    }
}
#undef KSWZ
#undef SBAR
}
constexpr int DM = 2048, NB = 4, SEQ = 4096, MT = NB * SEQ, FF = 5632, FF2 = 2 * FF, NH = 16, HD = 128, CH = 128, NG = 16;
constexpr float EPS = 1e-6f;
constexpr int NWAVES = 8, NTHREADS = NWAVES * 64;
constexpr size_t MiB = 1u << 20;
constexpr size_t WS_BAR = 0, BAR_ZERO_BYTES = 16384;
constexpr size_t WS_LOGF = 1 * MiB;
constexpr size_t WS_CA = 2 * MiB;
constexpr size_t WS_WSB = 4 * MiB;
constexpr size_t WS_WF = 5 * MiB;
constexpr size_t WS_W_AIN = 6 * MiB;
constexpr size_t WS_W_AOUT = WS_W_AIN + 32 * MiB;
constexpr size_t WS_W_KV = WS_W_AOUT + 16 * MiB;
constexpr size_t WS_W_QG = WS_W_KV + 16 * MiB;
constexpr size_t WS_W_BOUT = WS_W_QG + 32 * MiB;
constexpr size_t WS_W_UP = WS_W_BOUT + 16 * MiB;
constexpr size_t WS_W_DN = WS_W_UP + 176 * MiB;
constexpr size_t WS_XN = WS_W_DN + 88 * MiB;
constexpr size_t WS_XN2 = WS_XN + 64 * MiB;
constexpr size_t WS_KV = WS_XN2 + 64 * MiB;
constexpr size_t WS_BIG = WS_KV + 128 * MiB;
constexpr size_t WS_ACT = WS_BIG + 352 * MiB;
constexpr size_t WS_SSP = WS_ACT + 176 * MiB;
constexpr size_t WS_END = WS_SSP + 2 * MiB;
constexpr int LDS_BYTES = 147456, MISC_OFF = LDS_BYTES - 64, XS_OFF = 131072, RRW_OFF = XS_OFF + 8192;

typedef unsigned short bf16_t;
typedef float f32x4 __attribute__((ext_vector_type(4)));
typedef unsigned u32x4 __attribute__((ext_vector_type(4)));
typedef unsigned u32x2 __attribute__((ext_vector_type(2)));
typedef short bf16x8 __attribute__((ext_vector_type(8)));
#define LAS __attribute__((address_space(3)))
__device__ __forceinline__ unsigned pk2(float lo, float hi) { return pg8::cvt_pk_bf16(lo, hi); }
__device__ __forceinline__ float bf_lo(unsigned w) { return __uint_as_float(w << 16); }
__device__ __forceinline__ float bf_hi(unsigned w) { return __uint_as_float(w & 0xffff0000u); }
__device__ __forceinline__ float wave_sum(float v, int lane) {
#pragma unroll
    for (int o = 1; o < 64; o <<= 1) v += lane_read(v, lane ^ o);
    return v;
}
struct Args { const float* in[21]; float* out; unsigned char* ws; };
#define XB_TMO      128
#define XB_XCNT(j)  (256  + 64 * (j))
#define XB_XSUB(j)  (1280 + 64 * (j))
#define XB_XGEN(j)  (2304 + 64 * (j))
#define XB_TOP      3328
#define XB_TOPGEN   3392
#define XCD_BAR_WORDS 3456
#define XB_SPIN_CAP (1u << 18)

__device__ __forceinline__ unsigned xb_ld(unsigned* p)              { return __hip_atomic_load(p, __ATOMIC_RELAXED, __HIP_MEMORY_SCOPE_AGENT); }
__device__ __forceinline__ unsigned xb_add(unsigned* p, unsigned v) { return __hip_atomic_fetch_add(p, v, __ATOMIC_RELAXED, __HIP_MEMORY_SCOPE_AGENT); }
__device__ __forceinline__ unsigned xb_xcc_id() { return (unsigned)__builtin_amdgcn_s_getreg((3 << 11) | 20) & 0xFu; }
#define XB_SPIN(cond, bar) do { unsigned _sp = 0; while (cond) { __builtin_amdgcn_s_sleep(1); \
    if ((++_sp & 255u) == 0u) { if (xb_ld(&(bar)[XB_TMO])) break; if (_sp > XB_SPIN_CAP) { atomicAdd(&(bar)[XB_TMO], 1u); break; } } } } while (0)

struct XcdBarrier {
    unsigned* bar; unsigned x;
    volatile LAS unsigned* st;
};

__device__ __forceinline__ XcdBarrier xcd_barrier_post(unsigned* bar, volatile LAS unsigned* st) {
    XcdBarrier b; b.bar = bar; b.x = xb_xcc_id(); b.st = st;
    if (threadIdx.x == 0) (void)xb_add(&bar[XB_XCNT(b.x)], 1u);
    return b;
}
__device__ __forceinline__ void xcd_barrier_complete(unsigned* bar, unsigned x, unsigned& nloc, unsigned& nx) {
    const unsigned G = gridDim.x * gridDim.y * gridDim.z;
    unsigned sum, cnt, mine, sp = 0u;
    for (;;) {
        sum = 0u; cnt = 0u; mine = 0u;
#pragma unroll
        for (unsigned j = 0; j < 16; ++j) { const unsigned c = xb_ld(&bar[XB_XCNT(j)]); sum += c; cnt += (c > 0u) ? 1u : 0u; mine = (j == x) ? c : mine; }
        if (sum == G) break;
        __builtin_amdgcn_s_sleep(1);
        if ((++sp & 255u) == 0u) { if (xb_ld(&bar[XB_TMO])) break; if (sp > XB_SPIN_CAP) { atomicAdd(&bar[XB_TMO], 1u); break; } }
    }
    nloc = mine > 0u ? mine : 1u; nx = cnt > 0u ? cnt : 1u;
}

__device__ __forceinline__ void xcd_barrier(const XcdBarrier& b) {
    asm volatile("s_waitcnt vmcnt(0)" ::: "memory");
    __syncthreads();
    if (threadIdx.x == 0) {
        unsigned* bar = b.bar;
        __builtin_amdgcn_s_waitcnt(0);
        unsigned nloc = b.st[0], nx = b.st[1];
        if (nloc == 0u) { xcd_barrier_complete(bar, b.x, nloc, nx); b.st[0] = nloc; b.st[1] = nx; }
        const unsigned old = xb_add(&bar[XB_XSUB(b.x)], 1u);
        const unsigned gen = old / nloc;
        if (old + 1u == (gen + 1u) * nloc) {
            __builtin_amdgcn_fence(__ATOMIC_RELEASE, "agent");
            asm volatile("s_waitcnt vmcnt(0)" ::: "memory");
            const unsigned og = xb_add(&bar[XB_TOP], 1u);
            const unsigned tg = og / nx;
            if (og + 1u == (tg + 1u) * nx) xb_add(&bar[XB_TOPGEN], 1u);
            else XB_SPIN(xb_ld(&bar[XB_TOPGEN]) == tg, bar);
            __builtin_amdgcn_fence(__ATOMIC_ACQUIRE, "agent");
            xb_add(&bar[XB_XGEN(b.x)], 1u);
            asm volatile("s_waitcnt vmcnt(0)" ::: "memory");
        } else {
            XB_SPIN(xb_ld(&bar[XB_XGEN(b.x)]) == gen, bar);
            __builtin_amdgcn_fence(__ATOMIC_ACQUIRE, "agent");
            asm volatile("s_waitcnt vmcnt(0)" ::: "memory");
        }
    }
    __syncthreads();
}


__device__ __forceinline__ int up_row(int n) { return n < FF ? (n >> 7) * 256 + (n & 127) : ((n - FF) >> 7) * 256 + 128 + ((n - FF) & 127); }
constexpr int TR_LDS_PER_WAVE = 64 * 65 * 4;
__device__ __forceinline__ void transpose_item(const float* W, int K, int ld, int ncols, const float* gk, bf16_t* WT, int mode, LAS float* scr, int item, int lane) {
    const int nblk = ncols / 64, kb = item / nblk, nb = item % nblk, k0 = 64 * kb, n0 = 64 * nb, kr = lane >> 4, n4 = (lane & 15) * 4;
    f32x4 v[16];
#pragma unroll
    for (int i = 0; i < 16; ++i) v[i] = *(const f32x4*)(W + (size_t)(k0 + 4 * i + kr) * ld + n0 + n4);
#pragma unroll
    for (int i = 0; i < 16; ++i) { const int kk = 4 * i + kr; const float g = gk ? gk[k0 + kk] : 1.f; LAS float* d = scr + kk * 65 + n4; d[0] = v[i].x * g; d[1] = v[i].y * g; d[2] = v[i].z * g; d[3] = v[i].w * g; }
    asm volatile("s_waitcnt lgkmcnt(0)" ::: "memory");
    const int c = lane & 7; const int r0 = mode ? up_row(n0) : n0;
#pragma unroll
    for (int j = 0; j < 8; ++j) { const int n = (lane >> 3) + 8 * j; const LAS float* p = scr + (8 * c) * 65 + n;
        u32x4 o; o.x = pk2(p[0 * 65], p[1 * 65]); o.y = pk2(p[2 * 65], p[3 * 65]); o.z = pk2(p[4 * 65], p[5 * 65]); o.w = pk2(p[6 * 65], p[7 * 65]);
        *(u32x4*)(WT + (size_t)(r0 + n) * K + k0 + 8 * c) = o; }
    asm volatile("s_waitcnt lgkmcnt(0)" ::: "memory");
}
__device__ __forceinline__ void fgate_rows(const bf16_t* hb, const float* rss, const bf16_t* wfh, const bf16_t* wfl, const float* bf, float* logf, int gw, int NGW, int lane) {
    const int fr = lane & 15, fq = lane >> 4;
    for (int rg = gw; rg < MT / 16; rg += NGW) {
        const bf16_t* hrow = hb + (size_t)(rg * 16 + fr) * DM + 8 * fq; const bf16_t* wh = wfh + fr * DM + 8 * fq; const bf16_t* wl = wfl + fr * DM + 8 * fq;
        const f32x4* rp = (const f32x4*)(rss + (size_t)(rg * 16 + fr) * 32 + fq * 8); const f32x4 ra = rp[0], rb = rp[1];
        float ssq = ((ra[0] + ra[1]) + (ra[2] + ra[3])) + ((rb[0] + rb[1]) + (rb[2] + rb[3])); ssq += lane_read(ssq, lane ^ 16); ssq += lane_read(ssq, lane ^ 32);
        f32x4 acc = {0.f, 0.f, 0.f, 0.f};
#pragma unroll 4
        for (int ks = 0; ks < DM / 32; ++ks) {
            const bf16x8 hv = *(const bf16x8*)(hrow + 32 * ks), whv = *(const bf16x8*)(wh + 32 * ks), wlv = *(const bf16x8*)(wl + 32 * ks);
            acc = __builtin_amdgcn_mfma_f32_16x16x32_bf16(whv, hv, acc, 0, 0, 0);
            acc = __builtin_amdgcn_mfma_f32_16x16x32_bf16(wlv, hv, acc, 0, 0, 0);
        }
        const float r = 1.0f / sqrtf(ssq * (1.0f / DM) + EPS);
        const f32x4 b = *(const f32x4*)(bf + 4 * fq); f32x4 o;
#pragma unroll
        for (int e = 0; e < 4; ++e) { const float f = acc[e] * r + b[e]; o[e] = fminf(f, 0.f) - log1pf(expf(-fabsf(f))); }
        *(f32x4*)(logf + (size_t)(rg * 16 + fr) * 16 + 4 * fq) = o;
    }
}
__device__ __forceinline__ void scan_seq(const float* logf, unsigned long long* CA, int seq, int lane) {
    const int b = seq >> 4, hh = seq & 15;
    const float* lf = logf + ((size_t)b * SEQ + (size_t)lane * 64) * 16 + hh;
    float v[64];
#pragma unroll
    for (int i = 0; i < 64; ++i) v[i] = lf[i * 16];
#pragma unroll
    for (int i = 1; i < 64; ++i) v[i] += v[i - 1];
    const float tot = v[63]; float t = tot;
#pragma unroll
    for (int o = 1; o < 64; o <<= 1) { const float y = lane_read(t, lane >= o ? lane - o : lane); if (lane >= o) t += y; }
    const float excl = t - tot;
    unsigned long long* out = CA + (size_t)seq * SEQ + lane * 64;
#pragma unroll
    for (int i = 0; i < 64; ++i) { const float c = (excl + v[i]) * 11.313708498984761f;
        const unsigned h1 = pk2(c, 0.f) & 0xffffu; const float r1 = c - bf_lo(h1);
        const unsigned h2 = pk2(r1, 0.f) & 0xffffu; const float r2 = r1 - bf_lo(h2);
        const unsigned h3 = pk2(r2, 0.f) & 0xffffu;
        out[i] = (unsigned long long)(h1 | (h2 << 16)) | ((unsigned long long)h3 << 32); }
}
__device__ __forceinline__ void spatial_phase(LAS unsigned char* ldsp, const bf16_t* Z, const float* ssp, const bf16_t* wsb, const float* vnorm, const float* bs, bf16_t* GATED, int wave, int lane) {
    const int fr = lane & 15, fq = lane >> 4;
    for (int item = blockIdx.x; item < (MT / CH) * NG; item += gridDim.x) {
        const int ch = item >> 4, g = item & 15, row0 = ch * CH, cw = g * 128 + wave * 16;
        LAS float* rvs = (LAS float*)ldsp;
        __syncthreads();
        { const int t_ = wave * 64 + lane; if (t_ < CH) { const f32x4* p = (const f32x4*)(ssp + (size_t)(row0 + t_) * 32); float sq = 0.f;
#pragma unroll
            for (int q = 0; q < 8; ++q) { const f32x4 v = p[q]; sq += (v.x + v.y) + (v.z + v.w); }
            rvs[t_] = 1.0f / sqrtf(sq * (1.0f / DM) + EPS); } }
        __syncthreads();
        LAS unsigned* VS = (LAS unsigned*)(ldsp + 1024);
        { const int t_ = wave * 64 + lane, srow = t_ >> 2, c0 = (t_ & 3) * 32; const float rv = rvs[srow];
          const u32x4* gp = (const u32x4*)(Z + (size_t)(row0 + srow) * 4096 + 2048 + g * 128 + c0); u32x4 q[4];
#pragma unroll
          for (int jj = 0; jj < 4; ++jj) q[jj] = gp[jj];
#pragma unroll
          for (int jj = 0; jj < 4; ++jj) { LAS unsigned* d = VS + srow * 65 + (c0 >> 1) + jj * 4;
#pragma unroll
              for (int e = 0; e < 4; ++e) d[e] = pk2(bf_lo(q[jj][e]) * rv, bf_hi(q[jj][e]) * rv); } }
        __syncthreads();
        bf16x8 vf[4];
        { const LAS unsigned short* vs16 = (const LAS unsigned short*)VS + wave * 16 + fr;
#pragma unroll
          for (int ks = 0; ks < 4; ++ks) { unsigned hv[8];
#pragma unroll
              for (int i = 0; i < 8; ++i) hv[i] = vs16[(32 * ks + 8 * fq + i) * 130];
              u32x4 w; w.x = hv[0] | (hv[1] << 16); w.y = hv[2] | (hv[3] << 16); w.z = hv[4] | (hv[5] << 16); w.w = hv[6] | (hv[7] << 16); vf[ks] = __builtin_bit_cast(bf16x8, w); } }
        f32x4 acc[8];
#pragma unroll
        for (int m = 0; m < 8; ++m) { acc[m] = (f32x4){0.f, 0.f, 0.f, 0.f};
#pragma unroll
            for (int ks = 0; ks < 4; ++ks) if (32 * ks <= 16 * m + 15) {
                const bf16x8 wf = *(const bf16x8*)(wsb + ((size_t)(g * 128 + 16 * m + fr) * 128 + 32 * ks + 8 * fq));
                acc[m] = __builtin_amdgcn_mfma_f32_16x16x32_bf16(vf[ks], wf, acc[m], 0, 0, 0); } }
        const f32x4 vn = *(const f32x4*)(vnorm + cw + 4 * fq);
#pragma unroll
        for (int m = 0; m < 8; ++m) { const int t = 16 * m + fr; const size_t row = (size_t)(row0 + t); const float bias = bs[g * 128 + t];
            const u32x2 uu = *(const u32x2*)(Z + row * 4096 + cw + 4 * fq);
            const float o0 = bf_lo(uu.x) * (acc[m][0] * vn[0] + bias), o1 = bf_hi(uu.x) * (acc[m][1] * vn[1] + bias), o2 = bf_lo(uu.y) * (acc[m][2] * vn[2] + bias), o3 = bf_hi(uu.y) * (acc[m][3] * vn[3] + bias);
            u32x2 w; w.x = pk2(o0, o1); w.y = pk2(o2, o3); *(u32x2*)(GATED + row * DM + cw + 4 * fq) = w; }
    }
}
__device__ __forceinline__ void conv_phase(const bf16_t* BIG, const float* cw, const float* cb, bf16_t* ACT) {
    constexpr int NQ = FF / 8, RS = 32, NTASK = NQ * (MT / RS);
    const int tid_ = opaque_tid();
    for (int T = blockIdx.x * NTHREADS + tid_; T < NTASK; T += gridDim.x * NTHREADS) {
        const int qb = (NQ / 64 - 1) - T / (64 * (MT / RS)), rem = T % (64 * (MT / RS)), strip = rem >> 6, q = qb * 64 + (rem & 63), j0 = 8 * q, pg = (q >> 4) * 256 + (q & 15) * 8, row0 = strip * RS;
        float wg[3][8], wv[3][8], bg[8], bv[8];
#pragma unroll
        for (int k = 0; k < 3; ++k)
#pragma unroll
            for (int e = 0; e < 8; ++e) { wg[k][e] = cw[(size_t)k * FF2 + j0 + e]; wv[k][e] = cw[(size_t)k * FF2 + FF + j0 + e]; }
#pragma unroll
        for (int e = 0; e < 8; ++e) { bg[e] = cb[j0 + e]; bv[e] = cb[FF + j0 + e]; }
        const bf16_t* src = BIG + (size_t)row0 * FF2 + pg; bf16_t* dst = ACT + (size_t)row0 * FF + j0;
        u32x4 g2 = {0u, 0u, 0u, 0u}, g1 = g2, v2 = g2, v1 = g2;
        if ((row0 & (SEQ - 1)) != 0) { g2 = *(const u32x4*)(src - 2 * (size_t)FF2); v2 = *(const u32x4*)(src - 2 * (size_t)FF2 + 128); g1 = *(const u32x4*)(src - (size_t)FF2); v1 = *(const u32x4*)(src - (size_t)FF2 + 128); }
        for (int i0 = 0; i0 < RS; i0 += 8) {
            u32x4 gc[8], vc[8];
#pragma unroll
            for (int i = 0; i < 8; ++i) { gc[i] = *(const u32x4*)(src + (size_t)(i0 + i) * FF2); vc[i] = *(const u32x4*)(src + (size_t)(i0 + i) * FF2 + 128); }
#pragma unroll
            for (int i = 0; i < 8; ++i) { u32x4 o;
#pragma unroll
                for (int p = 0; p < 4; ++p) {
                    const float ga = wg[0][2 * p] * bf_lo(g2[p]) + wg[1][2 * p] * bf_lo(g1[p]) + wg[2][2 * p] * bf_lo(gc[i][p]) + bg[2 * p];
                    const float gb = wg[0][2 * p + 1] * bf_hi(g2[p]) + wg[1][2 * p + 1] * bf_hi(g1[p]) + wg[2][2 * p + 1] * bf_hi(gc[i][p]) + bg[2 * p + 1];
                    const float va = wv[0][2 * p] * bf_lo(v2[p]) + wv[1][2 * p] * bf_lo(v1[p]) + wv[2][2 * p] * bf_lo(vc[i][p]) + bv[2 * p];
                    const float vb = wv[0][2 * p + 1] * bf_hi(v2[p]) + wv[1][2 * p + 1] * bf_hi(v1[p]) + wv[2][2 * p + 1] * bf_hi(vc[i][p]) + bv[2 * p + 1];
                    const float sa = ga * __builtin_amdgcn_rcpf(1.0f + __builtin_amdgcn_exp2f(-1.4426950408889634f * ga)), sb = gb * __builtin_amdgcn_rcpf(1.0f + __builtin_amdgcn_exp2f(-1.4426950408889634f * gb));
                    o[p] = pk2(sa * va, sb * vb); }
                *(u32x4*)(dst + (size_t)(i0 + i) * FF) = o; g2 = g1; g1 = gc[i]; v2 = v1; v1 = vc[i]; }
        }
    }
}

typedef const Args __attribute__((address_space(4))) CArgs;
__device__ __forceinline__ CArgs* kargs() { CArgs* p = (CArgs*)__builtin_amdgcn_kernarg_segment_ptr(); asm volatile("" : "+s"(p)); return p; }
#define PTRS \
    CArgs* ap_ = kargs(); unsigned char* ws = ap_->ws; float* h = ap_->out; (void)ws; (void)h; \
    const float* x = ap_->in[0]; const float* a_norm = ap_->in[1]; const float* a_w_in = ap_->in[2]; const float* a_v_norm = ap_->in[3]; const float* a_w_s = ap_->in[4]; const float* a_b_s = ap_->in[5]; \
    const float* a_w_out = ap_->in[6]; const float* kv_norm = ap_->in[7]; const float* w_kvf = ap_->in[8]; const float* b_f = ap_->in[9]; const float* k_norm = ap_->in[10]; const float* b_norm = ap_->in[11]; \
    const float* b_w_qg = ap_->in[12]; const float* q_norm = ap_->in[13]; const float* b_w_out = ap_->in[14]; const float* f_norm = ap_->in[15]; const float* f_w_up = ap_->in[16]; const float* f_conv_w = ap_->in[17]; \
    const float* f_conv_b = ap_->in[18]; const float* f_w_down = ap_->in[19]; const float* final_norm = ap_->in[20]; \
    (void)x; (void)a_norm; (void)a_w_in; (void)a_v_norm; (void)a_w_s; (void)a_b_s; (void)a_w_out; (void)kv_norm; (void)w_kvf; (void)b_f; (void)k_norm; (void)b_norm; (void)b_w_qg; (void)q_norm; (void)b_w_out; \
    (void)f_norm; (void)f_w_up; (void)f_conv_w; (void)f_conv_b; (void)f_w_down; (void)final_norm; \
    float* VSS = (float*)(ws + WS_SSP); float* LOGF = (float*)(ws + WS_LOGF); unsigned long long* CA = (unsigned long long*)(ws + WS_CA); \
    bf16_t* WSB = (bf16_t*)(ws + WS_WSB); bf16_t* WFH = (bf16_t*)(ws + WS_WF); bf16_t* WFL = WFH + 16 * DM; \
    bf16_t* W_AIN = (bf16_t*)(ws + WS_W_AIN); bf16_t* W_AOUT = (bf16_t*)(ws + WS_W_AOUT); bf16_t* W_KV = (bf16_t*)(ws + WS_W_KV); bf16_t* W_QG = (bf16_t*)(ws + WS_W_QG); \
    bf16_t* W_BOUT = (bf16_t*)(ws + WS_W_BOUT); bf16_t* W_UP = (bf16_t*)(ws + WS_W_UP); bf16_t* W_DN = (bf16_t*)(ws + WS_W_DN); \
    bf16_t* HB = (bf16_t*)(ws + WS_XN); float* RSS = (float*)(ws + WS_XN2); bf16_t* KVB = (bf16_t*)(ws + WS_KV); bf16_t* BIG = (bf16_t*)(ws + WS_BIG); bf16_t* ACT = (bf16_t*)(ws + WS_ACT); \
    (void)VSS; (void)LOGF; (void)CA; (void)WSB; (void)WFH; (void)WFL; (void)W_AIN; (void)W_AOUT; (void)W_KV; (void)W_QG; (void)W_BOUT; (void)W_UP; (void)W_DN; (void)HB; (void)RSS; (void)KVB; (void)BIG; (void)ACT;
typedef pg8::EpiBf<1, true> EPI_A1; typedef pg8::EpiBf<0, true, true, true> EPI_KV; typedef pg8::EpiBf<2, true, false, true> EPI_QG; typedef pg8::EpiBf<0, true> EPI_UP;
#define GEMM_PHASE(EPI, Aptr, Bptr, NN, KK, ...) do { pg8::Gemm g_{Aptr, Bptr, MT, NN, KK}; pg8::StaticOrder S_; S_.init(MT, NN, G, (int)blockIdx.x); EPI E_{__VA_ARGS__}; \
    pg8::gemm_phase<EPI, pg8::StaticOrder, true, true>(ldsp, g_, S_, E_); } while (0)

__global__ void __launch_bounds__(NTHREADS, 2) fwd_megakernel(Args a) {
    extern __shared__ __attribute__((aligned(16))) unsigned char lds[];
    cg::grid_group grid = cg::this_grid();
#define GSYNC_CG() do { asm volatile("s_waitcnt vmcnt(0)" ::: "memory"); grid.sync(); } while (0)
#define GSYNC() xcd_barrier(xbar)
    const int wave = __builtin_amdgcn_readfirstlane(threadIdx.x >> 6);
    const int G = gridDim.x, gw = blockIdx.x * NWAVES + wave, NGW = G * NWAVES;
    LAS unsigned char* ldsp = (LAS unsigned char*)lds;
    if (threadIdx.x < 16) ((LAS unsigned*)(ldsp + MISC_OFF))[threadIdx.x] = 0u;
    __syncthreads();
    const XcdBarrier xbar = xcd_barrier_post((unsigned*)(kargs()->ws + WS_BAR), (volatile LAS unsigned*)(ldsp + MISC_OFF));

    {
        PTRS
        const int tid = opaque_tid(), lane = tid & 63;
        const int gt = blockIdx.x * NTHREADS + tid, NGT = G * NTHREADS;
        for (int i = gt; i < 2 * NG * CH * CH / 8; i += NGT) {
            const int e0 = i * 8, s0 = e0 & 127, t = (e0 >> 7) & 127; const f32x4 w0 = *(const f32x4*)(a_w_s + e0), w1 = *(const f32x4*)(a_w_s + e0 + 4);
            float y[8] = {w0.x, w0.y, w0.z, w0.w, w1.x, w1.y, w1.z, w1.w};
#pragma unroll
            for (int e = 0; e < 8; ++e) if (s0 + e > t) y[e] = 0.f;
            u32x4 o; o.x = pk2(y[0], y[1]); o.y = pk2(y[2], y[3]); o.z = pk2(y[4], y[5]); o.w = pk2(y[6], y[7]); *(u32x4*)(WSB + e0) = o; }
        for (int i = gt; i < 16 * DM; i += NGT) { const int n = i / DM, k = i % DM; const float w = kv_norm[k] * w_kvf[(size_t)k * 4112 + 4096 + n];
            const unsigned hi = pk2(w, 0.f) & 0xffffu; WFH[i] = (bf16_t)hi; WFL[i] = (bf16_t)(pk2(w - bf_lo(hi), 0.f) & 0xffffu); }
        LAS float* scr = (LAS float*)(ldsp + wave * TR_LDS_PER_WAVE);
        for (int it = gw; it < 48128 * (PROBE == 4 ? 2 : 1); it += NGW) {
            int r = it % 48128, K = DM, ld, ncols, mode = 0; const float* W; const float* g = nullptr; bf16_t* WT;
            if (r < 4096) { const int l = r >> 11; r &= 2047; W = a_w_in + (size_t)l * DM * 4096; g = a_norm + l * DM; WT = W_AIN + (size_t)l * 4096 * DM; ld = 4096; ncols = 4096; }
            else if ((r -= 4096) < 2048) { const int l = r >> 10; r &= 1023; W = a_w_out + (size_t)l * DM * DM; WT = W_AOUT + (size_t)l * DM * DM; ld = DM; ncols = DM; }
            else if ((r -= 2048) < 2048) { W = w_kvf; g = kv_norm; WT = W_KV; ld = 4112; ncols = 4096; }
            else if ((r -= 2048) < 4096) { const int l = r >> 11; r &= 2047; W = b_w_qg + (size_t)l * DM * 4096; g = b_norm + l * DM; WT = W_QG + (size_t)l * 4096 * DM; ld = 4096; ncols = 4096; }
            else if ((r -= 4096) < 2048) { const int l = r >> 10; r &= 1023; W = b_w_out + (size_t)l * DM * DM; WT = W_BOUT + (size_t)l * DM * DM; ld = DM; ncols = DM; }
            else if ((r -= 2048) < 22528) { const int l = r / 5632; r -= l * 5632; W = f_w_up + (size_t)l * DM * FF2; g = f_norm + l * DM; WT = W_UP + (size_t)l * FF2 * DM; ld = FF2; ncols = FF2; mode = 1; }
            else { r -= 22528; const int l = r / 2816; r -= l * 2816; W = f_w_down + (size_t)l * FF * DM; WT = W_DN + (size_t)l * DM * FF; K = FF; ld = DM; ncols = DM; }
            transpose_item(W, K, ld, ncols, g, WT, mode, scr, r, lane);
        }
        for (int m = gw; m < MT; m += NGW) {
            const f32x4* xr = (const f32x4*)(x + (size_t)m * DM) + lane; u32x2* o = (u32x2*)(HB + (size_t)m * DM) + lane; float sq = 0.f;
#pragma unroll
            for (int j = 0; j < 8; ++j) { const f32x4 v = xr[64 * j]; sq += (v.x * v.x + v.y * v.y) + (v.z * v.z + v.w * v.w); u32x2 w; w.x = pk2(v.x, v.y); w.y = pk2(v.z, v.w); o[64 * j] = w; }
            sq = wave_sum(sq, lane); if (lane < 32) RSS[(size_t)m * 32 + lane] = lane == 0 ? sq : 0.f;
        }
    }
    GSYNC_CG();

    for (int l = 0; l < 4; ++l) {
        if (l < 2) {
            for (int rep_ = 0; rep_ < (PROBE == 10 ? 2 : 1); ++rep_) {
            { PTRS GEMM_PHASE(EPI_A1, HB, W_AIN + (size_t)l * 4096 * DM, 4096, DM, BIG, 4096, 8, VSS, RSS, nullptr, nullptr, (LAS float*)(ldsp + RRW_OFF)); }
            GSYNC(); }
            for (int rep_ = 0; rep_ < (PROBE == 6 ? 2 : 1); ++rep_) { if (rep_) GSYNC();
            { PTRS const int lane = opaque_tid() & 63;
              spatial_phase(ldsp, BIG, VSS, WSB + (size_t)l * NG * CH * CH, a_v_norm + (size_t)l * DM, a_b_s + (size_t)l * NG * CH, ACT, wave, lane); } }
            GSYNC();
        } else {
            const int j = l - 2;
            if (j == 0) { { PTRS const int lane = opaque_tid() & 63; fgate_rows(HB, RSS, WFH, WFL, b_f, LOGF, gw, NGW, lane); }
                          PTRS GEMM_PHASE(EPI_KV, HB, W_KV, 4096, DM, KVB, 4096, 1 << 30, nullptr, RSS, k_norm, (LAS float*)(ldsp + XS_OFF), (LAS float*)(ldsp + RRW_OFF)); }
            { PTRS GEMM_PHASE(EPI_QG, HB, W_QG + (size_t)j * 4096 * DM, 4096, DM, BIG, 4096, 8, nullptr, RSS, q_norm + (size_t)j * HD, (LAS float*)(ldsp + XS_OFF), (LAS float*)(ldsp + RRW_OFF)); }
            GSYNC();
            if (j == 0) { { PTRS const int lane = opaque_tid() & 63; if (blockIdx.x < 8) scan_seq(LOGF, CA, blockIdx.x * 8 + wave, lane); }
                          GSYNC(); }
            for (int rep_ = 0; rep_ < (PROBE == 2 ? 2 : 1); ++rep_) {
            { PTRS att::AttnT T{(const att::bf16*)BIG, (const att::bf16*)KVB, (const att::bf16*)(KVB + (size_t)MT * 2048), (att::bf16*)ACT, BIG + 2048, CA};
              att::attn_phase((char*)lds, T, NB, NH, SEQ); }
            GSYNC(); }
        }
        { PTRS const bf16_t* Wt = l < 2 ? W_AOUT + (size_t)l * DM * DM : W_BOUT + (size_t)(l - 2) * DM * DM;
          GEMM_PHASE(pg8::EpiRes, ACT, Wt, DM, DM, HB, RSS, DM);
        }
        GSYNC();
        { PTRS GEMM_PHASE(EPI_UP, HB, W_UP + (size_t)l * FF2 * DM, FF2, DM, BIG, FF2, 1 << 30, nullptr, RSS, nullptr, nullptr, (LAS float*)(ldsp + RRW_OFF)); }
        GSYNC();
#if PROBE == 1
        { PTRS GEMM_PHASE(EPI_UP, HB, W_UP + (size_t)l * FF2 * DM, FF2, DM, BIG, FF2, 1 << 30, nullptr, RSS, nullptr, nullptr, (LAS float*)(ldsp + RRW_OFF)); }
        GSYNC();
#endif
        { PTRS conv_phase(BIG, f_conv_w + (size_t)l * 3 * FF2, f_conv_b + (size_t)l * FF2, ACT); }
        GSYNC();
#if PROBE == 3
        { PTRS conv_phase(BIG, f_conv_w + (size_t)l * 3 * FF2, f_conv_b + (size_t)l * FF2, ACT); }
        GSYNC();
#endif
        { PTRS GEMM_PHASE(pg8::EpiRes, ACT, W_DN + (size_t)l * DM * FF, DM, FF, HB, RSS, DM);
        }
        GSYNC();
    }
#if PROBE == 7
    for (int rep_ = 0; rep_ < 20; ++rep_) GSYNC();
#endif
    { PTRS const int lane = opaque_tid() & 63;
      for (int m = gw; m < MT; m += NGW) {
          const float part = lane < 32 ? RSS[(size_t)m * 32 + lane] : 0.f; const float r = 1.0f / sqrtf(wave_sum(part, lane) * (1.0f / DM) + EPS);
          const u32x4* p = (const u32x4*)(HB + (size_t)m * DM) + lane; float* orow = h + (size_t)m * DM;
#pragma unroll
          for (int j = 0; j < 4; ++j) { const u32x4 w = p[64 * j]; const int c = (64 * j + lane) * 8; const f32x4 g0 = *(const f32x4*)(final_norm + c), g1 = *(const f32x4*)(final_norm + c + 4);
              f32x4 o0 = {bf_lo(w.x) * r * g0[0], bf_hi(w.x) * r * g0[1], bf_lo(w.y) * r * g0[2], bf_hi(w.y) * r * g0[3]}, o1 = {bf_lo(w.z) * r * g1[0], bf_hi(w.z) * r * g1[1], bf_lo(w.w) * r * g1[2], bf_hi(w.w) * r * g1[3]};
              *(f32x4*)(orow + c) = o0; *(f32x4*)(orow + c + 4) = o1; } } }
}

extern "C" void kernel_launch(void* const* d_in, const int* in_sizes, int n_in, void* d_out, int out_size, void* d_ws, size_t ws_size, hipStream_t stream) {
    static int grid = 0;
    if (grid == 0) {
        if (n_in != 21 || out_size != MT * DM || ws_size < WS_END) { fprintf(stderr, "kernel_launch: unexpected shapes (n_in %d out %d ws %zu, need ws >= %zu)\n", n_in, out_size, ws_size, (size_t)WS_END); grid = -1; return; }
        int dev = 0, cus = 0, per_cu = 0;
        (void)hipGetDevice(&dev); (void)hipDeviceGetAttribute(&cus, hipDeviceAttributeMultiprocessorCount, dev);
        (void)hipFuncSetAttribute((const void*)fwd_megakernel, hipFuncAttributeMaxDynamicSharedMemorySize, LDS_BYTES);
        (void)hipOccupancyMaxActiveBlocksPerMultiprocessor(&per_cu, (const void*)fwd_megakernel, NTHREADS, LDS_BYTES);
        if (per_cu < 1) { fprintf(stderr, "kernel_launch: occupancy query says %d blocks per CU\n", per_cu); per_cu = 1; }
        grid = cus * 1;
        (void)hipGetLastError();
    }
    if (grid < 0) return;
    (void)hipMemsetAsync((char*)d_ws + WS_BAR, 0, BAR_ZERO_BYTES, stream);
    Args a{};
    for (int i = 0; i < 21; ++i) a.in[i] = (const float*)d_in[i];
    a.out = (float*)d_out; a.ws = (unsigned char*)d_ws;
    void* args[] = {&a};
    hipError_t e = hipLaunchCooperativeKernel((const void*)fwd_megakernel, dim3(grid), dim3(NTHREADS), args, LDS_BYTES, stream);
    if (e != hipSuccess) fprintf(stderr, "cooperative launch failed: %s (grid %d)\n", hipGetErrorString(e), grid);
}
```

```cpp
#include <hip/hip_runtime.h>
#include <hip/hip_cooperative_groups.h>
#include <hip/hip_bf16.h>
#include <cstdio>
#include <cstdint>
namespace cg = cooperative_groups;
#ifndef PROBE
#define PROBE 0
#endif
__device__ __forceinline__ float lane_read(float v, int src_lane) { return __builtin_bit_cast(float, __builtin_amdgcn_ds_bpermute(src_lane << 2, __builtin_bit_cast(int, v))); }
__device__ __forceinline__ int opaque_tid() { int t = threadIdx.x; asm volatile("" : "+v"(t)); return t; }
namespace pg8 {
#define PG8_LAS __attribute__((address_space(3)))
typedef unsigned short bf16_t;
typedef short bf16x8 __attribute__((ext_vector_type(8)));
typedef float f32x4 __attribute__((ext_vector_type(4)));
typedef unsigned u32x4 __attribute__((ext_vector_type(4)));
constexpr int BM = 256, BK = 64, HALF = 128, HTB = HALF * BK * 2  , STAGE_BYTES = 8 * HTB, NXCD = 8, WGM = 8;

__host__ __device__ __forceinline__ int lds_byte(int r, int c) { const int st = (r >> 4) * 2 + (c >> 5), rr = r & 15, cc = c & 31, ob = rr * 64 + cc * 2; return st * 1024 + (ob ^ (((ob >> 9) & 1) << 5)); }
__host__ __device__ __forceinline__ void stage_rc(int b, int& R, int& C) { const int st = b / 1024, sb = b % 1024, swz = sb ^ (((sb >> 9) & 1) << 5); R = (st >> 1) * 16 + swz / 64; C = (st & 1) * 32 + (swz % 64) / 2; }
__host__ __device__ __forceinline__ int perm32(int rho) { const int n = rho >> 4, i = rho & 15; return 8 * (i >> 2) + 4 * n + (i & 3); }

struct Unit { int pm, pn; };
struct Gemm { const bf16_t* A; const bf16_t* Bt; int M, N, K; };

struct StaticOrder {
    int nM, nN, nwg, G, c;
    __host__ __device__ void init(int M, int N, int G_, int c_) { nM = M / BM; nN = N / BM; nwg = nM * nN; G = G_; c = c_; }
    __host__ __device__ bool next(int i, Unit& u) const {
        const long L = (long)i * G + c; if (L >= nwg) return false;
        int wgid = (int)L; { const int q = nwg / NXCD, r = nwg % NXCD, xcd = wgid % NXCD, off = wgid / NXCD; wgid = (xcd < r ? xcd * (q + 1) : r * (q + 1) + (xcd - r) * q) + off; }
        const int nig = WGM * nN, gid = wgid / nig, fm = gid * WGM, gsz = (nM - fm) < WGM ? (nM - fm) : WGM;
        u.pm = fm + ((wgid % nig) % gsz); u.pn = (wgid % nig) / gsz; return true;
    }
    __device__ __forceinline__ void a_ready(const Unit&) const {}
    __device__ __forceinline__ void done(const Unit&) const {}
};

__device__ __forceinline__ unsigned cvt_pk_bf16(float lo, float hi) { unsigned r; asm volatile("v_cvt_pk_bf16_f32 %0, %1, %2" : "=v"(r) : "v"(lo), "v"(hi)); return r; }
typedef float f32x2 __attribute__((ext_vector_type(2)));
__device__ __forceinline__ f32x2 gelu_pk(f32x2 v) {
    const f32x2 av = __builtin_elementwise_abs(v), d = av * 0.2316418882f + 1.0f;
    f32x2 t; t.x = __builtin_amdgcn_rcpf(d.x); t.y = __builtin_amdgcn_rcpf(d.y);
    f32x2 q = t * 0.5307027145f + (-0.7265760135f); q = q * t + 0.7107068705f; q = q * t + (-0.142248368f); q = q * t + 0.127414796f; q = q * t;
    const f32x2 s = (v * v) * (-0.72134752044f);
    f32x2 e; e.x = __builtin_amdgcn_exp2f(s.x); e.y = __builtin_amdgcn_exp2f(s.y);
    const f32x2 m = v * (q * e), r = v - m;
    f32x2 o; o.x = v.x < 0.f ? m.x : r.x; o.y = v.y < 0.f ? m.y : r.y; return o;
}
constexpr float RS_INV = 1.0f / 2048.0f, RS_EPS = 1e-6f;
template <int MODE, bool RSCALE, bool HEADMAJOR = false, bool HN = false> struct EpiBf {
    static constexpr bool PERM = true, AFTER_DRAIN = false, IDEMPOTENT = true;
    bf16_t* O; int ldc; int split_pn; float* ss; const float* rs; const float* hgain; PG8_LAS float* xs; PG8_LAS float* rrw;
    __device__ __forceinline__ void load_raw(const Unit& u, int ai, int wr, int fr, int fq, f32x4 (&raw)[4][2]) const {
#pragma unroll
        for (int m = 0; m < 4; ++m) { const f32x4* p = (const f32x4*)(rs + (size_t)(u.pm * BM + wr * 64 + fr + ai * HALF + m * 16) * 32 + fq * 8); raw[m][0] = p[0]; raw[m][1] = p[1]; }
    }
    __device__ __forceinline__ void reduce_raw(const f32x4 (&raw)[4][2], int ai, int wr, int wc, int fr, int fq) const {
#pragma unroll
        for (int m = 0; m < 4; ++m) { const f32x4 a = raw[m][0], b = raw[m][1];
            float t = ((a[0] + a[1]) + (a[2] + a[3])) + ((b[0] + b[1]) + (b[2] + b[3])); t += lane_read(t, (fq * 16 + fr) ^ 16); t += lane_read(t, (fq * 16 + fr) ^ 32);
            if (fq == 0) rrw[((wr * 4 + wc) * 8 + ai * 4 + m) * 16 + fr] = 1.0f / sqrtf(t * RS_INV + RS_EPS); }
    }
    __device__ __forceinline__ void init(const Unit& u, int wr, int wc, int fr, int fq) const {
        if (RSCALE) { f32x4 raw[4][2]; load_raw(u, 0, wr, fr, fq, raw); reduce_raw(raw, 0, wr, wc, fr, fq); load_raw(u, 1, wr, fr, fq, raw); reduce_raw(raw, 1, wr, wc, fr, fq); }
    }
    __device__ __forceinline__ void operator()(const f32x4 (&acc)[2][2][4][2], const Unit& u, const Unit& nxt, bool has_next, int wr, int wc, int fr, int fq) const {
        const int row0 = u.pm * BM + wr * 64 + fr, col0 = u.pn * BM + wc * 32 + 8 * fq;
        const bool up = u.pn >= split_pn;
        float rr[2][4]; f32x4 raw[4][2];
#pragma unroll
        for (int ai = 0; ai < 2; ++ai)
#pragma unroll
            for (int m = 0; m < 4; ++m) rr[ai][m] = RSCALE ? rrw[((wr * 4 + wc) * 8 + ai * 4 + m) * 16 + fr] : 1.f;
        if (RSCALE) asm volatile("s_waitcnt lgkmcnt(0)" ::: "memory");
        f32x4 hg0 = {1.f, 1.f, 1.f, 1.f}, hg1 = hg0; const bool hn = HN && u.pn < 8;
        if (HN) { if (hn) {
#pragma unroll
            for (int ai = 0; ai < 2; ++ai)
#pragma unroll
                for (int m = 0; m < 4; ++m)
#pragma unroll
                    for (int bj = 0; bj < 2; ++bj) { const f32x4 v0 = acc[ai][bj][m][0] * rr[ai][m], v1 = acc[ai][bj][m][1] * rr[ai][m];
                        float t = ((v0[0] * v0[0] + v0[1] * v0[1]) + (v0[2] * v0[2] + v0[3] * v0[3])) + ((v1[0] * v1[0] + v1[1] * v1[1]) + (v1[2] * v1[2] + v1[3] * v1[3]));
                        t += lane_read(t, (fq * 16 + fr) ^ 16); t += lane_read(t, (fq * 16 + fr) ^ 32);
                        if (fq == 0) xs[(ai * HALF + wr * 64 + m * 16 + fr) * 8 + bj * 4 + wc] = t; }
            asm volatile("s_waitcnt lgkmcnt(0)" ::: "memory"); __builtin_amdgcn_s_barrier(); asm volatile("" ::: "memory");
            hg0 = *(const f32x4*)(hgain + wc * 32 + 8 * fq); hg1 = *(const f32x4*)(hgain + wc * 32 + 8 * fq + 4);
        } }
#pragma unroll
        for (int ai = 0; ai < 2; ++ai) {
            if (RSCALE) { if (has_next) load_raw(nxt, ai, wr, fr, fq, raw); }
#pragma unroll
            for (int m = 0; m < 4; ++m) { const int row = row0 + ai * HALF + m * 16; float s = 0.f; float hnr[2] = {1.f, 1.f};
                if (HN) { if (hn) { const PG8_LAS f32x4* xp = (const PG8_LAS f32x4*)(xs + (ai * HALF + wr * 64 + m * 16 + fr) * 8); const f32x4 a = xp[0], b = xp[1];
                    hnr[0] = 1.0f / sqrtf(((a[0] + a[1]) + (a[2] + a[3])) * (1.0f / 128.0f) + RS_EPS); hnr[1] = 1.0f / sqrtf(((b[0] + b[1]) + (b[2] + b[3])) * (1.0f / 128.0f) + RS_EPS); } }
                bf16_t* rowp = HEADMAJOR ? O + (u.pn >= 8 ? (size_t)16384 * 2048 : (size_t)0) + ((size_t)((row >> 12) * 16 + 2 * (u.pn & 7)) * 4096 + (row & 4095)) * 128 + wc * 32 + 8 * fq
                                         : O + (size_t)row * ldc + col0;
#pragma unroll
                for (int bj = 0; bj < 2; ++bj) { f32x4 v0 = acc[ai][bj][m][0], v1 = acc[ai][bj][m][1];
                    if (RSCALE) { v0 = v0 * rr[ai][m]; v1 = v1 * rr[ai][m]; }
                    if (HN) { if (hn) { v0 = (v0 * hnr[bj]) * hg0; v1 = (v1 * hnr[bj]) * hg1; } }
                    if (MODE == 1) { f32x2 a = gelu_pk((f32x2){v0[0], v0[1]}), b = gelu_pk((f32x2){v0[2], v0[3]}), c = gelu_pk((f32x2){v1[0], v1[1]}), d = gelu_pk((f32x2){v1[2], v1[3]});
                        v0 = (f32x4){a.x, a.y, b.x, b.y}; v1 = (f32x4){c.x, c.y, d.x, d.y};
                        s += (v0[0] * v0[0] + v0[1] * v0[1]) + (v0[2] * v0[2] + v0[3] * v0[3]) + (v1[0] * v1[0] + v1[1] * v1[1]) + (v1[2] * v1[2] + v1[3] * v1[3]); }
                    if (MODE == 2) { if (up) {
#pragma unroll
                        for (int e = 0; e < 4; ++e) { v0[e] = __builtin_amdgcn_rcpf(1.0f + __builtin_amdgcn_exp2f(-1.4426950408889634f * v0[e])); v1[e] = __builtin_amdgcn_rcpf(1.0f + __builtin_amdgcn_exp2f(-1.4426950408889634f * v1[e])); } } }
                    u32x4 w; w.x = cvt_pk_bf16(v0[0], v0[1]); w.y = cvt_pk_bf16(v0[2], v0[3]); w.z = cvt_pk_bf16(v1[0], v1[1]); w.w = cvt_pk_bf16(v1[2], v1[3]);
                    *(u32x4*)(rowp + (HEADMAJOR ? (size_t)bj * 4096 * 128 : (size_t)bj * HALF)) = w; }
                if (MODE == 1) { if (up) { s += lane_read(s, (fq * 16 + fr) ^ 16); s += lane_read(s, (fq * 16 + fr) ^ 32); if (fq == 0) ss[(size_t)row * 32 + (u.pn - split_pn) * 4 + wc] = s; } } }
            if (RSCALE) { if (has_next) reduce_raw(raw, ai, wr, wc, fr, fq); } }
    }
};
struct EpiRes {
    static constexpr bool PERM = true, AFTER_DRAIN = false, IDEMPOTENT = false;
    bf16_t* hb; float* rss; int ldc;
    __device__ __forceinline__ void init(const Unit&, int, int, int, int) const {}
    __device__ __forceinline__ void operator()(const f32x4 (&acc)[2][2][4][2], const Unit& u, const Unit&, bool, int wr, int wc, int fr, int fq) const {
        const int row0 = u.pm * BM + wr * 64 + fr, col0 = u.pn * BM + wc * 32 + 8 * fq;
        u32x4 bn[2][2];
#pragma unroll
        for (int mm = 0; mm < 2; ++mm)
#pragma unroll
            for (int bj = 0; bj < 2; ++bj) bn[mm][bj] = *(const u32x4*)(hb + (size_t)(row0 + mm * 16) * ldc + col0 + bj * HALF);
#pragma unroll
        for (int c = 0; c < 4; ++c) { const int ai = c >> 1; u32x4 b[2][2];
#pragma unroll
            for (int mm = 0; mm < 2; ++mm)
#pragma unroll
                for (int bj = 0; bj < 2; ++bj) b[mm][bj] = bn[mm][bj];
            if (c < 3) { const int c1 = c + 1, ai1 = c1 >> 1;
#pragma unroll
                for (int mm = 0; mm < 2; ++mm)
#pragma unroll
                    for (int bj = 0; bj < 2; ++bj) bn[mm][bj] = *(const u32x4*)(hb + (size_t)(row0 + ai1 * HALF + (2 * (c1 & 1) + mm) * 16) * ldc + col0 + bj * HALF); }
#pragma unroll
            for (int mm = 0; mm < 2; ++mm) { const int m = 2 * (c & 1) + mm; const int row = row0 + ai * HALF + m * 16; const size_t off = (size_t)row * ldc + col0; float s = 0.f;
#pragma unroll
                for (int bj = 0; bj < 2; ++bj) { const u32x4 q = b[mm][bj];
                    const f32x4 o0 = (f32x4){__uint_as_float(q.x << 16), __uint_as_float(q.x & 0xffff0000u), __uint_as_float(q.y << 16), __uint_as_float(q.y & 0xffff0000u)} + acc[ai][bj][m][0];
                    const f32x4 o1 = (f32x4){__uint_as_float(q.z << 16), __uint_as_float(q.z & 0xffff0000u), __uint_as_float(q.w << 16), __uint_as_float(q.w & 0xffff0000u)} + acc[ai][bj][m][1];
                    u32x4 w; w.x = cvt_pk_bf16(o0[0], o0[1]); w.y = cvt_pk_bf16(o0[2], o0[3]); w.z = cvt_pk_bf16(o1[0], o1[1]); w.w = cvt_pk_bf16(o1[2], o1[3]);
                    *(u32x4*)(hb + off + bj * HALF) = w;
                    s += ((o0[0] * o0[0] + o0[1] * o0[1]) + (o0[2] * o0[2] + o0[3] * o0[3])) + ((o1[0] * o1[0] + o1[1] * o1[1]) + (o1[2] * o1[2] + o1[3] * o1[3])); }
                s += lane_read(s, (fq * 16 + fr) ^ 16); s += lane_read(s, (fq * 16 + fr) ^ 32); if (fq == 0) rss[(size_t)row * 32 + u.pn * 4 + wc] = s; } }
    }
};
template <class Epi, class Sched, bool ALIGN_EPI = false, bool SP2 = false>
__device__ __forceinline__ void gemm_phase(PG8_LAS unsigned char* lds, const Gemm g, const Sched& S, const Epi& E) {
    const int tid = opaque_tid(), wid = __builtin_amdgcn_readfirstlane(tid >> 6), lane = tid & 63, wr = wid >> 2, wc = wid & 3, fr = lane & 15, fq = lane >> 4;
    const int K = g.K, nt = K / BK;
    unsigned voffA[2], voffB[2];
#pragma unroll
    for (int i = 0; i < 2; ++i) { int R, C; stage_rc(tid * 16 + i * 8192, R, C); const int Rb = Epi::PERM ? ((R & ~31) + perm32(R & 31)) : R;
        voffA[i] = (unsigned)(R * K + C) * 2u; voffB[i] = (unsigned)(Rb * K + C) * 2u; }
    const size_t kstep = (size_t)(BK * 2);
    const size_t hstep = (size_t)HALF * K * 2;
    const size_t tstep = 2 * hstep;
    const unsigned ldsw = (unsigned)wid * 1024u;
    const int aoff = lds_byte(wr * 64 + fr, fq * 8), boff = lds_byte(wc * 32 + fr, fq * 8);
#define PG8_SA(b, h) (((b) * 2 + (h)) * HTB)
#define PG8_SB(b, h) ((4 + (b) * 2 + (h)) * HTB)
#define PG8_STAGE(bufoff, gbase, voff) do { _Pragma("unroll") for (int _i = 0; _i < 2; ++_i) \
        __builtin_amdgcn_global_load_lds((const unsigned*)((const char*)(gbase) + (voff)[_i]), (PG8_LAS unsigned*)(lds + (bufoff) + ldsw + _i * 8192), 16, 0, 0); } while (0)
#define PG8_LDA(dst, b, h) do { _Pragma("unroll") for (int m = 0; m < 4; ++m) _Pragma("unroll") for (int k = 0; k < 2; ++k) dst[m][k] = *(const PG8_LAS bf16x8*)(lds + PG8_SA(b, h) + aoff + m * 2048 + k * 1024); } while (0)
#define PG8_LDB(dst, b, h) do { _Pragma("unroll") for (int n = 0; n < 2; ++n) _Pragma("unroll") for (int k = 0; k < 2; ++k) dst[n][k] = *(const PG8_LAS bf16x8*)(lds + PG8_SB(b, h) + boff + n * 2048 + k * 1024); } while (0)
#define PG8_MMA(ai, bj, At, Bt) do { __builtin_amdgcn_s_setprio(1); _Pragma("unroll") for (int m = 0; m < 4; ++m) _Pragma("unroll") for (int n = 0; n < 2; ++n) _Pragma("unroll") for (int k = 0; k < 2; ++k) \
        acc[ai][bj][m][n] = __builtin_amdgcn_mfma_f32_16x16x32_bf16(Bt[n][k], At[m][k], acc[ai][bj][m][n], 0, 0, 0); __builtin_amdgcn_s_setprio(0); } while (0)
#define PG8_WAIT_V(n) asm volatile("s_waitcnt vmcnt(" #n ")" ::: "memory")
#define PG8_WAIT_L(n) asm volatile("s_waitcnt lgkmcnt(" #n ")" ::: "memory")
#define PG8_BAR __builtin_amdgcn_s_barrier()
#define PG8_SCHED __builtin_amdgcn_sched_barrier(0)
    Unit cur, nxt; int ui = 0;
    if (!S.next(0, cur)) return;
    E.init(cur, wr, wc, fr, fq);
    f32x4 acc[2][2][4][2];
#pragma unroll
    for (int a = 0; a < 2; ++a)
#pragma unroll
        for (int b = 0; b < 2; ++b)
#pragma unroll
            for (int m = 0; m < 4; ++m)
#pragma unroll
                for (int n = 0; n < 2; ++n) acc[a][b][m][n] = (f32x4){0.f, 0.f, 0.f, 0.f};
    bf16x8 At[4][2], B0[2][2], B1[2][2];
    const char* cA = (const char*)g.A + (size_t)cur.pm * tstep; const char* cB = (const char*)g.Bt + (size_t)cur.pn * tstep;
    S.a_ready(cur);
    if constexpr (SP2) {
        PG8_STAGE(PG8_SB(0, 0), cB, voffB); PG8_STAGE(PG8_SB(0, 1), cB + hstep, voffB); PG8_STAGE(PG8_SA(0, 0), cA, voffA); PG8_STAGE(PG8_SA(0, 1), cA + hstep, voffA);
        if (wr == 1) PG8_BAR;
        PG8_WAIT_V(2); PG8_BAR;
        PG8_STAGE(PG8_SB(1, 0), cB + kstep, voffB); PG8_STAGE(PG8_SA(1, 0), cA + kstep, voffA); PG8_STAGE(PG8_SB(1, 1), cB + hstep + kstep, voffB);
        PG8_WAIT_V(6); PG8_BAR;
    } else {
        PG8_STAGE(PG8_SB(0, 0), cB, voffB); PG8_STAGE(PG8_SA(0, 0), cA, voffA); PG8_STAGE(PG8_SB(0, 1), cB + hstep, voffB); PG8_STAGE(PG8_SA(0, 1), cA + hstep, voffA);
        if (wr == 1) PG8_BAR;
        PG8_WAIT_V(4); PG8_BAR;
        PG8_STAGE(PG8_SB(1, 0), cB + kstep, voffB); PG8_STAGE(PG8_SA(1, 0), cA + kstep, voffA); PG8_STAGE(PG8_SB(1, 1), cB + hstep + kstep, voffB);
        PG8_WAIT_V(6); PG8_BAR;
    }
    for (;;) {
        const bool has_next = S.next(ui + 1, nxt);
        const char* nA = has_next ? (const char*)g.A + (size_t)nxt.pm * tstep : cA; const char* nB = has_next ? (const char*)g.Bt + (size_t)nxt.pn * tstep : cB;
        for (int t = 0; t < nt; t += 2) {
            const bool last = (t == nt - 2);
            const char* a1 = cA + (size_t)(t + 1) * kstep;
            const char* a2 = last ? nA : cA + (size_t)(t + 2) * kstep; const char* b2 = last ? nB : cB + (size_t)(t + 2) * kstep;
            const char* a3 = a2 + kstep; const char* b3 = b2 + kstep;
            if (last && has_next) S.a_ready(nxt);
            if constexpr (SP2) {
            PG8_LDB(B0, 0, 0); PG8_LDB(B1, 0, 1); PG8_SCHED; PG8_LDA(At, 0, 0); PG8_STAGE(PG8_SA(1, 1), a1 + hstep, voffA);
            PG8_WAIT_V(8); PG8_WAIT_L(0); PG8_BAR; PG8_MMA(0, 0, At, B0); PG8_MMA(0, 1, At, B1); PG8_BAR; PG8_SCHED;
            PG8_LDA(At, 0, 1); PG8_STAGE(PG8_SB(0, 0), b2, voffB); PG8_STAGE(PG8_SB(0, 1), b2 + hstep, voffB); PG8_STAGE(PG8_SA(0, 0), a2, voffA);
            PG8_WAIT_V(8); PG8_WAIT_L(0); PG8_BAR; PG8_MMA(1, 0, At, B0); PG8_MMA(1, 1, At, B1); PG8_BAR; PG8_SCHED;
            PG8_LDB(B0, 1, 0); PG8_LDB(B1, 1, 1); PG8_SCHED; PG8_LDA(At, 1, 0); PG8_STAGE(PG8_SA(0, 1), a2 + hstep, voffA);
            PG8_WAIT_V(8); PG8_WAIT_L(0); PG8_BAR; PG8_MMA(0, 0, At, B0); PG8_MMA(0, 1, At, B1); PG8_BAR; PG8_SCHED;
            PG8_LDA(At, 1, 1); PG8_STAGE(PG8_SB(1, 0), b3, voffB); PG8_STAGE(PG8_SB(1, 1), b3 + hstep, voffB); PG8_STAGE(PG8_SA(1, 0), a3, voffA);
            PG8_WAIT_V(8); PG8_WAIT_L(0); PG8_BAR; PG8_MMA(1, 0, At, B0); PG8_MMA(1, 1, At, B1); PG8_BAR; PG8_SCHED;
            } else {
            PG8_LDB(B0, 0, 0); PG8_SCHED; PG8_LDA(At, 0, 0); PG8_STAGE(PG8_SA(1, 1), a1 + hstep, voffA);
            PG8_WAIT_L(8); PG8_BAR; PG8_WAIT_L(0); PG8_MMA(0, 0, At, B0); PG8_BAR; PG8_SCHED;
            PG8_LDB(B1, 0, 1); PG8_STAGE(PG8_SB(0, 0), b2, voffB);
            PG8_BAR; PG8_WAIT_L(0); PG8_MMA(0, 1, At, B1); PG8_BAR;
            PG8_LDA(At, 0, 1); PG8_STAGE(PG8_SA(0, 0), a2, voffA);
            PG8_BAR; PG8_WAIT_L(0); PG8_MMA(1, 0, At, B0); PG8_BAR; PG8_SCHED;
            PG8_STAGE(PG8_SB(0, 1), b2 + hstep, voffB);
            PG8_WAIT_V(6); PG8_BAR; PG8_MMA(1, 1, At, B1); PG8_BAR;
            PG8_LDB(B0, 1, 0); PG8_SCHED; PG8_LDA(At, 1, 0); PG8_STAGE(PG8_SA(0, 1), a2 + hstep, voffA);
            PG8_WAIT_L(8); PG8_BAR; PG8_WAIT_L(0); PG8_MMA(0, 0, At, B0); PG8_BAR; PG8_SCHED;
            PG8_LDB(B1, 1, 1); PG8_STAGE(PG8_SB(1, 0), b3, voffB);
            PG8_BAR; PG8_WAIT_L(0); PG8_MMA(0, 1, At, B1); PG8_BAR;
            PG8_LDA(At, 1, 1); PG8_STAGE(PG8_SA(1, 0), a3, voffA);
            PG8_BAR; PG8_WAIT_L(0); PG8_MMA(1, 0, At, B0); PG8_BAR; PG8_SCHED;
            PG8_STAGE(PG8_SB(1, 1), b3 + hstep, voffB);
            PG8_WAIT_V(6); PG8_BAR; PG8_MMA(1, 1, At, B1); PG8_BAR;
            }
        }
        if constexpr (ALIGN_EPI) { if (wr == 0) PG8_BAR; }
        if constexpr (!Epi::AFTER_DRAIN) { E(acc, cur, nxt, has_next, wr, wc, fr, fq); S.done(cur); }
        if (!has_next) break;
#pragma unroll
        for (int a = 0; a < 2; ++a)
#pragma unroll
            for (int b = 0; b < 2; ++b)
#pragma unroll
                for (int m = 0; m < 4; ++m)
#pragma unroll
                    for (int n = 0; n < 2; ++n) acc[a][b][m][n] = (f32x4){0.f, 0.f, 0.f, 0.f};
        cur = nxt; cA = nA; cB = nB; ++ui;
        if constexpr (ALIGN_EPI) { if (wr == 1) PG8_BAR; }
    }
    PG8_WAIT_V(0);
    if constexpr (!ALIGN_EPI) { if (wr == 0) PG8_BAR; }
    PG8_BAR;
    if constexpr (Epi::AFTER_DRAIN) { E.fused(acc, cur, wr, wc, fr, fq, lds, wid, lane); S.done(cur); }
#undef PG8_SA
#undef PG8_SB
#undef PG8_STAGE
#undef PG8_LDA
#undef PG8_LDB
#undef PG8_MMA
#undef PG8_WAIT_V
#undef PG8_WAIT_L
#undef PG8_BAR
#undef PG8_SCHED
}
}
namespace att {
constexpr int D = 128, LDQ = 4096, LDK = 128, LDO = 2048, LDG = 4096;
constexpr float THR = 16.f; constexpr bool WSKIP = false;
typedef unsigned u32x4_t __attribute__((ext_vector_type(4)));
typedef short bf16x8_t __attribute__((ext_vector_type(8)));
__device__ __forceinline__ bf16x8_t ka_frag(unsigned lo, unsigned up, int hi) {
    u32x4_t w; w.x = hi ? 0u : lo; w.y = hi ? 0u : (up & 0xffffu); w.z = 0u; w.w = 0u;
    return __builtin_bit_cast(bf16x8_t, w);
}
__device__ __forceinline__ bf16x8_t qa_frag(int hi) {
    u32x4_t w; w.x = hi ? 0u : 0x3f803f80u; w.y = hi ? 0u : 0x00003f80u; w.z = 0u; w.w = 0u;
    return __builtin_bit_cast(bf16x8_t, w);
}
constexpr float SCALE = 0.08838834764831845f;
constexpr int NW = 8, QBLK = 32, KVBLK = 64, QB = NW * QBLK;
constexpr int SHM_V = KVBLK * D * 2, SHM_K = KVBLK * D * 2;
constexpr int ATT_LDS_BYTES = 2 * SHM_V + 2 * SHM_K + NW * 64 * 4;

using bf16 = __hip_bfloat16;
typedef short bf16x8 __attribute__((ext_vector_type(8)));
typedef short s16x4 __attribute__((ext_vector_type(4)));
typedef float f32x16 __attribute__((ext_vector_type(16)));
typedef float f32x4 __attribute__((ext_vector_type(4)));
typedef unsigned u32x4 __attribute__((ext_vector_type(4)));
template <class A, class Bt> struct same_t { static constexpr bool v = false; };
template <class A> struct same_t<A, A> { static constexpr bool v = true; };

#define KSWZ(row, colB) ((row) * 256 + ((colB) ^ (((row) & 7) << 4)))
#define SBAR() __builtin_amdgcn_sched_barrier(0)
__device__ __forceinline__ int v_st(int k, int c) { const int kk = (k & ~0xC) | ((k & 4) << 1) | ((k & 8) >> 1); return ((kk >> 3) * 4 + (c >> 5)) * 512 + ((kk & 7) * 32 + (c & 31)) * 2; }
__device__ __forceinline__ int v_rd_base(int lane) { return ((lane & 3) << 3) | (((lane >> 2) & 3) << 6) | (((lane >> 4) & 1) << 5) | (((lane >> 5) & 1) << 8); }
constexpr int v_rd_off(int d0, int ks, int half) { return d0 * 512 + ks * 4096 + half * 2048; }
__device__ __forceinline__ int crow(int r, int hi) { return (r & 3) + 8 * (r >> 2) + 4 * hi; }
__device__ __forceinline__ unsigned cvtpk(float lo, float hi) {
    unsigned r; asm volatile("v_cvt_pk_bf16_f32 %0, %1, %2" : "=v"(r) : "v"(lo), "v"(hi)); return r;
}
__device__ __forceinline__ bf16x8 pack8(f32x4 a, f32x4 b) {
    u32x4 w = {cvtpk(a[0], a[1]), cvtpk(a[2], a[3]), cvtpk(b[0], b[1]), cvtpk(b[2], b[3])};
    return *reinterpret_cast<bf16x8*>(&w);
}
template <class T> __device__ __forceinline__ bf16x8 load8(const T* p) {
    if constexpr (same_t<T, float>::v) { return pack8(*(const f32x4*)p, *(const f32x4*)(p + 4)); }
    else { return *reinterpret_cast<const bf16x8*>(p); }
}
__device__ __forceinline__ void mask_tile(f32x16& p0, f32x16& p1, int dq, unsigned W) {
    const float NEG = -__builtin_inff();
#pragma unroll
    for (int r = 0; r < 16; ++r) {
        const int c = (r & 3) + 8 * (r >> 2);
        if ((unsigned)(dq - c) >= W) p0[r] = NEG;
        if ((unsigned)(dq - c - 32) >= W) p1[r] = NEG;
    }
}
__device__ __forceinline__ void partialSM(f32x16& p0, f32x16& p1, float& m_reg, float& mn, float& alpha) {
    float pmax = p0[0]; for (int r = 1; r < 16; ++r) pmax = fmaxf(pmax, p0[r]); for (int r = 0; r < 16; ++r) pmax = fmaxf(pmax, p1[r]);
    { auto rr = __builtin_amdgcn_permlane32_swap(__float_as_uint(pmax), __float_as_uint(pmax), false, false);
      pmax = fmaxf(__uint_as_float(rr[0]), __uint_as_float(rr[1])); }
    constexpr float C2 = 1.4426950408889634f * SCALE;
    if (__builtin_expect(__all((pmax - m_reg) * SCALE <= THR), 1)) { mn = m_reg; alpha = 1.f; }
    else { mn = fmaxf(m_reg, pmax); alpha = __builtin_amdgcn_exp2f((m_reg - mn) * C2); m_reg = mn; }
    const float mnL = -mn * C2;
    for (int r = 0; r < 16; ++r) p0[r] = fmaf(p0[r], C2, mnL); for (int r = 0; r < 16; ++r) p1[r] = fmaf(p1[r], C2, mnL);
    for (int r = 0; r < 16; ++r) p0[r] = __builtin_amdgcn_exp2f(p0[r]);
}
__device__ __forceinline__ void finishSM(f32x16& p0, f32x16& p1, float alpha, float& l_reg, bf16x8& pa0, bf16x8& pa1, bf16x8& pa2, bf16x8& pa3) {
    for (int r = 0; r < 16; ++r) p1[r] = __builtin_amdgcn_exp2f(p1[r]);
    float ps = 0; for (int r = 0; r < 16; ++r) ps += p0[r]; for (int r = 0; r < 16; ++r) ps += p1[r];
    { auto rr = __builtin_amdgcn_permlane32_swap(__float_as_uint(ps), __float_as_uint(ps), false, false);
      ps = __uint_as_float(rr[0]) + __uint_as_float(rr[1]); }
    l_reg = l_reg * alpha + ps;
#define PK4(P, B_, OUT) do { unsigned a0 = cvtpk(P[B_+0], P[B_+1]), a1 = cvtpk(P[B_+2], P[B_+3]);                          \
        unsigned b0 = cvtpk(P[B_+4], P[B_+5]), b1 = cvtpk(P[B_+6], P[B_+7]);                                             \
        auto r0 = __builtin_amdgcn_permlane32_swap(a0, b0, false, false); auto r1 = __builtin_amdgcn_permlane32_swap(a1, b1, false, false); \
        u32x4 w = {r0[0], r1[0], r0[1], r1[1]}; OUT = *reinterpret_cast<bf16x8*>(&w); } while (0)
    PK4(p0, 0, pa0); PK4(p0, 8, pa1); PK4(p1, 0, pa2); PK4(p1, 8, pa3);
#undef PK4
}
template <int KB, bool SK>
__device__ __forceinline__ void qkt(f32x16& p0, f32x16& p1, const char* K_lds, int r32, int hi, const bf16x8* qr, bool act, unsigned long long c) {
    if (SK && !act) { const float NEG = -__builtin_inff();
#pragma unroll
        for (int r = 0; r < 16; ++r) { p0[r] = NEG; p1[r] = NEG; } return; }
    p0 = f32x16{}; p1 = f32x16{};
    const char* kb[4];
#pragma unroll
    for (int dd = 0; dd < 4; ++dd) kb[dd] = K_lds + KB * SHM_K + KSWZ(r32, (dd * 16 + hi * 8) * 2);
#pragma unroll
    for (int d0 = 0; d0 < 8; ++d0) { const char* a = kb[d0 & 3] + (d0 >> 2) * 128;
        bf16x8 b0 = *reinterpret_cast<const bf16x8*>(a);
        bf16x8 b1 = *reinterpret_cast<const bf16x8*>(a + 32 * 256);
        p0 = __builtin_amdgcn_mfma_f32_32x32x16_bf16(b0, qr[d0], p0, 0, 0, 0);
        p1 = __builtin_amdgcn_mfma_f32_32x32x16_bf16(b1, qr[d0], p1, 0, 0, 0); }
    { int h2 = hi; asm volatile("" : "+v"(h2));
      const bf16x8 qaf = qa_frag(h2);
      const unsigned cl = (unsigned)c, cu = (unsigned)(c >> 32);
      auto r0 = __builtin_amdgcn_permlane32_swap(cl, cl, false, false); auto r1 = __builtin_amdgcn_permlane32_swap(cu, cu, false, false);
      p0 = __builtin_amdgcn_mfma_f32_32x32x16_bf16(ka_frag(r0[0], r1[0], hi), qaf, p0, 0, 0, 0);
      p1 = __builtin_amdgcn_mfma_f32_32x32x16_bf16(ka_frag(r0[1], r1[1], hi), qaf, p1, 0, 0, 0); }
}
template <int VB, bool SK>
__device__ __forceinline__ void pv_tile(f32x16* o, int vb0, bf16x8 pa0, bf16x8 pa1, bf16x8 pa2, bf16x8 pa3, bool act) {
    if (SK && !act) return;
#define TRRD(dst, off) asm volatile("ds_read_b64_tr_b16 %0, %1 offset:%2" : "=&v"(dst) : "v"(vb0), "i"(off) : "memory")
#define PV_D0(d0) do { s16x4 l0, l1, l2, l3, h0, h1, h2, h3; constexpr int b_ = VB * SHM_V + v_rd_off(d0, 0, 0);     \
        TRRD(l0, b_); TRRD(h0, b_ + 2048); TRRD(l1, b_ + 4096); TRRD(h1, b_ + 6144); TRRD(l2, b_ + 8192); TRRD(h2, b_ + 10240); TRRD(l3, b_ + 12288); TRRD(h3, b_ + 14336); \
        asm volatile("s_waitcnt lgkmcnt(0)" ::: "memory"); SBAR();                 \
        o[d0] = __builtin_amdgcn_mfma_f32_32x32x16_bf16(pa0, (bf16x8){l0[0], l0[1], l0[2], l0[3], h0[0], h0[1], h0[2], h0[3]}, o[d0], 0, 0, 0);   \
        o[d0] = __builtin_amdgcn_mfma_f32_32x32x16_bf16(pa1, (bf16x8){l1[0], l1[1], l1[2], l1[3], h1[0], h1[1], h1[2], h1[3]}, o[d0], 0, 0, 0);   \
        o[d0] = __builtin_amdgcn_mfma_f32_32x32x16_bf16(pa2, (bf16x8){l2[0], l2[1], l2[2], l2[3], h2[0], h2[1], h2[2], h2[3]}, o[d0], 0, 0, 0);   \
        o[d0] = __builtin_amdgcn_mfma_f32_32x32x16_bf16(pa3, (bf16x8){l3[0], l3[1], l3[2], l3[3], h3[0], h3[1], h3[2], h3[3]}, o[d0], 0, 0, 0); } while (0)
    PV_D0(0); PV_D0(1); PV_D0(2); PV_D0(3);
#undef PV_D0
#undef TRRD
}

template <class TIn, class TOut> struct BlockRef { const TIn* Q; const TIn* K; const TIn* V; TOut* O; const unsigned short* G; const unsigned long long* CA; int P0; };
template <class TIn> struct Seam {
    bf16x8 qr[8];
    bf16x8 st_v0, st_v1, st_k0, st_k1; f32x4 sf0, sf1, sf2, sf3;
    unsigned long long ca;
    f32x4 tq[16];
};
__device__ __forceinline__ int swa_jlo(int P0, int W) { const int lowk = P0 - W + 1; return lowk > 0 ? lowk / KVBLK : 0; }
#define ROW(p, k0, rr) ((p) + (size_t)((k0) + (rr)) * LDK + sc)
#define VMW() asm volatile("s_waitcnt vmcnt(0)" ::: "memory")
#define VMWN(n) asm volatile("s_waitcnt vmcnt(%0)" :: "i"(n) : "memory")
#define SLOAD_H(Kp, Vp, CAp, k0) do { S.st_v0 = load8<TIn>(ROW(Vp, k0, sr)); S.st_v1 = load8<TIn>(ROW(Vp, k0, 32 + sr));              \
                         S.st_k0 = load8<TIn>(ROW(Kp, k0, sr)); S.st_k1 = load8<TIn>(ROW(Kp, k0, 32 + sr)); S.ca = (CAp)[(k0) + lane]; } while (0)
#define SWRITE_HK(bf) do { *(bf16x8*)(K_lds + (bf) * SHM_K + kws) = S.st_k0; *(bf16x8*)(K_lds + (bf) * SHM_K + kws + 32 * 256) = S.st_k1; } while (0)
#define SWRITE_HV(bf) do { *(bf16x8*)(V_lds + (bf) * SHM_V + vst0) = S.st_v0; *(bf16x8*)(V_lds + (bf) * SHM_V + vst1) = S.st_v1; } while (0)
#define SWRITE_H(bf) do { SWRITE_HV(bf); SWRITE_HK(bf); } while (0)
#define SLOAD_F(p, k0) do { S.sf0 = *(const f32x4*)ROW(p, k0, sr); S.sf1 = *(const f32x4*)(ROW(p, k0, sr) + 4);                \
                            S.sf2 = *(const f32x4*)ROW(p, k0, 32 + sr); S.sf3 = *(const f32x4*)(ROW(p, k0, 32 + sr) + 4); } while (0)
#define SWRITE_KF(bf) do { *(bf16x8*)(K_lds + (bf) * SHM_K + kws) = pack8(S.sf0, S.sf1); *(bf16x8*)(K_lds + (bf) * SHM_K + kws + 32 * 256) = pack8(S.sf2, S.sf3); } while (0)
#define SWRITE_VF(bf) do { *(bf16x8*)(V_lds + (bf) * SHM_V + vst0) = pack8(S.sf0, S.sf1); *(bf16x8*)(V_lds + (bf) * SHM_V + vst1) = pack8(S.sf2, S.sf3); } while (0)
template <class TIn, class TOut>
__device__ __forceinline__ void causal_swa_prime(const BlockRef<TIn, TOut>& cur, int W, char* lds, Seam<TIn>& S) {
    constexpr bool F32 = same_t<TIn, float>::v;
    const int tid = opaque_tid(), wid = __builtin_amdgcn_readfirstlane(tid >> 6), lane = tid & 63, r32 = lane & 31, hi = lane >> 5;
    const int sr = tid >> 4, sc = (tid & 15) * 8, kws = KSWZ(sr, sc * 2); char* K_lds = lds + 2 * SHM_V;
    const int kb0 = swa_jlo(cur.P0, W) * KVBLK;
    for (int d0 = 0; d0 < 8; ++d0) S.qr[d0] = load8<TIn>(cur.Q + (size_t)(wid * QBLK + r32) * LDQ + d0 * 16 + hi * 8);
    if constexpr (F32) { SLOAD_F((const float*)cur.K, kb0); VMW(); SWRITE_KF(0); SBAR(); SLOAD_F((const float*)cur.V, kb0); }
    else { SLOAD_H(cur.K, cur.V, cur.CA, kb0); VMW(); SWRITE_HK(0); }
    __syncthreads();
}
template <class TIn, class TOut>
__device__ __forceinline__ void causal_swa_block(const BlockRef<TIn, TOut>& cur, const BlockRef<TIn, TOut>& nxt, int skv, int W, char* lds, Seam<TIn>& S) {
    constexpr bool F32 = same_t<TIn, float>::v;
    const int tid = opaque_tid(), wid = __builtin_amdgcn_readfirstlane(tid >> 6), lane = tid & 63, r32 = lane & 31, hi = lane >> 5;
    const int j_lo = swa_jlo(cur.P0, W);
    int j_hi = (cur.P0 + QB - 1) / KVBLK + 1; if (j_hi > skv / KVBLK) j_hi = skv / KVBLK;
    const int NT = j_hi - j_lo;
    const int kbn = swa_jlo(nxt.P0, W) * KVBLK;
    const int qlo = cur.P0 + wid * QBLK, qm = qlo + r32 - 4 * hi;
    char* V_lds = lds; char* K_lds = lds + 2 * SHM_V;
    float* ws = (float*)(lds + 2 * SHM_V + 2 * SHM_K) + wid * 64; float* li_l = ws, * al_l = ws + 32;
    float m_reg = -1e30f, l_reg = 0; f32x16 o[4] = {};
    const int sr = tid >> 4, sc = (tid & 15) * 8, vst0 = v_st(sr, sc), vst1 = v_st(32 + sr, sc), kws = KSWZ(sr, sc * 2);
    const int vb0 = (int)(uintptr_t)V_lds + v_rd_base(lane);
    const TIn* Kh = cur.K; const TIn* Vh = cur.V; const unsigned long long* CAh = cur.CA;
#define RESC(a) do { if (__any((a) < 1.f)) { if (hi == 0) al_l[r32] = (a); asm volatile("s_waitcnt lgkmcnt(0)" ::: "memory");              \
                     for (int d_ = 0; d_ < 4; ++d_) for (int r = 0; r < 16; ++r) o[d_][r] *= al_l[crow(r, hi)]; } } while (0)
#define KBASE(t) ((j_lo + (t)) * KVBLK)
#define ACT(t) (KBASE(t) <= qlo + QBLK - 1 && KBASE(t) + KVBLK - 1 >= qlo - W + 1)
#define MASKT(P0_, P1_, t) do { const int kb_ = KBASE(t); if ((!SK || ACT(t)) && (kb_ + KVBLK - 1 > qlo || kb_ <= qlo + QBLK - 1 - W)) mask_tile(P0_, P1_, qm - kb_, (unsigned)W); } while (0)
    constexpr int NQL = F32 ? 16 : 8;
    constexpr bool SK = WSKIP && !F32;
#define SEAM_K0() do { VMWN(NQL); if constexpr (F32) { SWRITE_KF(0); SBAR(); SLOAD_F((const float*)nxt.V, kbn); } else { SWRITE_HK(0); } SBAR(); } while (0)
    f32x16 pA0, pA1, pB0, pB1; float mnA, mnB, alA, alB; bf16x8 pa0, pa1, pa2, pa3;
    if constexpr (F32) { VMW(); SWRITE_VF(0); SBAR(); } else { SWRITE_HV(0); SBAR(); }
    const unsigned long long hc = S.ca;
    if (NT > 1) { if constexpr (F32) SLOAD_F((const float*)Kh, KBASE(1)); else SLOAD_H(Kh, Vh, CAh, KBASE(1)); }
    SBAR(); qkt<0, SK>(pA0, pA1, K_lds, r32, hi, S.qr, ACT(0), hc);
    if constexpr (F32) { if (NT > 1) { VMW(); SWRITE_KF(1); SBAR(); SLOAD_F((const float*)Vh, KBASE(1)); } }
    MASKT(pA0, pA1, 0); partialSM(pA0, pA1, m_reg, mnA, alA);
    if (NT > 1) { VMW(); if constexpr (F32) { SWRITE_VF(1); SBAR(); if (NT > 2) SLOAD_F((const float*)Kh, KBASE(2)); } else SWRITE_H(1); }
    __syncthreads();
#define HALF_STEP(PX0, PX1, mnX, alX, PY0, PY1, alY, t, KB, VB, SB) do {                                                      \
        { const unsigned long long c_ = S.ca; SBAR(); qkt<KB, SK>(PX0, PX1, K_lds, r32, hi, S.qr, ACT(t), c_); }                                             \
        finishSM(PY0, PY1, alY, l_reg, pa0, pa1, pa2, pa3); SBAR();                                                           \
        if ((t) + 1 < NT) { if constexpr (F32) { VMW(); SWRITE_KF(SB); SBAR(); SLOAD_F((const float*)Vh, KBASE((t) + 1)); }  \
                            else { SLOAD_H(Kh, Vh, CAh, KBASE((t) + 1)); } SBAR(); }                                               \
        pv_tile<VB, SK>(o, vb0, pa0, pa1, pa2, pa3, ACT((t) - 1)); MASKT(PX0, PX1, (t)); partialSM(PX0, PX1, m_reg, mnX, alX);                                        \
        __syncthreads();                                                                                                      \
        if ((t) + 1 < NT) { VMW(); if constexpr (F32) { SWRITE_VF(SB); SBAR(); if ((t) + 2 < NT) SLOAD_F((const float*)Kh, KBASE((t) + 2)); } \
                            else { SWRITE_H(SB); } }                                                                          \
        RESC(alX); __syncthreads(); } while (0)
    for (int t = 1; t + 1 < NT; t += 2) {
        HALF_STEP(pB0, pB1, mnB, alB, pA0, pA1, alA, t, 1, 0, 0);
        HALF_STEP(pA0, pA1, mnA, alA, pB0, pB1, alB, t + 1, 0, 1, 1);
    }
    const bool even = (NT & 1) == 0;
    if (even) { const unsigned long long c_ = S.ca; SBAR(); qkt<1, SK>(pB0, pB1, K_lds, r32, hi, S.qr, ACT(NT - 1), c_); SBAR(); }
#define QROW(e) (nxt.Q + (size_t)(wid * QBLK + r32) * D + ((e) >> 1) * 16 + hi * 8 + ((e) & 1) * 4)
    if constexpr (F32) { SLOAD_F((const float*)nxt.K, kbn); SBAR();
#pragma unroll
        for (int e = 0; e < 8; ++e) S.tq[e] = *(const f32x4*)QROW(e); }
    else { SLOAD_H(nxt.K, nxt.V, nxt.CA, kbn); SBAR();
#pragma unroll
        for (int d0 = 0; d0 < 8; ++d0) S.qr[d0] = load8<TIn>(nxt.Q + (size_t)(wid * QBLK + r32) * LDQ + d0 * 16 + hi * 8); }
    SBAR();
    finishSM(pA0, pA1, alA, l_reg, pa0, pa1, pa2, pa3); SBAR();
    if constexpr (F32) {
#pragma unroll
        for (int e = 8; e < 16; ++e) S.tq[e] = *(const f32x4*)QROW(e); SBAR(); }
#undef QROW
    pv_tile<0, SK>(o, vb0, pa0, pa1, pa2, pa3, ACT(even ? NT - 2 : NT - 1));
    if (even) { MASKT(pB0, pB1, NT - 1); partialSM(pB0, pB1, m_reg, mnB, alB); __syncthreads(); RESC(alB);
        finishSM(pB0, pB1, alB, l_reg, pa0, pa1, pa2, pa3); SBAR(); pv_tile<1, SK>(o, vb0, pa0, pa1, pa2, pa3, ACT(NT - 1)); }
    SBAR(); SEAM_K0();
    if (hi == 0) li_l[r32] = l_reg; asm volatile("s_waitcnt lgkmcnt(0)" ::: "memory");
    float rli[16];
#pragma unroll
    for (int r = 0; r < 16; ++r) rli[r] = __builtin_amdgcn_rcpf(li_l[crow(r, hi)]);
    TOut* Ow = cur.O + (size_t)(wid * QBLK) * LDO; const unsigned short* Gw = cur.G + (size_t)(wid * QBLK) * LDG;
#pragma unroll
    for (int r = 0; r < 16; ++r) { const int orow = crow(r, hi);
#pragma unroll
        for (int d0 = 0; d0 < 4; ++d0) { const float v = o[d0][r] * rli[r];
            if constexpr (same_t<TOut, float>::v) { Ow[(size_t)orow * LDO + d0 * 32 + r32] = v; }
            else { const float vn = __builtin_bit_cast(float, __builtin_amdgcn_mov_dpp(__builtin_bit_cast(int, v), 0xB1, 0xf, 0xf, true));
                   if ((r32 & 1) == 0) { const unsigned g2 = *(const unsigned*)(Gw + (size_t)orow * LDG + d0 * 32 + r32);
                       *(unsigned*)(Ow + (size_t)orow * LDO + d0 * 32 + r32) = cvtpk(v * __uint_as_float(g2 << 16), vn * __uint_as_float(g2 & 0xffff0000u)); } } } }
    if constexpr (F32) {
#pragma unroll
        for (int d0 = 0; d0 < 8; ++d0) S.qr[d0] = pack8(S.tq[2 * d0], S.tq[2 * d0 + 1]); }
    __syncthreads();
#undef RESC
#undef KBASE
#undef ACT
#undef MASKT
#undef SEAM_K0
#undef HALF_STEP
}
#undef ROW
#undef VMW
#undef VMWN
#undef SLOAD_H
#undef SWRITE_HK
#undef SWRITE_HV
#undef SWRITE_H
#undef SLOAD_F
#undef SWRITE_KF
#undef SWRITE_VF

__host__ __device__ inline int swa_nx(int nqb, int nramp) { return (nramp + 1) / 2 + (nqb - nramp); }
struct SwaItem { int bh, qb0, qb1; };
__device__ __forceinline__ SwaItem swa_decode(int L, int nqb, int nx) {
    SwaItem it; const int xcd = L & 7, k = L >> 3, gi = k / nx, r = k - gi * nx;
    it.bh = gi * 8 + xcd; const int x = r;
    it.qb0 = nqb - 1 - x; it.qb1 = x;
    return it;
}
struct AttnT { const bf16* Q; const bf16* K; const bf16* V; bf16* O; const unsigned short* G; const unsigned long long* CA; };
__device__ __forceinline__ BlockRef<bf16, bf16> swa_ref(const SwaItem& it, int pass, const AttnT& T, int seq, int nh) {
    const int qb = pass ? it.qb1 : it.qb0, b = it.bh / nh, h = it.bh % nh; const size_t tok0 = (size_t)b * seq;
    BlockRef<bf16, bf16> r;
    r.Q = T.Q + (tok0 + (size_t)qb * QB) * LDQ + h * D; r.O = T.O + (tok0 + (size_t)qb * QB) * LDO + h * D; r.G = T.G + (tok0 + (size_t)qb * QB) * LDG + h * D;
    r.K = T.K + (size_t)it.bh * seq * D; r.V = T.V + (size_t)it.bh * seq * D; r.CA = T.CA + (size_t)it.bh * seq; r.P0 = qb * QB;
    return r;
}
__device__ __forceinline__ void attn_phase(char* lds, const AttnT& T, int nb, int nh, int seq) {
    const int W = 1 << 30, nqb = seq / QB, nx = nqb / 2, total = nx * nb * nh, stride = gridDim.x;
    int L = blockIdx.x; if (L >= total) return;
    SwaItem it = swa_decode(L, nqb, nx); int pass = 0;
    BlockRef<bf16, bf16> cur = swa_ref(it, 0, T, seq, nh);
    Seam<bf16> S;
    causal_swa_prime<bf16, bf16>(cur, W, lds, S);
    for (;;) {
        const bool more_pass = pass == 0 && it.qb1 != it.qb0, more_item = L + stride < total, last = !more_pass && !more_item;
        SwaItem itn = it; int passn = pass + 1, Ln = L;
        if (!more_pass) { passn = 0; Ln = more_item ? L + stride : L; itn = swa_decode(Ln, nqb, nx); }
        const BlockRef<bf16, bf16> nxt = last ? cur : swa_ref(itn, passn, T, seq, nh);
        causal_swa_block<bf16, bf16>(cur, nxt, seq, W, lds, S);
        if (last) break;
        cur = nxt; it = itn; pass = passn; L = Ln;
    }
}
#undef KSWZ
#undef SBAR
}
constexpr int DM = 2048, NB = 4, SEQ = 4096, MT = NB * SEQ, FF = 5632, FF2 = 2 * FF, NH = 16, HD = 128, CH = 128, NG = 16;
constexpr float EPS = 1e-6f;
constexpr int NWAVES = 8, NTHREADS = NWAVES * 64;
constexpr size_t MiB = 1u << 20;
constexpr size_t WS_BAR = 0, BAR_ZERO_BYTES = 16384;
constexpr size_t WS_LOGF = 1 * MiB;
constexpr size_t WS_CA = 2 * MiB;
constexpr size_t WS_WSB = 4 * MiB;
constexpr size_t WS_WF = 5 * MiB;
constexpr size_t WS_W_AIN = 6 * MiB;
constexpr size_t WS_W_AOUT = WS_W_AIN + 32 * MiB;
constexpr size_t WS_W_KV = WS_W_AOUT + 16 * MiB;
constexpr size_t WS_W_QG = WS_W_KV + 16 * MiB;
constexpr size_t WS_W_BOUT = WS_W_QG + 32 * MiB;
constexpr size_t WS_W_UP = WS_W_BOUT + 16 * MiB;
constexpr size_t WS_W_DN = WS_W_UP + 176 * MiB;
constexpr size_t WS_XN = WS_W_DN + 88 * MiB;
constexpr size_t WS_XN2 = WS_XN + 64 * MiB;
constexpr size_t WS_KV = WS_XN2 + 64 * MiB;
constexpr size_t WS_BIG = WS_KV + 128 * MiB;
constexpr size_t WS_ACT = WS_BIG + 352 * MiB;
constexpr size_t WS_SSP = WS_ACT + 176 * MiB;
constexpr size_t WS_END = WS_SSP + 2 * MiB;
constexpr int LDS_BYTES = 147456, MISC_OFF = LDS_BYTES - 64, XS_OFF = 131072, RRW_OFF = XS_OFF + 8192;

typedef unsigned short bf16_t;
typedef float f32x4 __attribute__((ext_vector_type(4)));
typedef unsigned u32x4 __attribute__((ext_vector_type(4)));
typedef unsigned u32x2 __attribute__((ext_vector_type(2)));
typedef short bf16x8 __attribute__((ext_vector_type(8)));
#define LAS __attribute__((address_space(3)))
__device__ __forceinline__ unsigned pk2(float lo, float hi) { return pg8::cvt_pk_bf16(lo, hi); }
__device__ __forceinline__ float bf_lo(unsigned w) { return __uint_as_float(w << 16); }
__device__ __forceinline__ float bf_hi(unsigned w) { return __uint_as_float(w & 0xffff0000u); }
__device__ __forceinline__ float wave_sum(float v, int lane) {
#pragma unroll
    for (int o = 1; o < 64; o <<= 1) v += lane_read(v, lane ^ o);
    return v;
}
struct Args { const float* in[21]; float* out; unsigned char* ws; };
#define XB_TMO      128
#define XB_XCNT(j)  (256  + 64 * (j))
#define XB_XSUB(j)  (1280 + 64 * (j))
#define XB_XGEN(j)  (2304 + 64 * (j))
#define XB_TOP      3328
#define XB_TOPGEN   3392
#define XCD_BAR_WORDS 3456
#define XB_SPIN_CAP (1u << 18)

__device__ __forceinline__ unsigned xb_ld(unsigned* p)              { return __hip_atomic_load(p, __ATOMIC_RELAXED, __HIP_MEMORY_SCOPE_AGENT); }
__device__ __forceinline__ unsigned xb_add(unsigned* p, unsigned v) { return __hip_atomic_fetch_add(p, v, __ATOMIC_RELAXED, __HIP_MEMORY_SCOPE_AGENT); }
__device__ __forceinline__ unsigned xb_xcc_id() { return (unsigned)__builtin_amdgcn_s_getreg((3 << 11) | 20) & 0xFu; }
#define XB_SPIN(cond, bar) do { unsigned _sp = 0; while (cond) { __builtin_amdgcn_s_sleep(1); \
    if ((++_sp & 255u) == 0u) { if (xb_ld(&(bar)[XB_TMO])) break; if (_sp > XB_SPIN_CAP) { atomicAdd(&(bar)[XB_TMO], 1u); break; } } } } while (0)

struct XcdBarrier {
    unsigned* bar; unsigned x;
    volatile LAS unsigned* st;
};

__device__ __forceinline__ XcdBarrier xcd_barrier_post(unsigned* bar, volatile LAS unsigned* st) {
    XcdBarrier b; b.bar = bar; b.x = xb_xcc_id(); b.st = st;
    if (threadIdx.x == 0) (void)xb_add(&bar[XB_XCNT(b.x)], 1u);
    return b;
}
__device__ __forceinline__ void xcd_barrier_complete(unsigned* bar, unsigned x, unsigned& nloc, unsigned& nx) {
    const unsigned G = gridDim.x * gridDim.y * gridDim.z;
    unsigned sum, cnt, mine, sp = 0u;
    for (;;) {
        sum = 0u; cnt = 0u; mine = 0u;
#pragma unroll
        for (unsigned j = 0; j < 16; ++j) { const unsigned c = xb_ld(&bar[XB_XCNT(j)]); sum += c; cnt += (c > 0u) ? 1u : 0u; mine = (j == x) ? c : mine; }
        if (sum == G) break;
        __builtin_amdgcn_s_sleep(1);
        if ((++sp & 255u) == 0u) { if (xb_ld(&bar[XB_TMO])) break; if (sp > XB_SPIN_CAP) { atomicAdd(&bar[XB_TMO], 1u); break; } }
    }
    nloc = mine > 0u ? mine : 1u; nx = cnt > 0u ? cnt : 1u;
}

__device__ __forceinline__ void xcd_barrier(const XcdBarrier& b) {
    asm volatile("s_waitcnt vmcnt(0)" ::: "memory");
    __syncthreads();
    if (threadIdx.x == 0) {
        unsigned* bar = b.bar;
        __builtin_amdgcn_s_waitcnt(0);
        unsigned nloc = b.st[0], nx = b.st[1];
        if (nloc == 0u) { xcd_barrier_complete(bar, b.x, nloc, nx); b.st[0] = nloc; b.st[1] = nx; }
        const unsigned old = xb_add(&bar[XB_XSUB(b.x)], 1u);
        const unsigned gen = old / nloc;
        if (old + 1u == (gen + 1u) * nloc) {
            __builtin_amdgcn_fence(__ATOMIC_RELEASE, "agent");
            asm volatile("s_waitcnt vmcnt(0)" ::: "memory");
            const unsigned og = xb_add(&bar[XB_TOP], 1u);
            const unsigned tg = og / nx;
            if (og + 1u == (tg + 1u) * nx) xb_add(&bar[XB_TOPGEN], 1u);
            else XB_SPIN(xb_ld(&bar[XB_TOPGEN]) == tg, bar);
            __builtin_amdgcn_fence(__ATOMIC_ACQUIRE, "agent");
            xb_add(&bar[XB_XGEN(b.x)], 1u);
            asm volatile("s_waitcnt vmcnt(0)" ::: "memory");
        } else {
            XB_SPIN(xb_ld(&bar[XB_XGEN(b.x)]) == gen, bar);
            __builtin_amdgcn_fence(__ATOMIC_ACQUIRE, "agent");
            asm volatile("s_waitcnt vmcnt(0)" ::: "memory");
        }
    }
    __syncthreads();
}


__device__ __forceinline__ int up_row(int n) { return n < FF ? (n >> 7) * 256 + (n & 127) : ((n - FF) >> 7) * 256 + 128 + ((n - FF) & 127); }
constexpr int TR_LDS_PER_WAVE = 64 * 65 * 4;
__device__ __forceinline__ void transpose_item(const float* W, int K, int ld, int ncols, const float* gk, bf16_t* WT, int mode, LAS float* scr, int item, int lane) {
    const int nblk = ncols / 64, kb = item / nblk, nb = item % nblk, k0 = 64 * kb, n0 = 64 * nb, kr = lane >> 4, n4 = (lane & 15) * 4;
    f32x4 v[16];
#pragma unroll
    for (int i = 0; i < 16; ++i) v[i] = *(const f32x4*)(W + (size_t)(k0 + 4 * i + kr) * ld + n0 + n4);
#pragma unroll
    for (int i = 0; i < 16; ++i) { const int kk = 4 * i + kr; const float g = gk ? gk[k0 + kk] : 1.f; LAS float* d = scr + kk * 65 + n4; d[0] = v[i].x * g; d[1] = v[i].y * g; d[2] = v[i].z * g; d[3] = v[i].w * g; }
    asm volatile("s_waitcnt lgkmcnt(0)" ::: "memory");
    const int c = lane & 7; const int r0 = mode ? up_row(n0) : n0;
#pragma unroll
    for (int j = 0; j < 8; ++j) { const int n = (lane >> 3) + 8 * j; const LAS float* p = scr + (8 * c) * 65 + n;
        u32x4 o; o.x = pk2(p[0 * 65], p[1 * 65]); o.y = pk2(p[2 * 65], p[3 * 65]); o.z = pk2(p[4 * 65], p[5 * 65]); o.w = pk2(p[6 * 65], p[7 * 65]);
        *(u32x4*)(WT + (size_t)(r0 + n) * K + k0 + 8 * c) = o; }
    asm volatile("s_waitcnt lgkmcnt(0)" ::: "memory");
}
__device__ __forceinline__ void fgate_rows(const bf16_t* hb, const float* rss, const bf16_t* wfh, const bf16_t* wfl, const float* bf, float* logf, int gw, int NGW, int lane) {
    const int fr = lane & 15, fq = lane >> 4;
    for (int rg = gw; rg < MT / 16; rg += NGW) {
        const bf16_t* hrow = hb + (size_t)(rg * 16 + fr) * DM + 8 * fq; const bf16_t* wh = wfh + fr * DM + 8 * fq; const bf16_t* wl = wfl + fr * DM + 8 * fq;
        const f32x4* rp = (const f32x4*)(rss + (size_t)(rg * 16 + fr) * 32 + fq * 8); const f32x4 ra = rp[0], rb = rp[1];
        float ssq = ((ra[0] + ra[1]) + (ra[2] + ra[3])) + ((rb[0] + rb[1]) + (rb[2] + rb[3])); ssq += lane_read(ssq, lane ^ 16); ssq += lane_read(ssq, lane ^ 32);
        f32x4 acc = {0.f, 0.f, 0.f, 0.f};
#pragma unroll 4
        for (int ks = 0; ks < DM / 32; ++ks) {
            const bf16x8 hv = *(const bf16x8*)(hrow + 32 * ks), whv = *(const bf16x8*)(wh + 32 * ks), wlv = *(const bf16x8*)(wl + 32 * ks);
            acc = __builtin_amdgcn_mfma_f32_16x16x32_bf16(whv, hv, acc, 0, 0, 0);
            acc = __builtin_amdgcn_mfma_f32_16x16x32_bf16(wlv, hv, acc, 0, 0, 0);
        }
        const float r = 1.0f / sqrtf(ssq * (1.0f / DM) + EPS);
        const f32x4 b = *(const f32x4*)(bf + 4 * fq); f32x4 o;
#pragma unroll
        for (int e = 0; e < 4; ++e) { const float f = acc[e] * r + b[e]; o[e] = fminf(f, 0.f) - log1pf(expf(-fabsf(f))); }
        *(f32x4*)(logf + (size_t)(rg * 16 + fr) * 16 + 4 * fq) = o;
    }
}
__device__ __forceinline__ void scan_seq(const float* logf, unsigned long long* CA, int seq, int lane) {
    const int b = seq >> 4, hh = seq & 15;
    const float* lf = logf + ((size_t)b * SEQ + (size_t)lane * 64) * 16 + hh;
    float v[64];
#pragma unroll
    for (int i = 0; i < 64; ++i) v[i] = lf[i * 16];
#pragma unroll
    for (int i = 1; i < 64; ++i) v[i] += v[i - 1];
    const float tot = v[63]; float t = tot;
#pragma unroll
    for (int o = 1; o < 64; o <<= 1) { const float y = lane_read(t, lane >= o ? lane - o : lane); if (lane >= o) t += y; }
    const float excl = t - tot;
    unsigned long long* out = CA + (size_t)seq * SEQ + lane * 64;
#pragma unroll
    for (int i = 0; i < 64; ++i) { const float c = (excl + v[i]) * -11.313708498984761f;
        const unsigned h1 = pk2(c, 0.f) & 0xffffu; const float r1 = c - bf_lo(h1);
        const unsigned h2 = pk2(r1, 0.f) & 0xffffu; const float r2 = r1 - bf_lo(h2);
        const unsigned h3 = pk2(r2, 0.f) & 0xffffu;
        out[i] = (unsigned long long)(h1 | (h2 << 16)) | ((unsigned long long)h3 << 32); }
}
__device__ __forceinline__ void spatial_phase(LAS unsigned char* ldsp, const bf16_t* Z, const float* ssp, const bf16_t* wsb, const float* vnorm, const float* bs, bf16_t* GATED, int wave, int lane) {
    const int fr = lane & 15, fq = lane >> 4;
    for (int item = blockIdx.x; item < (MT / CH) * NG; item += gridDim.x) {
        const int ch = item >> 4, g = item & 15, row0 = ch * CH, cw = g * 128 + wave * 16;
        LAS float* rvs = (LAS float*)ldsp;
        __syncthreads();
        { const int t_ = wave * 64 + lane; if (t_ < CH) { const f32x4* p = (const f32x4*)(ssp + (size_t)(row0 + t_) * 32); float sq = 0.f;
#pragma unroll
            for (int q = 0; q < 8; ++q) { const f32x4 v = p[q]; sq += (v.x + v.y) + (v.z + v.w); }
            rvs[t_] = 1.0f / sqrtf(sq * (1.0f / DM) + EPS); } }
        __syncthreads();
        LAS unsigned* VS = (LAS unsigned*)(ldsp + 1024);
        { const int t_ = wave * 64 + lane, srow = t_ >> 2, c0 = (t_ & 3) * 32; const float rv = rvs[srow];
          const u32x4* gp = (const u32x4*)(Z + (size_t)(row0 + srow) * 4096 + 2048 + g * 128 + c0); u32x4 q[4];
#pragma unroll
          for (int jj = 0; jj < 4; ++jj) q[jj] = gp[jj];
#pragma unroll
          for (int jj = 0; jj < 4; ++jj) { LAS unsigned* d = VS + srow * 65 + (c0 >> 1) + jj * 4;
#pragma unroll
              for (int e = 0; e < 4; ++e) d[e] = pk2(bf_lo(q[jj][e]) * rv, bf_hi(q[jj][e]) * rv); } }
        __syncthreads();
        bf16x8 vf[4];
        { const LAS unsigned short* vs16 = (const LAS unsigned short*)VS + wave * 16 + fr;
#pragma unroll
          for (int ks = 0; ks < 4; ++ks) { unsigned hv[8];
#pragma unroll
              for (int i = 0; i < 8; ++i) hv[i] = vs16[(32 * ks + 8 * fq + i) * 130];
              u32x4 w; w.x = hv[0] | (hv[1] << 16); w.y = hv[2] | (hv[3] << 16); w.z = hv[4] | (hv[5] << 16); w.w = hv[6] | (hv[7] << 16); vf[ks] = __builtin_bit_cast(bf16x8, w); } }
        f32x4 acc[8];
#pragma unroll
        for (int m = 0; m < 8; ++m) { acc[m] = (f32x4){0.f, 0.f, 0.f, 0.f};
#pragma unroll
            for (int ks = 0; ks < 4; ++ks) if (32 * ks <= 16 * m + 15) {
                const bf16x8 wf = *(const bf16x8*)(wsb + ((size_t)(g * 128 + 16 * m + fr) * 128 + 32 * ks + 8 * fq));
                acc[m] = __builtin_amdgcn_mfma_f32_16x16x32_bf16(vf[ks], wf, acc[m], 0, 0, 0); } }
        const f32x4 vn = *(const f32x4*)(vnorm + cw + 4 * fq);
#pragma unroll
        for (int m = 0; m < 8; ++m) { const int t = 16 * m + fr; const size_t row = (size_t)(row0 + t); const float bias = bs[g * 128 + t];
            const u32x2 uu = *(const u32x2*)(Z + row * 4096 + cw + 4 * fq);
            const float o0 = bf_lo(uu.x) * (acc[m][0] * vn[0] + bias), o1 = bf_hi(uu.x) * (acc[m][1] * vn[1] + bias), o2 = bf_lo(uu.y) * (acc[m][2] * vn[2] + bias), o3 = bf_hi(uu.y) * (acc[m][3] * vn[3] + bias);
            u32x2 w; w.x = pk2(o0, o1); w.y = pk2(o2, o3); *(u32x2*)(GATED + row * DM + cw + 4 * fq) = w; }
    }
}
__device__ __forceinline__ void conv_phase(const bf16_t* BIG, const float* cw, const float* cb, bf16_t* ACT) {
    constexpr int NQ = FF / 8, RS = 32, NTASK = NQ * (MT / RS);
    const int tid_ = opaque_tid();
    for (int T = blockIdx.x * NTHREADS + tid_; T < NTASK; T += gridDim.x * NTHREADS) {
        const int qb = (NQ / 64 - 1) - T / (64 * (MT / RS)), rem = T % (64 * (MT / RS)), strip = rem >> 6, q = qb * 64 + (rem & 63), j0 = 8 * q, pg = (q >> 4) * 256 + (q & 15) * 8, row0 = strip * RS;
        float wg[3][8], wv[3][8], bg[8], bv[8];
#pragma unroll
        for (int k = 0; k < 3; ++k)
#pragma unroll
            for (int e = 0; e < 8; ++e) { wg[k][e] = cw[(size_t)k * FF2 + j0 + e]; wv[k][e] = cw[(size_t)k * FF2 + FF + j0 + e]; }
#pragma unroll
        for (int e = 0; e < 8; ++e) { bg[e] = cb[j0 + e]; bv[e] = cb[FF + j0 + e]; }
        const bf16_t* src = BIG + (size_t)row0 * FF2 + pg; bf16_t* dst = ACT + (size_t)row0 * FF + j0;
        u32x4 g2 = {0u, 0u, 0u, 0u}, g1 = g2, v2 = g2, v1 = g2;
        if ((row0 & (SEQ - 1)) != 0) { g2 = *(const u32x4*)(src - 2 * (size_t)FF2); v2 = *(const u32x4*)(src - 2 * (size_t)FF2 + 128); g1 = *(const u32x4*)(src - (size_t)FF2); v1 = *(const u32x4*)(src - (size_t)FF2 + 128); }
        for (int i0 = 0; i0 < RS; i0 += 8) {
            u32x4 gc[8], vc[8];
#pragma unroll
            for (int i = 0; i < 8; ++i) { gc[i] = *(const u32x4*)(src + (size_t)(i0 + i) * FF2); vc[i] = *(const u32x4*)(src + (size_t)(i0 + i) * FF2 + 128); }
#pragma unroll
            for (int i = 0; i < 8; ++i) { u32x4 o;
#pragma unroll
                for (int p = 0; p < 4; ++p) {
                    const float ga = wg[0][2 * p] * bf_lo(g2[p]) + wg[1][2 * p] * bf_lo(g1[p]) + wg[2][2 * p] * bf_lo(gc[i][p]) + bg[2 * p];
                    const float gb = wg[0][2 * p + 1] * bf_hi(g2[p]) + wg[1][2 * p + 1] * bf_hi(g1[p]) + wg[2][2 * p + 1] * bf_hi(gc[i][p]) + bg[2 * p + 1];
                    const float va = wv[0][2 * p] * bf_lo(v2[p]) + wv[1][2 * p] * bf_lo(v1[p]) + wv[2][2 * p] * bf_lo(vc[i][p]) + bv[2 * p];
                    const float vb = wv[0][2 * p + 1] * bf_hi(v2[p]) + wv[1][2 * p + 1] * bf_hi(v1[p]) + wv[2][2 * p + 1] * bf_hi(vc[i][p]) + bv[2 * p + 1];
                    const float sa = ga * __builtin_amdgcn_rcpf(1.0f + __builtin_amdgcn_exp2f(-1.4426950408889634f * ga)), sb = gb * __builtin_amdgcn_rcpf(1.0f + __builtin_amdgcn_exp2f(-1.4426950408889634f * gb));
                    o[p] = pk2(sa * va, sb * vb); }
                *(u32x4*)(dst + (size_t)(i0 + i) * FF) = o; g2 = g1; g1 = gc[i]; v2 = v1; v1 = vc[i]; }
        }
    }
}

typedef const Args __attribute__((address_space(4))) CArgs;
__device__ __forceinline__ CArgs* kargs() { CArgs* p = (CArgs*)__builtin_amdgcn_kernarg_segment_ptr(); asm volatile("" : "+s"(p)); return p; }
#define PTRS \
    CArgs* ap_ = kargs(); unsigned char* ws = ap_->ws; float* h = ap_->out; (void)ws; (void)h; \
    const float* x = ap_->in[0]; const float* a_norm = ap_->in[1]; const float* a_w_in = ap_->in[2]; const float* a_v_norm = ap_->in[3]; const float* a_w_s = ap_->in[4]; const float* a_b_s = ap_->in[5]; \
    const float* a_w_out = ap_->in[6]; const float* kv_norm = ap_->in[7]; const float* w_kvf = ap_->in[8]; const float* b_f = ap_->in[9]; const float* k_norm = ap_->in[10]; const float* b_norm = ap_->in[11]; \
    const float* b_w_qg = ap_->in[12]; const float* q_norm = ap_->in[13]; const float* b_w_out = ap_->in[14]; const float* f_norm = ap_->in[15]; const float* f_w_up = ap_->in[16]; const float* f_conv_w = ap_->in[17]; \
    const float* f_conv_b = ap_->in[18]; const float* f_w_down = ap_->in[19]; const float* final_norm = ap_->in[20]; \
    (void)x; (void)a_norm; (void)a_w_in; (void)a_v_norm; (void)a_w_s; (void)a_b_s; (void)a_w_out; (void)kv_norm; (void)w_kvf; (void)b_f; (void)k_norm; (void)b_norm; (void)b_w_qg; (void)q_norm; (void)b_w_out; \
    (void)f_norm; (void)f_w_up; (void)f_conv_w; (void)f_conv_b; (void)f_w_down; (void)final_norm; \
    float* VSS = (float*)(ws + WS_SSP); float* LOGF = (float*)(ws + WS_LOGF); unsigned long long* CA = (unsigned long long*)(ws + WS_CA); \
    bf16_t* WSB = (bf16_t*)(ws + WS_WSB); bf16_t* WFH = (bf16_t*)(ws + WS_WF); bf16_t* WFL = WFH + 16 * DM; \
    bf16_t* W_AIN = (bf16_t*)(ws + WS_W_AIN); bf16_t* W_AOUT = (bf16_t*)(ws + WS_W_AOUT); bf16_t* W_KV = (bf16_t*)(ws + WS_W_KV); bf16_t* W_QG = (bf16_t*)(ws + WS_W_QG); \
    bf16_t* W_BOUT = (bf16_t*)(ws + WS_W_BOUT); bf16_t* W_UP = (bf16_t*)(ws + WS_W_UP); bf16_t* W_DN = (bf16_t*)(ws + WS_W_DN); \
    bf16_t* HB = (bf16_t*)(ws + WS_XN); float* RSS = (float*)(ws + WS_XN2); bf16_t* KVB = (bf16_t*)(ws + WS_KV); bf16_t* BIG = (bf16_t*)(ws + WS_BIG); bf16_t* ACT = (bf16_t*)(ws + WS_ACT); \
    (void)VSS; (void)LOGF; (void)CA; (void)WSB; (void)WFH; (void)WFL; (void)W_AIN; (void)W_AOUT; (void)W_KV; (void)W_QG; (void)W_BOUT; (void)W_UP; (void)W_DN; (void)HB; (void)RSS; (void)KVB; (void)BIG; (void)ACT;
typedef pg8::EpiBf<1, true> EPI_A1; typedef pg8::EpiBf<0, true, true, true> EPI_KV; typedef pg8::EpiBf<2, true, false, true> EPI_QG; typedef pg8::EpiBf<0, true> EPI_UP;
#define GEMM_PHASE(EPI, Aptr, Bptr, NN, KK, ...) do { pg8::Gemm g_{Aptr, Bptr, MT, NN, KK}; pg8::StaticOrder S_; S_.init(MT, NN, G, (int)blockIdx.x); EPI E_{__VA_ARGS__}; \
    pg8::gemm_phase<EPI, pg8::StaticOrder, true, true>(ldsp, g_, S_, E_); } while (0)

__global__ void __launch_bounds__(NTHREADS, 2) fwd_megakernel(Args a) {
    extern __shared__ __attribute__((aligned(16))) unsigned char lds[];
    cg::grid_group grid = cg::this_grid();
#define GSYNC_CG() do { asm volatile("s_waitcnt vmcnt(0)" ::: "memory"); grid.sync(); } while (0)
#define GSYNC() do { XcdBarrier b_ = xbar; asm volatile("" : "+s"(b_.bar), "+s"(b_.x)); xcd_barrier(b_); } while (0)
    const int wave = __builtin_amdgcn_readfirstlane(threadIdx.x >> 6);
    const int G = gridDim.x, gw = blockIdx.x * NWAVES + wave, NGW = G * NWAVES;
    LAS unsigned char* ldsp = (LAS unsigned char*)lds;
    if (threadIdx.x < 16) ((LAS unsigned*)(ldsp + MISC_OFF))[threadIdx.x] = 0u;
    __syncthreads();
    const XcdBarrier xbar = xcd_barrier_post((unsigned*)(kargs()->ws + WS_BAR), (volatile LAS unsigned*)(ldsp + MISC_OFF));

    {
        PTRS
        const int tid = opaque_tid(), lane = tid & 63;
        const int gt = blockIdx.x * NTHREADS + tid, NGT = G * NTHREADS;
        for (int i = gt; i < 2 * NG * CH * CH / 8; i += NGT) {
            const int e0 = i * 8, s0 = e0 & 127, t = (e0 >> 7) & 127; const f32x4 w0 = *(const f32x4*)(a_w_s + e0), w1 = *(const f32x4*)(a_w_s + e0 + 4);
            float y[8] = {w0.x, w0.y, w0.z, w0.w, w1.x, w1.y, w1.z, w1.w};
#pragma unroll
            for (int e = 0; e < 8; ++e) if (s0 + e > t) y[e] = 0.f;
            u32x4 o; o.x = pk2(y[0], y[1]); o.y = pk2(y[2], y[3]); o.z = pk2(y[4], y[5]); o.w = pk2(y[6], y[7]); *(u32x4*)(WSB + e0) = o; }
        for (int i = gt; i < 16 * DM; i += NGT) { const int n = i / DM, k = i % DM; const float w = kv_norm[k] * w_kvf[(size_t)k * 4112 + 4096 + n];
            const unsigned hi = pk2(w, 0.f) & 0xffffu; WFH[i] = (bf16_t)hi; WFL[i] = (bf16_t)(pk2(w - bf_lo(hi), 0.f) & 0xffffu); }
        LAS float* scr = (LAS float*)(ldsp + wave * TR_LDS_PER_WAVE);
        for (int it = gw; it < 48128 * (PROBE == 4 ? 2 : 1); it += NGW) {
            int r = it % 48128, K = DM, ld, ncols, mode = 0; const float* W; const float* g = nullptr; bf16_t* WT;
            if (r < 4096) { const int l = r >> 11; r &= 2047; W = a_w_in + (size_t)l * DM * 4096; g = a_norm + l * DM; WT = W_AIN + (size_t)l * 4096 * DM; ld = 4096; ncols = 4096; }
            else if ((r -= 4096) < 2048) { const int l = r >> 10; r &= 1023; W = a_w_out + (size_t)l * DM * DM; WT = W_AOUT + (size_t)l * DM * DM; ld = DM; ncols = DM; }
            else if ((r -= 2048) < 2048) { W = w_kvf; g = kv_norm; WT = W_KV; ld = 4112; ncols = 4096; }
            else if ((r -= 2048) < 4096) { const int l = r >> 11; r &= 2047; W = b_w_qg + (size_t)l * DM * 4096; g = b_norm + l * DM; WT = W_QG + (size_t)l * 4096 * DM; ld = 4096; ncols = 4096; }
            else if ((r -= 4096) < 2048) { const int l = r >> 10; r &= 1023; W = b_w_out + (size_t)l * DM * DM; WT = W_BOUT + (size_t)l * DM * DM; ld = DM; ncols = DM; }
            else if ((r -= 2048) < 22528) { const int l = r / 5632; r -= l * 5632; W = f_w_up + (size_t)l * DM * FF2; g = f_norm + l * DM; WT = W_UP + (size_t)l * FF2 * DM; ld = FF2; ncols = FF2; mode = 1; }
            else { r -= 22528; const int l = r / 2816; r -= l * 2816; W = f_w_down + (size_t)l * FF * DM; WT = W_DN + (size_t)l * DM * FF; K = FF; ld = DM; ncols = DM; }
            transpose_item(W, K, ld, ncols, g, WT, mode, scr, r, lane);
        }
        for (int m = gw; m < MT; m += NGW) {
            const f32x4* xr = (const f32x4*)(x + (size_t)m * DM) + lane; u32x2* o = (u32x2*)(HB + (size_t)m * DM) + lane; float sq = 0.f;
#pragma unroll
            for (int j = 0; j < 8; ++j) { const f32x4 v = xr[64 * j]; sq += (v.x * v.x + v.y * v.y) + (v.z * v.z + v.w * v.w); u32x2 w; w.x = pk2(v.x, v.y); w.y = pk2(v.z, v.w); o[64 * j] = w; }
            sq = wave_sum(sq, lane); if (lane < 32) RSS[(size_t)m * 32 + lane] = lane == 0 ? sq : 0.f;
        }
    }
    if (kargs()->ws == nullptr) GSYNC_CG();
    GSYNC();

    for (int l = 0; l < 4; ++l) {
        if (l < 2) {
            for (int rep_ = 0; rep_ < (PROBE == 10 ? 2 : 1); ++rep_) {
            { PTRS GEMM_PHASE(EPI_A1, HB, W_AIN + (size_t)l * 4096 * DM, 4096, DM, BIG, 4096, 8, VSS, RSS, nullptr, nullptr, (LAS float*)(ldsp + RRW_OFF)); }
            GSYNC(); }
            for (int rep_ = 0; rep_ < (PROBE == 6 ? 2 : 1); ++rep_) { if (rep_) GSYNC();
            { PTRS const int lane = opaque_tid() & 63;
              spatial_phase(ldsp, BIG, VSS, WSB + (size_t)l * NG * CH * CH, a_v_norm + (size_t)l * DM, a_b_s + (size_t)l * NG * CH, ACT, wave, lane); } }
            GSYNC();
        } else {
            const int j = l - 2;
            if (j == 0) { { PTRS const int lane = opaque_tid() & 63; fgate_rows(HB, RSS, WFH, WFL, b_f, LOGF, gw, NGW, lane); }
                          PTRS GEMM_PHASE(EPI_KV, HB, W_KV, 4096, DM, KVB, 4096, 1 << 30, nullptr, RSS, k_norm, (LAS float*)(ldsp + XS_OFF), (LAS float*)(ldsp + RRW_OFF)); }
            { PTRS GEMM_PHASE(EPI_QG, HB, W_QG + (size_t)j * 4096 * DM, 4096, DM, BIG, 4096, 8, nullptr, RSS, q_norm + (size_t)j * HD, (LAS float*)(ldsp + XS_OFF), (LAS float*)(ldsp + RRW_OFF)); }
            GSYNC();
            if (j == 0) { { PTRS const int lane = opaque_tid() & 63; if (blockIdx.x < 8) scan_seq(LOGF, CA, blockIdx.x * 8 + wave, lane); }
                          GSYNC(); }
            for (int rep_ = 0; rep_ < (PROBE == 2 ? 2 : 1); ++rep_) {
            { PTRS att::AttnT T{(const att::bf16*)BIG, (const att::bf16*)KVB, (const att::bf16*)(KVB + (size_t)MT * 2048), (att::bf16*)ACT, BIG + 2048, CA};
              att::attn_phase((char*)lds, T, NB, NH, SEQ); }
            GSYNC(); }
        }
        { PTRS const bf16_t* Wt = l < 2 ? W_AOUT + (size_t)l * DM * DM : W_BOUT + (size_t)(l - 2) * DM * DM;
          GEMM_PHASE(pg8::EpiRes, ACT, Wt, DM, DM, HB, RSS, DM);
        }
        GSYNC();
        { PTRS GEMM_PHASE(EPI_UP, HB, W_UP + (size_t)l * FF2 * DM, FF2, DM, BIG, FF2, 1 << 30, nullptr, RSS, nullptr, nullptr, (LAS float*)(ldsp + RRW_OFF)); }
        GSYNC();
#if PROBE == 1
        { PTRS GEMM_PHASE(EPI_UP, HB, W_UP + (size_t)l * FF2 * DM, FF2, DM, BIG, FF2, 1 << 30, nullptr, RSS, nullptr, nullptr, (LAS float*)(ldsp + RRW_OFF)); }
        GSYNC();
#endif
        { PTRS conv_phase(BIG, f_conv_w + (size_t)l * 3 * FF2, f_conv_b + (size_t)l * FF2, ACT); }
        GSYNC();
#if PROBE == 3
        { PTRS conv_phase(BIG, f_conv_w + (size_t)l * 3 * FF2, f_conv_b + (size_t)l * FF2, ACT); }
        GSYNC();
#endif
        { PTRS GEMM_PHASE(pg8::EpiRes, ACT, W_DN + (size_t)l * DM * FF, DM, FF, HB, RSS, DM);
        }
        GSYNC();
    }
#if PROBE == 7
    for (int rep_ = 0; rep_ < 20; ++rep_) GSYNC();
#endif
    { PTRS const int lane = opaque_tid() & 63;
      for (int m = gw; m < MT; m += NGW) {
          const float part = lane < 32 ? RSS[(size_t)m * 32 + lane] : 0.f; const float r = 1.0f / sqrtf(wave_sum(part, lane) * (1.0f / DM) + EPS);
          const u32x4* p = (const u32x4*)(HB + (size_t)m * DM) + lane; float* orow = h + (size_t)m * DM;
#pragma unroll
          for (int j = 0; j < 4; ++j) { const u32x4 w = p[64 * j]; const int c = (64 * j + lane) * 8; const f32x4 g0 = *(const f32x4*)(final_norm + c), g1 = *(const f32x4*)(final_norm + c + 4);
              f32x4 o0 = {bf_lo(w.x) * r * g0[0], bf_hi(w.x) * r * g0[1], bf_lo(w.y) * r * g0[2], bf_hi(w.y) * r * g0[3]}, o1 = {bf_lo(w.z) * r * g1[0], bf_hi(w.z) * r * g1[1], bf_lo(w.w) * r * g1[2], bf_hi(w.w) * r * g1[3]};
              *(f32x4*)(orow + c) = o0; *(f32x4*)(orow + c + 4) = o1; } } }
}

extern "C" void kernel_launch(void* const* d_in, const int* in_sizes, int n_in, void* d_out, int out_size, void* d_ws, size_t ws_size, hipStream_t stream) {
    static int grid = 0;
    if (grid == 0) {
        if (n_in != 21 || out_size != MT * DM || ws_size < WS_END) { fprintf(stderr, "kernel_launch: unexpected shapes (n_in %d out %d ws %zu, need ws >= %zu)\n", n_in, out_size, ws_size, (size_t)WS_END); grid = -1; return; }
        int dev = 0, cus = 0, per_cu = 0;
        (void)hipGetDevice(&dev); (void)hipDeviceGetAttribute(&cus, hipDeviceAttributeMultiprocessorCount, dev);
        (void)hipFuncSetAttribute((const void*)fwd_megakernel, hipFuncAttributeMaxDynamicSharedMemorySize, LDS_BYTES);
        (void)hipOccupancyMaxActiveBlocksPerMultiprocessor(&per_cu, (const void*)fwd_megakernel, NTHREADS, LDS_BYTES);
        if (per_cu < 1) { fprintf(stderr, "kernel_launch: occupancy query says %d blocks per CU\n", per_cu); per_cu = 1; }
        grid = cus * 1;
        (void)hipGetLastError();
    }
    if (grid < 0) return;
    (void)hipMemsetAsync((char*)d_ws + WS_BAR, 0, BAR_ZERO_BYTES, stream);
    Args a{};
    for (int i = 0; i < 21; ++i) a.in[i] = (const float*)d_in[i];
    a.out = (float*)d_out; a.ws = (unsigned char*)d_ws;
    void* args[] = {&a};
    hipError_t e = hipLaunchCooperativeKernel((const void*)fwd_megakernel, dim3(grid), dim3(NTHREADS), args, LDS_BYTES, stream);
    if (e != hipSuccess) fprintf(stderr, "cooperative launch failed: %s (grid %d)\n", hipGetErrorString(e), grid);
}
```

```cpp
#include <hip/hip_runtime.h>
#include <hip/hip_cooperative_groups.h>
#include <hip/hip_bf16.h>
#include <cstdio>
#include <cstdint>
namespace cg = cooperative_groups;
#ifndef PROBE
#define PROBE 0
#endif
__device__ __forceinline__ float lane_read(float v, int src_lane) { return __builtin_bit_cast(float, __builtin_amdgcn_ds_bpermute(src_lane << 2, __builtin_bit_cast(int, v))); }
__device__ __forceinline__ int opaque_tid() { int t = threadIdx.x; asm volatile("" : "+v"(t)); return t; }
namespace pg8 {
#define PG8_LAS __attribute__((address_space(3)))
typedef unsigned short bf16_t;
typedef short bf16x8 __attribute__((ext_vector_type(8)));
typedef float f32x4 __attribute__((ext_vector_type(4)));
typedef unsigned u32x4 __attribute__((ext_vector_type(4)));
constexpr int BM = 256, BK = 64, HALF = 128, HTB = HALF * BK * 2  , STAGE_BYTES = 8 * HTB, NXCD = 8, WGM = 8;

__host__ __device__ __forceinline__ int lds_byte(int r, int c) { const int st = (r >> 4) * 2 + (c >> 5), rr = r & 15, cc = c & 31, ob = rr * 64 + cc * 2; return st * 1024 + (ob ^ (((ob >> 9) & 1) << 5)); }
__host__ __device__ __forceinline__ void stage_rc(int b, int& R, int& C) { const int st = b / 1024, sb = b % 1024, swz = sb ^ (((sb >> 9) & 1) << 5); R = (st >> 1) * 16 + swz / 64; C = (st & 1) * 32 + (swz % 64) / 2; }
__host__ __device__ __forceinline__ int perm32(int rho) { const int n = rho >> 4, i = rho & 15; return 8 * (i >> 2) + 4 * n + (i & 3); }

struct Unit { int pm, pn; };
struct Gemm { const bf16_t* A; const bf16_t* Bt; int M, N, K; };

struct StaticOrder {
    int nM, nN, nwg, G, c;
    __host__ __device__ void init(int M, int N, int G_, int c_) { nM = M / BM; nN = N / BM; nwg = nM * nN; G = G_; c = c_; }
    __host__ __device__ bool next(int i, Unit& u) const {
        const long L = (long)i * G + c; if (L >= nwg) return false;
        int wgid = (int)L; { const int q = nwg / NXCD, r = nwg % NXCD, xcd = wgid % NXCD, off = wgid / NXCD; wgid = (xcd < r ? xcd * (q + 1) : r * (q + 1) + (xcd - r) * q) + off; }
        const int nig = WGM * nN, gid = wgid / nig, fm = gid * WGM, gsz = (nM - fm) < WGM ? (nM - fm) : WGM;
        u.pm = fm + ((wgid % nig) % gsz); u.pn = (wgid % nig) / gsz; return true;
    }
    __device__ __forceinline__ void a_ready(const Unit&) const {}
    __device__ __forceinline__ void done(const Unit&) const {}
};

__device__ __forceinline__ unsigned cvt_pk_bf16(float lo, float hi) { unsigned r; asm volatile("v_cvt_pk_bf16_f32 %0, %1, %2" : "=v"(r) : "v"(lo), "v"(hi)); return r; }
typedef float f32x2 __attribute__((ext_vector_type(2)));
__device__ __forceinline__ f32x2 gelu_pk(f32x2 v) {
    const f32x2 av = __builtin_elementwise_abs(v), d = av * 0.2316418882f + 1.0f;
    f32x2 t; t.x = __builtin_amdgcn_rcpf(d.x); t.y = __builtin_amdgcn_rcpf(d.y);
    f32x2 q = t * 0.5307027145f + (-0.7265760135f); q = q * t + 0.7107068705f; q = q * t + (-0.142248368f); q = q * t + 0.127414796f; q = q * t;
    const f32x2 s = (v * v) * (-0.72134752044f);
    f32x2 e; e.x = __builtin_amdgcn_exp2f(s.x); e.y = __builtin_amdgcn_exp2f(s.y);
    const f32x2 m = v * (q * e), r = v - m;
    f32x2 o; o.x = v.x < 0.f ? m.x : r.x; o.y = v.y < 0.f ? m.y : r.y; return o;
}
constexpr float RS_INV = 1.0f / 2048.0f, RS_EPS = 1e-6f;
template <int MODE, bool RSCALE, bool HEADMAJOR = false, bool HN = false> struct EpiBf {
    static constexpr bool PERM = true, AFTER_DRAIN = false, IDEMPOTENT = true;
    bf16_t* O; int ldc; int split_pn; float* ss; const float* rs; const float* hgain; PG8_LAS float* xs; PG8_LAS float* rrw;
    __device__ __forceinline__ void load_raw(const Unit& u, int ai, int wr, int fr, int fq, f32x4 (&raw)[4][2]) const {
#pragma unroll
        for (int m = 0; m < 4; ++m) { const f32x4* p = (const f32x4*)(rs + (size_t)(u.pm * BM + wr * 64 + fr + ai * HALF + m * 16) * 32 + fq * 8); raw[m][0] = p[0]; raw[m][1] = p[1]; }
    }
    __device__ __forceinline__ void reduce_raw(const f32x4 (&raw)[4][2], int ai, int wr, int wc, int fr, int fq) const {
#pragma unroll
        for (int m = 0; m < 4; ++m) { const f32x4 a = raw[m][0], b = raw[m][1];
            float t = ((a[0] + a[1]) + (a[2] + a[3])) + ((b[0] + b[1]) + (b[2] + b[3])); t += lane_read(t, (fq * 16 + fr) ^ 16); t += lane_read(t, (fq * 16 + fr) ^ 32);
            if (fq == 0) rrw[((wr * 4 + wc) * 8 + ai * 4 + m) * 16 + fr] = 1.0f / sqrtf(t * RS_INV + RS_EPS); }
    }
    __device__ __forceinline__ void init(const Unit& u, int wr, int wc, int fr, int fq) const {
        if (RSCALE) { f32x4 raw[4][2]; load_raw(u, 0, wr, fr, fq, raw); reduce_raw(raw, 0, wr, wc, fr, fq); load_raw(u, 1, wr, fr, fq, raw); reduce_raw(raw, 1, wr, wc, fr, fq); }
    }
    __device__ __forceinline__ void operator()(const f32x4 (&acc)[2][2][4][2], const Unit& u, const Unit& nxt, bool has_next, int wr, int wc, int fr, int fq) const {
        const int row0 = u.pm * BM + wr * 64 + fr, col0 = u.pn * BM + wc * 32 + 8 * fq;
        const bool up = u.pn >= split_pn;
        float rr[2][4]; f32x4 raw[4][2];
#pragma unroll
        for (int ai = 0; ai < 2; ++ai)
#pragma unroll
            for (int m = 0; m < 4; ++m) rr[ai][m] = RSCALE ? rrw[((wr * 4 + wc) * 8 + ai * 4 + m) * 16 + fr] : 1.f;
        if (RSCALE) asm volatile("s_waitcnt lgkmcnt(0)" ::: "memory");
        f32x4 hg0 = {1.f, 1.f, 1.f, 1.f}, hg1 = hg0; const bool hn = HN && u.pn < 8;
        if (HN) { if (hn) {
#pragma unroll
            for (int ai = 0; ai < 2; ++ai)
#pragma unroll
                for (int m = 0; m < 4; ++m)
#pragma unroll
                    for (int bj = 0; bj < 2; ++bj) { const f32x4 v0 = acc[ai][bj][m][0] * rr[ai][m], v1 = acc[ai][bj][m][1] * rr[ai][m];
                        float t = ((v0[0] * v0[0] + v0[1] * v0[1]) + (v0[2] * v0[2] + v0[3] * v0[3])) + ((v1[0] * v1[0] + v1[1] * v1[1]) + (v1[2] * v1[2] + v1[3] * v1[3]));
                        t += lane_read(t, (fq * 16 + fr) ^ 16); t += lane_read(t, (fq * 16 + fr) ^ 32);
                        if (fq == 0) xs[(ai * HALF + wr * 64 + m * 16 + fr) * 8 + bj * 4 + wc] = t; }
            asm volatile("s_waitcnt lgkmcnt(0)" ::: "memory"); __builtin_amdgcn_s_barrier(); asm volatile("" ::: "memory");
            hg0 = *(const f32x4*)(hgain + wc * 32 + 8 * fq); hg1 = *(const f32x4*)(hgain + wc * 32 + 8 * fq + 4);
        } }
#pragma unroll
        for (int ai = 0; ai < 2; ++ai) {
            if (RSCALE) { if (has_next) load_raw(nxt, ai, wr, fr, fq, raw); }
#pragma unroll
            for (int m = 0; m < 4; ++m) { const int row = row0 + ai * HALF + m * 16; float s = 0.f; float hnr[2] = {1.f, 1.f};
                if (HN) { if (hn) { const PG8_LAS f32x4* xp = (const PG8_LAS f32x4*)(xs + (ai * HALF + wr * 64 + m * 16 + fr) * 8); const f32x4 a = xp[0], b = xp[1];
                    hnr[0] = 1.0f / sqrtf(((a[0] + a[1]) + (a[2] + a[3])) * (1.0f / 128.0f) + RS_EPS); hnr[1] = 1.0f / sqrtf(((b[0] + b[1]) + (b[2] + b[3])) * (1.0f / 128.0f) + RS_EPS); } }
                bf16_t* rowp = HEADMAJOR ? O + (u.pn >= 8 ? (size_t)16384 * 2048 : (size_t)0) + ((size_t)((row >> 12) * 16 + 2 * (u.pn & 7)) * 4096 + (row & 4095)) * 128 + wc * 32 + 8 * fq
                                         : O + (size_t)row * ldc + col0;
#pragma unroll
                for (int bj = 0; bj < 2; ++bj) { f32x4 v0 = acc[ai][bj][m][0], v1 = acc[ai][bj][m][1];
                    if (RSCALE) { v0 = v0 * rr[ai][m]; v1 = v1 * rr[ai][m]; }
                    if (HN) { if (hn) { v0 = (v0 * hnr[bj]) * hg0; v1 = (v1 * hnr[bj]) * hg1; } }
                    if (MODE == 1) { f32x2 a = gelu_pk((f32x2){v0[0], v0[1]}), b = gelu_pk((f32x2){v0[2], v0[3]}), c = gelu_pk((f32x2){v1[0], v1[1]}), d = gelu_pk((f32x2){v1[2], v1[3]});
                        v0 = (f32x4){a.x, a.y, b.x, b.y}; v1 = (f32x4){c.x, c.y, d.x, d.y};
                        s += (v0[0] * v0[0] + v0[1] * v0[1]) + (v0[2] * v0[2] + v0[3] * v0[3]) + (v1[0] * v1[0] + v1[1] * v1[1]) + (v1[2] * v1[2] + v1[3] * v1[3]); }
                    if (MODE == 2) { if (up) {
#pragma unroll
                        for (int e = 0; e < 4; ++e) { v0[e] = __builtin_amdgcn_rcpf(1.0f + __builtin_amdgcn_exp2f(-1.4426950408889634f * v0[e])); v1[e] = __builtin_amdgcn_rcpf(1.0f + __builtin_amdgcn_exp2f(-1.4426950408889634f * v1[e])); } } }
                    u32x4 w; w.x = cvt_pk_bf16(v0[0], v0[1]); w.y = cvt_pk_bf16(v0[2], v0[3]); w.z = cvt_pk_bf16(v1[0], v1[1]); w.w = cvt_pk_bf16(v1[2], v1[3]);
                    *(u32x4*)(rowp + (HEADMAJOR ? (size_t)bj * 4096 * 128 : (size_t)bj * HALF)) = w; }
                if (MODE == 1) { if (up) { s += lane_read(s, (fq * 16 + fr) ^ 16); s += lane_read(s, (fq * 16 + fr) ^ 32); if (fq == 0) ss[(size_t)row * 32 + (u.pn - split_pn) * 4 + wc] = s; } } }
            if (RSCALE) { if (has_next) reduce_raw(raw, ai, wr, wc, fr, fq); } }
    }
};
struct EpiRes {
    static constexpr bool PERM = true, AFTER_DRAIN = false, IDEMPOTENT = false;
    bf16_t* hb; float* rss; int ldc;
    __device__ __forceinline__ void init(const Unit&, int, int, int, int) const {}
    __device__ __forceinline__ void operator()(const f32x4 (&acc)[2][2][4][2], const Unit& u, const Unit&, bool, int wr, int wc, int fr, int fq) const {
        const int row0 = u.pm * BM + wr * 64 + fr, col0 = u.pn * BM + wc * 32 + 8 * fq;
        u32x4 bn[2][2];
#pragma unroll
        for (int mm = 0; mm < 2; ++mm)
#pragma unroll
            for (int bj = 0; bj < 2; ++bj) bn[mm][bj] = *(const u32x4*)(hb + (size_t)(row0 + mm * 16) * ldc + col0 + bj * HALF);
#pragma unroll
        for (int c = 0; c < 4; ++c) { const int ai = c >> 1; u32x4 b[2][2];
#pragma unroll
            for (int mm = 0; mm < 2; ++mm)
#pragma unroll
                for (int bj = 0; bj < 2; ++bj) b[mm][bj] = bn[mm][bj];
            if (c < 3) { const int c1 = c + 1, ai1 = c1 >> 1;
#pragma unroll
                for (int mm = 0; mm < 2; ++mm)
#pragma unroll
                    for (int bj = 0; bj < 2; ++bj) bn[mm][bj] = *(const u32x4*)(hb + (size_t)(row0 + ai1 * HALF + (2 * (c1 & 1) + mm) * 16) * ldc + col0 + bj * HALF); }
#pragma unroll
            for (int mm = 0; mm < 2; ++mm) { const int m = 2 * (c & 1) + mm; const int row = row0 + ai * HALF + m * 16; const size_t off = (size_t)row * ldc + col0; float s = 0.f;
#pragma unroll
                for (int bj = 0; bj < 2; ++bj) { const u32x4 q = b[mm][bj];
                    const f32x4 o0 = (f32x4){__uint_as_float(q.x << 16), __uint_as_float(q.x & 0xffff0000u), __uint_as_float(q.y << 16), __uint_as_float(q.y & 0xffff0000u)} + acc[ai][bj][m][0];
                    const f32x4 o1 = (f32x4){__uint_as_float(q.z << 16), __uint_as_float(q.z & 0xffff0000u), __uint_as_float(q.w << 16), __uint_as_float(q.w & 0xffff0000u)} + acc[ai][bj][m][1];
                    u32x4 w; w.x = cvt_pk_bf16(o0[0], o0[1]); w.y = cvt_pk_bf16(o0[2], o0[3]); w.z = cvt_pk_bf16(o1[0], o1[1]); w.w = cvt_pk_bf16(o1[2], o1[3]);
                    *(u32x4*)(hb + off + bj * HALF) = w;
                    s += ((o0[0] * o0[0] + o0[1] * o0[1]) + (o0[2] * o0[2] + o0[3] * o0[3])) + ((o1[0] * o1[0] + o1[1] * o1[1]) + (o1[2] * o1[2] + o1[3] * o1[3])); }
                s += lane_read(s, (fq * 16 + fr) ^ 16); s += lane_read(s, (fq * 16 + fr) ^ 32); if (fq == 0) rss[(size_t)row * 32 + u.pn * 4 + wc] = s; } }
    }
};
template <class Epi, class Sched, bool ALIGN_EPI = false, bool SP2 = false>
__device__ __forceinline__ void gemm_phase(PG8_LAS unsigned char* lds, const Gemm g, const Sched& S, const Epi& E) {
    const int tid = opaque_tid(), wid = __builtin_amdgcn_readfirstlane(tid >> 6), lane = tid & 63, wr = wid >> 2, wc = wid & 3, fr = lane & 15, fq = lane >> 4;
    const int K = g.K, nt = K / BK;
    unsigned voffA[2], voffB[2];
#pragma unroll
    for (int i = 0; i < 2; ++i) { int R, C; stage_rc(tid * 16 + i * 8192, R, C); const int Rb = Epi::PERM ? ((R & ~31) + perm32(R & 31)) : R;
        voffA[i] = (unsigned)(R * K + C) * 2u; voffB[i] = (unsigned)(Rb * K + C) * 2u; }
    const size_t kstep = (size_t)(BK * 2);
    const size_t hstep = (size_t)HALF * K * 2;
    const size_t tstep = 2 * hstep;
    const unsigned ldsw = (unsigned)wid * 1024u;
    const int aoff = lds_byte(wr * 64 + fr, fq * 8), boff = lds_byte(wc * 32 + fr, fq * 8);
#define PG8_SA(b, h) (((b) * 2 + (h)) * HTB)
#define PG8_SB(b, h) ((4 + (b) * 2 + (h)) * HTB)
#define PG8_STAGE(bufoff, gbase, voff) do { _Pragma("unroll") for (int _i = 0; _i < 2; ++_i) \
        __builtin_amdgcn_global_load_lds((const unsigned*)((const char*)(gbase) + (voff)[_i]), (PG8_LAS unsigned*)(lds + (bufoff) + ldsw + _i * 8192), 16, 0, 0); } while (0)
#define PG8_LDA(dst, b, h) do { _Pragma("unroll") for (int m = 0; m < 4; ++m) _Pragma("unroll") for (int k = 0; k < 2; ++k) dst[m][k] = *(const PG8_LAS bf16x8*)(lds + PG8_SA(b, h) + aoff + m * 2048 + k * 1024); } while (0)
#define PG8_LDB(dst, b, h) do { _Pragma("unroll") for (int n = 0; n < 2; ++n) _Pragma("unroll") for (int k = 0; k < 2; ++k) dst[n][k] = *(const PG8_LAS bf16x8*)(lds + PG8_SB(b, h) + boff + n * 2048 + k * 1024); } while (0)
#define PG8_MMA(ai, bj, At, Bt) do { __builtin_amdgcn_s_setprio(1); _Pragma("unroll") for (int m = 0; m < 4; ++m) _Pragma("unroll") for (int n = 0; n < 2; ++n) _Pragma("unroll") for (int k = 0; k < 2; ++k) \
        acc[ai][bj][m][n] = __builtin_amdgcn_mfma_f32_16x16x32_bf16(Bt[n][k], At[m][k], acc[ai][bj][m][n], 0, 0, 0); __builtin_amdgcn_s_setprio(0); } while (0)
#define PG8_WAIT_V(n) asm volatile("s_waitcnt vmcnt(" #n ")" ::: "memory")
#define PG8_WAIT_L(n) asm volatile("s_waitcnt lgkmcnt(" #n ")" ::: "memory")
#define PG8_BAR __builtin_amdgcn_s_barrier()
#define PG8_SCHED __builtin_amdgcn_sched_barrier(0)
    Unit cur, nxt; int ui = 0;
    if (!S.next(0, cur)) return;
    E.init(cur, wr, wc, fr, fq);
    f32x4 acc[2][2][4][2];
#pragma unroll
    for (int a = 0; a < 2; ++a)
#pragma unroll
        for (int b = 0; b < 2; ++b)
#pragma unroll
            for (int m = 0; m < 4; ++m)
#pragma unroll
                for (int n = 0; n < 2; ++n) acc[a][b][m][n] = (f32x4){0.f, 0.f, 0.f, 0.f};
    bf16x8 At[4][2], B0[2][2], B1[2][2];
    const char* cA = (const char*)g.A + (size_t)cur.pm * tstep; const char* cB = (const char*)g.Bt + (size_t)cur.pn * tstep;
    S.a_ready(cur);
    if constexpr (SP2) {
        PG8_STAGE(PG8_SB(0, 0), cB, voffB); PG8_STAGE(PG8_SB(0, 1), cB + hstep, voffB); PG8_STAGE(PG8_SA(0, 0), cA, voffA); PG8_STAGE(PG8_SA(0, 1), cA + hstep, voffA);
        if (wr == 1) PG8_BAR;
        PG8_WAIT_V(2); PG8_BAR;
        PG8_STAGE(PG8_SB(1, 0), cB + kstep, voffB); PG8_STAGE(PG8_SA(1, 0), cA + kstep, voffA); PG8_STAGE(PG8_SB(1, 1), cB + hstep + kstep, voffB);
        PG8_WAIT_V(6); PG8_BAR;
    } else {
        PG8_STAGE(PG8_SB(0, 0), cB, voffB); PG8_STAGE(PG8_SA(0, 0), cA, voffA); PG8_STAGE(PG8_SB(0, 1), cB + hstep, voffB); PG8_STAGE(PG8_SA(0, 1), cA + hstep, voffA);
        if (wr == 1) PG8_BAR;
        PG8_WAIT_V(4); PG8_BAR;
        PG8_STAGE(PG8_SB(1, 0), cB + kstep, voffB); PG8_STAGE(PG8_SA(1, 0), cA + kstep, voffA); PG8_STAGE(PG8_SB(1, 1), cB + hstep + kstep, voffB);
        PG8_WAIT_V(6); PG8_BAR;
    }
    for (;;) {
        const bool has_next = S.next(ui + 1, nxt);
        const char* nA = has_next ? (const char*)g.A + (size_t)nxt.pm * tstep : cA; const char* nB = has_next ? (const char*)g.Bt + (size_t)nxt.pn * tstep : cB;
        for (int t = 0; t < nt; t += 2) {
            const bool last = (t == nt - 2);
            const char* a1 = cA + (size_t)(t + 1) * kstep;
            const char* a2 = last ? nA : cA + (size_t)(t + 2) * kstep; const char* b2 = last ? nB : cB + (size_t)(t + 2) * kstep;
            const char* a3 = a2 + kstep; const char* b3 = b2 + kstep;
            if (last && has_next) S.a_ready(nxt);
            if constexpr (SP2) {
            PG8_LDB(B0, 0, 0); PG8_LDB(B1, 0, 1); PG8_SCHED; PG8_LDA(At, 0, 0); PG8_STAGE(PG8_SA(1, 1), a1 + hstep, voffA);
            PG8_WAIT_V(8); PG8_WAIT_L(0); PG8_BAR; PG8_MMA(0, 0, At, B0); PG8_MMA(0, 1, At, B1); PG8_BAR; PG8_SCHED;
            PG8_LDA(At, 0, 1); PG8_STAGE(PG8_SB(0, 0), b2, voffB); PG8_STAGE(PG8_SB(0, 1), b2 + hstep, voffB); PG8_STAGE(PG8_SA(0, 0), a2, voffA);
            PG8_WAIT_V(8); PG8_WAIT_L(0); PG8_BAR; PG8_MMA(1, 0, At, B0); PG8_MMA(1, 1, At, B1); PG8_BAR; PG8_SCHED;
            PG8_LDB(B0, 1, 0); PG8_LDB(B1, 1, 1); PG8_SCHED; PG8_LDA(At, 1, 0); PG8_STAGE(PG8_SA(0, 1), a2 + hstep, voffA);
            PG8_WAIT_V(8); PG8_WAIT_L(0); PG8_BAR; PG8_MMA(0, 0, At, B0); PG8_MMA(0, 1, At, B1); PG8_BAR; PG8_SCHED;
            PG8_LDA(At, 1, 1); PG8_STAGE(PG8_SB(1, 0), b3, voffB); PG8_STAGE(PG8_SB(1, 1), b3 + hstep, voffB); PG8_STAGE(PG8_SA(1, 0), a3, voffA);
            PG8_WAIT_V(8); PG8_WAIT_L(0); PG8_BAR; PG8_MMA(1, 0, At, B0); PG8_MMA(1, 1, At, B1); PG8_BAR; PG8_SCHED;
            } else {
            PG8_LDB(B0, 0, 0); PG8_SCHED; PG8_LDA(At, 0, 0); PG8_STAGE(PG8_SA(1, 1), a1 + hstep, voffA);
            PG8_WAIT_L(8); PG8_BAR; PG8_WAIT_L(0); PG8_MMA(0, 0, At, B0); PG8_BAR; PG8_SCHED;
            PG8_LDB(B1, 0, 1); PG8_STAGE(PG8_SB(0, 0), b2, voffB);
            PG8_BAR; PG8_WAIT_L(0); PG8_MMA(0, 1, At, B1); PG8_BAR;
            PG8_LDA(At, 0, 1); PG8_STAGE(PG8_SA(0, 0), a2, voffA);
            PG8_BAR; PG8_WAIT_L(0); PG8_MMA(1, 0, At, B0); PG8_BAR; PG8_SCHED;
            PG8_STAGE(PG8_SB(0, 1), b2 + hstep, voffB);
            PG8_WAIT_V(6); PG8_BAR; PG8_MMA(1, 1, At, B1); PG8_BAR;
            PG8_LDB(B0, 1, 0); PG8_SCHED; PG8_LDA(At, 1, 0); PG8_STAGE(PG8_SA(0, 1), a2 + hstep, voffA);
            PG8_WAIT_L(8); PG8_BAR; PG8_WAIT_L(0); PG8_MMA(0, 0, At, B0); PG8_BAR; PG8_SCHED;
            PG8_LDB(B1, 1, 1); PG8_STAGE(PG8_SB(1, 0), b3, voffB);
            PG8_BAR; PG8_WAIT_L(0); PG8_MMA(0, 1, At, B1); PG8_BAR;
            PG8_LDA(At, 1, 1); PG8_STAGE(PG8_SA(1, 0), a3, voffA);
            PG8_BAR; PG8_WAIT_L(0); PG8_MMA(1, 0, At, B0); PG8_BAR; PG8_SCHED;
            PG8_STAGE(PG8_SB(1, 1), b3 + hstep, voffB);
            PG8_WAIT_V(6); PG8_BAR; PG8_MMA(1, 1, At, B1); PG8_BAR;
            }
        }
        if constexpr (ALIGN_EPI) { if (wr == 0) PG8_BAR; }
        if constexpr (!Epi::AFTER_DRAIN) { E(acc, cur, nxt, has_next, wr, wc, fr, fq); S.done(cur); }
        if (!has_next) break;
#pragma unroll
        for (int a = 0; a < 2; ++a)
#pragma unroll
            for (int b = 0; b < 2; ++b)
#pragma unroll
                for (int m = 0; m < 4; ++m)
#pragma unroll
                    for (int n = 0; n < 2; ++n) acc[a][b][m][n] = (f32x4){0.f, 0.f, 0.f, 0.f};
        cur = nxt; cA = nA; cB = nB; ++ui;
        if constexpr (ALIGN_EPI) { if (wr == 1) PG8_BAR; }
    }
    PG8_WAIT_V(0);
    if constexpr (!ALIGN_EPI) { if (wr == 0) PG8_BAR; }
    PG8_BAR;
    if constexpr (Epi::AFTER_DRAIN) { E.fused(acc, cur, wr, wc, fr, fq, lds, wid, lane); S.done(cur); }
#undef PG8_SA
#undef PG8_SB
#undef PG8_STAGE
#undef PG8_LDA
#undef PG8_LDB
#undef PG8_MMA
#undef PG8_WAIT_V
#undef PG8_WAIT_L
#undef PG8_BAR
#undef PG8_SCHED
}
}
namespace att {
constexpr int D = 128, LDQ = 4096, LDK = 128, LDO = 2048, LDG = 4096;
constexpr float THR = 16.f; constexpr bool WSKIP = false;
typedef unsigned u32x4_t __attribute__((ext_vector_type(4)));
typedef short bf16x8_t __attribute__((ext_vector_type(8)));
__device__ __forceinline__ bf16x8_t ka_frag(unsigned lo, unsigned up, int hi) {
    u32x4_t w; w.x = hi ? 0u : lo; w.y = hi ? 0u : (up & 0xffffu); w.z = 0u; w.w = 0u;
    return __builtin_bit_cast(bf16x8_t, w);
}
__device__ __forceinline__ bf16x8_t qa_frag(int hi) {
    u32x4_t w; w.x = hi ? 0u : 0x3f803f80u; w.y = hi ? 0u : 0x00003f80u; w.z = 0u; w.w = 0u;
    return __builtin_bit_cast(bf16x8_t, w);
}
constexpr float SCALE = 0.08838834764831845f;
constexpr int NW = 8, QBLK = 32, KVBLK = 64, QB = NW * QBLK;
constexpr int SHM_V = KVBLK * D * 2, SHM_K = KVBLK * D * 2;
constexpr int ATT_LDS_BYTES = 2 * SHM_V + 2 * SHM_K + NW * 64 * 4;

using bf16 = __hip_bfloat16;
typedef short bf16x8 __attribute__((ext_vector_type(8)));
typedef short s16x4 __attribute__((ext_vector_type(4)));
typedef float f32x16 __attribute__((ext_vector_type(16)));
typedef float f32x4 __attribute__((ext_vector_type(4)));
typedef unsigned u32x4 __attribute__((ext_vector_type(4)));
template <class A, class Bt> struct same_t { static constexpr bool v = false; };
template <class A> struct same_t<A, A> { static constexpr bool v = true; };

#define KSWZ(row, colB) ((row) * 256 + ((colB) ^ (((row) & 7) << 4)))
#define SBAR() __builtin_amdgcn_sched_barrier(0)
__device__ __forceinline__ int v_st(int k, int c) { const int kk = (k & ~0xC) | ((k & 4) << 1) | ((k & 8) >> 1); return ((kk >> 3) * 4 + (c >> 5)) * 512 + ((kk & 7) * 32 + (c & 31)) * 2; }
__device__ __forceinline__ int v_rd_base(int lane) { return ((lane & 3) << 3) | (((lane >> 2) & 3) << 6) | (((lane >> 4) & 1) << 5) | (((lane >> 5) & 1) << 8); }
constexpr int v_rd_off(int d0, int ks, int half) { return d0 * 512 + ks * 4096 + half * 2048; }
__device__ __forceinline__ int crow(int r, int hi) { return (r & 3) + 8 * (r >> 2) + 4 * hi; }
__device__ __forceinline__ unsigned cvtpk(float lo, float hi) {
    unsigned r; asm volatile("v_cvt_pk_bf16_f32 %0, %1, %2" : "=v"(r) : "v"(lo), "v"(hi)); return r;
}
__device__ __forceinline__ bf16x8 pack8(f32x4 a, f32x4 b) {
    u32x4 w = {cvtpk(a[0], a[1]), cvtpk(a[2], a[3]), cvtpk(b[0], b[1]), cvtpk(b[2], b[3])};
    return *reinterpret_cast<bf16x8*>(&w);
}
template <class T> __device__ __forceinline__ bf16x8 load8(const T* p) {
    if constexpr (same_t<T, float>::v) { return pack8(*(const f32x4*)p, *(const f32x4*)(p + 4)); }
    else { return *reinterpret_cast<const bf16x8*>(p); }
}
__device__ __forceinline__ void mask_tile(f32x16& p0, f32x16& p1, int dq, unsigned W) {
    const float NEG = -__builtin_inff();
#pragma unroll
    for (int r = 0; r < 16; ++r) {
        const int c = (r & 3) + 8 * (r >> 2);
        if ((unsigned)(dq - c) >= W) p0[r] = NEG;
        if ((unsigned)(dq - c - 32) >= W) p1[r] = NEG;
    }
}
__device__ __forceinline__ void partialSM(f32x16& p0, f32x16& p1, float& m_reg, float& mn, float& alpha) {
    float pmax = p0[0]; for (int r = 1; r < 16; ++r) pmax = fmaxf(pmax, p0[r]); for (int r = 0; r < 16; ++r) pmax = fmaxf(pmax, p1[r]);
    { auto rr = __builtin_amdgcn_permlane32_swap(__float_as_uint(pmax), __float_as_uint(pmax), false, false);
      pmax = fmaxf(__uint_as_float(rr[0]), __uint_as_float(rr[1])); }
    constexpr float C2 = 1.4426950408889634f * SCALE;
    if (__builtin_expect(__all((pmax - m_reg) * SCALE <= THR), 1)) { mn = m_reg; alpha = 1.f; }
    else { mn = fmaxf(m_reg, pmax); alpha = __builtin_amdgcn_exp2f((m_reg - mn) * C2); m_reg = mn; }
    const float mnL = -mn * C2;
    for (int r = 0; r < 16; ++r) p0[r] = fmaf(p0[r], C2, mnL); for (int r = 0; r < 16; ++r) p1[r] = fmaf(p1[r], C2, mnL);
    for (int r = 0; r < 16; ++r) p0[r] = __builtin_amdgcn_exp2f(p0[r]);
}
__device__ __forceinline__ void finishSM(f32x16& p0, f32x16& p1, float alpha, float& l_reg, bf16x8& pa0, bf16x8& pa1, bf16x8& pa2, bf16x8& pa3) {
    for (int r = 0; r < 16; ++r) p1[r] = __builtin_amdgcn_exp2f(p1[r]);
    float ps = 0; for (int r = 0; r < 16; ++r) ps += p0[r]; for (int r = 0; r < 16; ++r) ps += p1[r];
    { auto rr = __builtin_amdgcn_permlane32_swap(__float_as_uint(ps), __float_as_uint(ps), false, false);
      ps = __uint_as_float(rr[0]) + __uint_as_float(rr[1]); }
    l_reg = l_reg * alpha + ps;
#define PK4(P, B_, OUT) do { unsigned a0 = cvtpk(P[B_+0], P[B_+1]), a1 = cvtpk(P[B_+2], P[B_+3]);                          \
        unsigned b0 = cvtpk(P[B_+4], P[B_+5]), b1 = cvtpk(P[B_+6], P[B_+7]);                                             \
        auto r0 = __builtin_amdgcn_permlane32_swap(a0, b0, false, false); auto r1 = __builtin_amdgcn_permlane32_swap(a1, b1, false, false); \
        u32x4 w = {r0[0], r1[0], r0[1], r1[1]}; OUT = *reinterpret_cast<bf16x8*>(&w); } while (0)
    PK4(p0, 0, pa0); PK4(p0, 8, pa1); PK4(p1, 0, pa2); PK4(p1, 8, pa3);
#undef PK4
}
template <int KB, bool SK>
__device__ __forceinline__ void qkt(f32x16& p0, f32x16& p1, const char* K_lds, int r32, int hi, const bf16x8* qr, bool act, unsigned long long c) {
    if (SK && !act) { const float NEG = -__builtin_inff();
#pragma unroll
        for (int r = 0; r < 16; ++r) { p0[r] = NEG; p1[r] = NEG; } return; }
    p0 = f32x16{}; p1 = f32x16{};
    const char* kb[4];
#pragma unroll
    for (int dd = 0; dd < 4; ++dd) kb[dd] = K_lds + KB * SHM_K + KSWZ(r32, (dd * 16 + hi * 8) * 2);
#pragma unroll
    for (int d0 = 0; d0 < 8; ++d0) { const char* a = kb[d0 & 3] + (d0 >> 2) * 128;
        bf16x8 b0 = *reinterpret_cast<const bf16x8*>(a);
        bf16x8 b1 = *reinterpret_cast<const bf16x8*>(a + 32 * 256);
        p0 = __builtin_amdgcn_mfma_f32_32x32x16_bf16(b0, qr[d0], p0, 0, 0, 0);
        p1 = __builtin_amdgcn_mfma_f32_32x32x16_bf16(b1, qr[d0], p1, 0, 0, 0); }
    { int h2 = hi; asm volatile("" : "+v"(h2));
      const bf16x8 qaf = qa_frag(h2);
      const unsigned cl = (unsigned)c, cu = (unsigned)(c >> 32);
      auto r0 = __builtin_amdgcn_permlane32_swap(cl, cl, false, false); auto r1 = __builtin_amdgcn_permlane32_swap(cu, cu, false, false);
      p0 = __builtin_amdgcn_mfma_f32_32x32x16_bf16(ka_frag(r0[0], r1[0], hi), qaf, p0, 0, 0, 0);
      p1 = __builtin_amdgcn_mfma_f32_32x32x16_bf16(ka_frag(r0[1], r1[1], hi), qaf, p1, 0, 0, 0); }
}
template <int VB, bool SK>
__device__ __forceinline__ void pv_tile(f32x16* o, int vb0, bf16x8 pa0, bf16x8 pa1, bf16x8 pa2, bf16x8 pa3, bool act) {
    if (SK && !act) return;
#define TRRD(dst, off) asm volatile("ds_read_b64_tr_b16 %0, %1 offset:%2" : "=&v"(dst) : "v"(vb0), "i"(off) : "memory")
#define PV_D0(d0) do { s16x4 l0, l1, l2, l3, h0, h1, h2, h3; constexpr int b_ = VB * SHM_V + v_rd_off(d0, 0, 0);     \
        TRRD(l0, b_); TRRD(h0, b_ + 2048); TRRD(l1, b_ + 4096); TRRD(h1, b_ + 6144); TRRD(l2, b_ + 8192); TRRD(h2, b_ + 10240); TRRD(l3, b_ + 12288); TRRD(h3, b_ + 14336); \
        asm volatile("s_waitcnt lgkmcnt(0)" ::: "memory"); SBAR();                 \
        o[d0] = __builtin_amdgcn_mfma_f32_32x32x16_bf16(pa0, (bf16x8){l0[0], l0[1], l0[2], l0[3], h0[0], h0[1], h0[2], h0[3]}, o[d0], 0, 0, 0);   \
        o[d0] = __builtin_amdgcn_mfma_f32_32x32x16_bf16(pa1, (bf16x8){l1[0], l1[1], l1[2], l1[3], h1[0], h1[1], h1[2], h1[3]}, o[d0], 0, 0, 0);   \
        o[d0] = __builtin_amdgcn_mfma_f32_32x32x16_bf16(pa2, (bf16x8){l2[0], l2[1], l2[2], l2[3], h2[0], h2[1], h2[2], h2[3]}, o[d0], 0, 0, 0);   \
        o[d0] = __builtin_amdgcn_mfma_f32_32x32x16_bf16(pa3, (bf16x8){l3[0], l3[1], l3[2], l3[3], h3[0], h3[1], h3[2], h3[3]}, o[d0], 0, 0, 0); } while (0)
    PV_D0(0); PV_D0(1); PV_D0(2); PV_D0(3);
#undef PV_D0
#undef TRRD
}

template <class TIn, class TOut> struct BlockRef { const TIn* Q; const TIn* K; const TIn* V; TOut* O; const unsigned short* G; const unsigned long long* CA; int P0; };
template <class TIn> struct Seam {
    bf16x8 qr[8];
    bf16x8 st_v0, st_v1, st_k0, st_k1; f32x4 sf0, sf1, sf2, sf3;
    unsigned long long ca;
    f32x4 tq[16];
};
__device__ __forceinline__ int swa_jlo(int P0, int W) { const int lowk = P0 - W + 1; return lowk > 0 ? lowk / KVBLK : 0; }
#define ROW(p, k0, rr) ((p) + (size_t)((k0) + (rr)) * LDK + sc)
#define VMW() asm volatile("s_waitcnt vmcnt(0)" ::: "memory")
#define VMWN(n) asm volatile("s_waitcnt vmcnt(%0)" :: "i"(n) : "memory")
#define SLOAD_H(Kp, Vp, CAp, k0) do { S.st_v0 = load8<TIn>(ROW(Vp, k0, sr)); S.st_v1 = load8<TIn>(ROW(Vp, k0, 32 + sr));              \
                         S.st_k0 = load8<TIn>(ROW(Kp, k0, sr)); S.st_k1 = load8<TIn>(ROW(Kp, k0, 32 + sr)); S.ca = (CAp)[(k0) + lane]; } while (0)
#define SWRITE_HK(bf) do { *(bf16x8*)(K_lds + (bf) * SHM_K + kws) = S.st_k0; *(bf16x8*)(K_lds + (bf) * SHM_K + kws + 32 * 256) = S.st_k1; } while (0)
#define SWRITE_HV(bf) do { *(bf16x8*)(V_lds + (bf) * SHM_V + vst0) = S.st_v0; *(bf16x8*)(V_lds + (bf) * SHM_V + vst1) = S.st_v1; } while (0)
#define SWRITE_H(bf) do { SWRITE_HV(bf); SWRITE_HK(bf); } while (0)
#define SLOAD_F(p, k0) do { S.sf0 = *(const f32x4*)ROW(p, k0, sr); S.sf1 = *(const f32x4*)(ROW(p, k0, sr) + 4);                \
                            S.sf2 = *(const f32x4*)ROW(p, k0, 32 + sr); S.sf3 = *(const f32x4*)(ROW(p, k0, 32 + sr) + 4); } while (0)
#define SWRITE_KF(bf) do { *(bf16x8*)(K_lds + (bf) * SHM_K + kws) = pack8(S.sf0, S.sf1); *(bf16x8*)(K_lds + (bf) * SHM_K + kws + 32 * 256) = pack8(S.sf2, S.sf3); } while (0)
#define SWRITE_VF(bf) do { *(bf16x8*)(V_lds + (bf) * SHM_V + vst0) = pack8(S.sf0, S.sf1); *(bf16x8*)(V_lds + (bf) * SHM_V + vst1) = pack8(S.sf2, S.sf3); } while (0)
template <class TIn, class TOut>
__device__ __forceinline__ void causal_swa_prime(const BlockRef<TIn, TOut>& cur, int W, char* lds, Seam<TIn>& S) {
    constexpr bool F32 = same_t<TIn, float>::v;
    const int tid = opaque_tid(), wid = __builtin_amdgcn_readfirstlane(tid >> 6), lane = tid & 63, r32 = lane & 31, hi = lane >> 5;
    const int sr = tid >> 4, sc = (tid & 15) * 8, kws = KSWZ(sr, sc * 2); char* K_lds = lds + 2 * SHM_V;
    const int kb0 = swa_jlo(cur.P0, W) * KVBLK;
    for (int d0 = 0; d0 < 8; ++d0) S.qr[d0] = load8<TIn>(cur.Q + (size_t)(wid * QBLK + r32) * LDQ + d0 * 16 + hi * 8);
    if constexpr (F32) { SLOAD_F((const float*)cur.K, kb0); VMW(); SWRITE_KF(0); SBAR(); SLOAD_F((const float*)cur.V, kb0); }
    else { SLOAD_H(cur.K, cur.V, cur.CA, kb0); VMW(); SWRITE_HK(0); }
    __syncthreads();
}
template <class TIn, class TOut>
__device__ __forceinline__ void causal_swa_block(const BlockRef<TIn, TOut>& cur, const BlockRef<TIn, TOut>& nxt, int skv, int W, char* lds, Seam<TIn>& S) {
    constexpr bool F32 = same_t<TIn, float>::v;
    const int tid = opaque_tid(), wid = __builtin_amdgcn_readfirstlane(tid >> 6), lane = tid & 63, r32 = lane & 31, hi = lane >> 5;
    const int j_lo = swa_jlo(cur.P0, W);
    int j_hi = (cur.P0 + QB - 1) / KVBLK + 1; if (j_hi > skv / KVBLK) j_hi = skv / KVBLK;
    const int NT = j_hi - j_lo;
    const int kbn = swa_jlo(nxt.P0, W) * KVBLK;
    const int qlo = cur.P0 + wid * QBLK, qm = qlo + r32 - 4 * hi;
    char* V_lds = lds; char* K_lds = lds + 2 * SHM_V;
    float* ws = (float*)(lds + 2 * SHM_V + 2 * SHM_K) + wid * 64; float* li_l = ws, * al_l = ws + 32;
    float m_reg = -1e30f, l_reg = 0; f32x16 o[4] = {};
    const int sr = tid >> 4, sc = (tid & 15) * 8, vst0 = v_st(sr, sc), vst1 = v_st(32 + sr, sc), kws = KSWZ(sr, sc * 2);
    const int vb0 = (int)(uintptr_t)V_lds + v_rd_base(lane);
    const TIn* Kh = cur.K; const TIn* Vh = cur.V; const unsigned long long* CAh = cur.CA;
#define RESC(a) do { if (__any((a) < 1.f)) { if (hi == 0) al_l[r32] = (a); asm volatile("s_waitcnt lgkmcnt(0)" ::: "memory");              \
                     for (int d_ = 0; d_ < 4; ++d_) for (int r = 0; r < 16; ++r) o[d_][r] *= al_l[crow(r, hi)]; } } while (0)
#define KBASE(t) ((j_lo + (t)) * KVBLK)
#define ACT(t) (KBASE(t) <= qlo + QBLK - 1 && KBASE(t) + KVBLK - 1 >= qlo - W + 1)
#define MASKT(P0_, P1_, t) do { const int kb_ = KBASE(t); if ((!SK || ACT(t)) && (kb_ + KVBLK - 1 > qlo || kb_ <= qlo + QBLK - 1 - W)) mask_tile(P0_, P1_, qm - kb_, (unsigned)W); } while (0)
    constexpr int NQL = F32 ? 16 : 8;
    constexpr bool SK = WSKIP && !F32;
#define SEAM_K0() do { VMWN(NQL); if constexpr (F32) { SWRITE_KF(0); SBAR(); SLOAD_F((const float*)nxt.V, kbn); } else { SWRITE_HK(0); } SBAR(); } while (0)
    f32x16 pA0, pA1, pB0, pB1; float mnA, mnB, alA, alB; bf16x8 pa0, pa1, pa2, pa3;
    if constexpr (F32) { VMW(); SWRITE_VF(0); SBAR(); } else { SWRITE_HV(0); SBAR(); }
    const unsigned long long hc = S.ca;
    if (NT > 1) { if constexpr (F32) SLOAD_F((const float*)Kh, KBASE(1)); else SLOAD_H(Kh, Vh, CAh, KBASE(1)); }
    SBAR(); qkt<0, SK>(pA0, pA1, K_lds, r32, hi, S.qr, ACT(0), hc);
    if constexpr (F32) { if (NT > 1) { VMW(); SWRITE_KF(1); SBAR(); SLOAD_F((const float*)Vh, KBASE(1)); } }
    MASKT(pA0, pA1, 0); partialSM(pA0, pA1, m_reg, mnA, alA);
    if (NT > 1) { VMW(); if constexpr (F32) { SWRITE_VF(1); SBAR(); if (NT > 2) SLOAD_F((const float*)Kh, KBASE(2)); } else SWRITE_H(1); }
    __syncthreads();
#define HALF_STEP(PX0, PX1, mnX, alX, PY0, PY1, alY, t, KB, VB, SB) do {                                                      \
        { const unsigned long long c_ = S.ca; SBAR(); qkt<KB, SK>(PX0, PX1, K_lds, r32, hi, S.qr, ACT(t), c_); }                                             \
        finishSM(PY0, PY1, alY, l_reg, pa0, pa1, pa2, pa3); SBAR();                                                           \
        if ((t) + 1 < NT) { if constexpr (F32) { VMW(); SWRITE_KF(SB); SBAR(); SLOAD_F((const float*)Vh, KBASE((t) + 1)); }  \
                            else { SLOAD_H(Kh, Vh, CAh, KBASE((t) + 1)); } SBAR(); }                                               \
        pv_tile<VB, SK>(o, vb0, pa0, pa1, pa2, pa3, ACT((t) - 1)); MASKT(PX0, PX1, (t)); partialSM(PX0, PX1, m_reg, mnX, alX);                                        \
        __syncthreads();                                                                                                      \
        if ((t) + 1 < NT) { VMW(); if constexpr (F32) { SWRITE_VF(SB); SBAR(); if ((t) + 2 < NT) SLOAD_F((const float*)Kh, KBASE((t) + 2)); } \
                            else { SWRITE_H(SB); } }                                                                          \
        RESC(alX); __syncthreads(); } while (0)
    for (int t = 1; t + 1 < NT; t += 2) {
        HALF_STEP(pB0, pB1, mnB, alB, pA0, pA1, alA, t, 1, 0, 0);
        HALF_STEP(pA0, pA1, mnA, alA, pB0, pB1, alB, t + 1, 0, 1, 1);
    }
    const bool even = (NT & 1) == 0;
    if (even) { const unsigned long long c_ = S.ca; SBAR(); qkt<1, SK>(pB0, pB1, K_lds, r32, hi, S.qr, ACT(NT - 1), c_); SBAR(); }
#define QROW(e) (nxt.Q + (size_t)(wid * QBLK + r32) * D + ((e) >> 1) * 16 + hi * 8 + ((e) & 1) * 4)
    if constexpr (F32) { SLOAD_F((const float*)nxt.K, kbn); SBAR();
#pragma unroll
        for (int e = 0; e < 8; ++e) S.tq[e] = *(const f32x4*)QROW(e); }
    else { SLOAD_H(nxt.K, nxt.V, nxt.CA, kbn); SBAR();
#pragma unroll
        for (int d0 = 0; d0 < 8; ++d0) S.qr[d0] = load8<TIn>(nxt.Q + (size_t)(wid * QBLK + r32) * LDQ + d0 * 16 + hi * 8); }
    SBAR();
    finishSM(pA0, pA1, alA, l_reg, pa0, pa1, pa2, pa3); SBAR();
    if constexpr (F32) {
#pragma unroll
        for (int e = 8; e < 16; ++e) S.tq[e] = *(const f32x4*)QROW(e); SBAR(); }
#undef QROW
    pv_tile<0, SK>(o, vb0, pa0, pa1, pa2, pa3, ACT(even ? NT - 2 : NT - 1));
    if (even) { MASKT(pB0, pB1, NT - 1); partialSM(pB0, pB1, m_reg, mnB, alB); __syncthreads(); RESC(alB);
        finishSM(pB0, pB1, alB, l_reg, pa0, pa1, pa2, pa3); SBAR(); pv_tile<1, SK>(o, vb0, pa0, pa1, pa2, pa3, ACT(NT - 1)); }
    SBAR(); SEAM_K0();
    if (hi == 0) li_l[r32] = l_reg; asm volatile("s_waitcnt lgkmcnt(0)" ::: "memory");
    float rli[16];
#pragma unroll
    for (int r = 0; r < 16; ++r) rli[r] = __builtin_amdgcn_rcpf(li_l[crow(r, hi)]);
    TOut* Ow = cur.O + (size_t)(wid * QBLK) * LDO; const unsigned short* Gw = cur.G + (size_t)(wid * QBLK) * LDG;
#pragma unroll
    for (int r = 0; r < 16; ++r) { const int orow = crow(r, hi);
#pragma unroll
        for (int d0 = 0; d0 < 4; ++d0) { const float v = o[d0][r] * rli[r];
            if constexpr (same_t<TOut, float>::v) { Ow[(size_t)orow * LDO + d0 * 32 + r32] = v; }
            else { const float vn = __builtin_bit_cast(float, __builtin_amdgcn_mov_dpp(__builtin_bit_cast(int, v), 0xB1, 0xf, 0xf, true));
                   if ((r32 & 1) == 0) { const unsigned g2 = *(const unsigned*)(Gw + (size_t)orow * LDG + d0 * 32 + r32);
                       *(unsigned*)(Ow + (size_t)orow * LDO + d0 * 32 + r32) = cvtpk(v * __uint_as_float(g2 << 16), vn * __uint_as_float(g2 & 0xffff0000u)); } } } }
    if constexpr (F32) {
#pragma unroll
        for (int d0 = 0; d0 < 8; ++d0) S.qr[d0] = pack8(S.tq[2 * d0], S.tq[2 * d0 + 1]); }
    __syncthreads();
#undef RESC
#undef KBASE
#undef ACT
#undef MASKT
#undef SEAM_K0
#undef HALF_STEP
}
#undef ROW
#undef VMW
#undef VMWN
#undef SLOAD_H
#undef SWRITE_HK
#undef SWRITE_HV
#undef SWRITE_H
#undef SLOAD_F
#undef SWRITE_KF
#undef SWRITE_VF

__host__ __device__ inline int swa_nx(int nqb, int nramp) { return (nramp + 1) / 2 + (nqb - nramp); }
struct SwaItem { int bh, qb0, qb1; };
__device__ __forceinline__ SwaItem swa_decode(int L, int nqb, int nx) {
    SwaItem it; const int xcd = L & 7, k = L >> 3, gi = k / nx, r = k - gi * nx;
    it.bh = gi * 8 + xcd; const int x = r;
    it.qb0 = nqb - 1 - x; it.qb1 = x;
    return it;
}
struct AttnT { const bf16* Q; const bf16* K; const bf16* V; bf16* O; const unsigned short* G; const unsigned long long* CA; };
__device__ __forceinline__ BlockRef<bf16, bf16> swa_ref(const SwaItem& it, int pass, const AttnT& T, int seq, int nh) {
    const int qb = pass ? it.qb1 : it.qb0, b = it.bh / nh, h = it.bh % nh; const size_t tok0 = (size_t)b * seq;
    BlockRef<bf16, bf16> r;
    r.Q = T.Q + (tok0 + (size_t)qb * QB) * LDQ + h * D; r.O = T.O + (tok0 + (size_t)qb * QB) * LDO + h * D; r.G = T.G + (tok0 + (size_t)qb * QB) * LDG + h * D;
    r.K = T.K + (size_t)it.bh * seq * D; r.V = T.V + (size_t)it.bh * seq * D; r.CA = T.CA + (size_t)it.bh * seq; r.P0 = qb * QB;
    return r;
}
__device__ __forceinline__ void attn_phase(char* lds, const AttnT& T, int nb, int nh, int seq) {
    const int W = 1 << 30, nqb = seq / QB, nx = nqb / 2, total = nx * nb * nh, stride = gridDim.x;
    int L = blockIdx.x; if (L >= total) return;
    SwaItem it = swa_decode(L, nqb, nx); int pass = 0;
    BlockRef<bf16, bf16> cur = swa_ref(it, 0, T, seq, nh);
    Seam<bf16> S;
    causal_swa_prime<bf16, bf16>(cur, W, lds, S);
    for (;;) {
        const bool more_pass = pass == 0 && it.qb1 != it.qb0, more_item = L + stride < total, last = !more_pass && !more_item;
        SwaItem itn = it; int passn = pass + 1, Ln = L;
        if (!more_pass) { passn = 0; Ln = more_item ? L + stride : L; itn = swa_decode(Ln, nqb, nx); }
        const BlockRef<bf16, bf16> nxt = last ? cur : swa_ref(itn, passn, T, seq, nh);
        causal_swa_block<bf16, bf16>(cur, nxt, seq, W, lds, S);
        if (last) break;
        cur = nxt; it = itn; pass = passn; L = Ln;
    }
}
#undef KSWZ
#undef SBAR
}
constexpr int DM = 2048, NB = 4, SEQ = 4096, MT = NB * SEQ, FF = 5632, FF2 = 2 * FF, NH = 16, HD = 128, CH = 128, NG = 16;
constexpr float EPS = 1e-6f;
constexpr int NWAVES = 8, NTHREADS = NWAVES * 64;
constexpr size_t MiB = 1u << 20;
constexpr size_t WS_BAR = 0, BAR_ZERO_BYTES = 16384;
constexpr size_t WS_LOGF = 1 * MiB;
constexpr size_t WS_CA = 2 * MiB;
constexpr size_t WS_WSB = 4 * MiB;
constexpr size_t WS_WF = 5 * MiB;
constexpr size_t WS_W_AIN = 6 * MiB;
constexpr size_t WS_W_AOUT = WS_W_AIN + 32 * MiB;
constexpr size_t WS_W_KV = WS_W_AOUT + 16 * MiB;
constexpr size_t WS_W_QG = WS_W_KV + 16 * MiB;
constexpr size_t WS_W_BOUT = WS_W_QG + 32 * MiB;
constexpr size_t WS_W_UP = WS_W_BOUT + 16 * MiB;
constexpr size_t WS_W_DN = WS_W_UP + 176 * MiB;
constexpr size_t WS_XN = WS_W_DN + 88 * MiB;
constexpr size_t WS_XN2 = WS_XN + 64 * MiB;
constexpr size_t WS_KV = WS_XN2 + 64 * MiB;
constexpr size_t WS_BIG = WS_KV + 128 * MiB;
constexpr size_t WS_ACT = WS_BIG + 352 * MiB;
constexpr size_t WS_SSP = WS_ACT + 176 * MiB;
constexpr size_t WS_END = WS_SSP + 2 * MiB;
constexpr int LDS_BYTES = 147456, MISC_OFF = LDS_BYTES - 64, XS_OFF = 131072, RRW_OFF = XS_OFF + 8192;

typedef unsigned short bf16_t;
typedef float f32x4 __attribute__((ext_vector_type(4)));
typedef unsigned u32x4 __attribute__((ext_vector_type(4)));
typedef unsigned u32x2 __attribute__((ext_vector_type(2)));
typedef short bf16x8 __attribute__((ext_vector_type(8)));
#define LAS __attribute__((address_space(3)))
__device__ __forceinline__ unsigned pk2(float lo, float hi) { return pg8::cvt_pk_bf16(lo, hi); }
__device__ __forceinline__ float bf_lo(unsigned w) { return __uint_as_float(w << 16); }
__device__ __forceinline__ float bf_hi(unsigned w) { return __uint_as_float(w & 0xffff0000u); }
__device__ __forceinline__ float wave_sum(float v, int lane) {
#pragma unroll
    for (int o = 1; o < 64; o <<= 1) v += lane_read(v, lane ^ o);
    return v;
}
struct Args { const float* in[21]; float* out; unsigned char* ws; };
#define XB_TMO      128
#define XB_XCNT(j)  (256  + 64 * (j))
#define XB_XSUB(j)  (1280 + 64 * (j))
#define XB_XGEN(j)  (2304 + 64 * (j))
#define XB_TOP      3328
#define XB_TOPGEN   3392
#define XCD_BAR_WORDS 3456
#define XB_SPIN_CAP (1u << 18)

__device__ __forceinline__ unsigned xb_ld(unsigned* p)              { return __hip_atomic_load(p, __ATOMIC_RELAXED, __HIP_MEMORY_SCOPE_AGENT); }
__device__ __forceinline__ unsigned xb_add(unsigned* p, unsigned v) { return __hip_atomic_fetch_add(p, v, __ATOMIC_RELAXED, __HIP_MEMORY_SCOPE_AGENT); }
__device__ __forceinline__ unsigned xb_xcc_id() { return (unsigned)__builtin_amdgcn_s_getreg((3 << 11) | 20) & 0xFu; }
#define XB_SPIN(cond, bar) do { unsigned _sp = 0; while (cond) { __builtin_amdgcn_s_sleep(1); \
    if ((++_sp & 255u) == 0u) { if (xb_ld(&(bar)[XB_TMO])) break; if (_sp > XB_SPIN_CAP) { atomicAdd(&(bar)[XB_TMO], 1u); break; } } } } while (0)

struct XcdBarrier {
    unsigned* bar; unsigned x;
    volatile LAS unsigned* st;
};

__device__ __forceinline__ XcdBarrier xcd_barrier_post(unsigned* bar, volatile LAS unsigned* st) {
    XcdBarrier b; b.bar = bar; b.x = xb_xcc_id(); b.st = st;
    if (threadIdx.x == 0) (void)xb_add(&bar[XB_XCNT(b.x)], 1u);
    return b;
}
__device__ __forceinline__ void xcd_barrier_complete(unsigned* bar, unsigned x, unsigned& nloc, unsigned& nx) {
    const unsigned G = gridDim.x * gridDim.y * gridDim.z;
    unsigned sum, cnt, mine, sp = 0u;
    for (;;) {
        sum = 0u; cnt = 0u; mine = 0u;
#pragma unroll
        for (unsigned j = 0; j < 16; ++j) { const unsigned c = xb_ld(&bar[XB_XCNT(j)]); sum += c; cnt += (c > 0u) ? 1u : 0u; mine = (j == x) ? c : mine; }
        if (sum == G) break;
        __builtin_amdgcn_s_sleep(1);
        if ((++sp & 255u) == 0u) { if (xb_ld(&bar[XB_TMO])) break; if (sp > XB_SPIN_CAP) { atomicAdd(&bar[XB_TMO], 1u); break; } }
    }
    nloc = mine > 0u ? mine : 1u; nx = cnt > 0u ? cnt : 1u;
}

__device__ __forceinline__ void xcd_barrier(const XcdBarrier& b) {
    asm volatile("s_waitcnt vmcnt(0)" ::: "memory");
    __syncthreads();
    if (threadIdx.x == 0) {
        unsigned* bar = b.bar;
        __builtin_amdgcn_s_waitcnt(0);
        unsigned nloc = b.st[0], nx = b.st[1];
        if (nloc == 0u) { xcd_barrier_complete(bar, b.x, nloc, nx); b.st[0] = nloc; b.st[1] = nx; }
        const unsigned old = xb_add(&bar[XB_XSUB(b.x)], 1u);
        const unsigned gen = old / nloc;
        if (old + 1u == (gen + 1u) * nloc) {
            __builtin_amdgcn_fence(__ATOMIC_RELEASE, "agent");
            asm volatile("s_waitcnt vmcnt(0)" ::: "memory");
            const unsigned og = xb_add(&bar[XB_TOP], 1u);
            const unsigned tg = og / nx;
            if (og + 1u == (tg + 1u) * nx) xb_add(&bar[XB_TOPGEN], 1u);
            else XB_SPIN(xb_ld(&bar[XB_TOPGEN]) == tg, bar);
            __builtin_amdgcn_fence(__ATOMIC_ACQUIRE, "agent");
            xb_add(&bar[XB_XGEN(b.x)], 1u);
            asm volatile("s_waitcnt vmcnt(0)" ::: "memory");
        } else {
            XB_SPIN(xb_ld(&bar[XB_XGEN(b.x)]) == gen, bar);
            __builtin_amdgcn_fence(__ATOMIC_ACQUIRE, "agent");
            asm volatile("s_waitcnt vmcnt(0)" ::: "memory");
        }
    }
    __syncthreads();
}


__device__ __forceinline__ int up_row(int n) { return n < FF ? (n >> 7) * 256 + (n & 127) : ((n - FF) >> 7) * 256 + 128 + ((n - FF) & 127); }
constexpr int TR_LDS_PER_WAVE = 64 * 65 * 4;
__device__ __forceinline__ void transpose_item(const float* W, int K, int ld, int ncols, const float* gk, bf16_t* WT, int mode, LAS float* scr, int item, int lane) {
    const int nblk = ncols / 64, kb = item / nblk, nb = item % nblk, k0 = 64 * kb, n0 = 64 * nb, kr = lane >> 4, n4 = (lane & 15) * 4;
    f32x4 v[16];
#pragma unroll
    for (int i = 0; i < 16; ++i) v[i] = *(const f32x4*)(W + (size_t)(k0 + 4 * i + kr) * ld + n0 + n4);
#pragma unroll
    for (int i = 0; i < 16; ++i) { const int kk = 4 * i + kr; const float g = gk ? gk[k0 + kk] : 1.f; LAS float* d = scr + kk * 65 + n4; d[0] = v[i].x * g; d[1] = v[i].y * g; d[2] = v[i].z * g; d[3] = v[i].w * g; }
    asm volatile("s_waitcnt lgkmcnt(0)" ::: "memory");
    const int c = lane & 7; const int r0 = mode ? up_row(n0) : n0;
#pragma unroll
    for (int j = 0; j < 8; ++j) { const int n = (lane >> 3) + 8 * j; const LAS float* p = scr + (8 * c) * 65 + n;
        u32x4 o; o.x = pk2(p[0 * 65], p[1 * 65]); o.y = pk2(p[2 * 65], p[3 * 65]); o.z = pk2(p[4 * 65], p[5 * 65]); o.w = pk2(p[6 * 65], p[7 * 65]);
        *(u32x4*)(WT + (size_t)(r0 + n) * K + k0 + 8 * c) = o; }
    asm volatile("s_waitcnt lgkmcnt(0)" ::: "memory");
}
__device__ __forceinline__ void fgate_rows(LAS unsigned char* ldsp, const bf16_t* hb, const float* rss, const bf16_t* wfh, const bf16_t* wfl, const float* bf, float* logf, int wave, int lane) {
    const int fr = lane & 15, fq = lane >> 4, kh = wave >> 2; LAS f32x4* part = (LAS f32x4*)ldsp;
    for (int rg0 = blockIdx.x * 4; rg0 < MT / 16; rg0 += gridDim.x * 4) {
        const int rg = rg0 + (wave & 3);
        const bf16_t* hrow = hb + (size_t)(rg * 16 + fr) * DM + 8 * fq + kh * (DM / 2); const bf16_t* wh = wfh + fr * DM + 8 * fq + kh * (DM / 2); const bf16_t* wl = wfl + fr * DM + 8 * fq + kh * (DM / 2);
        f32x4 acc = {0.f, 0.f, 0.f, 0.f};
#pragma unroll 8
        for (int ks = 0; ks < DM / 64; ++ks) {
            const bf16x8 hv = *(const bf16x8*)(hrow + 32 * ks), whv = *(const bf16x8*)(wh + 32 * ks), wlv = *(const bf16x8*)(wl + 32 * ks);
            acc = __builtin_amdgcn_mfma_f32_16x16x32_bf16(whv, hv, acc, 0, 0, 0);
            acc = __builtin_amdgcn_mfma_f32_16x16x32_bf16(wlv, hv, acc, 0, 0, 0);
        }
        __syncthreads();
        if (kh == 1) part[(wave & 3) * 64 + lane] = acc;
        __syncthreads();
        if (kh == 0) {
            acc = acc + part[(wave & 3) * 64 + lane];
            const f32x4* rp = (const f32x4*)(rss + (size_t)(rg * 16 + fr) * 32 + fq * 8); const f32x4 ra = rp[0], rb = rp[1];
            float ssq = ((ra[0] + ra[1]) + (ra[2] + ra[3])) + ((rb[0] + rb[1]) + (rb[2] + rb[3])); ssq += lane_read(ssq, lane ^ 16); ssq += lane_read(ssq, lane ^ 32);
            const float r = 1.0f / sqrtf(ssq * (1.0f / DM) + EPS);
            const f32x4 b = *(const f32x4*)(bf + 4 * fq); f32x4 o;
#pragma unroll
            for (int e = 0; e < 4; ++e) { const float f = acc[e] * r + b[e]; o[e] = fminf(f, 0.f) - log1pf(expf(-fabsf(f))); }
            *(f32x4*)(logf + (size_t)(rg * 16 + fr) * 16 + 4 * fq) = o;
        }
    }
}
__device__ __forceinline__ void scan_seq(const float* logf, unsigned long long* CA, int seq, int lane) {
    const int b = seq >> 4, hh = seq & 15;
    const float* lf = logf + ((size_t)b * SEQ + (size_t)lane * 64) * 16 + hh;
    float v[64];
#pragma unroll
    for (int i = 0; i < 64; ++i) v[i] = lf[i * 16];
#pragma unroll
    for (int i = 1; i < 64; ++i) v[i] += v[i - 1];
    const float tot = v[63]; float t = tot;
#pragma unroll
    for (int o = 1; o < 64; o <<= 1) { const float y = lane_read(t, lane >= o ? lane - o : lane); if (lane >= o) t += y; }
    const float excl = t - tot;
    unsigned long long* out = CA + (size_t)seq * SEQ + lane * 64;
#pragma unroll
    for (int i = 0; i < 64; ++i) { const float c = (excl + v[i]) * -11.313708498984761f;
        const unsigned h1 = pk2(c, 0.f) & 0xffffu; const float r1 = c - bf_lo(h1);
        const unsigned h2 = pk2(r1, 0.f) & 0xffffu; const float r2 = r1 - bf_lo(h2);
        const unsigned h3 = pk2(r2, 0.f) & 0xffffu;
        out[i] = (unsigned long long)(h1 | (h2 << 16)) | ((unsigned long long)h3 << 32); }
}
__device__ __forceinline__ void spatial_phase(LAS unsigned char* ldsp, const bf16_t* Z, const float* ssp, const bf16_t* wsb, const float* vnorm, const float* bs, bf16_t* GATED, int wave, int lane) {
    const int fr = lane & 15, fq = lane >> 4;
    for (int item = blockIdx.x; item < (MT / CH) * NG; item += gridDim.x) {
        const int ch = item >> 4, g = item & 15, row0 = ch * CH, cw = g * 128 + wave * 16;
        LAS float* rvs = (LAS float*)ldsp;
        __syncthreads();
        { const int t_ = wave * 64 + lane; if (t_ < CH) { const f32x4* p = (const f32x4*)(ssp + (size_t)(row0 + t_) * 32); float sq = 0.f;
#pragma unroll
            for (int q = 0; q < 8; ++q) { const f32x4 v = p[q]; sq += (v.x + v.y) + (v.z + v.w); }
            rvs[t_] = 1.0f / sqrtf(sq * (1.0f / DM) + EPS); } }
        __syncthreads();
        LAS unsigned* VS = (LAS unsigned*)(ldsp + 1024);
        { const int t_ = wave * 64 + lane, srow = t_ >> 2, c0 = (t_ & 3) * 32; const float rv = rvs[srow];
          const u32x4* gp = (const u32x4*)(Z + (size_t)(row0 + srow) * 4096 + 2048 + g * 128 + c0); u32x4 q[4];
#pragma unroll
          for (int jj = 0; jj < 4; ++jj) q[jj] = gp[jj];
#pragma unroll
          for (int jj = 0; jj < 4; ++jj) { LAS unsigned* d = VS + srow * 65 + (c0 >> 1) + jj * 4;
#pragma unroll
              for (int e = 0; e < 4; ++e) d[e] = pk2(bf_lo(q[jj][e]) * rv, bf_hi(q[jj][e]) * rv); } }
        __syncthreads();
        bf16x8 vf[4];
        { const LAS unsigned short* vs16 = (const LAS unsigned short*)VS + wave * 16 + fr;
#pragma unroll
          for (int ks = 0; ks < 4; ++ks) { unsigned hv[8];
#pragma unroll
              for (int i = 0; i < 8; ++i) hv[i] = vs16[(32 * ks + 8 * fq + i) * 130];
              u32x4 w; w.x = hv[0] | (hv[1] << 16); w.y = hv[2] | (hv[3] << 16); w.z = hv[4] | (hv[5] << 16); w.w = hv[6] | (hv[7] << 16); vf[ks] = __builtin_bit_cast(bf16x8, w); } }
        f32x4 acc[8];
#pragma unroll
        for (int m = 0; m < 8; ++m) { acc[m] = (f32x4){0.f, 0.f, 0.f, 0.f};
#pragma unroll
            for (int ks = 0; ks < 4; ++ks) if (32 * ks <= 16 * m + 15) {
                const bf16x8 wf = *(const bf16x8*)(wsb + ((size_t)(g * 128 + 16 * m + fr) * 128 + 32 * ks + 8 * fq));
                acc[m] = __builtin_amdgcn_mfma_f32_16x16x32_bf16(vf[ks], wf, acc[m], 0, 0, 0); } }
        const f32x4 vn = *(const f32x4*)(vnorm + cw + 4 * fq);
#pragma unroll
        for (int m = 0; m < 8; ++m) { const int t = 16 * m + fr; const size_t row = (size_t)(row0 + t); const float bias = bs[g * 128 + t];
            const u32x2 uu = *(const u32x2*)(Z + row * 4096 + cw + 4 * fq);
            const float o0 = bf_lo(uu.x) * (acc[m][0] * vn[0] + bias), o1 = bf_hi(uu.x) * (acc[m][1] * vn[1] + bias), o2 = bf_lo(uu.y) * (acc[m][2] * vn[2] + bias), o3 = bf_hi(uu.y) * (acc[m][3] * vn[3] + bias);
            u32x2 w; w.x = pk2(o0, o1); w.y = pk2(o2, o3); *(u32x2*)(GATED + row * DM + cw + 4 * fq) = w; }
    }
}
__device__ __forceinline__ void conv_phase(const bf16_t* BIG, const float* cw, const float* cb, bf16_t* ACT) {
    constexpr int NQ = FF / 8, RS = 32, NTASK = NQ * (MT / RS);
    const int tid_ = opaque_tid();
    for (int T = blockIdx.x * NTHREADS + tid_; T < NTASK; T += gridDim.x * NTHREADS) {
        const int qb = (NQ / 64 - 1) - T / (64 * (MT / RS)), rem = T % (64 * (MT / RS)), strip = rem >> 6, q = qb * 64 + (rem & 63), j0 = 8 * q, pg = (q >> 4) * 256 + (q & 15) * 8, row0 = strip * RS;
        float wg[3][8], wv[3][8], bg[8], bv[8];
#pragma unroll
        for (int k = 0; k < 3; ++k)
#pragma unroll
            for (int e = 0; e < 8; ++e) { wg[k][e] = cw[(size_t)k * FF2 + j0 + e]; wv[k][e] = cw[(size_t)k * FF2 + FF + j0 + e]; }
#pragma unroll
        for (int e = 0; e < 8; ++e) { bg[e] = cb[j0 + e]; bv[e] = cb[FF + j0 + e]; }
        const bf16_t* src = BIG + (size_t)row0 * FF2 + pg; bf16_t* dst = ACT + (size_t)row0 * FF + j0;
        u32x4 g2 = {0u, 0u, 0u, 0u}, g1 = g2, v2 = g2, v1 = g2;
        if ((row0 & (SEQ - 1)) != 0) { g2 = *(const u32x4*)(src - 2 * (size_t)FF2); v2 = *(const u32x4*)(src - 2 * (size_t)FF2 + 128); g1 = *(const u32x4*)(src - (size_t)FF2); v1 = *(const u32x4*)(src - (size_t)FF2 + 128); }
        for (int i0 = 0; i0 < RS; i0 += 8) {
            u32x4 gc[8], vc[8];
#pragma unroll
            for (int i = 0; i < 8; ++i) { gc[i] = *(const u32x4*)(src + (size_t)(i0 + i) * FF2); vc[i] = *(const u32x4*)(src + (size_t)(i0 + i) * FF2 + 128); }
#pragma unroll
            for (int i = 0; i < 8; ++i) { u32x4 o;
#pragma unroll
                for (int p = 0; p < 4; ++p) {
                    const float ga = wg[0][2 * p] * bf_lo(g2[p]) + wg[1][2 * p] * bf_lo(g1[p]) + wg[2][2 * p] * bf_lo(gc[i][p]) + bg[2 * p];
                    const float gb = wg[0][2 * p + 1] * bf_hi(g2[p]) + wg[1][2 * p + 1] * bf_hi(g1[p]) + wg[2][2 * p + 1] * bf_hi(gc[i][p]) + bg[2 * p + 1];
                    const float va = wv[0][2 * p] * bf_lo(v2[p]) + wv[1][2 * p] * bf_lo(v1[p]) + wv[2][2 * p] * bf_lo(vc[i][p]) + bv[2 * p];
                    const float vb = wv[0][2 * p + 1] * bf_hi(v2[p]) + wv[1][2 * p + 1] * bf_hi(v1[p]) + wv[2][2 * p + 1] * bf_hi(vc[i][p]) + bv[2 * p + 1];
                    const float sa = ga * __builtin_amdgcn_rcpf(1.0f + __builtin_amdgcn_exp2f(-1.4426950408889634f * ga)), sb = gb * __builtin_amdgcn_rcpf(1.0f + __builtin_amdgcn_exp2f(-1.4426950408889634f * gb));
                    o[p] = pk2(sa * va, sb * vb); }
                *(u32x4*)(dst + (size_t)(i0 + i) * FF) = o; g2 = g1; g1 = gc[i]; v2 = v1; v1 = vc[i]; }
        }
    }
}

typedef const Args __attribute__((address_space(4))) CArgs;
__device__ __forceinline__ CArgs* kargs() { CArgs* p = (CArgs*)__builtin_amdgcn_kernarg_segment_ptr(); asm volatile("" : "+s"(p)); return p; }
#define PTRS \
    CArgs* ap_ = kargs(); unsigned char* ws = ap_->ws; float* h = ap_->out; (void)ws; (void)h; \
    const float* x = ap_->in[0]; const float* a_norm = ap_->in[1]; const float* a_w_in = ap_->in[2]; const float* a_v_norm = ap_->in[3]; const float* a_w_s = ap_->in[4]; const float* a_b_s = ap_->in[5]; \
    const float* a_w_out = ap_->in[6]; const float* kv_norm = ap_->in[7]; const float* w_kvf = ap_->in[8]; const float* b_f = ap_->in[9]; const float* k_norm = ap_->in[10]; const float* b_norm = ap_->in[11]; \
    const float* b_w_qg = ap_->in[12]; const float* q_norm = ap_->in[13]; const float* b_w_out = ap_->in[14]; const float* f_norm = ap_->in[15]; const float* f_w_up = ap_->in[16]; const float* f_conv_w = ap_->in[17]; \
    const float* f_conv_b = ap_->in[18]; const float* f_w_down = ap_->in[19]; const float* final_norm = ap_->in[20]; \
    (void)x; (void)a_norm; (void)a_w_in; (void)a_v_norm; (void)a_w_s; (void)a_b_s; (void)a_w_out; (void)kv_norm; (void)w_kvf; (void)b_f; (void)k_norm; (void)b_norm; (void)b_w_qg; (void)q_norm; (void)b_w_out; \
    (void)f_norm; (void)f_w_up; (void)f_conv_w; (void)f_conv_b; (void)f_w_down; (void)final_norm; \
    float* VSS = (float*)(ws + WS_SSP); float* LOGF = (float*)(ws + WS_LOGF); unsigned long long* CA = (unsigned long long*)(ws + WS_CA); \
    bf16_t* WSB = (bf16_t*)(ws + WS_WSB); bf16_t* WFH = (bf16_t*)(ws + WS_WF); bf16_t* WFL = WFH + 16 * DM; \
    bf16_t* W_AIN = (bf16_t*)(ws + WS_W_AIN); bf16_t* W_AOUT = (bf16_t*)(ws + WS_W_AOUT); bf16_t* W_KV = (bf16_t*)(ws + WS_W_KV); bf16_t* W_QG = (bf16_t*)(ws + WS_W_QG); \
    bf16_t* W_BOUT = (bf16_t*)(ws + WS_W_BOUT); bf16_t* W_UP = (bf16_t*)(ws + WS_W_UP); bf16_t* W_DN = (bf16_t*)(ws + WS_W_DN); \
    bf16_t* HB = (bf16_t*)(ws + WS_XN); float* RSS = (float*)(ws + WS_XN2); bf16_t* KVB = (bf16_t*)(ws + WS_KV); bf16_t* BIG = (bf16_t*)(ws + WS_BIG); bf16_t* ACT = (bf16_t*)(ws + WS_ACT); \
    (void)VSS; (void)LOGF; (void)CA; (void)WSB; (void)WFH; (void)WFL; (void)W_AIN; (void)W_AOUT; (void)W_KV; (void)W_QG; (void)W_BOUT; (void)W_UP; (void)W_DN; (void)HB; (void)RSS; (void)KVB; (void)BIG; (void)ACT;
typedef pg8::EpiBf<1, true> EPI_A1; typedef pg8::EpiBf<0, true, true, true> EPI_KV; typedef pg8::EpiBf<2, true, false, true> EPI_QG; typedef pg8::EpiBf<0, true> EPI_UP;
#define GEMM_PHASE(EPI, Aptr, Bptr, NN, KK, ...) do { pg8::Gemm g_{Aptr, Bptr, MT, NN, KK}; pg8::StaticOrder S_; S_.init(MT, NN, G, (int)blockIdx.x); EPI E_{__VA_ARGS__}; \
    pg8::gemm_phase<EPI, pg8::StaticOrder, true, true>(ldsp, g_, S_, E_); } while (0)

__global__ void __launch_bounds__(NTHREADS, 2) fwd_megakernel(Args a) {
    extern __shared__ __attribute__((aligned(16))) unsigned char lds[];
    cg::grid_group grid = cg::this_grid();
#define GSYNC_CG() do { asm volatile("s_waitcnt vmcnt(0)" ::: "memory"); grid.sync(); } while (0)
#define GSYNC() do { XcdBarrier b_ = xbar; asm volatile("" : "+s"(b_.bar), "+s"(b_.x)); xcd_barrier(b_); } while (0)
    const int wave = __builtin_amdgcn_readfirstlane(threadIdx.x >> 6);
    const int G = gridDim.x, gw = blockIdx.x * NWAVES + wave, NGW = G * NWAVES;
    LAS unsigned char* ldsp = (LAS unsigned char*)lds;
    if (threadIdx.x < 16) ((LAS unsigned*)(ldsp + MISC_OFF))[threadIdx.x] = 0u;
    __syncthreads();
    const XcdBarrier xbar = xcd_barrier_post((unsigned*)(kargs()->ws + WS_BAR), (volatile LAS unsigned*)(ldsp + MISC_OFF));

    {
        PTRS
        const int tid = opaque_tid(), lane = tid & 63;
        const int gt = blockIdx.x * NTHREADS + tid, NGT = G * NTHREADS;
        for (int i = gt; i < 2 * NG * CH * CH / 8; i += NGT) {
            const int e0 = i * 8, s0 = e0 & 127, t = (e0 >> 7) & 127; const f32x4 w0 = *(const f32x4*)(a_w_s + e0), w1 = *(const f32x4*)(a_w_s + e0 + 4);
            float y[8] = {w0.x, w0.y, w0.z, w0.w, w1.x, w1.y, w1.z, w1.w};
#pragma unroll
            for (int e = 0; e < 8; ++e) if (s0 + e > t) y[e] = 0.f;
            u32x4 o; o.x = pk2(y[0], y[1]); o.y = pk2(y[2], y[3]); o.z = pk2(y[4], y[5]); o.w = pk2(y[6], y[7]); *(u32x4*)(WSB + e0) = o; }
        for (int i = gt; i < 16 * DM; i += NGT) { const int n = i / DM, k = i % DM; const float w = kv_norm[k] * w_kvf[(size_t)k * 4112 + 4096 + n];
            const unsigned hi = pk2(w, 0.f) & 0xffffu; WFH[i] = (bf16_t)hi; WFL[i] = (bf16_t)(pk2(w - bf_lo(hi), 0.f) & 0xffffu); }
        LAS float* scr = (LAS float*)(ldsp + wave * TR_LDS_PER_WAVE);
        for (int it = gw; it < 48128 * (PROBE == 4 ? 2 : 1); it += NGW) {
            int r = it % 48128, K = DM, ld, ncols, mode = 0; const float* W; const float* g = nullptr; bf16_t* WT;
            if (r < 4096) { const int l = r >> 11; r &= 2047; W = a_w_in + (size_t)l * DM * 4096; g = a_norm + l * DM; WT = W_AIN + (size_t)l * 4096 * DM; ld = 4096; ncols = 4096; }
            else if ((r -= 4096) < 2048) { const int l = r >> 10; r &= 1023; W = a_w_out + (size_t)l * DM * DM; WT = W_AOUT + (size_t)l * DM * DM; ld = DM; ncols = DM; }
            else if ((r -= 2048) < 2048) { W = w_kvf; g = kv_norm; WT = W_KV; ld = 4112; ncols = 4096; }
            else if ((r -= 2048) < 4096) { const int l = r >> 11; r &= 2047; W = b_w_qg + (size_t)l * DM * 4096; g = b_norm + l * DM; WT = W_QG + (size_t)l * 4096 * DM; ld = 4096; ncols = 4096; }
            else if ((r -= 4096) < 2048) { const int l = r >> 10; r &= 1023; W = b_w_out + (size_t)l * DM * DM; WT = W_BOUT + (size_t)l * DM * DM; ld = DM; ncols = DM; }
            else if ((r -= 2048) < 22528) { const int l = r / 5632; r -= l * 5632; W = f_w_up + (size_t)l * DM * FF2; g = f_norm + l * DM; WT = W_UP + (size_t)l * FF2 * DM; ld = FF2; ncols = FF2; mode = 1; }
            else { r -= 22528; const int l = r / 2816; r -= l * 2816; W = f_w_down + (size_t)l * FF * DM; WT = W_DN + (size_t)l * DM * FF; K = FF; ld = DM; ncols = DM; }
            transpose_item(W, K, ld, ncols, g, WT, mode, scr, r, lane);
        }
        for (int m = gw; m < MT; m += NGW) {
            const f32x4* xr = (const f32x4*)(x + (size_t)m * DM) + lane; u32x2* o = (u32x2*)(HB + (size_t)m * DM) + lane; float sq = 0.f;
#pragma unroll
            for (int j = 0; j < 8; ++j) { const f32x4 v = xr[64 * j]; sq += (v.x * v.x + v.y * v.y) + (v.z * v.z + v.w * v.w); u32x2 w; w.x = pk2(v.x, v.y); w.y = pk2(v.z, v.w); o[64 * j] = w; }
            sq = wave_sum(sq, lane); if (lane < 32) RSS[(size_t)m * 32 + lane] = lane == 0 ? sq : 0.f;
        }
    }
    if (kargs()->ws == nullptr) GSYNC_CG();
    GSYNC();

    for (int l = 0; l < 4; ++l) {
        if (l < 2) {
            for (int rep_ = 0; rep_ < (PROBE == 10 ? 2 : 1); ++rep_) {
            { PTRS GEMM_PHASE(EPI_A1, HB, W_AIN + (size_t)l * 4096 * DM, 4096, DM, BIG, 4096, 8, VSS, RSS, nullptr, nullptr, (LAS float*)(ldsp + RRW_OFF)); }
            GSYNC(); }
            for (int rep_ = 0; rep_ < (PROBE == 6 ? 2 : 1); ++rep_) { if (rep_) GSYNC();
            { PTRS const int lane = opaque_tid() & 63;
              spatial_phase(ldsp, BIG, VSS, WSB + (size_t)l * NG * CH * CH, a_v_norm + (size_t)l * DM, a_b_s + (size_t)l * NG * CH, ACT, wave, lane); } }
            GSYNC();
        } else {
            const int j = l - 2;
            if (j == 0) { { PTRS const int lane = opaque_tid() & 63; fgate_rows(ldsp, HB, RSS, WFH, WFL, b_f, LOGF, wave, lane); }
                          PTRS GEMM_PHASE(EPI_KV, HB, W_KV, 4096, DM, KVB, 4096, 1 << 30, nullptr, RSS, k_norm, (LAS float*)(ldsp + XS_OFF), (LAS float*)(ldsp + RRW_OFF)); }
            { PTRS GEMM_PHASE(EPI_QG, HB, W_QG + (size_t)j * 4096 * DM, 4096, DM, BIG, 4096, 8, nullptr, RSS, q_norm + (size_t)j * HD, (LAS float*)(ldsp + XS_OFF), (LAS float*)(ldsp + RRW_OFF)); }
            GSYNC();
            if (j == 0) { { PTRS const int lane = opaque_tid() & 63; if (blockIdx.x < 8) scan_seq(LOGF, CA, blockIdx.x * 8 + wave, lane); }
                          GSYNC(); }
            for (int rep_ = 0; rep_ < (PROBE == 2 ? 2 : 1); ++rep_) {
            { PTRS att::AttnT T{(const att::bf16*)BIG, (const att::bf16*)KVB, (const att::bf16*)(KVB + (size_t)MT * 2048), (att::bf16*)ACT, BIG + 2048, CA};
              att::attn_phase((char*)lds, T, NB, NH, SEQ); }
            GSYNC(); }
        }
        { PTRS const bf16_t* Wt = l < 2 ? W_AOUT + (size_t)l * DM * DM : W_BOUT + (size_t)(l - 2) * DM * DM;
          GEMM_PHASE(pg8::EpiRes, ACT, Wt, DM, DM, HB, RSS, DM);
        }
        GSYNC();
        { PTRS GEMM_PHASE(EPI_UP, HB, W_UP + (size_t)l * FF2 * DM, FF2, DM, BIG, FF2, 1 << 30, nullptr, RSS, nullptr, nullptr, (LAS float*)(ldsp + RRW_OFF)); }
        GSYNC();
#if PROBE == 1
        { PTRS GEMM_PHASE(EPI_UP, HB, W_UP + (size_t)l * FF2 * DM, FF2, DM, BIG, FF2, 1 << 30, nullptr, RSS, nullptr, nullptr, (LAS float*)(ldsp + RRW_OFF)); }
        GSYNC();
#endif
        { PTRS conv_phase(BIG, f_conv_w + (size_t)l * 3 * FF2, f_conv_b + (size_t)l * FF2, ACT); }
        GSYNC();
#if PROBE == 3
        { PTRS conv_phase(BIG, f_conv_w + (size_t)l * 3 * FF2, f_conv_b + (size_t)l * FF2, ACT); }
        GSYNC();
#endif
        { PTRS GEMM_PHASE(pg8::EpiRes, ACT, W_DN + (size_t)l * DM * FF, DM, FF, HB, RSS, DM);
        }
        GSYNC();
    }
#if PROBE == 7
    for (int rep_ = 0; rep_ < 20; ++rep_) GSYNC();
#endif
    { PTRS const int lane = opaque_tid() & 63;
      for (int m = gw; m < MT; m += NGW) {
          const float part = lane < 32 ? RSS[(size_t)m * 32 + lane] : 0.f; const float r = 1.0f / sqrtf(wave_sum(part, lane) * (1.0f / DM) + EPS);
          const u32x4* p = (const u32x4*)(HB + (size_t)m * DM) + lane; float* orow = h + (size_t)m * DM;
#pragma unroll
          for (int j = 0; j < 4; ++j) { const u32x4 w = p[64 * j]; const int c = (64 * j + lane) * 8; const f32x4 g0 = *(const f32x4*)(final_norm + c), g1 = *(const f32x4*)(final_norm + c + 4);
              f32x4 o0 = {bf_lo(w.x) * r * g0[0], bf_hi(w.x) * r * g0[1], bf_lo(w.y) * r * g0[2], bf_hi(w.y) * r * g0[3]}, o1 = {bf_lo(w.z) * r * g1[0], bf_hi(w.z) * r * g1[1], bf_lo(w.w) * r * g1[2], bf_hi(w.w) * r * g1[3]};
              *(f32x4*)(orow + c) = o0; *(f32x4*)(orow + c + 4) = o1; } } }
}

extern "C" void kernel_launch(void* const* d_in, const int* in_sizes, int n_in, void* d_out, int out_size, void* d_ws, size_t ws_size, hipStream_t stream) {
    static int grid = 0;
    if (grid == 0) {
        if (n_in != 21 || out_size != MT * DM || ws_size < WS_END) { fprintf(stderr, "kernel_launch: unexpected shapes (n_in %d out %d ws %zu, need ws >= %zu)\n", n_in, out_size, ws_size, (size_t)WS_END); grid = -1; return; }
        int dev = 0, cus = 0, per_cu = 0;
        (void)hipGetDevice(&dev); (void)hipDeviceGetAttribute(&cus, hipDeviceAttributeMultiprocessorCount, dev);
        (void)hipFuncSetAttribute((const void*)fwd_megakernel, hipFuncAttributeMaxDynamicSharedMemorySize, LDS_BYTES);
        (void)hipOccupancyMaxActiveBlocksPerMultiprocessor(&per_cu, (const void*)fwd_megakernel, NTHREADS, LDS_BYTES);
        if (per_cu < 1) { fprintf(stderr, "kernel_launch: occupancy query says %d blocks per CU\n", per_cu); per_cu = 1; }
        grid = cus * 1;
        (void)hipGetLastError();
    }
    if (grid < 0) return;
    (void)hipMemsetAsync((char*)d_ws + WS_BAR, 0, BAR_ZERO_BYTES, stream);
    Args a{};
    for (int i = 0; i < 21; ++i) a.in[i] = (const float*)d_in[i];
    a.out = (float*)d_out; a.ws = (unsigned char*)d_ws;
    void* args[] = {&a};
    hipError_t e = hipLaunchCooperativeKernel((const void*)fwd_megakernel, dim3(grid), dim3(NTHREADS), args, LDS_BYTES, stream);
    if (e != hipSuccess) fprintf(stderr, "cooperative launch failed: %s (grid %d)\n", hipGetErrorString(e), grid);
}
```

```cpp
#include <hip/hip_runtime.h>
#include <hip/hip_cooperative_groups.h>
#include <hip/hip_bf16.h>
#include <cstdio>
#include <cstdint>
namespace cg = cooperative_groups;
#ifndef PROBE
#define PROBE 0
#endif
__device__ __forceinline__ float lane_read(float v, int src_lane) { return __builtin_bit_cast(float, __builtin_amdgcn_ds_bpermute(src_lane << 2, __builtin_bit_cast(int, v))); }
__device__ __forceinline__ int opaque_tid() { int t = threadIdx.x; asm volatile("" : "+v"(t)); return t; }
namespace pg8 {
#define PG8_LAS __attribute__((address_space(3)))
typedef unsigned short bf16_t;
typedef short bf16x8 __attribute__((ext_vector_type(8)));
typedef float f32x4 __attribute__((ext_vector_type(4)));
typedef unsigned u32x4 __attribute__((ext_vector_type(4)));
constexpr int BM = 256, BK = 64, HALF = 128, HTB = HALF * BK * 2  , STAGE_BYTES = 8 * HTB, NXCD = 8, WGM = 8;

__host__ __device__ __forceinline__ int lds_byte(int r, int c) { const int st = (r >> 4) * 2 + (c >> 5), rr = r & 15, cc = c & 31, ob = rr * 64 + cc * 2; return st * 1024 + (ob ^ (((ob >> 9) & 1) << 5)); }
__host__ __device__ __forceinline__ void stage_rc(int b, int& R, int& C) { const int st = b / 1024, sb = b % 1024, swz = sb ^ (((sb >> 9) & 1) << 5); R = (st >> 1) * 16 + swz / 64; C = (st & 1) * 32 + (swz % 64) / 2; }
__host__ __device__ __forceinline__ int perm32(int rho) { const int n = rho >> 4, i = rho & 15; return 8 * (i >> 2) + 4 * n + (i & 3); }

struct Unit { int pm, pn; };
struct Gemm { const bf16_t* A; const bf16_t* Bt; int M, N, K; };

struct StaticOrder {
    int nM, nN, nwg, G, c;
    __host__ __device__ void init(int M, int N, int G_, int c_) { nM = M / BM; nN = N / BM; nwg = nM * nN; G = G_; c = c_; }
    __host__ __device__ bool next(int i, Unit& u) const {
        const long L = (long)i * G + c; if (L >= nwg) return false;
        int wgid = (int)L; { const int q = nwg / NXCD, r = nwg % NXCD, xcd = wgid % NXCD, off = wgid / NXCD; wgid = (xcd < r ? xcd * (q + 1) : r * (q + 1) + (xcd - r) * q) + off; }
        const int nig = WGM * nN, gid = wgid / nig, fm = gid * WGM, gsz = (nM - fm) < WGM ? (nM - fm) : WGM;
        u.pm = fm + ((wgid % nig) % gsz); u.pn = (wgid % nig) / gsz; return true;
    }
    __device__ __forceinline__ void a_ready(const Unit&) const {}
    __device__ __forceinline__ void done(const Unit&) const {}
};

__device__ __forceinline__ unsigned cvt_pk_bf16(float lo, float hi) { unsigned r; asm volatile("v_cvt_pk_bf16_f32 %0, %1, %2" : "=v"(r) : "v"(lo), "v"(hi)); return r; }
typedef float f32x2 __attribute__((ext_vector_type(2)));
__device__ __forceinline__ f32x2 gelu_pk(f32x2 v) {
    const f32x2 av = __builtin_elementwise_abs(v), d = av * 0.2316418882f + 1.0f;
    f32x2 t; t.x = __builtin_amdgcn_rcpf(d.x); t.y = __builtin_amdgcn_rcpf(d.y);
    f32x2 q = t * 0.5307027145f + (-0.7265760135f); q = q * t + 0.7107068705f; q = q * t + (-0.142248368f); q = q * t + 0.127414796f; q = q * t;
    const f32x2 s = (v * v) * (-0.72134752044f);
    f32x2 e; e.x = __builtin_amdgcn_exp2f(s.x); e.y = __builtin_amdgcn_exp2f(s.y);
    const f32x2 m = v * (q * e), r = v - m;
    f32x2 o; o.x = v.x < 0.f ? m.x : r.x; o.y = v.y < 0.f ? m.y : r.y; return o;
}
constexpr float RS_INV = 1.0f / 2048.0f, RS_EPS = 1e-6f;
template <int MODE, bool RSCALE, bool HEADMAJOR = false, bool HN = false> struct EpiBf {
    static constexpr bool PERM = true, AFTER_DRAIN = false, IDEMPOTENT = true;
    bf16_t* O; int ldc; int split_pn; float* ss; const float* rs; const float* hgain; PG8_LAS float* xs; PG8_LAS float* rrw;
    __device__ __forceinline__ void load_raw(const Unit& u, int ai, int wr, int fr, int fq, f32x4 (&raw)[4][2]) const {
#pragma unroll
        for (int m = 0; m < 4; ++m) { const f32x4* p = (const f32x4*)(rs + (size_t)(u.pm * BM + wr * 64 + fr + ai * HALF + m * 16) * 32 + fq * 8); raw[m][0] = p[0]; raw[m][1] = p[1]; }
    }
    __device__ __forceinline__ void reduce_raw(const f32x4 (&raw)[4][2], int ai, int wr, int wc, int fr, int fq) const {
#pragma unroll
        for (int m = 0; m < 4; ++m) { const f32x4 a = raw[m][0], b = raw[m][1];
            float t = ((a[0] + a[1]) + (a[2] + a[3])) + ((b[0] + b[1]) + (b[2] + b[3])); t += lane_read(t, (fq * 16 + fr) ^ 16); t += lane_read(t, (fq * 16 + fr) ^ 32);
            if (fq == 0) rrw[((wr * 4 + wc) * 8 + ai * 4 + m) * 16 + fr] = 1.0f / sqrtf(t * RS_INV + RS_EPS); }
    }
    __device__ __forceinline__ void init(const Unit& u, int wr, int wc, int fr, int fq) const {
        if (RSCALE) { f32x4 raw[4][2]; load_raw(u, 0, wr, fr, fq, raw); reduce_raw(raw, 0, wr, wc, fr, fq); load_raw(u, 1, wr, fr, fq, raw); reduce_raw(raw, 1, wr, wc, fr, fq); }
    }
    __device__ __forceinline__ void operator()(const f32x4 (&acc)[2][2][4][2], const Unit& u, const Unit& nxt, bool has_next, int wr, int wc, int fr, int fq) const {
        const int row0 = u.pm * BM + wr * 64 + fr, col0 = u.pn * BM + wc * 32 + 8 * fq;
        const bool up = u.pn >= split_pn;
        float rr[2][4]; f32x4 raw[4][2];
#pragma unroll
        for (int ai = 0; ai < 2; ++ai)
#pragma unroll
            for (int m = 0; m < 4; ++m) rr[ai][m] = RSCALE ? rrw[((wr * 4 + wc) * 8 + ai * 4 + m) * 16 + fr] : 1.f;
        if (RSCALE) asm volatile("s_waitcnt lgkmcnt(0)" ::: "memory");
        f32x4 hg0 = {1.f, 1.f, 1.f, 1.f}, hg1 = hg0; const bool hn = HN && u.pn < 8;
        if (HN) { if (hn) {
#pragma unroll
            for (int ai = 0; ai < 2; ++ai)
#pragma unroll
                for (int m = 0; m < 4; ++m)
#pragma unroll
                    for (int bj = 0; bj < 2; ++bj) { const f32x4 v0 = acc[ai][bj][m][0] * rr[ai][m], v1 = acc[ai][bj][m][1] * rr[ai][m];
                        float t = ((v0[0] * v0[0] + v0[1] * v0[1]) + (v0[2] * v0[2] + v0[3] * v0[3])) + ((v1[0] * v1[0] + v1[1] * v1[1]) + (v1[2] * v1[2] + v1[3] * v1[3]));
                        t += lane_read(t, (fq * 16 + fr) ^ 16); t += lane_read(t, (fq * 16 + fr) ^ 32);
                        if (fq == 0) xs[(ai * HALF + wr * 64 + m * 16 + fr) * 8 + bj * 4 + wc] = t; }
            asm volatile("s_waitcnt lgkmcnt(0)" ::: "memory"); __builtin_amdgcn_s_barrier(); asm volatile("" ::: "memory");
            hg0 = *(const f32x4*)(hgain + wc * 32 + 8 * fq); hg1 = *(const f32x4*)(hgain + wc * 32 + 8 * fq + 4);
        } }
#pragma unroll
        for (int ai = 0; ai < 2; ++ai) {
            if (RSCALE) { if (has_next) load_raw(nxt, ai, wr, fr, fq, raw); }
#pragma unroll
            for (int m = 0; m < 4; ++m) { const int row = row0 + ai * HALF + m * 16; float s = 0.f; float hnr[2] = {1.f, 1.f};
                if (HN) { if (hn) { const PG8_LAS f32x4* xp = (const PG8_LAS f32x4*)(xs + (ai * HALF + wr * 64 + m * 16 + fr) * 8); const f32x4 a = xp[0], b = xp[1];
                    hnr[0] = 1.0f / sqrtf(((a[0] + a[1]) + (a[2] + a[3])) * (1.0f / 128.0f) + RS_EPS); hnr[1] = 1.0f / sqrtf(((b[0] + b[1]) + (b[2] + b[3])) * (1.0f / 128.0f) + RS_EPS); } }
                bf16_t* rowp = HEADMAJOR ? O + (u.pn >= 8 ? (size_t)16384 * 2048 : (size_t)0) + ((size_t)((row >> 12) * 16 + 2 * (u.pn & 7)) * 4096 + (row & 4095)) * 128 + wc * 32 + 8 * fq
                                         : O + (size_t)row * ldc + col0;
#pragma unroll
                for (int bj = 0; bj < 2; ++bj) { f32x4 v0 = acc[ai][bj][m][0], v1 = acc[ai][bj][m][1];
                    if (RSCALE) { v0 = v0 * rr[ai][m]; v1 = v1 * rr[ai][m]; }
                    if (HN) { if (hn) { v0 = (v0 * hnr[bj]) * hg0; v1 = (v1 * hnr[bj]) * hg1; } }
                    if (MODE == 1) { f32x2 a = gelu_pk((f32x2){v0[0], v0[1]}), b = gelu_pk((f32x2){v0[2], v0[3]}), c = gelu_pk((f32x2){v1[0], v1[1]}), d = gelu_pk((f32x2){v1[2], v1[3]});
                        v0 = (f32x4){a.x, a.y, b.x, b.y}; v1 = (f32x4){c.x, c.y, d.x, d.y};
                        s += (v0[0] * v0[0] + v0[1] * v0[1]) + (v0[2] * v0[2] + v0[3] * v0[3]) + (v1[0] * v1[0] + v1[1] * v1[1]) + (v1[2] * v1[2] + v1[3] * v1[3]); }
                    if (MODE == 2) { if (up) {
#pragma unroll
                        for (int e = 0; e < 4; ++e) { v0[e] = __builtin_amdgcn_rcpf(1.0f + __builtin_amdgcn_exp2f(-1.4426950408889634f * v0[e])); v1[e] = __builtin_amdgcn_rcpf(1.0f + __builtin_amdgcn_exp2f(-1.4426950408889634f * v1[e])); } } }
                    u32x4 w; w.x = cvt_pk_bf16(v0[0], v0[1]); w.y = cvt_pk_bf16(v0[2], v0[3]); w.z = cvt_pk_bf16(v1[0], v1[1]); w.w = cvt_pk_bf16(v1[2], v1[3]);
                    *(u32x4*)(rowp + (HEADMAJOR ? (size_t)bj * 4096 * 128 : (size_t)bj * HALF)) = w; }
                if (MODE == 1) { if (up) { s += lane_read(s, (fq * 16 + fr) ^ 16); s += lane_read(s, (fq * 16 + fr) ^ 32); if (fq == 0) ss[(size_t)row * 32 + (u.pn - split_pn) * 4 + wc] = s; } } }
            if (RSCALE) { if (has_next) reduce_raw(raw, ai, wr, wc, fr, fq); } }
    }
};
struct EpiRes {
    static constexpr bool PERM = true, AFTER_DRAIN = false, IDEMPOTENT = false;
    bf16_t* hb; float* rss; int ldc;
    __device__ __forceinline__ void init(const Unit&, int, int, int, int) const {}
    __device__ __forceinline__ void operator()(const f32x4 (&acc)[2][2][4][2], const Unit& u, const Unit&, bool, int wr, int wc, int fr, int fq) const {
        const int row0 = u.pm * BM + wr * 64 + fr, col0 = u.pn * BM + wc * 32 + 8 * fq;
        u32x4 bn[2][2];
#pragma unroll
        for (int mm = 0; mm < 2; ++mm)
#pragma unroll
            for (int bj = 0; bj < 2; ++bj) bn[mm][bj] = *(const u32x4*)(hb + (size_t)(row0 + mm * 16) * ldc + col0 + bj * HALF);
#pragma unroll
        for (int c = 0; c < 4; ++c) { const int ai = c >> 1; u32x4 b[2][2];
#pragma unroll
            for (int mm = 0; mm < 2; ++mm)
#pragma unroll
                for (int bj = 0; bj < 2; ++bj) b[mm][bj] = bn[mm][bj];
            if (c < 3) { const int c1 = c + 1, ai1 = c1 >> 1;
#pragma unroll
                for (int mm = 0; mm < 2; ++mm)
#pragma unroll
                    for (int bj = 0; bj < 2; ++bj) bn[mm][bj] = *(const u32x4*)(hb + (size_t)(row0 + ai1 * HALF + (2 * (c1 & 1) + mm) * 16) * ldc + col0 + bj * HALF); }
#pragma unroll
            for (int mm = 0; mm < 2; ++mm) { const int m = 2 * (c & 1) + mm; const int row = row0 + ai * HALF + m * 16; const size_t off = (size_t)row * ldc + col0; float s = 0.f;
#pragma unroll
                for (int bj = 0; bj < 2; ++bj) { const u32x4 q = b[mm][bj];
                    const f32x4 o0 = (f32x4){__uint_as_float(q.x << 16), __uint_as_float(q.x & 0xffff0000u), __uint_as_float(q.y << 16), __uint_as_float(q.y & 0xffff0000u)} + acc[ai][bj][m][0];
                    const f32x4 o1 = (f32x4){__uint_as_float(q.z << 16), __uint_as_float(q.z & 0xffff0000u), __uint_as_float(q.w << 16), __uint_as_float(q.w & 0xffff0000u)} + acc[ai][bj][m][1];
                    u32x4 w; w.x = cvt_pk_bf16(o0[0], o0[1]); w.y = cvt_pk_bf16(o0[2], o0[3]); w.z = cvt_pk_bf16(o1[0], o1[1]); w.w = cvt_pk_bf16(o1[2], o1[3]);
                    *(u32x4*)(hb + off + bj * HALF) = w;
                    s += ((o0[0] * o0[0] + o0[1] * o0[1]) + (o0[2] * o0[2] + o0[3] * o0[3])) + ((o1[0] * o1[0] + o1[1] * o1[1]) + (o1[2] * o1[2] + o1[3] * o1[3])); }
                s += lane_read(s, (fq * 16 + fr) ^ 16); s += lane_read(s, (fq * 16 + fr) ^ 32); if (fq == 0) rss[(size_t)row * 32 + u.pn * 4 + wc] = s; } }
    }
};
template <class Epi, class Sched, bool ALIGN_EPI = false, bool SP2 = false>
__device__ __forceinline__ void gemm_phase(PG8_LAS unsigned char* lds, const Gemm g, const Sched& S, const Epi& E) {
    const int tid = opaque_tid(), wid = __builtin_amdgcn_readfirstlane(tid >> 6), lane = tid & 63, wr = wid >> 2, wc = wid & 3, fr = lane & 15, fq = lane >> 4;
    const int K = g.K, nt = K / BK;
    unsigned voffA[2], voffB[2];
#pragma unroll
    for (int i = 0; i < 2; ++i) { int R, C; stage_rc(tid * 16 + i * 8192, R, C); const int Rb = Epi::PERM ? ((R & ~31) + perm32(R & 31)) : R;
        voffA[i] = (unsigned)(R * K + C) * 2u; voffB[i] = (unsigned)(Rb * K + C) * 2u; }
    const size_t kstep = (size_t)(BK * 2);
    const size_t hstep = (size_t)HALF * K * 2;
    const size_t tstep = 2 * hstep;
    const unsigned ldsw = (unsigned)wid * 1024u;
    const int aoff = lds_byte(wr * 64 + fr, fq * 8), boff = lds_byte(wc * 32 + fr, fq * 8);
#define PG8_SA(b, h) (((b) * 2 + (h)) * HTB)
#define PG8_SB(b, h) ((4 + (b) * 2 + (h)) * HTB)
#define PG8_STAGE(bufoff, gbase, voff) do { _Pragma("unroll") for (int _i = 0; _i < 2; ++_i) \
        __builtin_amdgcn_global_load_lds((const unsigned*)((const char*)(gbase) + (voff)[_i]), (PG8_LAS unsigned*)(lds + (bufoff) + ldsw + _i * 8192), 16, 0, 0); } while (0)
#define PG8_LDA(dst, b, h) do { _Pragma("unroll") for (int m = 0; m < 4; ++m) _Pragma("unroll") for (int k = 0; k < 2; ++k) dst[m][k] = *(const PG8_LAS bf16x8*)(lds + PG8_SA(b, h) + aoff + m * 2048 + k * 1024); } while (0)
#define PG8_LDB(dst, b, h) do { _Pragma("unroll") for (int n = 0; n < 2; ++n) _Pragma("unroll") for (int k = 0; k < 2; ++k) dst[n][k] = *(const PG8_LAS bf16x8*)(lds + PG8_SB(b, h) + boff + n * 2048 + k * 1024); } while (0)
#define PG8_MMA(ai, bj, At, Bt) do { __builtin_amdgcn_s_setprio(1); _Pragma("unroll") for (int m = 0; m < 4; ++m) _Pragma("unroll") for (int n = 0; n < 2; ++n) _Pragma("unroll") for (int k = 0; k < 2; ++k) \
        acc[ai][bj][m][n] = __builtin_amdgcn_mfma_f32_16x16x32_bf16(Bt[n][k], At[m][k], acc[ai][bj][m][n], 0, 0, 0); __builtin_amdgcn_s_setprio(0); } while (0)
#define PG8_WAIT_V(n) asm volatile("s_waitcnt vmcnt(" #n ")" ::: "memory")
#define PG8_WAIT_L(n) asm volatile("s_waitcnt lgkmcnt(" #n ")" ::: "memory")
#define PG8_BAR __builtin_amdgcn_s_barrier()
#define PG8_SCHED __builtin_amdgcn_sched_barrier(0)
    Unit cur, nxt; int ui = 0;
    if (!S.next(0, cur)) return;
    E.init(cur, wr, wc, fr, fq);
    f32x4 acc[2][2][4][2];
#pragma unroll
    for (int a = 0; a < 2; ++a)
#pragma unroll
        for (int b = 0; b < 2; ++b)
#pragma unroll
            for (int m = 0; m < 4; ++m)
#pragma unroll
                for (int n = 0; n < 2; ++n) acc[a][b][m][n] = (f32x4){0.f, 0.f, 0.f, 0.f};
    bf16x8 At[4][2], B0[2][2], B1[2][2];
    const char* cA = (const char*)g.A + (size_t)cur.pm * tstep; const char* cB = (const char*)g.Bt + (size_t)cur.pn * tstep;
    S.a_ready(cur);
    if constexpr (SP2) {
        PG8_STAGE(PG8_SB(0, 0), cB, voffB); PG8_STAGE(PG8_SB(0, 1), cB + hstep, voffB); PG8_STAGE(PG8_SA(0, 0), cA, voffA); PG8_STAGE(PG8_SA(0, 1), cA + hstep, voffA);
        if (wr == 1) PG8_BAR;
        PG8_WAIT_V(2); PG8_BAR;
        PG8_STAGE(PG8_SB(1, 0), cB + kstep, voffB); PG8_STAGE(PG8_SA(1, 0), cA + kstep, voffA); PG8_STAGE(PG8_SB(1, 1), cB + hstep + kstep, voffB);
        PG8_WAIT_V(6); PG8_BAR;
    } else {
        PG8_STAGE(PG8_SB(0, 0), cB, voffB); PG8_STAGE(PG8_SA(0, 0), cA, voffA); PG8_STAGE(PG8_SB(0, 1), cB + hstep, voffB); PG8_STAGE(PG8_SA(0, 1), cA + hstep, voffA);
        if (wr == 1) PG8_BAR;
        PG8_WAIT_V(4); PG8_BAR;
        PG8_STAGE(PG8_SB(1, 0), cB + kstep, voffB); PG8_STAGE(PG8_SA(1, 0), cA + kstep, voffA); PG8_STAGE(PG8_SB(1, 1), cB + hstep + kstep, voffB);
        PG8_WAIT_V(6); PG8_BAR;
    }
    for (;;) {
        const bool has_next = S.next(ui + 1, nxt);
        const char* nA = has_next ? (const char*)g.A + (size_t)nxt.pm * tstep : cA; const char* nB = has_next ? (const char*)g.Bt + (size_t)nxt.pn * tstep : cB;
        for (int t = 0; t < nt; t += 2) {
            const bool last = (t == nt - 2);
            const char* a1 = cA + (size_t)(t + 1) * kstep;
            const char* a2 = last ? nA : cA + (size_t)(t + 2) * kstep; const char* b2 = last ? nB : cB + (size_t)(t + 2) * kstep;
            const char* a3 = a2 + kstep; const char* b3 = b2 + kstep;
            if (last && has_next) S.a_ready(nxt);
            if constexpr (SP2) {
            PG8_LDB(B0, 0, 0); PG8_LDB(B1, 0, 1); PG8_SCHED; PG8_LDA(At, 0, 0); PG8_STAGE(PG8_SA(1, 1), a1 + hstep, voffA);
            PG8_WAIT_V(8); PG8_WAIT_L(0); PG8_BAR; PG8_MMA(0, 0, At, B0); PG8_MMA(0, 1, At, B1); PG8_BAR; PG8_SCHED;
            PG8_LDA(At, 0, 1); PG8_STAGE(PG8_SB(0, 0), b2, voffB); PG8_STAGE(PG8_SB(0, 1), b2 + hstep, voffB); PG8_STAGE(PG8_SA(0, 0), a2, voffA);
            PG8_WAIT_V(8); PG8_WAIT_L(0); PG8_BAR; PG8_MMA(1, 0, At, B0); PG8_MMA(1, 1, At, B1); PG8_BAR; PG8_SCHED;
            PG8_LDB(B0, 1, 0); PG8_LDB(B1, 1, 1); PG8_SCHED; PG8_LDA(At, 1, 0); PG8_STAGE(PG8_SA(0, 1), a2 + hstep, voffA);
            PG8_WAIT_V(8); PG8_WAIT_L(0); PG8_BAR; PG8_MMA(0, 0, At, B0); PG8_MMA(0, 1, At, B1); PG8_BAR; PG8_SCHED;
            PG8_LDA(At, 1, 1); PG8_STAGE(PG8_SB(1, 0), b3, voffB); PG8_STAGE(PG8_SB(1, 1), b3 + hstep, voffB); PG8_STAGE(PG8_SA(1, 0), a3, voffA);
            PG8_WAIT_V(8); PG8_WAIT_L(0); PG8_BAR; PG8_MMA(1, 0, At, B0); PG8_MMA(1, 1, At, B1); PG8_BAR; PG8_SCHED;
            } else {
            PG8_LDB(B0, 0, 0); PG8_SCHED; PG8_LDA(At, 0, 0); PG8_STAGE(PG8_SA(1, 1), a1 + hstep, voffA);
            PG8_WAIT_L(8); PG8_BAR; PG8_WAIT_L(0); PG8_MMA(0, 0, At, B0); PG8_BAR; PG8_SCHED;
            PG8_LDB(B1, 0, 1); PG8_STAGE(PG8_SB(0, 0), b2, voffB);
            PG8_BAR; PG8_WAIT_L(0); PG8_MMA(0, 1, At, B1); PG8_BAR;
            PG8_LDA(At, 0, 1); PG8_STAGE(PG8_SA(0, 0), a2, voffA);
            PG8_BAR; PG8_WAIT_L(0); PG8_MMA(1, 0, At, B0); PG8_BAR; PG8_SCHED;
            PG8_STAGE(PG8_SB(0, 1), b2 + hstep, voffB);
            PG8_WAIT_V(6); PG8_BAR; PG8_MMA(1, 1, At, B1); PG8_BAR;
            PG8_LDB(B0, 1, 0); PG8_SCHED; PG8_LDA(At, 1, 0); PG8_STAGE(PG8_SA(0, 1), a2 + hstep, voffA);
            PG8_WAIT_L(8); PG8_BAR; PG8_WAIT_L(0); PG8_MMA(0, 0, At, B0); PG8_BAR; PG8_SCHED;
            PG8_LDB(B1, 1, 1); PG8_STAGE(PG8_SB(1, 0), b3, voffB);
            PG8_BAR; PG8_WAIT_L(0); PG8_MMA(0, 1, At, B1); PG8_BAR;
            PG8_LDA(At, 1, 1); PG8_STAGE(PG8_SA(1, 0), a3, voffA);
            PG8_BAR; PG8_WAIT_L(0); PG8_MMA(1, 0, At, B0); PG8_BAR; PG8_SCHED;
            PG8_STAGE(PG8_SB(1, 1), b3 + hstep, voffB);
            PG8_WAIT_V(6); PG8_BAR; PG8_MMA(1, 1, At, B1); PG8_BAR;
            }
        }
        if constexpr (ALIGN_EPI) { if (wr == 0) PG8_BAR; }
        if constexpr (!Epi::AFTER_DRAIN) { E(acc, cur, nxt, has_next, wr, wc, fr, fq); S.done(cur); }
        if (!has_next) break;
#pragma unroll
        for (int a = 0; a < 2; ++a)
#pragma unroll
            for (int b = 0; b < 2; ++b)
#pragma unroll
                for (int m = 0; m < 4; ++m)
#pragma unroll
                    for (int n = 0; n < 2; ++n) acc[a][b][m][n] = (f32x4){0.f, 0.f, 0.f, 0.f};
        cur = nxt; cA = nA; cB = nB; ++ui;
        if constexpr (ALIGN_EPI) { if (wr == 1) PG8_BAR; }
    }
    PG8_WAIT_V(0);
    if constexpr (!ALIGN_EPI) { if (wr == 0) PG8_BAR; }
    PG8_BAR;
    if constexpr (Epi::AFTER_DRAIN) { E.fused(acc, cur, wr, wc, fr, fq, lds, wid, lane); S.done(cur); }
#undef PG8_SA
#undef PG8_SB
#undef PG8_STAGE
#undef PG8_LDA
#undef PG8_LDB
#undef PG8_MMA
#undef PG8_WAIT_V
#undef PG8_WAIT_L
#undef PG8_BAR
#undef PG8_SCHED
}
}
namespace att {
constexpr int D = 128, LDQ = 4096, LDK = 128, LDO = 2048, LDG = 4096;
constexpr float THR = 16.f; constexpr bool WSKIP = false;
typedef unsigned u32x4_t __attribute__((ext_vector_type(4)));
typedef short bf16x8_t __attribute__((ext_vector_type(8)));
__device__ __forceinline__ bf16x8_t ka_frag(unsigned lo, unsigned up, int hi) {
    u32x4_t w; w.x = hi ? 0u : lo; w.y = hi ? 0u : (up & 0xffffu); w.z = 0u; w.w = 0u;
    return __builtin_bit_cast(bf16x8_t, w);
}
__device__ __forceinline__ bf16x8_t qa_frag(int hi) {
    u32x4_t w; w.x = hi ? 0u : 0x3f803f80u; w.y = hi ? 0u : 0x00003f80u; w.z = 0u; w.w = 0u;
    return __builtin_bit_cast(bf16x8_t, w);
}
constexpr float SCALE = 0.08838834764831845f;
constexpr int NW = 8, QBLK = 32, KVBLK = 64, QB = NW * QBLK;
constexpr int SHM_V = KVBLK * D * 2, SHM_K = KVBLK * D * 2;
constexpr int ATT_LDS_BYTES = 2 * SHM_V + 2 * SHM_K + NW * 64 * 4;

using bf16 = __hip_bfloat16;
typedef short bf16x8 __attribute__((ext_vector_type(8)));
typedef short s16x4 __attribute__((ext_vector_type(4)));
typedef float f32x16 __attribute__((ext_vector_type(16)));
typedef float f32x4 __attribute__((ext_vector_type(4)));
typedef unsigned u32x4 __attribute__((ext_vector_type(4)));
template <class A, class Bt> struct same_t { static constexpr bool v = false; };
template <class A> struct same_t<A, A> { static constexpr bool v = true; };

#define KSWZ(row, colB) ((row) * 256 + ((colB) ^ (((row) & 7) << 4)))
#define SBAR() __builtin_amdgcn_sched_barrier(0)
__device__ __forceinline__ int v_st(int k, int c) { const int kk = (k & ~0xC) | ((k & 4) << 1) | ((k & 8) >> 1); return ((kk >> 3) * 4 + (c >> 5)) * 512 + ((kk & 7) * 32 + (c & 31)) * 2; }
__device__ __forceinline__ int v_rd_base(int lane) { return ((lane & 3) << 3) | (((lane >> 2) & 3) << 6) | (((lane >> 4) & 1) << 5) | (((lane >> 5) & 1) << 8); }
constexpr int v_rd_off(int d0, int ks, int half) { return d0 * 512 + ks * 4096 + half * 2048; }
__device__ __forceinline__ int crow(int r, int hi) { return (r & 3) + 8 * (r >> 2) + 4 * hi; }
__device__ __forceinline__ unsigned cvtpk(float lo, float hi) {
    unsigned r; asm volatile("v_cvt_pk_bf16_f32 %0, %1, %2" : "=v"(r) : "v"(lo), "v"(hi)); return r;
}
__device__ __forceinline__ bf16x8 pack8(f32x4 a, f32x4 b) {
    u32x4 w = {cvtpk(a[0], a[1]), cvtpk(a[2], a[3]), cvtpk(b[0], b[1]), cvtpk(b[2], b[3])};
    return *reinterpret_cast<bf16x8*>(&w);
}
template <class T> __device__ __forceinline__ bf16x8 load8(const T* p) {
    if constexpr (same_t<T, float>::v) { return pack8(*(const f32x4*)p, *(const f32x4*)(p + 4)); }
    else { return *reinterpret_cast<const bf16x8*>(p); }
}
__device__ __forceinline__ void mask_tile(f32x16& p0, f32x16& p1, int dq, unsigned W) {
    const float NEG = -__builtin_inff();
#pragma unroll
    for (int r = 0; r < 16; ++r) {
        const int c = (r & 3) + 8 * (r >> 2);
        if ((unsigned)(dq - c) >= W) p0[r] = NEG;
        if ((unsigned)(dq - c - 32) >= W) p1[r] = NEG;
    }
}
__device__ __forceinline__ void partialSM(f32x16& p0, f32x16& p1, float& m_reg, float& mn, float& alpha) {
    float pmax = p0[0]; for (int r = 1; r < 16; ++r) pmax = fmaxf(pmax, p0[r]); for (int r = 0; r < 16; ++r) pmax = fmaxf(pmax, p1[r]);
    { auto rr = __builtin_amdgcn_permlane32_swap(__float_as_uint(pmax), __float_as_uint(pmax), false, false);
      pmax = fmaxf(__uint_as_float(rr[0]), __uint_as_float(rr[1])); }
    constexpr float C2 = 1.4426950408889634f * SCALE;
    if (__builtin_expect(__all((pmax - m_reg) * SCALE <= THR), 1)) { mn = m_reg; alpha = 1.f; }
    else { mn = fmaxf(m_reg, pmax); alpha = __builtin_amdgcn_exp2f((m_reg - mn) * C2); m_reg = mn; }
    const float mnL = -mn * C2;
    for (int r = 0; r < 16; ++r) p0[r] = fmaf(p0[r], C2, mnL); for (int r = 0; r < 16; ++r) p1[r] = fmaf(p1[r], C2, mnL);
    for (int r = 0; r < 16; ++r) p0[r] = __builtin_amdgcn_exp2f(p0[r]);
}
__device__ __forceinline__ void finishSM(f32x16& p0, f32x16& p1, float alpha, float& l_reg, bf16x8& pa0, bf16x8& pa1, bf16x8& pa2, bf16x8& pa3) {
    for (int r = 0; r < 16; ++r) p1[r] = __builtin_amdgcn_exp2f(p1[r]);
    float ps = 0; for (int r = 0; r < 16; ++r) ps += p0[r]; for (int r = 0; r < 16; ++r) ps += p1[r];
    { auto rr = __builtin_amdgcn_permlane32_swap(__float_as_uint(ps), __float_as_uint(ps), false, false);
      ps = __uint_as_float(rr[0]) + __uint_as_float(rr[1]); }
    l_reg = l_reg * alpha + ps;
#define PK4(P, B_, OUT) do { unsigned a0 = cvtpk(P[B_+0], P[B_+1]), a1 = cvtpk(P[B_+2], P[B_+3]);                          \
        unsigned b0 = cvtpk(P[B_+4], P[B_+5]), b1 = cvtpk(P[B_+6], P[B_+7]);                                             \
        auto r0 = __builtin_amdgcn_permlane32_swap(a0, b0, false, false); auto r1 = __builtin_amdgcn_permlane32_swap(a1, b1, false, false); \
        u32x4 w = {r0[0], r1[0], r0[1], r1[1]}; OUT = *reinterpret_cast<bf16x8*>(&w); } while (0)
    PK4(p0, 0, pa0); PK4(p0, 8, pa1); PK4(p1, 0, pa2); PK4(p1, 8, pa3);
#undef PK4
}
template <int KB, bool SK>
__device__ __forceinline__ void qkt(f32x16& p0, f32x16& p1, const char* K_lds, int r32, int hi, const bf16x8* qr, bool act, unsigned long long c) {
    if (SK && !act) { const float NEG = -__builtin_inff();
#pragma unroll
        for (int r = 0; r < 16; ++r) { p0[r] = NEG; p1[r] = NEG; } return; }
    p0 = f32x16{}; p1 = f32x16{};
    const char* kb[4];
#pragma unroll
    for (int dd = 0; dd < 4; ++dd) kb[dd] = K_lds + KB * SHM_K + KSWZ(r32, (dd * 16 + hi * 8) * 2);
#pragma unroll
    for (int d0 = 0; d0 < 8; ++d0) { const char* a = kb[d0 & 3] + (d0 >> 2) * 128;
        bf16x8 b0 = *reinterpret_cast<const bf16x8*>(a);
        bf16x8 b1 = *reinterpret_cast<const bf16x8*>(a + 32 * 256);
        p0 = __builtin_amdgcn_mfma_f32_32x32x16_bf16(b0, qr[d0], p0, 0, 0, 0);
        p1 = __builtin_amdgcn_mfma_f32_32x32x16_bf16(b1, qr[d0], p1, 0, 0, 0); }
    { int h2 = hi; asm volatile("" : "+v"(h2));
      const bf16x8 qaf = qa_frag(h2);
      const unsigned cl = (unsigned)c, cu = (unsigned)(c >> 32);
      auto r0 = __builtin_amdgcn_permlane32_swap(cl, cl, false, false); auto r1 = __builtin_amdgcn_permlane32_swap(cu, cu, false, false);
      p0 = __builtin_amdgcn_mfma_f32_32x32x16_bf16(ka_frag(r0[0], r1[0], hi), qaf, p0, 0, 0, 0);
      p1 = __builtin_amdgcn_mfma_f32_32x32x16_bf16(ka_frag(r0[1], r1[1], hi), qaf, p1, 0, 0, 0); }
}
template <int VB, bool SK>
__device__ __forceinline__ void pv_tile(f32x16* o, int vb0, bf16x8 pa0, bf16x8 pa1, bf16x8 pa2, bf16x8 pa3, bool act) {
    if (SK && !act) return;
#define TRRD(dst, off) asm volatile("ds_read_b64_tr_b16 %0, %1 offset:%2" : "=&v"(dst) : "v"(vb0), "i"(off) : "memory")
#define PV_D0(d0) do { s16x4 l0, l1, l2, l3, h0, h1, h2, h3; constexpr int b_ = VB * SHM_V + v_rd_off(d0, 0, 0);     \
        TRRD(l0, b_); TRRD(h0, b_ + 2048); TRRD(l1, b_ + 4096); TRRD(h1, b_ + 6144); TRRD(l2, b_ + 8192); TRRD(h2, b_ + 10240); TRRD(l3, b_ + 12288); TRRD(h3, b_ + 14336); \
        asm volatile("s_waitcnt lgkmcnt(0)" ::: "memory"); SBAR();                 \
        o[d0] = __builtin_amdgcn_mfma_f32_32x32x16_bf16(pa0, (bf16x8){l0[0], l0[1], l0[2], l0[3], h0[0], h0[1], h0[2], h0[3]}, o[d0], 0, 0, 0);   \
        o[d0] = __builtin_amdgcn_mfma_f32_32x32x16_bf16(pa1, (bf16x8){l1[0], l1[1], l1[2], l1[3], h1[0], h1[1], h1[2], h1[3]}, o[d0], 0, 0, 0);   \
        o[d0] = __builtin_amdgcn_mfma_f32_32x32x16_bf16(pa2, (bf16x8){l2[0], l2[1], l2[2], l2[3], h2[0], h2[1], h2[2], h2[3]}, o[d0], 0, 0, 0);   \
        o[d0] = __builtin_amdgcn_mfma_f32_32x32x16_bf16(pa3, (bf16x8){l3[0], l3[1], l3[2], l3[3], h3[0], h3[1], h3[2], h3[3]}, o[d0], 0, 0, 0); } while (0)
    PV_D0(0); PV_D0(1); PV_D0(2); PV_D0(3);
#undef PV_D0
#undef TRRD
}

template <class TIn, class TOut> struct BlockRef { const TIn* Q; const TIn* K; const TIn* V; TOut* O; const unsigned short* G; const unsigned long long* CA; int P0; };
template <class TIn> struct Seam {
    bf16x8 qr[8];
    bf16x8 st_v0, st_v1, st_k0, st_k1; f32x4 sf0, sf1, sf2, sf3;
    unsigned long long ca;
    f32x4 tq[16];
};
__device__ __forceinline__ int swa_jlo(int P0, int W) { const int lowk = P0 - W + 1; return lowk > 0 ? lowk / KVBLK : 0; }
#define ROW(p, k0, rr) ((p) + (size_t)((k0) + (rr)) * LDK + sc)
#define VMW() asm volatile("s_waitcnt vmcnt(0)" ::: "memory")
#define VMWN(n) asm volatile("s_waitcnt vmcnt(%0)" :: "i"(n) : "memory")
#define SLOAD_H(Kp, Vp, CAp, k0) do { S.st_v0 = load8<TIn>(ROW(Vp, k0, sr)); S.st_v1 = load8<TIn>(ROW(Vp, k0, 32 + sr));              \
                         S.st_k0 = load8<TIn>(ROW(Kp, k0, sr)); S.st_k1 = load8<TIn>(ROW(Kp, k0, 32 + sr)); S.ca = (CAp)[(k0) + lane]; } while (0)
#define SWRITE_HK(bf) do { *(bf16x8*)(K_lds + (bf) * SHM_K + kws) = S.st_k0; *(bf16x8*)(K_lds + (bf) * SHM_K + kws + 32 * 256) = S.st_k1; } while (0)
#define SWRITE_HV(bf) do { *(bf16x8*)(V_lds + (bf) * SHM_V + vst0) = S.st_v0; *(bf16x8*)(V_lds + (bf) * SHM_V + vst1) = S.st_v1; } while (0)
#define SWRITE_H(bf) do { SWRITE_HV(bf); SWRITE_HK(bf); } while (0)
#define SLOAD_F(p, k0) do { S.sf0 = *(const f32x4*)ROW(p, k0, sr); S.sf1 = *(const f32x4*)(ROW(p, k0, sr) + 4);                \
                            S.sf2 = *(const f32x4*)ROW(p, k0, 32 + sr); S.sf3 = *(const f32x4*)(ROW(p, k0, 32 + sr) + 4); } while (0)
#define SWRITE_KF(bf) do { *(bf16x8*)(K_lds + (bf) * SHM_K + kws) = pack8(S.sf0, S.sf1); *(bf16x8*)(K_lds + (bf) * SHM_K + kws + 32 * 256) = pack8(S.sf2, S.sf3); } while (0)
#define SWRITE_VF(bf) do { *(bf16x8*)(V_lds + (bf) * SHM_V + vst0) = pack8(S.sf0, S.sf1); *(bf16x8*)(V_lds + (bf) * SHM_V + vst1) = pack8(S.sf2, S.sf3); } while (0)
template <class TIn, class TOut>
__device__ __forceinline__ void causal_swa_prime(const BlockRef<TIn, TOut>& cur, int W, char* lds, Seam<TIn>& S) {
    constexpr bool F32 = same_t<TIn, float>::v;
    const int tid = opaque_tid(), wid = __builtin_amdgcn_readfirstlane(tid >> 6), lane = tid & 63, r32 = lane & 31, hi = lane >> 5;
    const int sr = tid >> 4, sc = (tid & 15) * 8, kws = KSWZ(sr, sc * 2); char* K_lds = lds + 2 * SHM_V;
    const int kb0 = swa_jlo(cur.P0, W) * KVBLK;
    for (int d0 = 0; d0 < 8; ++d0) S.qr[d0] = load8<TIn>(cur.Q + (size_t)(wid * QBLK + r32) * LDQ + d0 * 16 + hi * 8);
    if constexpr (F32) { SLOAD_F((const float*)cur.K, kb0); VMW(); SWRITE_KF(0); SBAR(); SLOAD_F((const float*)cur.V, kb0); }
    else { SLOAD_H(cur.K, cur.V, cur.CA, kb0); VMW(); SWRITE_HK(0); }
    __syncthreads();
}
template <class TIn, class TOut>
__device__ __forceinline__ void causal_swa_block(const BlockRef<TIn, TOut>& cur, const BlockRef<TIn, TOut>& nxt, int skv, int W, char* lds, Seam<TIn>& S) {
    constexpr bool F32 = same_t<TIn, float>::v;
    const int tid = opaque_tid(), wid = __builtin_amdgcn_readfirstlane(tid >> 6), lane = tid & 63, r32 = lane & 31, hi = lane >> 5;
    const int j_lo = swa_jlo(cur.P0, W);
    int j_hi = (cur.P0 + QB - 1) / KVBLK + 1; if (j_hi > skv / KVBLK) j_hi = skv / KVBLK;
    const int NT = j_hi - j_lo;
    const int kbn = swa_jlo(nxt.P0, W) * KVBLK;
    const int qlo = cur.P0 + wid * QBLK, qm = qlo + r32 - 4 * hi;
    char* V_lds = lds; char* K_lds = lds + 2 * SHM_V;
    float* ws = (float*)(lds + 2 * SHM_V + 2 * SHM_K) + wid * 64; float* li_l = ws, * al_l = ws + 32;
    float m_reg = -1e30f, l_reg = 0; f32x16 o[4] = {};
    const int sr = tid >> 4, sc = (tid & 15) * 8, vst0 = v_st(sr, sc), vst1 = v_st(32 + sr, sc), kws = KSWZ(sr, sc * 2);
    const int vb0 = (int)(uintptr_t)V_lds + v_rd_base(lane);
    const TIn* Kh = cur.K; const TIn* Vh = cur.V; const unsigned long long* CAh = cur.CA;
#define RESC(a) do { if (__any((a) < 1.f)) { if (hi == 0) al_l[r32] = (a); asm volatile("s_waitcnt lgkmcnt(0)" ::: "memory");              \
                     for (int d_ = 0; d_ < 4; ++d_) for (int r = 0; r < 16; ++r) o[d_][r] *= al_l[crow(r, hi)]; } } while (0)
#define KBASE(t) ((j_lo + (t)) * KVBLK)
#define ACT(t) (KBASE(t) <= qlo + QBLK - 1 && KBASE(t) + KVBLK - 1 >= qlo - W + 1)
#define MASKT(P0_, P1_, t) do { const int kb_ = KBASE(t); if ((!SK || ACT(t)) && (kb_ + KVBLK - 1 > qlo || kb_ <= qlo + QBLK - 1 - W)) mask_tile(P0_, P1_, qm - kb_, (unsigned)W); } while (0)
    constexpr int NQL = F32 ? 16 : 8;
    constexpr bool SK = WSKIP && !F32;
#define SEAM_K0() do { VMWN(NQL); if constexpr (F32) { SWRITE_KF(0); SBAR(); SLOAD_F((const float*)nxt.V, kbn); } else { SWRITE_HK(0); } SBAR(); } while (0)
    f32x16 pA0, pA1, pB0, pB1; float mnA, mnB, alA, alB; bf16x8 pa0, pa1, pa2, pa3;
    if constexpr (F32) { VMW(); SWRITE_VF(0); SBAR(); } else { SWRITE_HV(0); SBAR(); }
    const unsigned long long hc = S.ca;
    if (NT > 1) { if constexpr (F32) SLOAD_F((const float*)Kh, KBASE(1)); else SLOAD_H(Kh, Vh, CAh, KBASE(1)); }
    SBAR(); qkt<0, SK>(pA0, pA1, K_lds, r32, hi, S.qr, ACT(0), hc);
    if constexpr (F32) { if (NT > 1) { VMW(); SWRITE_KF(1); SBAR(); SLOAD_F((const float*)Vh, KBASE(1)); } }
    MASKT(pA0, pA1, 0); partialSM(pA0, pA1, m_reg, mnA, alA);
    if (NT > 1) { VMW(); if constexpr (F32) { SWRITE_VF(1); SBAR(); if (NT > 2) SLOAD_F((const float*)Kh, KBASE(2)); } else SWRITE_H(1); }
    __syncthreads();
#define HALF_STEP(PX0, PX1, mnX, alX, PY0, PY1, alY, t, KB, VB, SB) do {                                                      \
        { const unsigned long long c_ = S.ca; SBAR(); qkt<KB, SK>(PX0, PX1, K_lds, r32, hi, S.qr, ACT(t), c_); }                                             \
        finishSM(PY0, PY1, alY, l_reg, pa0, pa1, pa2, pa3); SBAR();                                                           \
        if ((t) + 1 < NT) { if constexpr (F32) { VMW(); SWRITE_KF(SB); SBAR(); SLOAD_F((const float*)Vh, KBASE((t) + 1)); }  \
                            else { SLOAD_H(Kh, Vh, CAh, KBASE((t) + 1)); } SBAR(); }                                               \
        pv_tile<VB, SK>(o, vb0, pa0, pa1, pa2, pa3, ACT((t) - 1)); MASKT(PX0, PX1, (t)); partialSM(PX0, PX1, m_reg, mnX, alX);                                        \
        __syncthreads();                                                                                                      \
        if ((t) + 1 < NT) { VMW(); if constexpr (F32) { SWRITE_VF(SB); SBAR(); if ((t) + 2 < NT) SLOAD_F((const float*)Kh, KBASE((t) + 2)); } \
                            else { SWRITE_H(SB); } }                                                                          \
        RESC(alX); __syncthreads(); } while (0)
    for (int t = 1; t + 1 < NT; t += 2) {
        HALF_STEP(pB0, pB1, mnB, alB, pA0, pA1, alA, t, 1, 0, 0);
        HALF_STEP(pA0, pA1, mnA, alA, pB0, pB1, alB, t + 1, 0, 1, 1);
    }
    const bool even = (NT & 1) == 0;
    if (even) { const unsigned long long c_ = S.ca; SBAR(); qkt<1, SK>(pB0, pB1, K_lds, r32, hi, S.qr, ACT(NT - 1), c_); SBAR(); }
#define QROW(e) (nxt.Q + (size_t)(wid * QBLK + r32) * D + ((e) >> 1) * 16 + hi * 8 + ((e) & 1) * 4)
    if constexpr (F32) { SLOAD_F((const float*)nxt.K, kbn); SBAR();
#pragma unroll
        for (int e = 0; e < 8; ++e) S.tq[e] = *(const f32x4*)QROW(e); }
    else { SLOAD_H(nxt.K, nxt.V, nxt.CA, kbn); SBAR();
#pragma unroll
        for (int d0 = 0; d0 < 8; ++d0) S.qr[d0] = load8<TIn>(nxt.Q + (size_t)(wid * QBLK + r32) * LDQ + d0 * 16 + hi * 8); }
    SBAR();
    finishSM(pA0, pA1, alA, l_reg, pa0, pa1, pa2, pa3); SBAR();
    if constexpr (F32) {
#pragma unroll
        for (int e = 8; e < 16; ++e) S.tq[e] = *(const f32x4*)QROW(e); SBAR(); }
#undef QROW
    pv_tile<0, SK>(o, vb0, pa0, pa1, pa2, pa3, ACT(even ? NT - 2 : NT - 1));
    if (even) { MASKT(pB0, pB1, NT - 1); partialSM(pB0, pB1, m_reg, mnB, alB); __syncthreads(); RESC(alB);
        finishSM(pB0, pB1, alB, l_reg, pa0, pa1, pa2, pa3); SBAR(); pv_tile<1, SK>(o, vb0, pa0, pa1, pa2, pa3, ACT(NT - 1)); }
    SBAR(); SEAM_K0();
    if (hi == 0) li_l[r32] = l_reg; asm volatile("s_waitcnt lgkmcnt(0)" ::: "memory");
    float rli[16];
#pragma unroll
    for (int r = 0; r < 16; ++r) rli[r] = __builtin_amdgcn_rcpf(li_l[crow(r, hi)]);
    TOut* Ow = cur.O + (size_t)(wid * QBLK) * LDO; const unsigned short* Gw = cur.G + (size_t)(wid * QBLK) * LDG;
    unsigned gv[16][4];
#pragma unroll
    for (int r = 0; r < 16; ++r)
#pragma unroll
        for (int d0 = 0; d0 < 4; ++d0) gv[r][d0] = *(const unsigned*)(Gw + (size_t)crow(r, hi) * LDG + d0 * 32 + (r32 & ~1));
#pragma unroll
    for (int r = 0; r < 16; ++r) { const int orow = crow(r, hi);
#pragma unroll
        for (int d0 = 0; d0 < 4; ++d0) { const float v = o[d0][r] * rli[r];
            if constexpr (same_t<TOut, float>::v) { Ow[(size_t)orow * LDO + d0 * 32 + r32] = v; }
            else { const float vn = __builtin_bit_cast(float, __builtin_amdgcn_mov_dpp(__builtin_bit_cast(int, v), 0xB1, 0xf, 0xf, true));
                   const unsigned g2 = gv[r][d0];
                   if ((r32 & 1) == 0) *(unsigned*)(Ow + (size_t)orow * LDO + d0 * 32 + r32) = cvtpk(v * __uint_as_float(g2 << 16), vn * __uint_as_float(g2 & 0xffff0000u)); } } }
    if constexpr (F32) {
#pragma unroll
        for (int d0 = 0; d0 < 8; ++d0) S.qr[d0] = pack8(S.tq[2 * d0], S.tq[2 * d0 + 1]); }
    __syncthreads();
#undef RESC
#undef KBASE
#undef ACT
#undef MASKT
#undef SEAM_K0
#undef HALF_STEP
}
#undef ROW
#undef VMW
#undef VMWN
#undef SLOAD_H
#undef SWRITE_HK
#undef SWRITE_HV
#undef SWRITE_H
#undef SLOAD_F
#undef SWRITE_KF
#undef SWRITE_VF

__host__ __device__ inline int swa_nx(int nqb, int nramp) { return (nramp + 1) / 2 + (nqb - nramp); }
struct SwaItem { int bh, qb0, qb1; };
__device__ __forceinline__ SwaItem swa_decode(int L, int nqb, int nx) {
    SwaItem it; const int xcd = L & 7, k = L >> 3, gi = k / nx, r = k - gi * nx;
    it.bh = gi * 8 + xcd; const int x = r;
    it.qb0 = nqb - 1 - x; it.qb1 = x;
    return it;
}
struct AttnT { const bf16* Q; const bf16* K; const bf16* V; bf16* O; const unsigned short* G; const unsigned long long* CA; };
__device__ __forceinline__ BlockRef<bf16, bf16> swa_ref(const SwaItem& it, int pass, const AttnT& T, int seq, int nh) {
    const int qb = pass ? it.qb1 : it.qb0, b = it.bh / nh, h = it.bh % nh; const size_t tok0 = (size_t)b * seq;
    BlockRef<bf16, bf16> r;
    r.Q = T.Q + (tok0 + (size_t)qb * QB) * LDQ + h * D; r.O = T.O + (tok0 + (size_t)qb * QB) * LDO + h * D; r.G = T.G + (tok0 + (size_t)qb * QB) * LDG + h * D;
    r.K = T.K + (size_t)it.bh * seq * D; r.V = T.V + (size_t)it.bh * seq * D; r.CA = T.CA + (size_t)it.bh * seq; r.P0 = qb * QB;
    return r;
}
__device__ __forceinline__ void attn_phase(char* lds, const AttnT& T, int nb, int nh, int seq) {
    const int W = 1 << 30, nqb = seq / QB, nx = nqb / 2, total = nx * nb * nh, stride = gridDim.x;
    int L = blockIdx.x; if (L >= total) return;
    SwaItem it = swa_decode(L, nqb, nx); int pass = 0;
    BlockRef<bf16, bf16> cur = swa_ref(it, 0, T, seq, nh);
    Seam<bf16> S;
    causal_swa_prime<bf16, bf16>(cur, W, lds, S);
    for (;;) {
        const bool more_pass = pass == 0 && it.qb1 != it.qb0, more_item = L + stride < total, last = !more_pass && !more_item;
        SwaItem itn = it; int passn = pass + 1, Ln = L;
        if (!more_pass) { passn = 0; Ln = more_item ? L + stride : L; itn = swa_decode(Ln, nqb, nx); }
        const BlockRef<bf16, bf16> nxt = last ? cur : swa_ref(itn, passn, T, seq, nh);
        causal_swa_block<bf16, bf16>(cur, nxt, seq, W, lds, S);
        if (last) break;
        cur = nxt; it = itn; pass = passn; L = Ln;
    }
}
#undef KSWZ
#undef SBAR
}
constexpr int DM = 2048, NB = 4, SEQ = 4096, MT = NB * SEQ, FF = 5632, FF2 = 2 * FF, NH = 16, HD = 128, CH = 128, NG = 16;
constexpr float EPS = 1e-6f;
constexpr int NWAVES = 8, NTHREADS = NWAVES * 64;
constexpr size_t MiB = 1u << 20;
constexpr size_t WS_BAR = 0, BAR_ZERO_BYTES = 16384;
constexpr size_t WS_LOGF = 1 * MiB;
constexpr size_t WS_CA = 2 * MiB;
constexpr size_t WS_WSB = 4 * MiB;
constexpr size_t WS_WF = 5 * MiB;
constexpr size_t WS_W_AIN = 6 * MiB;
constexpr size_t WS_W_AOUT = WS_W_AIN + 32 * MiB;
constexpr size_t WS_W_KV = WS_W_AOUT + 16 * MiB;
constexpr size_t WS_W_QG = WS_W_KV + 16 * MiB;
constexpr size_t WS_W_BOUT = WS_W_QG + 32 * MiB;
constexpr size_t WS_W_UP = WS_W_BOUT + 16 * MiB;
constexpr size_t WS_W_DN = WS_W_UP + 176 * MiB;
constexpr size_t WS_XN = WS_W_DN + 88 * MiB;
constexpr size_t WS_XN2 = WS_XN + 64 * MiB;
constexpr size_t WS_KV = WS_XN2 + 64 * MiB;
constexpr size_t WS_BIG = WS_KV + 128 * MiB;
constexpr size_t WS_ACT = WS_BIG + 352 * MiB;
constexpr size_t WS_SSP = WS_ACT + 176 * MiB;
constexpr size_t WS_END = WS_SSP + 2 * MiB;
constexpr int LDS_BYTES = 147456, MISC_OFF = LDS_BYTES - 64, XS_OFF = 131072, RRW_OFF = XS_OFF + 8192;

typedef unsigned short bf16_t;
typedef float f32x4 __attribute__((ext_vector_type(4)));
typedef unsigned u32x4 __attribute__((ext_vector_type(4)));
typedef unsigned u32x2 __attribute__((ext_vector_type(2)));
typedef short bf16x8 __attribute__((ext_vector_type(8)));
#define LAS __attribute__((address_space(3)))
__device__ __forceinline__ unsigned pk2(float lo, float hi) { return pg8::cvt_pk_bf16(lo, hi); }
__device__ __forceinline__ float bf_lo(unsigned w) { return __uint_as_float(w << 16); }
__device__ __forceinline__ float bf_hi(unsigned w) { return __uint_as_float(w & 0xffff0000u); }
__device__ __forceinline__ float wave_sum(float v, int lane) {
#pragma unroll
    for (int o = 1; o < 64; o <<= 1) v += lane_read(v, lane ^ o);
    return v;
}
struct Args { const float* in[21]; float* out; unsigned char* ws; };
#define XB_TMO      128
#define XB_XCNT(j)  (256  + 64 * (j))
#define XB_XSUB(j)  (1280 + 64 * (j))
#define XB_XGEN(j)  (2304 + 64 * (j))
#define XB_TOP      3328
#define XB_TOPGEN   3392
#define XCD_BAR_WORDS 3456
#define XB_SPIN_CAP (1u << 18)

__device__ __forceinline__ unsigned xb_ld(unsigned* p)              { return __hip_atomic_load(p, __ATOMIC_RELAXED, __HIP_MEMORY_SCOPE_AGENT); }
__device__ __forceinline__ unsigned xb_add(unsigned* p, unsigned v) { return __hip_atomic_fetch_add(p, v, __ATOMIC_RELAXED, __HIP_MEMORY_SCOPE_AGENT); }
__device__ __forceinline__ unsigned xb_xcc_id() { return (unsigned)__builtin_amdgcn_s_getreg((3 << 11) | 20) & 0xFu; }
#define XB_SPIN(cond, bar) do { unsigned _sp = 0; while (cond) { __builtin_amdgcn_s_sleep(1); \
    if ((++_sp & 255u) == 0u) { if (xb_ld(&(bar)[XB_TMO])) break; if (_sp > XB_SPIN_CAP) { atomicAdd(&(bar)[XB_TMO], 1u); break; } } } } while (0)

struct XcdBarrier {
    unsigned* bar; unsigned x;
    volatile LAS unsigned* st;
};

__device__ __forceinline__ XcdBarrier xcd_barrier_post(unsigned* bar, volatile LAS unsigned* st) {
    XcdBarrier b; b.bar = bar; b.x = xb_xcc_id(); b.st = st;
    if (threadIdx.x == 0) (void)xb_add(&bar[XB_XCNT(b.x)], 1u);
    return b;
}
__device__ __forceinline__ void xcd_barrier_complete(unsigned* bar, unsigned x, unsigned& nloc, unsigned& nx) {
    const unsigned G = gridDim.x * gridDim.y * gridDim.z;
    unsigned sum, cnt, mine, sp = 0u;
    for (;;) {
        sum = 0u; cnt = 0u; mine = 0u;
#pragma unroll
        for (unsigned j = 0; j < 16; ++j) { const unsigned c = xb_ld(&bar[XB_XCNT(j)]); sum += c; cnt += (c > 0u) ? 1u : 0u; mine = (j == x) ? c : mine; }
        if (sum == G) break;
        __builtin_amdgcn_s_sleep(1);
        if ((++sp & 255u) == 0u) { if (xb_ld(&bar[XB_TMO])) break; if (sp > XB_SPIN_CAP) { atomicAdd(&bar[XB_TMO], 1u); break; } }
    }
    nloc = mine > 0u ? mine : 1u; nx = cnt > 0u ? cnt : 1u;
}

__device__ __forceinline__ void xcd_barrier(const XcdBarrier& b) {
    asm volatile("s_waitcnt vmcnt(0)" ::: "memory");
    __syncthreads();
    if (threadIdx.x == 0) {
        unsigned* bar = b.bar;
        __builtin_amdgcn_s_waitcnt(0);
        unsigned nloc = b.st[0], nx = b.st[1];
        if (nloc == 0u) { xcd_barrier_complete(bar, b.x, nloc, nx); b.st[0] = nloc; b.st[1] = nx; }
        const unsigned old = xb_add(&bar[XB_XSUB(b.x)], 1u);
        const unsigned gen = old / nloc;
        if (old + 1u == (gen + 1u) * nloc) {
            __builtin_amdgcn_fence(__ATOMIC_RELEASE, "agent");
            asm volatile("s_waitcnt vmcnt(0)" ::: "memory");
            const unsigned og = xb_add(&bar[XB_TOP], 1u);
            const unsigned tg = og / nx;
            if (og + 1u == (tg + 1u) * nx) xb_add(&bar[XB_TOPGEN], 1u);
            else XB_SPIN(xb_ld(&bar[XB_TOPGEN]) == tg, bar);
            __builtin_amdgcn_fence(__ATOMIC_ACQUIRE, "agent");
            xb_add(&bar[XB_XGEN(b.x)], 1u);
            asm volatile("s_waitcnt vmcnt(0)" ::: "memory");
        } else {
            XB_SPIN(xb_ld(&bar[XB_XGEN(b.x)]) == gen, bar);
            __builtin_amdgcn_fence(__ATOMIC_ACQUIRE, "agent");
            asm volatile("s_waitcnt vmcnt(0)" ::: "memory");
        }
    }
    __syncthreads();
}


__device__ __forceinline__ int up_row(int n) { return n < FF ? (n >> 7) * 256 + (n & 127) : ((n - FF) >> 7) * 256 + 128 + ((n - FF) & 127); }
constexpr int TR_LDS_PER_WAVE = 64 * 65 * 4;
__device__ __forceinline__ void transpose_item(const float* W, int K, int ld, int ncols, const float* gk, bf16_t* WT, int mode, LAS float* scr, int item, int lane) {
    const int nblk = ncols / 64, kb = item / nblk, nb = item % nblk, k0 = 64 * kb, n0 = 64 * nb, kr = lane >> 4, n4 = (lane & 15) * 4;
    f32x4 v[16];
#pragma unroll
    for (int i = 0; i < 16; ++i) v[i] = *(const f32x4*)(W + (size_t)(k0 + 4 * i + kr) * ld + n0 + n4);
#pragma unroll
    for (int i = 0; i < 16; ++i) { const int kk = 4 * i + kr; const float g = gk ? gk[k0 + kk] : 1.f; LAS float* d = scr + kk * 65 + n4; d[0] = v[i].x * g; d[1] = v[i].y * g; d[2] = v[i].z * g; d[3] = v[i].w * g; }
    asm volatile("s_waitcnt lgkmcnt(0)" ::: "memory");
    const int c = lane & 7; const int r0 = mode ? up_row(n0) : n0;
#pragma unroll
    for (int j = 0; j < 8; ++j) { const int n = (lane >> 3) + 8 * j; const LAS float* p = scr + (8 * c) * 65 + n;
        u32x4 o; o.x = pk2(p[0 * 65], p[1 * 65]); o.y = pk2(p[2 * 65], p[3 * 65]); o.z = pk2(p[4 * 65], p[5 * 65]); o.w = pk2(p[6 * 65], p[7 * 65]);
        *(u32x4*)(WT + (size_t)(r0 + n) * K + k0 + 8 * c) = o; }
    asm volatile("s_waitcnt lgkmcnt(0)" ::: "memory");
}
__device__ __forceinline__ void fgate_rows(LAS unsigned char* ldsp, const bf16_t* hb, const float* rss, const bf16_t* wfh, const bf16_t* wfl, const float* bf, float* logf, int wave, int lane) {
    const int fr = lane & 15, fq = lane >> 4, kh = wave >> 2; LAS f32x4* part = (LAS f32x4*)ldsp;
    for (int rg0 = blockIdx.x * 4; rg0 < MT / 16; rg0 += gridDim.x * 4) {
        const int rg = rg0 + (wave & 3);
        const bf16_t* hrow = hb + (size_t)(rg * 16 + fr) * DM + 8 * fq + kh * (DM / 2); const bf16_t* wh = wfh + fr * DM + 8 * fq + kh * (DM / 2); const bf16_t* wl = wfl + fr * DM + 8 * fq + kh * (DM / 2);
        f32x4 acc = {0.f, 0.f, 0.f, 0.f};
#pragma unroll 8
        for (int ks = 0; ks < DM / 64; ++ks) {
            const bf16x8 hv = *(const bf16x8*)(hrow + 32 * ks), whv = *(const bf16x8*)(wh + 32 * ks), wlv = *(const bf16x8*)(wl + 32 * ks);
            acc = __builtin_amdgcn_mfma_f32_16x16x32_bf16(whv, hv, acc, 0, 0, 0);
            acc = __builtin_amdgcn_mfma_f32_16x16x32_bf16(wlv, hv, acc, 0, 0, 0);
        }
        __syncthreads();
        if (kh == 1) part[(wave & 3) * 64 + lane] = acc;
        __syncthreads();
        if (kh == 0) {
            acc = acc + part[(wave & 3) * 64 + lane];
            const f32x4* rp = (const f32x4*)(rss + (size_t)(rg * 16 + fr) * 32 + fq * 8); const f32x4 ra = rp[0], rb = rp[1];
            float ssq = ((ra[0] + ra[1]) + (ra[2] + ra[3])) + ((rb[0] + rb[1]) + (rb[2] + rb[3])); ssq += lane_read(ssq, lane ^ 16); ssq += lane_read(ssq, lane ^ 32);
            const float r = 1.0f / sqrtf(ssq * (1.0f / DM) + EPS);
            const f32x4 b = *(const f32x4*)(bf + 4 * fq); f32x4 o;
#pragma unroll
            for (int e = 0; e < 4; ++e) { const float f = acc[e] * r + b[e]; o[e] = fminf(f, 0.f) - log1pf(expf(-fabsf(f))); }
            *(f32x4*)(logf + (size_t)(rg * 16 + fr) * 16 + 4 * fq) = o;
        }
    }
}
__device__ __forceinline__ void scan_seq(const float* logf, unsigned long long* CA, int seq, int lane) {
    const int b = seq >> 4, hh = seq & 15;
    const float* lf = logf + ((size_t)b * SEQ + (size_t)lane * 64) * 16 + hh;
    float v[64];
#pragma unroll
    for (int i = 0; i < 64; ++i) v[i] = lf[i * 16];
#pragma unroll
    for (int i = 1; i < 64; ++i) v[i] += v[i - 1];
    const float tot = v[63]; float t = tot;
#pragma unroll
    for (int o = 1; o < 64; o <<= 1) { const float y = lane_read(t, lane >= o ? lane - o : lane); if (lane >= o) t += y; }
    const float excl = t - tot;
    unsigned long long* out = CA + (size_t)seq * SEQ + lane * 64;
#pragma unroll
    for (int i = 0; i < 64; ++i) { const float c = (excl + v[i]) * -11.313708498984761f;
        const unsigned h1 = pk2(c, 0.f) & 0xffffu; const float r1 = c - bf_lo(h1);
        const unsigned h2 = pk2(r1, 0.f) & 0xffffu; const float r2 = r1 - bf_lo(h2);
        const unsigned h3 = pk2(r2, 0.f) & 0xffffu;
        out[i] = (unsigned long long)(h1 | (h2 << 16)) | ((unsigned long long)h3 << 32); }
}
__device__ __forceinline__ void spatial_phase(LAS unsigned char* ldsp, const bf16_t* Z, const float* ssp, const bf16_t* wsb, const float* vnorm, const float* bs, bf16_t* GATED, int wave, int lane) {
    const int fr = lane & 15, fq = lane >> 4;
    for (int item = blockIdx.x; item < (MT / CH) * NG; item += gridDim.x) {
        const int ch = item >> 4, g = item & 15, row0 = ch * CH, cw = g * 128 + wave * 16;
        LAS float* rvs = (LAS float*)ldsp;
        __syncthreads();
        { const int t_ = wave * 64 + lane; if (t_ < CH) { const f32x4* p = (const f32x4*)(ssp + (size_t)(row0 + t_) * 32); float sq = 0.f;
#pragma unroll
            for (int q = 0; q < 8; ++q) { const f32x4 v = p[q]; sq += (v.x + v.y) + (v.z + v.w); }
            rvs[t_] = 1.0f / sqrtf(sq * (1.0f / DM) + EPS); } }
        __syncthreads();
        LAS unsigned* VS = (LAS unsigned*)(ldsp + 1024);
        { const int t_ = wave * 64 + lane, srow = t_ >> 2, c0 = (t_ & 3) * 32; const float rv = rvs[srow];
          const u32x4* gp = (const u32x4*)(Z + (size_t)(row0 + srow) * 4096 + 2048 + g * 128 + c0); u32x4 q[4];
#pragma unroll
          for (int jj = 0; jj < 4; ++jj) q[jj] = gp[jj];
#pragma unroll
          for (int jj = 0; jj < 4; ++jj) { LAS unsigned* d = VS + srow * 65 + (c0 >> 1) + jj * 4;
#pragma unroll
              for (int e = 0; e < 4; ++e) d[e] = pk2(bf_lo(q[jj][e]) * rv, bf_hi(q[jj][e]) * rv); } }
        __syncthreads();
        bf16x8 vf[4];
        { const LAS unsigned short* vs16 = (const LAS unsigned short*)VS + wave * 16 + fr;
#pragma unroll
          for (int ks = 0; ks < 4; ++ks) { unsigned hv[8];
#pragma unroll
              for (int i = 0; i < 8; ++i) hv[i] = vs16[(32 * ks + 8 * fq + i) * 130];
              u32x4 w; w.x = hv[0] | (hv[1] << 16); w.y = hv[2] | (hv[3] << 16); w.z = hv[4] | (hv[5] << 16); w.w = hv[6] | (hv[7] << 16); vf[ks] = __builtin_bit_cast(bf16x8, w); } }
        f32x4 acc[8];
#pragma unroll
        for (int m = 0; m < 8; ++m) { acc[m] = (f32x4){0.f, 0.f, 0.f, 0.f};
#pragma unroll
            for (int ks = 0; ks < 4; ++ks) if (32 * ks <= 16 * m + 15) {
                const bf16x8 wf = *(const bf16x8*)(wsb + ((size_t)(g * 128 + 16 * m + fr) * 128 + 32 * ks + 8 * fq));
                acc[m] = __builtin_amdgcn_mfma_f32_16x16x32_bf16(vf[ks], wf, acc[m], 0, 0, 0); } }
        const f32x4 vn = *(const f32x4*)(vnorm + cw + 4 * fq);
#pragma unroll
        for (int m = 0; m < 8; ++m) { const int t = 16 * m + fr; const size_t row = (size_t)(row0 + t); const float bias = bs[g * 128 + t];
            const u32x2 uu = *(const u32x2*)(Z + row * 4096 + cw + 4 * fq);
            const float o0 = bf_lo(uu.x) * (acc[m][0] * vn[0] + bias), o1 = bf_hi(uu.x) * (acc[m][1] * vn[1] + bias), o2 = bf_lo(uu.y) * (acc[m][2] * vn[2] + bias), o3 = bf_hi(uu.y) * (acc[m][3] * vn[3] + bias);
            u32x2 w; w.x = pk2(o0, o1); w.y = pk2(o2, o3); *(u32x2*)(GATED + row * DM + cw + 4 * fq) = w; }
    }
}
__device__ __forceinline__ void conv_phase(const bf16_t* BIG, const float* cw, const float* cb, bf16_t* ACT) {
    constexpr int NQ = FF / 8, RS = 32, NTASK = NQ * (MT / RS);
    const int tid_ = opaque_tid();
    for (int T = blockIdx.x * NTHREADS + tid_; T < NTASK; T += gridDim.x * NTHREADS) {
        const int qb = (NQ / 64 - 1) - T / (64 * (MT / RS)), rem = T % (64 * (MT / RS)), strip = rem >> 6, q = qb * 64 + (rem & 63), j0 = 8 * q, pg = (q >> 4) * 256 + (q & 15) * 8, row0 = strip * RS;
        float wg[3][8], wv[3][8], bg[8], bv[8];
#pragma unroll
        for (int k = 0; k < 3; ++k)
#pragma unroll
            for (int e = 0; e < 8; ++e) { wg[k][e] = cw[(size_t)k * FF2 + j0 + e]; wv[k][e] = cw[(size_t)k * FF2 + FF + j0 + e]; }
#pragma unroll
        for (int e = 0; e < 8; ++e) { bg[e] = cb[j0 + e]; bv[e] = cb[FF + j0 + e]; }
        const bf16_t* src = BIG + (size_t)row0 * FF2 + pg; bf16_t* dst = ACT + (size_t)row0 * FF + j0;
        u32x4 g2 = {0u, 0u, 0u, 0u}, g1 = g2, v2 = g2, v1 = g2;
        if ((row0 & (SEQ - 1)) != 0) { g2 = *(const u32x4*)(src - 2 * (size_t)FF2); v2 = *(const u32x4*)(src - 2 * (size_t)FF2 + 128); g1 = *(const u32x4*)(src - (size_t)FF2); v1 = *(const u32x4*)(src - (size_t)FF2 + 128); }
        for (int i0 = 0; i0 < RS; i0 += 8) {
            u32x4 gc[8], vc[8];
#pragma unroll
            for (int i = 0; i < 8; ++i) { gc[i] = *(const u32x4*)(src + (size_t)(i0 + i) * FF2); vc[i] = *(const u32x4*)(src + (size_t)(i0 + i) * FF2 + 128); }
#pragma unroll
            for (int i = 0; i < 8; ++i) { u32x4 o;
#pragma unroll
                for (int p = 0; p < 4; ++p) {
                    const float ga = wg[0][2 * p] * bf_lo(g2[p]) + wg[1][2 * p] * bf_lo(g1[p]) + wg[2][2 * p] * bf_lo(gc[i][p]) + bg[2 * p];
                    const float gb = wg[0][2 * p + 1] * bf_hi(g2[p]) + wg[1][2 * p + 1] * bf_hi(g1[p]) + wg[2][2 * p + 1] * bf_hi(gc[i][p]) + bg[2 * p + 1];
                    const float va = wv[0][2 * p] * bf_lo(v2[p]) + wv[1][2 * p] * bf_lo(v1[p]) + wv[2][2 * p] * bf_lo(vc[i][p]) + bv[2 * p];
                    const float vb = wv[0][2 * p + 1] * bf_hi(v2[p]) + wv[1][2 * p + 1] * bf_hi(v1[p]) + wv[2][2 * p + 1] * bf_hi(vc[i][p]) + bv[2 * p + 1];
                    const float sa = ga * __builtin_amdgcn_rcpf(1.0f + __builtin_amdgcn_exp2f(-1.4426950408889634f * ga)), sb = gb * __builtin_amdgcn_rcpf(1.0f + __builtin_amdgcn_exp2f(-1.4426950408889634f * gb));
                    o[p] = pk2(sa * va, sb * vb); }
                *(u32x4*)(dst + (size_t)(i0 + i) * FF) = o; g2 = g1; g1 = gc[i]; v2 = v1; v1 = vc[i]; }
        }
    }
}

typedef const Args __attribute__((address_space(4))) CArgs;
__device__ __forceinline__ CArgs* kargs() { CArgs* p = (CArgs*)__builtin_amdgcn_kernarg_segment_ptr(); asm volatile("" : "+s"(p)); return p; }
#define PTRS \
    CArgs* ap_ = kargs(); unsigned char* ws = ap_->ws; float* h = ap_->out; (void)ws; (void)h; \
    const float* x = ap_->in[0]; const float* a_norm = ap_->in[1]; const float* a_w_in = ap_->in[2]; const float* a_v_norm = ap_->in[3]; const float* a_w_s = ap_->in[4]; const float* a_b_s = ap_->in[5]; \
    const float* a_w_out = ap_->in[6]; const float* kv_norm = ap_->in[7]; const float* w_kvf = ap_->in[8]; const float* b_f = ap_->in[9]; const float* k_norm = ap_->in[10]; const float* b_norm = ap_->in[11]; \
    const float* b_w_qg = ap_->in[12]; const float* q_norm = ap_->in[13]; const float* b_w_out = ap_->in[14]; const float* f_norm = ap_->in[15]; const float* f_w_up = ap_->in[16]; const float* f_conv_w = ap_->in[17]; \
    const float* f_conv_b = ap_->in[18]; const float* f_w_down = ap_->in[19]; const float* final_norm = ap_->in[20]; \
    (void)x; (void)a_norm; (void)a_w_in; (void)a_v_norm; (void)a_w_s; (void)a_b_s; (void)a_w_out; (void)kv_norm; (void)w_kvf; (void)b_f; (void)k_norm; (void)b_norm; (void)b_w_qg; (void)q_norm; (void)b_w_out; \
    (void)f_norm; (void)f_w_up; (void)f_conv_w; (void)f_conv_b; (void)f_w_down; (void)final_norm; \
    float* VSS = (float*)(ws + WS_SSP); float* LOGF = (float*)(ws + WS_LOGF); unsigned long long* CA = (unsigned long long*)(ws + WS_CA); \
    bf16_t* WSB = (bf16_t*)(ws + WS_WSB); bf16_t* WFH = (bf16_t*)(ws + WS_WF); bf16_t* WFL = WFH + 16 * DM; \
    bf16_t* W_AIN = (bf16_t*)(ws + WS_W_AIN); bf16_t* W_AOUT = (bf16_t*)(ws + WS_W_AOUT); bf16_t* W_KV = (bf16_t*)(ws + WS_W_KV); bf16_t* W_QG = (bf16_t*)(ws + WS_W_QG); \
    bf16_t* W_BOUT = (bf16_t*)(ws + WS_W_BOUT); bf16_t* W_UP = (bf16_t*)(ws + WS_W_UP); bf16_t* W_DN = (bf16_t*)(ws + WS_W_DN); \
    bf16_t* HB = (bf16_t*)(ws + WS_XN); float* RSS = (float*)(ws + WS_XN2); bf16_t* KVB = (bf16_t*)(ws + WS_KV); bf16_t* BIG = (bf16_t*)(ws + WS_BIG); bf16_t* ACT = (bf16_t*)(ws + WS_ACT); \
    (void)VSS; (void)LOGF; (void)CA; (void)WSB; (void)WFH; (void)WFL; (void)W_AIN; (void)W_AOUT; (void)W_KV; (void)W_QG; (void)W_BOUT; (void)W_UP; (void)W_DN; (void)HB; (void)RSS; (void)KVB; (void)BIG; (void)ACT;
typedef pg8::EpiBf<1, true> EPI_A1; typedef pg8::EpiBf<0, true, true, true> EPI_KV; typedef pg8::EpiBf<2, true, false, true> EPI_QG; typedef pg8::EpiBf<0, true> EPI_UP;
#define GEMM_PHASE(EPI, Aptr, Bptr, NN, KK, ...) do { pg8::Gemm g_{Aptr, Bptr, MT, NN, KK}; pg8::StaticOrder S_; S_.init(MT, NN, G, (int)blockIdx.x); EPI E_{__VA_ARGS__}; \
    pg8::gemm_phase<EPI, pg8::StaticOrder, true, true>(ldsp, g_, S_, E_); } while (0)

__global__ void __launch_bounds__(NTHREADS, 2) fwd_megakernel(Args a) {
    extern __shared__ __attribute__((aligned(16))) unsigned char lds[];
    cg::grid_group grid = cg::this_grid();
#define GSYNC_CG() do { asm volatile("s_waitcnt vmcnt(0)" ::: "memory"); grid.sync(); } while (0)
#define GSYNC() do { XcdBarrier b_ = xbar; asm volatile("" : "+s"(b_.bar), "+s"(b_.x)); xcd_barrier(b_); } while (0)
    const int wave = __builtin_amdgcn_readfirstlane(threadIdx.x >> 6);
    const int G = gridDim.x, gw = blockIdx.x * NWAVES + wave, NGW = G * NWAVES;
    LAS unsigned char* ldsp = (LAS unsigned char*)lds;
    if (threadIdx.x < 16) ((LAS unsigned*)(ldsp + MISC_OFF))[threadIdx.x] = 0u;
    __syncthreads();
    const XcdBarrier xbar = xcd_barrier_post((unsigned*)(kargs()->ws + WS_BAR), (volatile LAS unsigned*)(ldsp + MISC_OFF));

    {
        PTRS
        const int tid = opaque_tid(), lane = tid & 63;
        const int gt = blockIdx.x * NTHREADS + tid, NGT = G * NTHREADS;
        for (int i = gt; i < 2 * NG * CH * CH / 8; i += NGT) {
            const int e0 = i * 8, s0 = e0 & 127, t = (e0 >> 7) & 127; const f32x4 w0 = *(const f32x4*)(a_w_s + e0), w1 = *(const f32x4*)(a_w_s + e0 + 4);
            float y[8] = {w0.x, w0.y, w0.z, w0.w, w1.x, w1.y, w1.z, w1.w};
#pragma unroll
            for (int e = 0; e < 8; ++e) if (s0 + e > t) y[e] = 0.f;
            u32x4 o; o.x = pk2(y[0], y[1]); o.y = pk2(y[2], y[3]); o.z = pk2(y[4], y[5]); o.w = pk2(y[6], y[7]); *(u32x4*)(WSB + e0) = o; }
        for (int i = gt; i < 16 * DM; i += NGT) { const int n = i / DM, k = i % DM; const float w = kv_norm[k] * w_kvf[(size_t)k * 4112 + 4096 + n];
            const unsigned hi = pk2(w, 0.f) & 0xffffu; WFH[i] = (bf16_t)hi; WFL[i] = (bf16_t)(pk2(w - bf_lo(hi), 0.f) & 0xffffu); }
        LAS float* scr = (LAS float*)(ldsp + wave * TR_LDS_PER_WAVE);
        for (int it = gw; it < 48128 * (PROBE == 4 ? 2 : 1); it += NGW) {
            int r = it % 48128, K = DM, ld, ncols, mode = 0; const float* W; const float* g = nullptr; bf16_t* WT;
            if (r < 4096) { const int l = r >> 11; r &= 2047; W = a_w_in + (size_t)l * DM * 4096; g = a_norm + l * DM; WT = W_AIN + (size_t)l * 4096 * DM; ld = 4096; ncols = 4096; }
            else if ((r -= 4096) < 2048) { const int l = r >> 10; r &= 1023; W = a_w_out + (size_t)l * DM * DM; WT = W_AOUT + (size_t)l * DM * DM; ld = DM; ncols = DM; }
            else if ((r -= 2048) < 2048) { W = w_kvf; g = kv_norm; WT = W_KV; ld = 4112; ncols = 4096; }
            else if ((r -= 2048) < 4096) { const int l = r >> 11; r &= 2047; W = b_w_qg + (size_t)l * DM * 4096; g = b_norm + l * DM; WT = W_QG + (size_t)l * 4096 * DM; ld = 4096; ncols = 4096; }
            else if ((r -= 4096) < 2048) { const int l = r >> 10; r &= 1023; W = b_w_out + (size_t)l * DM * DM; WT = W_BOUT + (size_t)l * DM * DM; ld = DM; ncols = DM; }
            else if ((r -= 2048) < 22528) { const int l = r / 5632; r -= l * 5632; W = f_w_up + (size_t)l * DM * FF2; g = f_norm + l * DM; WT = W_UP + (size_t)l * FF2 * DM; ld = FF2; ncols = FF2; mode = 1; }
            else { r -= 22528; const int l = r / 2816; r -= l * 2816; W = f_w_down + (size_t)l * FF * DM; WT = W_DN + (size_t)l * DM * FF; K = FF; ld = DM; ncols = DM; }
            transpose_item(W, K, ld, ncols, g, WT, mode, scr, r, lane);
        }
        for (int m = gw; m < MT; m += NGW) {
            const f32x4* xr = (const f32x4*)(x + (size_t)m * DM) + lane; u32x2* o = (u32x2*)(HB + (size_t)m * DM) + lane; float sq = 0.f;
#pragma unroll
            for (int j = 0; j < 8; ++j) { const f32x4 v = xr[64 * j]; sq += (v.x * v.x + v.y * v.y) + (v.z * v.z + v.w * v.w); u32x2 w; w.x = pk2(v.x, v.y); w.y = pk2(v.z, v.w); o[64 * j] = w; }
            sq = wave_sum(sq, lane); if (lane < 32) RSS[(size_t)m * 32 + lane] = lane == 0 ? sq : 0.f;
        }
    }
    if (kargs()->ws == nullptr) GSYNC_CG();
    GSYNC();

    for (int l = 0; l < 4; ++l) {
        if (l < 2) {
            for (int rep_ = 0; rep_ < (PROBE == 10 ? 2 : 1); ++rep_) {
            { PTRS GEMM_PHASE(EPI_A1, HB, W_AIN + (size_t)l * 4096 * DM, 4096, DM, BIG, 4096, 8, VSS, RSS, nullptr, nullptr, (LAS float*)(ldsp + RRW_OFF)); }
            GSYNC(); }
            for (int rep_ = 0; rep_ < (PROBE == 6 ? 2 : 1); ++rep_) { if (rep_) GSYNC();
            { PTRS const int lane = opaque_tid() & 63;
              spatial_phase(ldsp, BIG, VSS, WSB + (size_t)l * NG * CH * CH, a_v_norm + (size_t)l * DM, a_b_s + (size_t)l * NG * CH, ACT, wave, lane); } }
            GSYNC();
        } else {
            const int j = l - 2;
            if (j == 0) { { PTRS const int lane = opaque_tid() & 63; fgate_rows(ldsp, HB, RSS, WFH, WFL, b_f, LOGF, wave, lane); }
                          PTRS GEMM_PHASE(EPI_KV, HB, W_KV, 4096, DM, KVB, 4096, 1 << 30, nullptr, RSS, k_norm, (LAS float*)(ldsp + XS_OFF), (LAS float*)(ldsp + RRW_OFF)); }
            { PTRS GEMM_PHASE(EPI_QG, HB, W_QG + (size_t)j * 4096 * DM, 4096, DM, BIG, 4096, 8, nullptr, RSS, q_norm + (size_t)j * HD, (LAS float*)(ldsp + XS_OFF), (LAS float*)(ldsp + RRW_OFF)); }
            GSYNC();
            if (j == 0) { { PTRS const int lane = opaque_tid() & 63; if (blockIdx.x < 8) scan_seq(LOGF, CA, blockIdx.x * 8 + wave, lane); }
                          GSYNC(); }
            for (int rep_ = 0; rep_ < (PROBE == 2 ? 2 : 1); ++rep_) {
            { PTRS att::AttnT T{(const att::bf16*)BIG, (const att::bf16*)KVB, (const att::bf16*)(KVB + (size_t)MT * 2048), (att::bf16*)ACT, BIG + 2048, CA};
              att::attn_phase((char*)lds, T, NB, NH, SEQ); }
            GSYNC(); }
        }
        { PTRS const bf16_t* Wt = l < 2 ? W_AOUT + (size_t)l * DM * DM : W_BOUT + (size_t)(l - 2) * DM * DM;
          GEMM_PHASE(pg8::EpiRes, ACT, Wt, DM, DM, HB, RSS, DM);
        }
        GSYNC();
        { PTRS GEMM_PHASE(EPI_UP, HB, W_UP + (size_t)l * FF2 * DM, FF2, DM, BIG, FF2, 1 << 30, nullptr, RSS, nullptr, nullptr, (LAS float*)(ldsp + RRW_OFF)); }
        GSYNC();
#if PROBE == 1
        { PTRS GEMM_PHASE(EPI_UP, HB, W_UP + (size_t)l * FF2 * DM, FF2, DM, BIG, FF2, 1 << 30, nullptr, RSS, nullptr, nullptr, (LAS float*)(ldsp + RRW_OFF)); }
        GSYNC();
#endif
        { PTRS conv_phase(BIG, f_conv_w + (size_t)l * 3 * FF2, f_conv_b + (size_t)l * FF2, ACT); }
        GSYNC();
#if PROBE == 3
        { PTRS conv_phase(BIG, f_conv_w + (size_t)l * 3 * FF2, f_conv_b + (size_t)l * FF2, ACT); }
        GSYNC();
#endif
        { PTRS GEMM_PHASE(pg8::EpiRes, ACT, W_DN + (size_t)l * DM * FF, DM, FF, HB, RSS, DM);
        }
        GSYNC();
    }
#if PROBE == 7
    for (int rep_ = 0; rep_ < 20; ++rep_) GSYNC();
#endif
    { PTRS const int lane = opaque_tid() & 63;
      for (int m = gw; m < MT; m += NGW) {
          const float part = lane < 32 ? RSS[(size_t)m * 32 + lane] : 0.f; const float r = 1.0f / sqrtf(wave_sum(part, lane) * (1.0f / DM) + EPS);
          const u32x4* p = (const u32x4*)(HB + (size_t)m * DM) + lane; float* orow = h + (size_t)m * DM;
#pragma unroll
          for (int j = 0; j < 4; ++j) { const u32x4 w = p[64 * j]; const int c = (64 * j + lane) * 8; const f32x4 g0 = *(const f32x4*)(final_norm + c), g1 = *(const f32x4*)(final_norm + c + 4);
              f32x4 o0 = {bf_lo(w.x) * r * g0[0], bf_hi(w.x) * r * g0[1], bf_lo(w.y) * r * g0[2], bf_hi(w.y) * r * g0[3]}, o1 = {bf_lo(w.z) * r * g1[0], bf_hi(w.z) * r * g1[1], bf_lo(w.w) * r * g1[2], bf_hi(w.w) * r * g1[3]};
              *(f32x4*)(orow + c) = o0; *(f32x4*)(orow + c + 4) = o1; } } }
}

extern "C" void kernel_launch(void* const* d_in, const int* in_sizes, int n_in, void* d_out, int out_size, void* d_ws, size_t ws_size, hipStream_t stream) {
    static int grid = 0;
    if (grid == 0) {
        if (n_in != 21 || out_size != MT * DM || ws_size < WS_END) { fprintf(stderr, "kernel_launch: unexpected shapes (n_in %d out %d ws %zu, need ws >= %zu)\n", n_in, out_size, ws_size, (size_t)WS_END); grid = -1; return; }
        int dev = 0, cus = 0, per_cu = 0;
        (void)hipGetDevice(&dev); (void)hipDeviceGetAttribute(&cus, hipDeviceAttributeMultiprocessorCount, dev);
        (void)hipFuncSetAttribute((const void*)fwd_megakernel, hipFuncAttributeMaxDynamicSharedMemorySize, LDS_BYTES);
        (void)hipOccupancyMaxActiveBlocksPerMultiprocessor(&per_cu, (const void*)fwd_megakernel, NTHREADS, LDS_BYTES);
        if (per_cu < 1) { fprintf(stderr, "kernel_launch: occupancy query says %d blocks per CU\n", per_cu); per_cu = 1; }
        grid = cus * 1;
        (void)hipGetLastError();
    }
    if (grid < 0) return;
    (void)hipMemsetAsync((char*)d_ws + WS_BAR, 0, BAR_ZERO_BYTES, stream);
    Args a{};
    for (int i = 0; i < 21; ++i) a.in[i] = (const float*)d_in[i];
    a.out = (float*)d_out; a.ws = (unsigned char*)d_ws;
    void* args[] = {&a};
    hipError_t e = hipLaunchCooperativeKernel((const void*)fwd_megakernel, dim3(grid), dim3(NTHREADS), args, LDS_BYTES, stream);
    if (e != hipSuccess) fprintf(stderr, "cooperative launch failed: %s (grid %d)\n", hipGetErrorString(e), grid);
}
```

```cpp
#include <hip/hip_runtime.h>
#include <hip/hip_cooperative_groups.h>
#include <hip/hip_bf16.h>
#include <cstdio>
#include <cstdint>
namespace cg = cooperative_groups;
#ifndef PROBE
#define PROBE 0
#endif
__device__ __forceinline__ float lane_read(float v, int src_lane) { return __builtin_bit_cast(float, __builtin_amdgcn_ds_bpermute(src_lane << 2, __builtin_bit_cast(int, v))); }
__device__ __forceinline__ int opaque_tid() { int t = threadIdx.x; asm volatile("" : "+v"(t)); return t; }
namespace pg8 {
#define PG8_LAS __attribute__((address_space(3)))
typedef unsigned short bf16_t;
typedef short bf16x8 __attribute__((ext_vector_type(8)));
typedef float f32x4 __attribute__((ext_vector_type(4)));
typedef unsigned u32x4 __attribute__((ext_vector_type(4)));
constexpr int BM = 256, BK = 64, HALF = 128, HTB = HALF * BK * 2  , STAGE_BYTES = 8 * HTB, NXCD = 8, WGM = 8;

__host__ __device__ __forceinline__ int lds_byte(int r, int c) { const int st = (r >> 4) * 2 + (c >> 5), rr = r & 15, cc = c & 31, ob = rr * 64 + cc * 2; return st * 1024 + (ob ^ (((ob >> 9) & 1) << 5)); }
__host__ __device__ __forceinline__ void stage_rc(int b, int& R, int& C) { const int st = b / 1024, sb = b % 1024, swz = sb ^ (((sb >> 9) & 1) << 5); R = (st >> 1) * 16 + swz / 64; C = (st & 1) * 32 + (swz % 64) / 2; }
__host__ __device__ __forceinline__ int perm32(int rho) { const int n = rho >> 4, i = rho & 15; return 8 * (i >> 2) + 4 * n + (i & 3); }

struct Unit { int pm, pn; };
struct Gemm { const bf16_t* A; const bf16_t* Bt; int M, N, K; };

struct StaticOrder {
    int nM, nN, nwg, G, c;
    __host__ __device__ void init(int M, int N, int G_, int c_) { nM = M / BM; nN = N / BM; nwg = nM * nN; G = G_; c = c_; }
    __host__ __device__ bool next(int i, Unit& u) const {
        const long L = (long)i * G + c; if (L >= nwg) return false;
        int wgid = (int)L; { const int q = nwg / NXCD, r = nwg % NXCD, xcd = wgid % NXCD, off = wgid / NXCD; wgid = (xcd < r ? xcd * (q + 1) : r * (q + 1) + (xcd - r) * q) + off; }
        const int nig = WGM * nN, gid = wgid / nig, fm = gid * WGM, gsz = (nM - fm) < WGM ? (nM - fm) : WGM;
        u.pm = fm + ((wgid % nig) % gsz); u.pn = (wgid % nig) / gsz; return true;
    }
    __device__ __forceinline__ void a_ready(const Unit&) const {}
    __device__ __forceinline__ void done(const Unit&) const {}
};

__device__ __forceinline__ unsigned cvt_pk_bf16(float lo, float hi) { unsigned r; asm volatile("v_cvt_pk_bf16_f32 %0, %1, %2" : "=v"(r) : "v"(lo), "v"(hi)); return r; }
typedef float f32x2 __attribute__((ext_vector_type(2)));
__device__ __forceinline__ f32x2 gelu_pk(f32x2 v) {
    const f32x2 av = __builtin_elementwise_abs(v), d = av * 0.2316418882f + 1.0f;
    f32x2 t; t.x = __builtin_amdgcn_rcpf(d.x); t.y = __builtin_amdgcn_rcpf(d.y);
    f32x2 q = t * 0.5307027145f + (-0.7265760135f); q = q * t + 0.7107068705f; q = q * t + (-0.142248368f); q = q * t + 0.127414796f; q = q * t;
    const f32x2 s = (v * v) * (-0.72134752044f);
    f32x2 e; e.x = __builtin_amdgcn_exp2f(s.x); e.y = __builtin_amdgcn_exp2f(s.y);
    const f32x2 m = v * (q * e), r = v - m;
    f32x2 o; o.x = v.x < 0.f ? m.x : r.x; o.y = v.y < 0.f ? m.y : r.y; return o;
}
constexpr float RS_INV = 1.0f / 2048.0f, RS_EPS = 1e-6f;
template <int MODE, bool RSCALE, bool HEADMAJOR = false, bool HN = false> struct EpiBf {
    static constexpr bool PERM = true, AFTER_DRAIN = false, IDEMPOTENT = true;
    bf16_t* O; int ldc; int split_pn; float* ss; const float* rs; const float* hgain; PG8_LAS float* xs; PG8_LAS float* rrw;
    __device__ __forceinline__ void load_raw(const Unit& u, int ai, int wr, int fr, int fq, f32x4 (&raw)[4][2]) const {
#pragma unroll
        for (int m = 0; m < 4; ++m) { const f32x4* p = (const f32x4*)(rs + (size_t)(u.pm * BM + wr * 64 + fr + ai * HALF + m * 16) * 32 + fq * 8); raw[m][0] = p[0]; raw[m][1] = p[1]; }
    }
    __device__ __forceinline__ void reduce_raw(const f32x4 (&raw)[4][2], int ai, int wr, int wc, int fr, int fq) const {
#pragma unroll
        for (int m = 0; m < 4; ++m) { const f32x4 a = raw[m][0], b = raw[m][1];
            float t = ((a[0] + a[1]) + (a[2] + a[3])) + ((b[0] + b[1]) + (b[2] + b[3])); t += lane_read(t, (fq * 16 + fr) ^ 16); t += lane_read(t, (fq * 16 + fr) ^ 32);
            if (fq == 0) rrw[((wr * 4 + wc) * 8 + ai * 4 + m) * 16 + fr] = 1.0f / sqrtf(t * RS_INV + RS_EPS); }
    }
    __device__ __forceinline__ void init(const Unit& u, int wr, int wc, int fr, int fq) const {
        if (RSCALE) { f32x4 raw[4][2]; load_raw(u, 0, wr, fr, fq, raw); reduce_raw(raw, 0, wr, wc, fr, fq); load_raw(u, 1, wr, fr, fq, raw); reduce_raw(raw, 1, wr, wc, fr, fq); }
    }
    __device__ __forceinline__ void operator()(const f32x4 (&acc)[2][2][4][2], const Unit& u, const Unit& nxt, bool has_next, int wr, int wc, int fr, int fq) const {
        const int row0 = u.pm * BM + wr * 64 + fr, col0 = u.pn * BM + wc * 32 + 8 * fq;
        const bool up = u.pn >= split_pn;
        float rr[2][4]; f32x4 raw[4][2];
#pragma unroll
        for (int ai = 0; ai < 2; ++ai)
#pragma unroll
            for (int m = 0; m < 4; ++m) rr[ai][m] = RSCALE ? rrw[((wr * 4 + wc) * 8 + ai * 4 + m) * 16 + fr] : 1.f;
        if (RSCALE) asm volatile("s_waitcnt lgkmcnt(0)" ::: "memory");
        f32x4 hg0 = {1.f, 1.f, 1.f, 1.f}, hg1 = hg0; const bool hn = HN && u.pn < 8;
        if (HN) { if (hn) {
#pragma unroll
            for (int ai = 0; ai < 2; ++ai)
#pragma unroll
                for (int m = 0; m < 4; ++m)
#pragma unroll
                    for (int bj = 0; bj < 2; ++bj) { const f32x4 v0 = acc[ai][bj][m][0] * rr[ai][m], v1 = acc[ai][bj][m][1] * rr[ai][m];
                        float t = ((v0[0] * v0[0] + v0[1] * v0[1]) + (v0[2] * v0[2] + v0[3] * v0[3])) + ((v1[0] * v1[0] + v1[1] * v1[1]) + (v1[2] * v1[2] + v1[3] * v1[3]));
                        t += lane_read(t, (fq * 16 + fr) ^ 16); t += lane_read(t, (fq * 16 + fr) ^ 32);
                        if (fq == 0) xs[(ai * HALF + wr * 64 + m * 16 + fr) * 8 + bj * 4 + wc] = t; }
            asm volatile("s_waitcnt lgkmcnt(0)" ::: "memory"); __builtin_amdgcn_s_barrier(); asm volatile("" ::: "memory");
            hg0 = *(const f32x4*)(hgain + wc * 32 + 8 * fq); hg1 = *(const f32x4*)(hgain + wc * 32 + 8 * fq + 4);
        } }
#pragma unroll
        for (int ai = 0; ai < 2; ++ai) {
            if (RSCALE) { if (has_next) load_raw(nxt, ai, wr, fr, fq, raw); }
#pragma unroll
            for (int m = 0; m < 4; ++m) { const int row = row0 + ai * HALF + m * 16; float s = 0.f; float hnr[2] = {1.f, 1.f};
                if (HN) { if (hn) { const PG8_LAS f32x4* xp = (const PG8_LAS f32x4*)(xs + (ai * HALF + wr * 64 + m * 16 + fr) * 8); const f32x4 a = xp[0], b = xp[1];
                    hnr[0] = 1.0f / sqrtf(((a[0] + a[1]) + (a[2] + a[3])) * (1.0f / 128.0f) + RS_EPS); hnr[1] = 1.0f / sqrtf(((b[0] + b[1]) + (b[2] + b[3])) * (1.0f / 128.0f) + RS_EPS); } }
                bf16_t* rowp = HEADMAJOR ? O + (u.pn >= 8 ? (size_t)16384 * 2048 : (size_t)0) + ((size_t)((row >> 12) * 16 + 2 * (u.pn & 7)) * 4096 + (row & 4095)) * 128 + wc * 32 + 8 * fq
                                         : O + (size_t)row * ldc + col0;
#pragma unroll
                for (int bj = 0; bj < 2; ++bj) { f32x4 v0 = acc[ai][bj][m][0], v1 = acc[ai][bj][m][1];
                    if (RSCALE) { v0 = v0 * rr[ai][m]; v1 = v1 * rr[ai][m]; }
                    if (HN) { if (hn) { v0 = (v0 * hnr[bj]) * hg0; v1 = (v1 * hnr[bj]) * hg1; } }
                    if (MODE == 1) { f32x2 a = gelu_pk((f32x2){v0[0], v0[1]}), b = gelu_pk((f32x2){v0[2], v0[3]}), c = gelu_pk((f32x2){v1[0], v1[1]}), d = gelu_pk((f32x2){v1[2], v1[3]});
                        v0 = (f32x4){a.x, a.y, b.x, b.y}; v1 = (f32x4){c.x, c.y, d.x, d.y};
                        s += (v0[0] * v0[0] + v0[1] * v0[1]) + (v0[2] * v0[2] + v0[3] * v0[3]) + (v1[0] * v1[0] + v1[1] * v1[1]) + (v1[2] * v1[2] + v1[3] * v1[3]); }
                    if (MODE == 2) { if (up) {
#pragma unroll
                        for (int e = 0; e < 4; ++e) { v0[e] = __builtin_amdgcn_rcpf(1.0f + __builtin_amdgcn_exp2f(-1.4426950408889634f * v0[e])); v1[e] = __builtin_amdgcn_rcpf(1.0f + __builtin_amdgcn_exp2f(-1.4426950408889634f * v1[e])); } } }
                    u32x4 w; w.x = cvt_pk_bf16(v0[0], v0[1]); w.y = cvt_pk_bf16(v0[2], v0[3]); w.z = cvt_pk_bf16(v1[0], v1[1]); w.w = cvt_pk_bf16(v1[2], v1[3]);
                    *(u32x4*)(rowp + (HEADMAJOR ? (size_t)bj * 4096 * 128 : (size_t)bj * HALF)) = w; }
                if (MODE == 1) { if (up) { s += lane_read(s, (fq * 16 + fr) ^ 16); s += lane_read(s, (fq * 16 + fr) ^ 32); if (fq == 0) ss[(size_t)row * 32 + (u.pn - split_pn) * 4 + wc] = s; } } }
            if (RSCALE) { if (has_next) reduce_raw(raw, ai, wr, wc, fr, fq); } }
    }
};
struct EpiRes {
    static constexpr bool PERM = true, AFTER_DRAIN = false, IDEMPOTENT = false;
    bf16_t* hb; float* rss; int ldc;
    __device__ __forceinline__ void init(const Unit&, int, int, int, int) const {}
    __device__ __forceinline__ void operator()(const f32x4 (&acc)[2][2][4][2], const Unit& u, const Unit&, bool, int wr, int wc, int fr, int fq) const {
        const int row0 = u.pm * BM + wr * 64 + fr, col0 = u.pn * BM + wc * 32 + 8 * fq;
        u32x4 bn[2][2];
#pragma unroll
        for (int mm = 0; mm < 2; ++mm)
#pragma unroll
            for (int bj = 0; bj < 2; ++bj) bn[mm][bj] = *(const u32x4*)(hb + (size_t)(row0 + mm * 16) * ldc + col0 + bj * HALF);
#pragma unroll
        for (int c = 0; c < 4; ++c) { const int ai = c >> 1; u32x4 b[2][2];
#pragma unroll
            for (int mm = 0; mm < 2; ++mm)
#pragma unroll
                for (int bj = 0; bj < 2; ++bj) b[mm][bj] = bn[mm][bj];
            if (c < 3) { const int c1 = c + 1, ai1 = c1 >> 1;
#pragma unroll
                for (int mm = 0; mm < 2; ++mm)
#pragma unroll
                    for (int bj = 0; bj < 2; ++bj) bn[mm][bj] = *(const u32x4*)(hb + (size_t)(row0 + ai1 * HALF + (2 * (c1 & 1) + mm) * 16) * ldc + col0 + bj * HALF); }
#pragma unroll
            for (int mm = 0; mm < 2; ++mm) { const int m = 2 * (c & 1) + mm; const int row = row0 + ai * HALF + m * 16; const size_t off = (size_t)row * ldc + col0; float s = 0.f;
#pragma unroll
                for (int bj = 0; bj < 2; ++bj) { const u32x4 q = b[mm][bj];
                    const f32x4 o0 = (f32x4){__uint_as_float(q.x << 16), __uint_as_float(q.x & 0xffff0000u), __uint_as_float(q.y << 16), __uint_as_float(q.y & 0xffff0000u)} + acc[ai][bj][m][0];
                    const f32x4 o1 = (f32x4){__uint_as_float(q.z << 16), __uint_as_float(q.z & 0xffff0000u), __uint_as_float(q.w << 16), __uint_as_float(q.w & 0xffff0000u)} + acc[ai][bj][m][1];
                    u32x4 w; w.x = cvt_pk_bf16(o0[0], o0[1]); w.y = cvt_pk_bf16(o0[2], o0[3]); w.z = cvt_pk_bf16(o1[0], o1[1]); w.w = cvt_pk_bf16(o1[2], o1[3]);
                    *(u32x4*)(hb + off + bj * HALF) = w;
                    s += ((o0[0] * o0[0] + o0[1] * o0[1]) + (o0[2] * o0[2] + o0[3] * o0[3])) + ((o1[0] * o1[0] + o1[1] * o1[1]) + (o1[2] * o1[2] + o1[3] * o1[3])); }
                s += lane_read(s, (fq * 16 + fr) ^ 16); s += lane_read(s, (fq * 16 + fr) ^ 32); if (fq == 0) rss[(size_t)row * 32 + u.pn * 4 + wc] = s; } }
    }
};
template <class Epi, class Sched, bool ALIGN_EPI = false, bool SP2 = false>
__device__ __forceinline__ void gemm_phase(PG8_LAS unsigned char* lds, const Gemm g, const Sched& S, const Epi& E) {
    const int tid = opaque_tid(), wid = __builtin_amdgcn_readfirstlane(tid >> 6), lane = tid & 63, wr = wid >> 2, wc = wid & 3, fr = lane & 15, fq = lane >> 4;
    const int K = g.K, nt = K / BK;
    unsigned voffA[2], voffB[2];
#pragma unroll
    for (int i = 0; i < 2; ++i) { int R, C; stage_rc(tid * 16 + i * 8192, R, C); const int Rb = Epi::PERM ? ((R & ~31) + perm32(R & 31)) : R;
        voffA[i] = (unsigned)(R * K + C) * 2u; voffB[i] = (unsigned)(Rb * K + C) * 2u; }
    const size_t kstep = (size_t)(BK * 2);
    const size_t hstep = (size_t)HALF * K * 2;
    const size_t tstep = 2 * hstep;
    const unsigned ldsw = (unsigned)wid * 1024u;
    const int aoff = lds_byte(wr * 64 + fr, fq * 8), boff = lds_byte(wc * 32 + fr, fq * 8);
#define PG8_SA(b, h) (((b) * 2 + (h)) * HTB)
#define PG8_SB(b, h) ((4 + (b) * 2 + (h)) * HTB)
#define PG8_STAGE(bufoff, gbase, voff) do { _Pragma("unroll") for (int _i = 0; _i < 2; ++_i) \
        __builtin_amdgcn_global_load_lds((const unsigned*)((const char*)(gbase) + (voff)[_i]), (PG8_LAS unsigned*)(lds + (bufoff) + ldsw + _i * 8192), 16, 0, 0); } while (0)
#define PG8_LDA(dst, b, h) do { _Pragma("unroll") for (int m = 0; m < 4; ++m) _Pragma("unroll") for (int k = 0; k < 2; ++k) dst[m][k] = *(const PG8_LAS bf16x8*)(lds + PG8_SA(b, h) + aoff + m * 2048 + k * 1024); } while (0)
#define PG8_LDB(dst, b, h) do { _Pragma("unroll") for (int n = 0; n < 2; ++n) _Pragma("unroll") for (int k = 0; k < 2; ++k) dst[n][k] = *(const PG8_LAS bf16x8*)(lds + PG8_SB(b, h) + boff + n * 2048 + k * 1024); } while (0)
#define PG8_MMA(ai, bj, At, Bt) do { __builtin_amdgcn_s_setprio(1); _Pragma("unroll") for (int m = 0; m < 4; ++m) _Pragma("unroll") for (int n = 0; n < 2; ++n) _Pragma("unroll") for (int k = 0; k < 2; ++k) \
        acc[ai][bj][m][n] = __builtin_amdgcn_mfma_f32_16x16x32_bf16(Bt[n][k], At[m][k], acc[ai][bj][m][n], 0, 0, 0); __builtin_amdgcn_s_setprio(0); } while (0)
#define PG8_WAIT_V(n) asm volatile("s_waitcnt vmcnt(" #n ")" ::: "memory")
#define PG8_WAIT_L(n) asm volatile("s_waitcnt lgkmcnt(" #n ")" ::: "memory")
#define PG8_BAR __builtin_amdgcn_s_barrier()
#define PG8_SCHED __builtin_amdgcn_sched_barrier(0)
    Unit cur, nxt; int ui = 0;
    if (!S.next(0, cur)) return;
    E.init(cur, wr, wc, fr, fq);
    f32x4 acc[2][2][4][2];
#pragma unroll
    for (int a = 0; a < 2; ++a)
#pragma unroll
        for (int b = 0; b < 2; ++b)
#pragma unroll
            for (int m = 0; m < 4; ++m)
#pragma unroll
                for (int n = 0; n < 2; ++n) acc[a][b][m][n] = (f32x4){0.f, 0.f, 0.f, 0.f};
    bf16x8 At[4][2], B0[2][2], B1[2][2];
    const char* cA = (const char*)g.A + (size_t)cur.pm * tstep; const char* cB = (const char*)g.Bt + (size_t)cur.pn * tstep;
    S.a_ready(cur);
    if constexpr (SP2) {
        PG8_STAGE(PG8_SB(0, 0), cB, voffB); PG8_STAGE(PG8_SB(0, 1), cB + hstep, voffB); PG8_STAGE(PG8_SA(0, 0), cA, voffA); PG8_STAGE(PG8_SA(0, 1), cA + hstep, voffA);
        if (wr == 1) PG8_BAR;
        PG8_WAIT_V(2); PG8_BAR;
        PG8_STAGE(PG8_SB(1, 0), cB + kstep, voffB); PG8_STAGE(PG8_SA(1, 0), cA + kstep, voffA); PG8_STAGE(PG8_SB(1, 1), cB + hstep + kstep, voffB);
        PG8_WAIT_V(6); PG8_BAR;
    } else {
        PG8_STAGE(PG8_SB(0, 0), cB, voffB); PG8_STAGE(PG8_SA(0, 0), cA, voffA); PG8_STAGE(PG8_SB(0, 1), cB + hstep, voffB); PG8_STAGE(PG8_SA(0, 1), cA + hstep, voffA);
        if (wr == 1) PG8_BAR;
        PG8_WAIT_V(4); PG8_BAR;
        PG8_STAGE(PG8_SB(1, 0), cB + kstep, voffB); PG8_STAGE(PG8_SA(1, 0), cA + kstep, voffA); PG8_STAGE(PG8_SB(1, 1), cB + hstep + kstep, voffB);
        PG8_WAIT_V(6); PG8_BAR;
    }
    for (;;) {
        const bool has_next = S.next(ui + 1, nxt);
        const char* nA = has_next ? (const char*)g.A + (size_t)nxt.pm * tstep : cA; const char* nB = has_next ? (const char*)g.Bt + (size_t)nxt.pn * tstep : cB;
        for (int t = 0; t < nt; t += 2) {
            const bool last = (t == nt - 2);
            const char* a1 = cA + (size_t)(t + 1) * kstep;
            const char* a2 = last ? nA : cA + (size_t)(t + 2) * kstep; const char* b2 = last ? nB : cB + (size_t)(t + 2) * kstep;
            const char* a3 = a2 + kstep; const char* b3 = b2 + kstep;
            if (last && has_next) S.a_ready(nxt);
            if constexpr (SP2) {
            PG8_LDB(B0, 0, 0); PG8_LDB(B1, 0, 1); PG8_SCHED; PG8_LDA(At, 0, 0); PG8_STAGE(PG8_SA(1, 1), a1 + hstep, voffA);
            PG8_WAIT_V(8); PG8_WAIT_L(0); PG8_BAR; PG8_MMA(0, 0, At, B0); PG8_MMA(0, 1, At, B1); PG8_BAR; PG8_SCHED;
            PG8_LDA(At, 0, 1); PG8_STAGE(PG8_SB(0, 0), b2, voffB); PG8_STAGE(PG8_SB(0, 1), b2 + hstep, voffB); PG8_STAGE(PG8_SA(0, 0), a2, voffA);
            PG8_WAIT_V(8); PG8_WAIT_L(0); PG8_BAR; PG8_MMA(1, 0, At, B0); PG8_MMA(1, 1, At, B1); PG8_BAR; PG8_SCHED;
            PG8_LDB(B0, 1, 0); PG8_LDB(B1, 1, 1); PG8_SCHED; PG8_LDA(At, 1, 0); PG8_STAGE(PG8_SA(0, 1), a2 + hstep, voffA);
            PG8_WAIT_V(8); PG8_WAIT_L(0); PG8_BAR; PG8_MMA(0, 0, At, B0); PG8_MMA(0, 1, At, B1); PG8_BAR; PG8_SCHED;
            PG8_LDA(At, 1, 1); PG8_STAGE(PG8_SB(1, 0), b3, voffB); PG8_STAGE(PG8_SB(1, 1), b3 + hstep, voffB); PG8_STAGE(PG8_SA(1, 0), a3, voffA);
            PG8_WAIT_V(8); PG8_WAIT_L(0); PG8_BAR; PG8_MMA(1, 0, At, B0); PG8_MMA(1, 1, At, B1); PG8_BAR; PG8_SCHED;
            } else {
            PG8_LDB(B0, 0, 0); PG8_SCHED; PG8_LDA(At, 0, 0); PG8_STAGE(PG8_SA(1, 1), a1 + hstep, voffA);
            PG8_WAIT_L(8); PG8_BAR; PG8_WAIT_L(0); PG8_MMA(0, 0, At, B0); PG8_BAR; PG8_SCHED;
            PG8_LDB(B1, 0, 1); PG8_STAGE(PG8_SB(0, 0), b2, voffB);
            PG8_BAR; PG8_WAIT_L(0); PG8_MMA(0, 1, At, B1); PG8_BAR;
            PG8_LDA(At, 0, 1); PG8_STAGE(PG8_SA(0, 0), a2, voffA);
            PG8_BAR; PG8_WAIT_L(0); PG8_MMA(1, 0, At, B0); PG8_BAR; PG8_SCHED;
            PG8_STAGE(PG8_SB(0, 1), b2 + hstep, voffB);
            PG8_WAIT_V(6); PG8_BAR; PG8_MMA(1, 1, At, B1); PG8_BAR;
            PG8_LDB(B0, 1, 0); PG8_SCHED; PG8_LDA(At, 1, 0); PG8_STAGE(PG8_SA(0, 1), a2 + hstep, voffA);
            PG8_WAIT_L(8); PG8_BAR; PG8_WAIT_L(0); PG8_MMA(0, 0, At, B0); PG8_BAR; PG8_SCHED;
            PG8_LDB(B1, 1, 1); PG8_STAGE(PG8_SB(1, 0), b3, voffB);
            PG8_BAR; PG8_WAIT_L(0); PG8_MMA(0, 1, At, B1); PG8_BAR;
            PG8_LDA(At, 1, 1); PG8_STAGE(PG8_SA(1, 0), a3, voffA);
            PG8_BAR; PG8_WAIT_L(0); PG8_MMA(1, 0, At, B0); PG8_BAR; PG8_SCHED;
            PG8_STAGE(PG8_SB(1, 1), b3 + hstep, voffB);
            PG8_WAIT_V(6); PG8_BAR; PG8_MMA(1, 1, At, B1); PG8_BAR;
            }
        }
        if constexpr (ALIGN_EPI) { if (wr == 0) PG8_BAR; }
        if constexpr (!Epi::AFTER_DRAIN) { E(acc, cur, nxt, has_next, wr, wc, fr, fq); S.done(cur); }
        if (!has_next) break;
#pragma unroll
        for (int a = 0; a < 2; ++a)
#pragma unroll
            for (int b = 0; b < 2; ++b)
#pragma unroll
                for (int m = 0; m < 4; ++m)
#pragma unroll
                    for (int n = 0; n < 2; ++n) acc[a][b][m][n] = (f32x4){0.f, 0.f, 0.f, 0.f};
        cur = nxt; cA = nA; cB = nB; ++ui;
        if constexpr (ALIGN_EPI) { if (wr == 1) PG8_BAR; }
    }
    PG8_WAIT_V(0);
    if constexpr (!ALIGN_EPI) { if (wr == 0) PG8_BAR; }
    PG8_BAR;
    if constexpr (Epi::AFTER_DRAIN) { E.fused(acc, cur, wr, wc, fr, fq, lds, wid, lane); S.done(cur); }
#undef PG8_SA
#undef PG8_SB
#undef PG8_STAGE
#undef PG8_LDA
#undef PG8_LDB
#undef PG8_MMA
#undef PG8_WAIT_V
#undef PG8_WAIT_L
#undef PG8_BAR
#undef PG8_SCHED
}
}
namespace att {
constexpr int D = 128, LDQ = 4096, LDK = 128, LDO = 2048, LDG = 4096;
constexpr float THR = 16.f; constexpr bool WSKIP = false;
typedef unsigned u32x4_t __attribute__((ext_vector_type(4)));
typedef short bf16x8_t __attribute__((ext_vector_type(8)));
__device__ __forceinline__ bf16x8_t ka_frag(unsigned lo, unsigned up, int hi) {
    u32x4_t w; w.x = hi ? 0u : lo; w.y = hi ? 0u : (up & 0xffffu); w.z = 0u; w.w = 0u;
    return __builtin_bit_cast(bf16x8_t, w);
}
__device__ __forceinline__ bf16x8_t qa_frag(int hi) {
    u32x4_t w; w.x = hi ? 0u : 0x3f803f80u; w.y = hi ? 0u : 0x00003f80u; w.z = 0u; w.w = 0u;
    return __builtin_bit_cast(bf16x8_t, w);
}
constexpr float SCALE = 0.08838834764831845f;
constexpr int NW = 8, QBLK = 32, KVBLK = 64, QB = NW * QBLK;
constexpr int SHM_V = KVBLK * D * 2, SHM_K = KVBLK * D * 2;
constexpr int ATT_LDS_BYTES = 2 * SHM_V + 2 * SHM_K + NW * 64 * 4;

using bf16 = __hip_bfloat16;
typedef short bf16x8 __attribute__((ext_vector_type(8)));
typedef short s16x4 __attribute__((ext_vector_type(4)));
typedef float f32x16 __attribute__((ext_vector_type(16)));
typedef float f32x4 __attribute__((ext_vector_type(4)));
typedef unsigned u32x4 __attribute__((ext_vector_type(4)));
template <class A, class Bt> struct same_t { static constexpr bool v = false; };
template <class A> struct same_t<A, A> { static constexpr bool v = true; };

#define KSWZ(row, colB) ((row) * 256 + ((colB) ^ (((row) & 7) << 4)))
#define SBAR() __builtin_amdgcn_sched_barrier(0)
__device__ __forceinline__ int v_st(int k, int c) { const int kk = (k & ~0xC) | ((k & 4) << 1) | ((k & 8) >> 1); return ((kk >> 3) * 4 + (c >> 5)) * 512 + ((kk & 7) * 32 + (c & 31)) * 2; }
__device__ __forceinline__ int v_rd_base(int lane) { return ((lane & 3) << 3) | (((lane >> 2) & 3) << 6) | (((lane >> 4) & 1) << 5) | (((lane >> 5) & 1) << 8); }
constexpr int v_rd_off(int d0, int ks, int half) { return d0 * 512 + ks * 4096 + half * 2048; }
__device__ __forceinline__ int crow(int r, int hi) { return (r & 3) + 8 * (r >> 2) + 4 * hi; }
__device__ __forceinline__ unsigned cvtpk(float lo, float hi) {
    unsigned r; asm volatile("v_cvt_pk_bf16_f32 %0, %1, %2" : "=v"(r) : "v"(lo), "v"(hi)); return r;
}
__device__ __forceinline__ bf16x8 pack8(f32x4 a, f32x4 b) {
    u32x4 w = {cvtpk(a[0], a[1]), cvtpk(a[2], a[3]), cvtpk(b[0], b[1]), cvtpk(b[2], b[3])};
    return *reinterpret_cast<bf16x8*>(&w);
}
template <class T> __device__ __forceinline__ bf16x8 load8(const T* p) {
    if constexpr (same_t<T, float>::v) { return pack8(*(const f32x4*)p, *(const f32x4*)(p + 4)); }
    else { return *reinterpret_cast<const bf16x8*>(p); }
}
__device__ __forceinline__ void mask_tile(f32x16& p0, f32x16& p1, int dq, unsigned W) {
    const float NEG = -__builtin_inff();
#pragma unroll
    for (int r = 0; r < 16; ++r) {
        const int c = (r & 3) + 8 * (r >> 2);
        if ((unsigned)(dq - c) >= W) p0[r] = NEG;
        if ((unsigned)(dq - c - 32) >= W) p1[r] = NEG;
    }
}
__device__ __forceinline__ void partialSM(f32x16& p0, f32x16& p1, float& m_reg, float& mn, float& alpha) {
    float pmax = p0[0]; for (int r = 1; r < 16; ++r) pmax = fmaxf(pmax, p0[r]); for (int r = 0; r < 16; ++r) pmax = fmaxf(pmax, p1[r]);
    { auto rr = __builtin_amdgcn_permlane32_swap(__float_as_uint(pmax), __float_as_uint(pmax), false, false);
      pmax = fmaxf(__uint_as_float(rr[0]), __uint_as_float(rr[1])); }
    constexpr float C2 = 1.4426950408889634f * SCALE;
    if (__builtin_expect(__all((pmax - m_reg) * SCALE <= THR), 1)) { mn = m_reg; alpha = 1.f; }
    else { mn = fmaxf(m_reg, pmax); alpha = __builtin_amdgcn_exp2f((m_reg - mn) * C2); m_reg = mn; }
    const float mnL = -mn * C2;
    for (int r = 0; r < 16; ++r) p0[r] = fmaf(p0[r], C2, mnL); for (int r = 0; r < 16; ++r) p1[r] = fmaf(p1[r], C2, mnL);
    for (int r = 0; r < 16; ++r) p0[r] = __builtin_amdgcn_exp2f(p0[r]);
}
__device__ __forceinline__ void finishSM(f32x16& p0, f32x16& p1, float alpha, float& l_reg, bf16x8& pa0, bf16x8& pa1, bf16x8& pa2, bf16x8& pa3) {
    for (int r = 0; r < 16; ++r) p1[r] = __builtin_amdgcn_exp2f(p1[r]);
    float ps = 0; for (int r = 0; r < 16; ++r) ps += p0[r]; for (int r = 0; r < 16; ++r) ps += p1[r];
    { auto rr = __builtin_amdgcn_permlane32_swap(__float_as_uint(ps), __float_as_uint(ps), false, false);
      ps = __uint_as_float(rr[0]) + __uint_as_float(rr[1]); }
    l_reg = l_reg * alpha + ps;
#define PK4(P, B_, OUT) do { unsigned a0 = cvtpk(P[B_+0], P[B_+1]), a1 = cvtpk(P[B_+2], P[B_+3]);                          \
        unsigned b0 = cvtpk(P[B_+4], P[B_+5]), b1 = cvtpk(P[B_+6], P[B_+7]);                                             \
        auto r0 = __builtin_amdgcn_permlane32_swap(a0, b0, false, false); auto r1 = __builtin_amdgcn_permlane32_swap(a1, b1, false, false); \
        u32x4 w = {r0[0], r1[0], r0[1], r1[1]}; OUT = *reinterpret_cast<bf16x8*>(&w); } while (0)
    PK4(p0, 0, pa0); PK4(p0, 8, pa1); PK4(p1, 0, pa2); PK4(p1, 8, pa3);
#undef PK4
}
template <int KB, bool SK>
__device__ __forceinline__ void qkt(f32x16& p0, f32x16& p1, const char* K_lds, int r32, int hi, const bf16x8* qr, bool act, unsigned long long c) {
    if (SK && !act) { const float NEG = -__builtin_inff();
#pragma unroll
        for (int r = 0; r < 16; ++r) { p0[r] = NEG; p1[r] = NEG; } return; }
    p0 = f32x16{}; p1 = f32x16{};
    const char* kb[4];
#pragma unroll
    for (int dd = 0; dd < 4; ++dd) kb[dd] = K_lds + KB * SHM_K + KSWZ(r32, (dd * 16 + hi * 8) * 2);
#pragma unroll
    for (int d0 = 0; d0 < 8; ++d0) { const char* a = kb[d0 & 3] + (d0 >> 2) * 128;
        bf16x8 b0 = *reinterpret_cast<const bf16x8*>(a);
        bf16x8 b1 = *reinterpret_cast<const bf16x8*>(a + 32 * 256);
        p0 = __builtin_amdgcn_mfma_f32_32x32x16_bf16(b0, qr[d0], p0, 0, 0, 0);
        p1 = __builtin_amdgcn_mfma_f32_32x32x16_bf16(b1, qr[d0], p1, 0, 0, 0); }
    { int h2 = hi; asm volatile("" : "+v"(h2));
      const bf16x8 qaf = qa_frag(h2);
      const unsigned cl = (unsigned)c, cu = (unsigned)(c >> 32);
      auto r0 = __builtin_amdgcn_permlane32_swap(cl, cl, false, false); auto r1 = __builtin_amdgcn_permlane32_swap(cu, cu, false, false);
      p0 = __builtin_amdgcn_mfma_f32_32x32x16_bf16(ka_frag(r0[0], r1[0], hi), qaf, p0, 0, 0, 0);
      p1 = __builtin_amdgcn_mfma_f32_32x32x16_bf16(ka_frag(r0[1], r1[1], hi), qaf, p1, 0, 0, 0); }
}
template <int VB, bool SK>
__device__ __forceinline__ void pv_tile(f32x16* o, int vb0, bf16x8 pa0, bf16x8 pa1, bf16x8 pa2, bf16x8 pa3, bool act) {
    if (SK && !act) return;
#define TRRD(dst, off) asm volatile("ds_read_b64_tr_b16 %0, %1 offset:%2" : "=&v"(dst) : "v"(vb0), "i"(off) : "memory")
#define PV_D0(d0) do { s16x4 l0, l1, l2, l3, h0, h1, h2, h3; constexpr int b_ = VB * SHM_V + v_rd_off(d0, 0, 0);     \
        TRRD(l0, b_); TRRD(h0, b_ + 2048); TRRD(l1, b_ + 4096); TRRD(h1, b_ + 6144); TRRD(l2, b_ + 8192); TRRD(h2, b_ + 10240); TRRD(l3, b_ + 12288); TRRD(h3, b_ + 14336); \
        asm volatile("s_waitcnt lgkmcnt(0)" ::: "memory"); SBAR();                 \
        o[d0] = __builtin_amdgcn_mfma_f32_32x32x16_bf16(pa0, (bf16x8){l0[0], l0[1], l0[2], l0[3], h0[0], h0[1], h0[2], h0[3]}, o[d0], 0, 0, 0);   \
        o[d0] = __builtin_amdgcn_mfma_f32_32x32x16_bf16(pa1, (bf16x8){l1[0], l1[1], l1[2], l1[3], h1[0], h1[1], h1[2], h1[3]}, o[d0], 0, 0, 0);   \
        o[d0] = __builtin_amdgcn_mfma_f32_32x32x16_bf16(pa2, (bf16x8){l2[0], l2[1], l2[2], l2[3], h2[0], h2[1], h2[2], h2[3]}, o[d0], 0, 0, 0);   \
        o[d0] = __builtin_amdgcn_mfma_f32_32x32x16_bf16(pa3, (bf16x8){l3[0], l3[1], l3[2], l3[3], h3[0], h3[1], h3[2], h3[3]}, o[d0], 0, 0, 0); } while (0)
    PV_D0(0); PV_D0(1); PV_D0(2); PV_D0(3);
#undef PV_D0
#undef TRRD
}

template <class TIn, class TOut> struct BlockRef { const TIn* Q; const TIn* K; const TIn* V; TOut* O; const unsigned short* G; const unsigned long long* CA; int P0; };
template <class TIn> struct Seam {
    bf16x8 qr[8];
    bf16x8 st_v0, st_v1, st_k0, st_k1; f32x4 sf0, sf1, sf2, sf3;
    unsigned long long ca;
    f32x4 tq[16];
};
__device__ __forceinline__ int swa_jlo(int P0, int W) { const int lowk = P0 - W + 1; return lowk > 0 ? lowk / KVBLK : 0; }
#define ROW(p, k0, rr) ((p) + (size_t)((k0) + (rr)) * LDK + sc)
#define VMW() asm volatile("s_waitcnt vmcnt(0)" ::: "memory")
#define VMWN(n) asm volatile("s_waitcnt vmcnt(%0)" :: "i"(n) : "memory")
#define SLOAD_H(Kp, Vp, CAp, k0) do { S.st_v0 = load8<TIn>(ROW(Vp, k0, sr)); S.st_v1 = load8<TIn>(ROW(Vp, k0, 32 + sr));              \
                         S.st_k0 = load8<TIn>(ROW(Kp, k0, sr)); S.st_k1 = load8<TIn>(ROW(Kp, k0, 32 + sr)); S.ca = (CAp)[(k0) + lane]; } while (0)
#define SWRITE_HK(bf) do { *(bf16x8*)(K_lds + (bf) * SHM_K + kws) = S.st_k0; *(bf16x8*)(K_lds + (bf) * SHM_K + kws + 32 * 256) = S.st_k1; } while (0)
#define SWRITE_HV(bf) do { *(bf16x8*)(V_lds + (bf) * SHM_V + vst0) = S.st_v0; *(bf16x8*)(V_lds + (bf) * SHM_V + vst1) = S.st_v1; } while (0)
#define SWRITE_H(bf) do { SWRITE_HV(bf); SWRITE_HK(bf); } while (0)
#define SLOAD_F(p, k0) do { S.sf0 = *(const f32x4*)ROW(p, k0, sr); S.sf1 = *(const f32x4*)(ROW(p, k0, sr) + 4);                \
                            S.sf2 = *(const f32x4*)ROW(p, k0, 32 + sr); S.sf3 = *(const f32x4*)(ROW(p, k0, 32 + sr) + 4); } while (0)
#define SWRITE_KF(bf) do { *(bf16x8*)(K_lds + (bf) * SHM_K + kws) = pack8(S.sf0, S.sf1); *(bf16x8*)(K_lds + (bf) * SHM_K + kws + 32 * 256) = pack8(S.sf2, S.sf3); } while (0)
#define SWRITE_VF(bf) do { *(bf16x8*)(V_lds + (bf) * SHM_V + vst0) = pack8(S.sf0, S.sf1); *(bf16x8*)(V_lds + (bf) * SHM_V + vst1) = pack8(S.sf2, S.sf3); } while (0)
template <class TIn, class TOut>
__device__ __forceinline__ void causal_swa_prime(const BlockRef<TIn, TOut>& cur, int W, char* lds, Seam<TIn>& S) {
    constexpr bool F32 = same_t<TIn, float>::v;
    const int tid = opaque_tid(), wid = __builtin_amdgcn_readfirstlane(tid >> 6), lane = tid & 63, r32 = lane & 31, hi = lane >> 5;
    const int sr = tid >> 4, sc = (tid & 15) * 8, kws = KSWZ(sr, sc * 2); char* K_lds = lds + 2 * SHM_V;
    const int kb0 = swa_jlo(cur.P0, W) * KVBLK;
    for (int d0 = 0; d0 < 8; ++d0) S.qr[d0] = load8<TIn>(cur.Q + (size_t)(wid * QBLK + r32) * LDQ + d0 * 16 + hi * 8);
    if constexpr (F32) { SLOAD_F((const float*)cur.K, kb0); VMW(); SWRITE_KF(0); SBAR(); SLOAD_F((const float*)cur.V, kb0); }
    else { SLOAD_H(cur.K, cur.V, cur.CA, kb0); VMW(); SWRITE_HK(0); }
    __syncthreads();
}
template <class TIn, class TOut>
__device__ __forceinline__ void causal_swa_block(const BlockRef<TIn, TOut>& cur, const BlockRef<TIn, TOut>& nxt, int skv, int W, char* lds, Seam<TIn>& S) {
    constexpr bool F32 = same_t<TIn, float>::v;
    const int tid = opaque_tid(), wid = __builtin_amdgcn_readfirstlane(tid >> 6), lane = tid & 63, r32 = lane & 31, hi = lane >> 5;
    const int j_lo = swa_jlo(cur.P0, W);
    int j_hi = (cur.P0 + QB - 1) / KVBLK + 1; if (j_hi > skv / KVBLK) j_hi = skv / KVBLK;
    const int NT = j_hi - j_lo;
    const int kbn = swa_jlo(nxt.P0, W) * KVBLK;
    const int qlo = cur.P0 + wid * QBLK, qm = qlo + r32 - 4 * hi;
    char* V_lds = lds; char* K_lds = lds + 2 * SHM_V;
    float* ws = (float*)(lds + 2 * SHM_V + 2 * SHM_K) + wid * 64; float* li_l = ws, * al_l = ws + 32;
    float m_reg = -1e30f, l_reg = 0; f32x16 o[4] = {};
    const int sr = tid >> 4, sc = (tid & 15) * 8, vst0 = v_st(sr, sc), vst1 = v_st(32 + sr, sc), kws = KSWZ(sr, sc * 2);
    const int vb0 = (int)(uintptr_t)V_lds + v_rd_base(lane);
    const TIn* Kh = cur.K; const TIn* Vh = cur.V; const unsigned long long* CAh = cur.CA;
#define RESC(a) do { if (__any((a) < 1.f)) { if (hi == 0) al_l[r32] = (a); asm volatile("s_waitcnt lgkmcnt(0)" ::: "memory");              \
                     for (int d_ = 0; d_ < 4; ++d_) for (int r = 0; r < 16; ++r) o[d_][r] *= al_l[crow(r, hi)]; } } while (0)
#define KBASE(t) ((j_lo + (t)) * KVBLK)
#define ACT(t) (KBASE(t) <= qlo + QBLK - 1 && KBASE(t) + KVBLK - 1 >= qlo - W + 1)
#define MASKT(P0_, P1_, t) do { const int kb_ = KBASE(t); if ((!SK || ACT(t)) && (kb_ + KVBLK - 1 > qlo || kb_ <= qlo + QBLK - 1 - W)) mask_tile(P0_, P1_, qm - kb_, (unsigned)W); } while (0)
    constexpr int NQL = F32 ? 16 : 8;
    constexpr bool SK = WSKIP && !F32;
#define SEAM_K0() do { VMWN(NQL); if constexpr (F32) { SWRITE_KF(0); SBAR(); SLOAD_F((const float*)nxt.V, kbn); } else { SWRITE_HK(0); } SBAR(); } while (0)
    f32x16 pA0, pA1, pB0, pB1; float mnA, mnB, alA, alB; bf16x8 pa0, pa1, pa2, pa3;
    if constexpr (F32) { VMW(); SWRITE_VF(0); SBAR(); } else { SWRITE_HV(0); SBAR(); }
    const unsigned long long hc = S.ca;
    if (NT > 1) { if constexpr (F32) SLOAD_F((const float*)Kh, KBASE(1)); else SLOAD_H(Kh, Vh, CAh, KBASE(1)); }
    SBAR(); qkt<0, SK>(pA0, pA1, K_lds, r32, hi, S.qr, ACT(0), hc);
    if constexpr (F32) { if (NT > 1) { VMW(); SWRITE_KF(1); SBAR(); SLOAD_F((const float*)Vh, KBASE(1)); } }
    MASKT(pA0, pA1, 0); partialSM(pA0, pA1, m_reg, mnA, alA);
    if (NT > 1) { VMW(); if constexpr (F32) { SWRITE_VF(1); SBAR(); if (NT > 2) SLOAD_F((const float*)Kh, KBASE(2)); } else SWRITE_H(1); }
    __syncthreads();
#define HALF_STEP(PX0, PX1, mnX, alX, PY0, PY1, alY, t, KB, VB, SB) do {                                                      \
        { const unsigned long long c_ = S.ca; SBAR(); qkt<KB, SK>(PX0, PX1, K_lds, r32, hi, S.qr, ACT(t), c_); }                                             \
        finishSM(PY0, PY1, alY, l_reg, pa0, pa1, pa2, pa3); SBAR();                                                           \
        if ((t) + 1 < NT) { if constexpr (F32) { VMW(); SWRITE_KF(SB); SBAR(); SLOAD_F((const float*)Vh, KBASE((t) + 1)); }  \
                            else { SLOAD_H(Kh, Vh, CAh, KBASE((t) + 1)); } SBAR(); }                                               \
        pv_tile<VB, SK>(o, vb0, pa0, pa1, pa2, pa3, ACT((t) - 1)); MASKT(PX0, PX1, (t)); partialSM(PX0, PX1, m_reg, mnX, alX);                                        \
        __syncthreads();                                                                                                      \
        if ((t) + 1 < NT) { VMW(); if constexpr (F32) { SWRITE_VF(SB); SBAR(); if ((t) + 2 < NT) SLOAD_F((const float*)Kh, KBASE((t) + 2)); } \
                            else { SWRITE_H(SB); } }                                                                          \
        RESC(alX); __syncthreads(); } while (0)
    for (int t = 1; t + 1 < NT; t += 2) {
        HALF_STEP(pB0, pB1, mnB, alB, pA0, pA1, alA, t, 1, 0, 0);
        HALF_STEP(pA0, pA1, mnA, alA, pB0, pB1, alB, t + 1, 0, 1, 1);
    }
    const bool even = (NT & 1) == 0;
    if (even) { const unsigned long long c_ = S.ca; SBAR(); qkt<1, SK>(pB0, pB1, K_lds, r32, hi, S.qr, ACT(NT - 1), c_); SBAR(); }
#define QROW(e) (nxt.Q + (size_t)(wid * QBLK + r32) * D + ((e) >> 1) * 16 + hi * 8 + ((e) & 1) * 4)
    if constexpr (F32) { SLOAD_F((const float*)nxt.K, kbn); SBAR();
#pragma unroll
        for (int e = 0; e < 8; ++e) S.tq[e] = *(const f32x4*)QROW(e); }
    else { SLOAD_H(nxt.K, nxt.V, nxt.CA, kbn); SBAR();
#pragma unroll
        for (int d0 = 0; d0 < 8; ++d0) S.qr[d0] = load8<TIn>(nxt.Q + (size_t)(wid * QBLK + r32) * LDQ + d0 * 16 + hi * 8); }
    SBAR();
    finishSM(pA0, pA1, alA, l_reg, pa0, pa1, pa2, pa3); SBAR();
    if constexpr (F32) {
#pragma unroll
        for (int e = 8; e < 16; ++e) S.tq[e] = *(const f32x4*)QROW(e); SBAR(); }
#undef QROW
    pv_tile<0, SK>(o, vb0, pa0, pa1, pa2, pa3, ACT(even ? NT - 2 : NT - 1));
    if (even) { MASKT(pB0, pB1, NT - 1); partialSM(pB0, pB1, m_reg, mnB, alB); __syncthreads(); RESC(alB);
        finishSM(pB0, pB1, alB, l_reg, pa0, pa1, pa2, pa3); SBAR(); pv_tile<1, SK>(o, vb0, pa0, pa1, pa2, pa3, ACT(NT - 1)); }
    SBAR(); SEAM_K0();
    if (hi == 0) li_l[r32] = l_reg; asm volatile("s_waitcnt lgkmcnt(0)" ::: "memory");
    float rli[16];
#pragma unroll
    for (int r = 0; r < 16; ++r) rli[r] = __builtin_amdgcn_rcpf(li_l[crow(r, hi)]);
    TOut* Ow = cur.O + (size_t)(wid * QBLK) * LDO; const unsigned short* Gw = cur.G + (size_t)(wid * QBLK) * LDG;
    unsigned gv[16][4];
#pragma unroll
    for (int r = 0; r < 16; ++r)
#pragma unroll
        for (int d0 = 0; d0 < 4; ++d0) gv[r][d0] = *(const unsigned*)(Gw + (size_t)crow(r, hi) * LDG + d0 * 32 + (r32 & ~1));
#pragma unroll
    for (int r = 0; r < 16; ++r) { const int orow = crow(r, hi);
#pragma unroll
        for (int d0 = 0; d0 < 4; ++d0) { const float v = o[d0][r] * rli[r];
            if constexpr (same_t<TOut, float>::v) { Ow[(size_t)orow * LDO + d0 * 32 + r32] = v; }
            else { const float vn = __builtin_bit_cast(float, __builtin_amdgcn_mov_dpp(__builtin_bit_cast(int, v), 0xB1, 0xf, 0xf, true));
                   const unsigned g2 = gv[r][d0];
                   if ((r32 & 1) == 0) *(unsigned*)(Ow + (size_t)orow * LDO + d0 * 32 + r32) = cvtpk(v * __uint_as_float(g2 << 16), vn * __uint_as_float(g2 & 0xffff0000u)); } } }
    if constexpr (F32) {
#pragma unroll
        for (int d0 = 0; d0 < 8; ++d0) S.qr[d0] = pack8(S.tq[2 * d0], S.tq[2 * d0 + 1]); }
    __syncthreads();
#undef RESC
#undef KBASE
#undef ACT
#undef MASKT
#undef SEAM_K0
#undef HALF_STEP
}
#undef ROW
#undef VMW
#undef VMWN
#undef SLOAD_H
#undef SWRITE_HK
#undef SWRITE_HV
#undef SWRITE_H
#undef SLOAD_F
#undef SWRITE_KF
#undef SWRITE_VF

__host__ __device__ inline int swa_nx(int nqb, int nramp) { return (nramp + 1) / 2 + (nqb - nramp); }
struct SwaItem { int bh, qb0, qb1; };
__device__ __forceinline__ SwaItem swa_decode(int L, int nqb, int nx) {
    SwaItem it; const int xcd = L & 7, k = L >> 3, gi = k / nx, r = k - gi * nx;
    it.bh = gi * 8 + xcd; const int x = r;
    it.qb0 = nqb - 1 - x; it.qb1 = x;
    return it;
}
struct AttnT { const bf16* Q; const bf16* K; const bf16* V; bf16* O; const unsigned short* G; const unsigned long long* CA; };
__device__ __forceinline__ BlockRef<bf16, bf16> swa_ref(const SwaItem& it, int pass, const AttnT& T, int seq, int nh) {
    const int qb = pass ? it.qb1 : it.qb0, b = it.bh / nh, h = it.bh % nh; const size_t tok0 = (size_t)b * seq;
    BlockRef<bf16, bf16> r;
    r.Q = T.Q + (tok0 + (size_t)qb * QB) * LDQ + h * D; r.O = T.O + (tok0 + (size_t)qb * QB) * LDO + h * D; r.G = T.G + (tok0 + (size_t)qb * QB) * LDG + h * D;
    r.K = T.K + (size_t)it.bh * seq * D; r.V = T.V + (size_t)it.bh * seq * D; r.CA = T.CA + (size_t)it.bh * seq; r.P0 = qb * QB;
    return r;
}
__device__ __forceinline__ void attn_phase(char* lds, const AttnT& T, int nb, int nh, int seq) {
    const int W = 1 << 30, nqb = seq / QB, nx = nqb / 2, total = nx * nb * nh, stride = gridDim.x;
    int L = blockIdx.x; if (L >= total) return;
    SwaItem it = swa_decode(L, nqb, nx); int pass = 0;
    BlockRef<bf16, bf16> cur = swa_ref(it, 0, T, seq, nh);
    Seam<bf16> S;
    causal_swa_prime<bf16, bf16>(cur, W, lds, S);
    for (;;) {
        const bool more_pass = pass == 0 && it.qb1 != it.qb0, more_item = L + stride < total, last = !more_pass && !more_item;
        SwaItem itn = it; int passn = pass + 1, Ln = L;
        if (!more_pass) { passn = 0; Ln = more_item ? L + stride : L; itn = swa_decode(Ln, nqb, nx); }
        const BlockRef<bf16, bf16> nxt = last ? cur : swa_ref(itn, passn, T, seq, nh);
        causal_swa_block<bf16, bf16>(cur, nxt, seq, W, lds, S);
        if (last) break;
        cur = nxt; it = itn; pass = passn; L = Ln;
    }
}
#undef KSWZ
#undef SBAR
}
constexpr int DM = 2048, NB = 4, SEQ = 4096, MT = NB * SEQ, FF = 5632, FF2 = 2 * FF, NH = 16, HD = 128, CH = 128, NG = 16;
constexpr float EPS = 1e-6f;
constexpr int NWAVES = 8, NTHREADS = NWAVES * 64;
constexpr size_t MiB = 1u << 20;
constexpr size_t WS_BAR = 0, BAR_ZERO_BYTES = 16384;
constexpr size_t WS_LOGF = 1 * MiB;
constexpr size_t WS_CA = 2 * MiB;
constexpr size_t WS_WSB = 4 * MiB;
constexpr size_t WS_WF = 5 * MiB;
constexpr size_t WS_W_AIN = 6 * MiB;
constexpr size_t WS_W_AOUT = WS_W_AIN + 32 * MiB;
constexpr size_t WS_W_KV = WS_W_AOUT + 16 * MiB;
constexpr size_t WS_W_QG = WS_W_KV + 16 * MiB;
constexpr size_t WS_W_BOUT = WS_W_QG + 32 * MiB;
constexpr size_t WS_W_UP = WS_W_BOUT + 16 * MiB;
constexpr size_t WS_W_DN = WS_W_UP + 176 * MiB;
constexpr size_t WS_XN = WS_W_DN + 88 * MiB;
constexpr size_t WS_XN2 = WS_XN + 64 * MiB;
constexpr size_t WS_KV = WS_XN2 + 64 * MiB;
constexpr size_t WS_BIG = WS_KV + 128 * MiB;
constexpr size_t WS_ACT = WS_BIG + 352 * MiB;
constexpr size_t WS_SSP = WS_ACT + 176 * MiB;
constexpr size_t WS_END = WS_SSP + 2 * MiB;
constexpr int LDS_BYTES = 147456, MISC_OFF = LDS_BYTES - 64, XS_OFF = 131072, RRW_OFF = XS_OFF + 8192;

typedef unsigned short bf16_t;
typedef float f32x4 __attribute__((ext_vector_type(4)));
typedef unsigned u32x4 __attribute__((ext_vector_type(4)));
typedef unsigned u32x2 __attribute__((ext_vector_type(2)));
typedef short bf16x8 __attribute__((ext_vector_type(8)));
#define LAS __attribute__((address_space(3)))
__device__ __forceinline__ unsigned pk2(float lo, float hi) { return pg8::cvt_pk_bf16(lo, hi); }
__device__ __forceinline__ float bf_lo(unsigned w) { return __uint_as_float(w << 16); }
__device__ __forceinline__ float bf_hi(unsigned w) { return __uint_as_float(w & 0xffff0000u); }
__device__ __forceinline__ float wave_sum(float v, int lane) {
#pragma unroll
    for (int o = 1; o < 64; o <<= 1) v += lane_read(v, lane ^ o);
    return v;
}
struct Args { const float* in[21]; float* out; unsigned char* ws; };
#define XB_TMO      128
#define XB_XCNT(j)  (256  + 64 * (j))
#define XB_XSUB(j)  (1280 + 64 * (j))
#define XB_XGEN(j)  (2304 + 64 * (j))
#define XB_TOP      3328
#define XB_TOPGEN   3392
#define XCD_BAR_WORDS 3456
#define XB_SPIN_CAP (1u << 18)

__device__ __forceinline__ unsigned xb_ld(unsigned* p)              { return __hip_atomic_load(p, __ATOMIC_RELAXED, __HIP_MEMORY_SCOPE_AGENT); }
__device__ __forceinline__ unsigned xb_add(unsigned* p, unsigned v) { return __hip_atomic_fetch_add(p, v, __ATOMIC_RELAXED, __HIP_MEMORY_SCOPE_AGENT); }
__device__ __forceinline__ unsigned xb_xcc_id() { return (unsigned)__builtin_amdgcn_s_getreg((3 << 11) | 20) & 0xFu; }
#define XB_SPIN(cond, bar) do { unsigned _sp = 0; while (cond) { __builtin_amdgcn_s_sleep(1); \
    if ((++_sp & 255u) == 0u) { if (xb_ld(&(bar)[XB_TMO])) break; if (_sp > XB_SPIN_CAP) { atomicAdd(&(bar)[XB_TMO], 1u); break; } } } } while (0)

struct XcdBarrier {
    unsigned* bar; unsigned x;
    volatile LAS unsigned* st;
};

__device__ __forceinline__ XcdBarrier xcd_barrier_post(unsigned* bar, volatile LAS unsigned* st) {
    XcdBarrier b; b.bar = bar; b.x = xb_xcc_id(); b.st = st;
    if (threadIdx.x == 0) (void)xb_add(&bar[XB_XCNT(b.x)], 1u);
    return b;
}
__device__ __forceinline__ void xcd_barrier_complete(unsigned* bar, unsigned x, unsigned& nloc, unsigned& nx) {
    const unsigned G = gridDim.x * gridDim.y * gridDim.z;
    unsigned sum, cnt, mine, sp = 0u;
    for (;;) {
        sum = 0u; cnt = 0u; mine = 0u;
#pragma unroll
        for (unsigned j = 0; j < 16; ++j) { const unsigned c = xb_ld(&bar[XB_XCNT(j)]); sum += c; cnt += (c > 0u) ? 1u : 0u; mine = (j == x) ? c : mine; }
        if (sum == G) break;
        __builtin_amdgcn_s_sleep(1);
        if ((++sp & 255u) == 0u) { if (xb_ld(&bar[XB_TMO])) break; if (sp > XB_SPIN_CAP) { atomicAdd(&bar[XB_TMO], 1u); break; } }
    }
    nloc = mine > 0u ? mine : 1u; nx = cnt > 0u ? cnt : 1u;
}

__device__ __forceinline__ void xcd_barrier(const XcdBarrier& b) {
    asm volatile("s_waitcnt vmcnt(0)" ::: "memory");
    __syncthreads();
    if (threadIdx.x == 0) {
        unsigned* bar = b.bar;
        __builtin_amdgcn_s_waitcnt(0);
        unsigned nloc = b.st[0], nx = b.st[1];
        if (nloc == 0u) { xcd_barrier_complete(bar, b.x, nloc, nx); b.st[0] = nloc; b.st[1] = nx; }
        const unsigned old = xb_add(&bar[XB_XSUB(b.x)], 1u);
        const unsigned gen = old / nloc;
        if (old + 1u == (gen + 1u) * nloc) {
            __builtin_amdgcn_fence(__ATOMIC_RELEASE, "agent");
            asm volatile("s_waitcnt vmcnt(0)" ::: "memory");
            const unsigned og = xb_add(&bar[XB_TOP], 1u);
            const unsigned tg = og / nx;
            if (og + 1u == (tg + 1u) * nx) xb_add(&bar[XB_TOPGEN], 1u);
            else XB_SPIN(xb_ld(&bar[XB_TOPGEN]) == tg, bar);
            __builtin_amdgcn_fence(__ATOMIC_ACQUIRE, "agent");
            xb_add(&bar[XB_XGEN(b.x)], 1u);
            asm volatile("s_waitcnt vmcnt(0)" ::: "memory");
        } else {
            XB_SPIN(xb_ld(&bar[XB_XGEN(b.x)]) == gen, bar);
            __builtin_amdgcn_fence(__ATOMIC_ACQUIRE, "agent");
            asm volatile("s_waitcnt vmcnt(0)" ::: "memory");
        }
    }
    __syncthreads();
}


__device__ __forceinline__ int up_row(int n) { return n < FF ? (n >> 7) * 256 + (n & 127) : ((n - FF) >> 7) * 256 + 128 + ((n - FF) & 127); }
constexpr int TR_LDS_PER_WAVE = 64 * 65 * 4;
__device__ __forceinline__ void transpose_item(const float* W, int K, int ld, int ncols, const float* gk, bf16_t* WT, int mode, LAS float* scr, int item, int lane) {
    const int nblk = ncols / 64, kb = item / nblk, nb = item % nblk, k0 = 64 * kb, n0 = 64 * nb, kr = lane >> 4, n4 = (lane & 15) * 4;
    f32x4 v[16];
#pragma unroll
    for (int i = 0; i < 16; ++i) v[i] = *(const f32x4*)(W + (size_t)(k0 + 4 * i + kr) * ld + n0 + n4);
#pragma unroll
    for (int i = 0; i < 16; ++i) { const int kk = 4 * i + kr; const float g = gk ? gk[k0 + kk] : 1.f; LAS float* d = scr + kk * 65 + n4; d[0] = v[i].x * g; d[1] = v[i].y * g; d[2] = v[i].z * g; d[3] = v[i].w * g; }
    asm volatile("s_waitcnt lgkmcnt(0)" ::: "memory");
    const int c = lane & 7; const int r0 = mode ? up_row(n0) : n0;
#pragma unroll
    for (int j = 0; j < 8; ++j) { const int n = (lane >> 3) + 8 * j; const LAS float* p = scr + (8 * c) * 65 + n;
        u32x4 o; o.x = pk2(p[0 * 65], p[1 * 65]); o.y = pk2(p[2 * 65], p[3 * 65]); o.z = pk2(p[4 * 65], p[5 * 65]); o.w = pk2(p[6 * 65], p[7 * 65]);
        *(u32x4*)(WT + (size_t)(r0 + n) * K + k0 + 8 * c) = o; }
    asm volatile("s_waitcnt lgkmcnt(0)" ::: "memory");
}
__device__ __forceinline__ void fgate_rows(LAS unsigned char* ldsp, const bf16_t* hb, const float* rss, const bf16_t* wfh, const bf16_t* wfl, const float* bf, float* logf, int wave, int lane) {
    const int fr = lane & 15, fq = lane >> 4, kh = wave >> 2; LAS f32x4* part = (LAS f32x4*)ldsp;
    for (int rg0 = blockIdx.x * 4; rg0 < MT / 16; rg0 += gridDim.x * 4) {
        const int rg = rg0 + (wave & 3);
        const bf16_t* hrow = hb + (size_t)(rg * 16 + fr) * DM + 8 * fq + kh * (DM / 2); const bf16_t* wh = wfh + fr * DM + 8 * fq + kh * (DM / 2); const bf16_t* wl = wfl + fr * DM + 8 * fq + kh * (DM / 2);
        f32x4 acc = {0.f, 0.f, 0.f, 0.f};
        for (int ks0 = 0; ks0 < DM / 64; ks0 += 8) {
            bf16x8 hv[8], whv[8], wlv[8];
#pragma unroll
            for (int i = 0; i < 8; ++i) { hv[i] = *(const bf16x8*)(hrow + 32 * (ks0 + i)); whv[i] = *(const bf16x8*)(wh + 32 * (ks0 + i)); wlv[i] = *(const bf16x8*)(wl + 32 * (ks0 + i)); }
#pragma unroll
            for (int i = 0; i < 8; ++i) asm volatile("" : "+v"(hv[i]), "+v"(whv[i]), "+v"(wlv[i]) :: "memory");
#pragma unroll
            for (int i = 0; i < 8; ++i) { acc = __builtin_amdgcn_mfma_f32_16x16x32_bf16(whv[i], hv[i], acc, 0, 0, 0); acc = __builtin_amdgcn_mfma_f32_16x16x32_bf16(wlv[i], hv[i], acc, 0, 0, 0); }
        }
        __syncthreads();
        if (kh == 1) part[(wave & 3) * 64 + lane] = acc;
        __syncthreads();
        if (kh == 0) {
            acc = acc + part[(wave & 3) * 64 + lane];
            const f32x4* rp = (const f32x4*)(rss + (size_t)(rg * 16 + fr) * 32 + fq * 8); const f32x4 ra = rp[0], rb = rp[1];
            float ssq = ((ra[0] + ra[1]) + (ra[2] + ra[3])) + ((rb[0] + rb[1]) + (rb[2] + rb[3])); ssq += lane_read(ssq, lane ^ 16); ssq += lane_read(ssq, lane ^ 32);
            const float r = 1.0f / sqrtf(ssq * (1.0f / DM) + EPS);
            const f32x4 b = *(const f32x4*)(bf + 4 * fq); f32x4 o;
#pragma unroll
            for (int e = 0; e < 4; ++e) { const float f = acc[e] * r + b[e]; o[e] = fminf(f, 0.f) - log1pf(expf(-fabsf(f))); }
            *(f32x4*)(logf + (size_t)(rg * 16 + fr) * 16 + 4 * fq) = o;
        }
    }
}
__device__ __forceinline__ void scan_seq(const float* logf, unsigned long long* CA, int seq, int lane) {
    const int b = seq >> 4, hh = seq & 15;
    const float* lf = logf + ((size_t)b * SEQ + (size_t)lane * 64) * 16 + hh;
    float v[64];
#pragma unroll
    for (int i = 0; i < 64; ++i) v[i] = lf[i * 16];
#pragma unroll
    for (int i = 1; i < 64; ++i) v[i] += v[i - 1];
    const float tot = v[63]; float t = tot;
#pragma unroll
    for (int o = 1; o < 64; o <<= 1) { const float y = lane_read(t, lane >= o ? lane - o : lane); if (lane >= o) t += y; }
    const float excl = t - tot;
    unsigned long long* out = CA + (size_t)seq * SEQ + lane * 64;
#pragma unroll
    for (int i = 0; i < 64; ++i) { const float c = (excl + v[i]) * -11.313708498984761f;
        const unsigned h1 = pk2(c, 0.f) & 0xffffu; const float r1 = c - bf_lo(h1);
        const unsigned h2 = pk2(r1, 0.f) & 0xffffu; const float r2 = r1 - bf_lo(h2);
        const unsigned h3 = pk2(r2, 0.f) & 0xffffu;
        out[i] = (unsigned long long)(h1 | (h2 << 16)) | ((unsigned long long)h3 << 32); }
}
__device__ __forceinline__ void spatial_phase(LAS unsigned char* ldsp, const bf16_t* Z, const float* ssp, const bf16_t* wsb, const float* vnorm, const float* bs, bf16_t* GATED, int wave, int lane) {
    const int fr = lane & 15, fq = lane >> 4;
    for (int item = blockIdx.x; item < (MT / CH) * NG; item += gridDim.x) {
        const int ch = item >> 4, g = item & 15, row0 = ch * CH, cw = g * 128 + wave * 16;
        LAS float* rvs = (LAS float*)ldsp;
        __syncthreads();
        { const int t_ = wave * 64 + lane; if (t_ < CH) { const f32x4* p = (const f32x4*)(ssp + (size_t)(row0 + t_) * 32); float sq = 0.f;
#pragma unroll
            for (int q = 0; q < 8; ++q) { const f32x4 v = p[q]; sq += (v.x + v.y) + (v.z + v.w); }
            rvs[t_] = 1.0f / sqrtf(sq * (1.0f / DM) + EPS); } }
        __syncthreads();
        LAS unsigned* VS = (LAS unsigned*)(ldsp + 1024);
        { const int t_ = wave * 64 + lane, srow = t_ >> 2, c0 = (t_ & 3) * 32; const float rv = rvs[srow];
          const u32x4* gp = (const u32x4*)(Z + (size_t)(row0 + srow) * 4096 + 2048 + g * 128 + c0); u32x4 q[4];
#pragma unroll
          for (int jj = 0; jj < 4; ++jj) q[jj] = gp[jj];
#pragma unroll
          for (int jj = 0; jj < 4; ++jj) { LAS unsigned* d = VS + srow * 65 + (c0 >> 1) + jj * 4;
#pragma unroll
              for (int e = 0; e < 4; ++e) d[e] = pk2(bf_lo(q[jj][e]) * rv, bf_hi(q[jj][e]) * rv); } }
        __syncthreads();
        bf16x8 vf[4];
        { const LAS unsigned short* vs16 = (const LAS unsigned short*)VS + wave * 16 + fr;
#pragma unroll
          for (int ks = 0; ks < 4; ++ks) { unsigned hv[8];
#pragma unroll
              for (int i = 0; i < 8; ++i) hv[i] = vs16[(32 * ks + 8 * fq + i) * 130];
              u32x4 w; w.x = hv[0] | (hv[1] << 16); w.y = hv[2] | (hv[3] << 16); w.z = hv[4] | (hv[5] << 16); w.w = hv[6] | (hv[7] << 16); vf[ks] = __builtin_bit_cast(bf16x8, w); } }
        bf16x8 wfr[8][4]; u32x2 uu[8]; float bias[8];
#pragma unroll
        for (int m = 0; m < 8; ++m) {
#pragma unroll
            for (int ks = 0; ks < 4; ++ks) if (32 * ks <= 16 * m + 15) wfr[m][ks] = *(const bf16x8*)(wsb + ((size_t)(g * 128 + 16 * m + fr) * 128 + 32 * ks + 8 * fq));
            uu[m] = *(const u32x2*)(Z + (size_t)(row0 + 16 * m + fr) * 4096 + cw + 4 * fq); bias[m] = bs[g * 128 + 16 * m + fr]; }
        const f32x4 vn = *(const f32x4*)(vnorm + cw + 4 * fq);
        f32x4 acc[8];
#pragma unroll
        for (int m = 0; m < 8; ++m) { acc[m] = (f32x4){0.f, 0.f, 0.f, 0.f};
#pragma unroll
            for (int ks = 0; ks < 4; ++ks) if (32 * ks <= 16 * m + 15) acc[m] = __builtin_amdgcn_mfma_f32_16x16x32_bf16(vf[ks], wfr[m][ks], acc[m], 0, 0, 0); }
#pragma unroll
        for (int m = 0; m < 8; ++m) { const size_t row = (size_t)(row0 + 16 * m + fr);
            const float o0 = bf_lo(uu[m].x) * (acc[m][0] * vn[0] + bias[m]), o1 = bf_hi(uu[m].x) * (acc[m][1] * vn[1] + bias[m]), o2 = bf_lo(uu[m].y) * (acc[m][2] * vn[2] + bias[m]), o3 = bf_hi(uu[m].y) * (acc[m][3] * vn[3] + bias[m]);
            u32x2 w; w.x = pk2(o0, o1); w.y = pk2(o2, o3); *(u32x2*)(GATED + row * DM + cw + 4 * fq) = w; }
    }
}
__device__ __forceinline__ void conv_phase(const bf16_t* BIG, const float* cw, const float* cb, bf16_t* ACT) {
    constexpr int NQ = FF / 8, RS = 32, NTASK = NQ * (MT / RS);
    const int tid_ = opaque_tid();
    for (int T = blockIdx.x * NTHREADS + tid_; T < NTASK; T += gridDim.x * NTHREADS) {
        const int qb = (NQ / 64 - 1) - T / (64 * (MT / RS)), rem = T % (64 * (MT / RS)), strip = rem >> 6, q = qb * 64 + (rem & 63), j0 = 8 * q, pg = (q >> 4) * 256 + (q & 15) * 8, row0 = strip * RS;
        float wg[3][8], wv[3][8], bg[8], bv[8];
#pragma unroll
        for (int k = 0; k < 3; ++k)
#pragma unroll
            for (int e = 0; e < 8; ++e) { wg[k][e] = cw[(size_t)k * FF2 + j0 + e]; wv[k][e] = cw[(size_t)k * FF2 + FF + j0 + e]; }
#pragma unroll
        for (int e = 0; e < 8; ++e) { bg[e] = cb[j0 + e]; bv[e] = cb[FF + j0 + e]; }
        const bf16_t* src = BIG + (size_t)row0 * FF2 + pg; bf16_t* dst = ACT + (size_t)row0 * FF + j0;
        u32x4 g2 = {0u, 0u, 0u, 0u}, g1 = g2, v2 = g2, v1 = g2;
        if ((row0 & (SEQ - 1)) != 0) { g2 = *(const u32x4*)(src - 2 * (size_t)FF2); v2 = *(const u32x4*)(src - 2 * (size_t)FF2 + 128); g1 = *(const u32x4*)(src - (size_t)FF2); v1 = *(const u32x4*)(src - (size_t)FF2 + 128); }
        for (int i0 = 0; i0 < RS; i0 += 8) {
            u32x4 gc[8], vc[8];
#pragma unroll
            for (int i = 0; i < 8; ++i) { gc[i] = *(const u32x4*)(src + (size_t)(i0 + i) * FF2); vc[i] = *(const u32x4*)(src + (size_t)(i0 + i) * FF2 + 128); }
#pragma unroll
            for (int i = 0; i < 8; ++i) { u32x4 o;
#pragma unroll
                for (int p = 0; p < 4; ++p) {
                    const float ga = wg[0][2 * p] * bf_lo(g2[p]) + wg[1][2 * p] * bf_lo(g1[p]) + wg[2][2 * p] * bf_lo(gc[i][p]) + bg[2 * p];
                    const float gb = wg[0][2 * p + 1] * bf_hi(g2[p]) + wg[1][2 * p + 1] * bf_hi(g1[p]) + wg[2][2 * p + 1] * bf_hi(gc[i][p]) + bg[2 * p + 1];
                    const float va = wv[0][2 * p] * bf_lo(v2[p]) + wv[1][2 * p] * bf_lo(v1[p]) + wv[2][2 * p] * bf_lo(vc[i][p]) + bv[2 * p];
                    const float vb = wv[0][2 * p + 1] * bf_hi(v2[p]) + wv[1][2 * p + 1] * bf_hi(v1[p]) + wv[2][2 * p + 1] * bf_hi(vc[i][p]) + bv[2 * p + 1];
                    const float sa = ga * __builtin_amdgcn_rcpf(1.0f + __builtin_amdgcn_exp2f(-1.4426950408889634f * ga)), sb = gb * __builtin_amdgcn_rcpf(1.0f + __builtin_amdgcn_exp2f(-1.4426950408889634f * gb));
                    o[p] = pk2(sa * va, sb * vb); }
                *(u32x4*)(dst + (size_t)(i0 + i) * FF) = o; g2 = g1; g1 = gc[i]; v2 = v1; v1 = vc[i]; }
        }
    }
}

typedef const Args __attribute__((address_space(4))) CArgs;
__device__ __forceinline__ CArgs* kargs() { CArgs* p = (CArgs*)__builtin_amdgcn_kernarg_segment_ptr(); asm volatile("" : "+s"(p)); return p; }
#define PTRS \
    CArgs* ap_ = kargs(); unsigned char* ws = ap_->ws; float* h = ap_->out; (void)ws; (void)h; \
    const float* x = ap_->in[0]; const float* a_norm = ap_->in[1]; const float* a_w_in = ap_->in[2]; const float* a_v_norm = ap_->in[3]; const float* a_w_s = ap_->in[4]; const float* a_b_s = ap_->in[5]; \
    const float* a_w_out = ap_->in[6]; const float* kv_norm = ap_->in[7]; const float* w_kvf = ap_->in[8]; const float* b_f = ap_->in[9]; const float* k_norm = ap_->in[10]; const float* b_norm = ap_->in[11]; \
    const float* b_w_qg = ap_->in[12]; const float* q_norm = ap_->in[13]; const float* b_w_out = ap_->in[14]; const float* f_norm = ap_->in[15]; const float* f_w_up = ap_->in[16]; const float* f_conv_w = ap_->in[17]; \
    const float* f_conv_b = ap_->in[18]; const float* f_w_down = ap_->in[19]; const float* final_norm = ap_->in[20]; \
    (void)x; (void)a_norm; (void)a_w_in; (void)a_v_norm; (void)a_w_s; (void)a_b_s; (void)a_w_out; (void)kv_norm; (void)w_kvf; (void)b_f; (void)k_norm; (void)b_norm; (void)b_w_qg; (void)q_norm; (void)b_w_out; \
    (void)f_norm; (void)f_w_up; (void)f_conv_w; (void)f_conv_b; (void)f_w_down; (void)final_norm; \
    float* VSS = (float*)(ws + WS_SSP); float* LOGF = (float*)(ws + WS_LOGF); unsigned long long* CA = (unsigned long long*)(ws + WS_CA); \
    bf16_t* WSB = (bf16_t*)(ws + WS_WSB); bf16_t* WFH = (bf16_t*)(ws + WS_WF); bf16_t* WFL = WFH + 16 * DM; \
    bf16_t* W_AIN = (bf16_t*)(ws + WS_W_AIN); bf16_t* W_AOUT = (bf16_t*)(ws + WS_W_AOUT); bf16_t* W_KV = (bf16_t*)(ws + WS_W_KV); bf16_t* W_QG = (bf16_t*)(ws + WS_W_QG); \
    bf16_t* W_BOUT = (bf16_t*)(ws + WS_W_BOUT); bf16_t* W_UP = (bf16_t*)(ws + WS_W_UP); bf16_t* W_DN = (bf16_t*)(ws + WS_W_DN); \
    bf16_t* HB = (bf16_t*)(ws + WS_XN); float* RSS = (float*)(ws + WS_XN2); bf16_t* KVB = (bf16_t*)(ws + WS_KV); bf16_t* BIG = (bf16_t*)(ws + WS_BIG); bf16_t* ACT = (bf16_t*)(ws + WS_ACT); \
    (void)VSS; (void)LOGF; (void)CA; (void)WSB; (void)WFH; (void)WFL; (void)W_AIN; (void)W_AOUT; (void)W_KV; (void)W_QG; (void)W_BOUT; (void)W_UP; (void)W_DN; (void)HB; (void)RSS; (void)KVB; (void)BIG; (void)ACT;
typedef pg8::EpiBf<1, true> EPI_A1; typedef pg8::EpiBf<0, true, true, true> EPI_KV; typedef pg8::EpiBf<2, true, false, true> EPI_QG; typedef pg8::EpiBf<0, true> EPI_UP;
#define GEMM_PHASE(EPI, Aptr, Bptr, NN, KK, ...) do { pg8::Gemm g_{Aptr, Bptr, MT, NN, KK}; pg8::StaticOrder S_; S_.init(MT, NN, G, (int)blockIdx.x); EPI E_{__VA_ARGS__}; \
    pg8::gemm_phase<EPI, pg8::StaticOrder, true, true>(ldsp, g_, S_, E_); } while (0)

__global__ void __launch_bounds__(NTHREADS, 2) fwd_megakernel(Args a) {
    extern __shared__ __attribute__((aligned(16))) unsigned char lds[];
    cg::grid_group grid = cg::this_grid();
#define GSYNC_CG() do { asm volatile("s_waitcnt vmcnt(0)" ::: "memory"); grid.sync(); } while (0)
#define GSYNC() do { XcdBarrier b_ = xbar; asm volatile("" : "+s"(b_.bar), "+s"(b_.x)); xcd_barrier(b_); } while (0)
    const int wave = __builtin_amdgcn_readfirstlane(threadIdx.x >> 6);
    const int G = gridDim.x, gw = blockIdx.x * NWAVES + wave, NGW = G * NWAVES;
    LAS unsigned char* ldsp = (LAS unsigned char*)lds;
    if (threadIdx.x < 16) ((LAS unsigned*)(ldsp + MISC_OFF))[threadIdx.x] = 0u;
    __syncthreads();
    const XcdBarrier xbar = xcd_barrier_post((unsigned*)(kargs()->ws + WS_BAR), (volatile LAS unsigned*)(ldsp + MISC_OFF));

    {
        PTRS
        const int tid = opaque_tid(), lane = tid & 63;
        const int gt = blockIdx.x * NTHREADS + tid, NGT = G * NTHREADS;
        for (int i = gt; i < 2 * NG * CH * CH / 8; i += NGT) {
            const int e0 = i * 8, s0 = e0 & 127, t = (e0 >> 7) & 127; const f32x4 w0 = *(const f32x4*)(a_w_s + e0), w1 = *(const f32x4*)(a_w_s + e0 + 4);
            float y[8] = {w0.x, w0.y, w0.z, w0.w, w1.x, w1.y, w1.z, w1.w};
#pragma unroll
            for (int e = 0; e < 8; ++e) if (s0 + e > t) y[e] = 0.f;
            u32x4 o; o.x = pk2(y[0], y[1]); o.y = pk2(y[2], y[3]); o.z = pk2(y[4], y[5]); o.w = pk2(y[6], y[7]); *(u32x4*)(WSB + e0) = o; }
        for (int i = gt; i < 16 * DM; i += NGT) { const int n = i / DM, k = i % DM; const float w = kv_norm[k] * w_kvf[(size_t)k * 4112 + 4096 + n];
            const unsigned hi = pk2(w, 0.f) & 0xffffu; WFH[i] = (bf16_t)hi; WFL[i] = (bf16_t)(pk2(w - bf_lo(hi), 0.f) & 0xffffu); }
        LAS float* scr = (LAS float*)(ldsp + wave * TR_LDS_PER_WAVE);
        for (int it = gw; it < 48128 * (PROBE == 4 ? 2 : 1); it += NGW) {
            int r = it % 48128, K = DM, ld, ncols, mode = 0; const float* W; const float* g = nullptr; bf16_t* WT;
            if (r < 4096) { const int l = r >> 11; r &= 2047; W = a_w_in + (size_t)l * DM * 4096; g = a_norm + l * DM; WT = W_AIN + (size_t)l * 4096 * DM; ld = 4096; ncols = 4096; }
            else if ((r -= 4096) < 2048) { const int l = r >> 10; r &= 1023; W = a_w_out + (size_t)l * DM * DM; WT = W_AOUT + (size_t)l * DM * DM; ld = DM; ncols = DM; }
            else if ((r -= 2048) < 2048) { W = w_kvf; g = kv_norm; WT = W_KV; ld = 4112; ncols = 4096; }
            else if ((r -= 2048) < 4096) { const int l = r >> 11; r &= 2047; W = b_w_qg + (size_t)l * DM * 4096; g = b_norm + l * DM; WT = W_QG + (size_t)l * 4096 * DM; ld = 4096; ncols = 4096; }
            else if ((r -= 4096) < 2048) { const int l = r >> 10; r &= 1023; W = b_w_out + (size_t)l * DM * DM; WT = W_BOUT + (size_t)l * DM * DM; ld = DM; ncols = DM; }
            else if ((r -= 2048) < 22528) { const int l = r / 5632; r -= l * 5632; W = f_w_up + (size_t)l * DM * FF2; g = f_norm + l * DM; WT = W_UP + (size_t)l * FF2 * DM; ld = FF2; ncols = FF2; mode = 1; }
            else { r -= 22528; const int l = r / 2816; r -= l * 2816; W = f_w_down + (size_t)l * FF * DM; WT = W_DN + (size_t)l * DM * FF; K = FF; ld = DM; ncols = DM; }
            transpose_item(W, K, ld, ncols, g, WT, mode, scr, r, lane);
        }
        for (int m = gw; m < MT; m += NGW) {
            const f32x4* xr = (const f32x4*)(x + (size_t)m * DM) + lane; u32x2* o = (u32x2*)(HB + (size_t)m * DM) + lane; float sq = 0.f; f32x4 xv[8];
#pragma unroll
            for (int j = 0; j < 8; ++j) xv[j] = xr[64 * j];
#pragma unroll
            for (int j = 0; j < 8; ++j) { const f32x4 v = xv[j]; sq += (v.x * v.x + v.y * v.y) + (v.z * v.z + v.w * v.w); u32x2 w; w.x = pk2(v.x, v.y); w.y = pk2(v.z, v.w); o[64 * j] = w; }
            sq = wave_sum(sq, lane); if (lane < 32) RSS[(size_t)m * 32 + lane] = lane == 0 ? sq : 0.f;
        }
    }
    if (kargs()->ws == nullptr) GSYNC_CG();
    GSYNC();

    for (int l = 0; l < 4; ++l) {
        if (l < 2) {
            for (int rep_ = 0; rep_ < (PROBE == 10 ? 2 : 1); ++rep_) {
            { PTRS GEMM_PHASE(EPI_A1, HB, W_AIN + (size_t)l * 4096 * DM, 4096, DM, BIG, 4096, 8, VSS, RSS, nullptr, nullptr, (LAS float*)(ldsp + RRW_OFF)); }
            GSYNC(); }
            for (int rep_ = 0; rep_ < (PROBE == 6 ? 2 : 1); ++rep_) { if (rep_) GSYNC();
            { PTRS const int lane = opaque_tid() & 63;
              spatial_phase(ldsp, BIG, VSS, WSB + (size_t)l * NG * CH * CH, a_v_norm + (size_t)l * DM, a_b_s + (size_t)l * NG * CH, ACT, wave, lane); } }
            GSYNC();
        } else {
            const int j = l - 2;
            if (j == 0) { { PTRS const int lane = opaque_tid() & 63; fgate_rows(ldsp, HB, RSS, WFH, WFL, b_f, LOGF, wave, lane); }
                          PTRS GEMM_PHASE(EPI_KV, HB, W_KV, 4096, DM, KVB, 4096, 1 << 30, nullptr, RSS, k_norm, (LAS float*)(ldsp + XS_OFF), (LAS float*)(ldsp + RRW_OFF)); }
            { PTRS GEMM_PHASE(EPI_QG, HB, W_QG + (size_t)j * 4096 * DM, 4096, DM, BIG, 4096, 8, nullptr, RSS, q_norm + (size_t)j * HD, (LAS float*)(ldsp + XS_OFF), (LAS float*)(ldsp + RRW_OFF)); }
            GSYNC();
            if (j == 0) { { PTRS const int lane = opaque_tid() & 63; if (blockIdx.x < 8) scan_seq(LOGF, CA, blockIdx.x * 8 + wave, lane); }
                          GSYNC(); }
            for (int rep_ = 0; rep_ < (PROBE == 2 ? 2 : 1); ++rep_) {
            { PTRS att::AttnT T{(const att::bf16*)BIG, (const att::bf16*)KVB, (const att::bf16*)(KVB + (size_t)MT * 2048), (att::bf16*)ACT, BIG + 2048, CA};
              att::attn_phase((char*)lds, T, NB, NH, SEQ); }
            GSYNC(); }
        }
        { PTRS const bf16_t* Wt = l < 2 ? W_AOUT + (size_t)l * DM * DM : W_BOUT + (size_t)(l - 2) * DM * DM;
          GEMM_PHASE(pg8::EpiRes, ACT, Wt, DM, DM, HB, RSS, DM);
        }
        GSYNC();
        { PTRS GEMM_PHASE(EPI_UP, HB, W_UP + (size_t)l * FF2 * DM, FF2, DM, BIG, FF2, 1 << 30, nullptr, RSS, nullptr, nullptr, (LAS float*)(ldsp + RRW_OFF)); }
        GSYNC();
#if PROBE == 1
        { PTRS GEMM_PHASE(EPI_UP, HB, W_UP + (size_t)l * FF2 * DM, FF2, DM, BIG, FF2, 1 << 30, nullptr, RSS, nullptr, nullptr, (LAS float*)(ldsp + RRW_OFF)); }
        GSYNC();
#endif
        { PTRS conv_phase(BIG, f_conv_w + (size_t)l * 3 * FF2, f_conv_b + (size_t)l * FF2, ACT); }
        GSYNC();
#if PROBE == 3
        { PTRS conv_phase(BIG, f_conv_w + (size_t)l * 3 * FF2, f_conv_b + (size_t)l * FF2, ACT); }
        GSYNC();
#endif
        { PTRS GEMM_PHASE(pg8::EpiRes, ACT, W_DN + (size_t)l * DM * FF, DM, FF, HB, RSS, DM);
        }
        GSYNC();
    }
#if PROBE == 7
    for (int rep_ = 0; rep_ < 20; ++rep_) GSYNC();
#endif
    { PTRS const int lane = opaque_tid() & 63;
      for (int m = gw; m < MT; m += NGW) {
          const float part = lane < 32 ? RSS[(size_t)m * 32 + lane] : 0.f; const float r = 1.0f / sqrtf(wave_sum(part, lane) * (1.0f / DM) + EPS);
          const u32x4* p = (const u32x4*)(HB + (size_t)m * DM) + lane; float* orow = h + (size_t)m * DM; u32x4 wq[4]; f32x4 gq[4][2];
#pragma unroll
          for (int j = 0; j < 4; ++j) { wq[j] = p[64 * j]; const int c = (64 * j + lane) * 8; gq[j][0] = *(const f32x4*)(final_norm + c); gq[j][1] = *(const f32x4*)(final_norm + c + 4); }
#pragma unroll
          for (int j = 0; j < 4; ++j) { const u32x4 w = wq[j]; const int c = (64 * j + lane) * 8; const f32x4 g0 = gq[j][0], g1 = gq[j][1];
              f32x4 o0 = {bf_lo(w.x) * r * g0[0], bf_hi(w.x) * r * g0[1], bf_lo(w.y) * r * g0[2], bf_hi(w.y) * r * g0[3]}, o1 = {bf_lo(w.z) * r * g1[0], bf_hi(w.z) * r * g1[1], bf_lo(w.w) * r * g1[2], bf_hi(w.w) * r * g1[3]};
              *(f32x4*)(orow + c) = o0; *(f32x4*)(orow + c + 4) = o1; } } }
}

extern "C" void kernel_launch(void* const* d_in, const int* in_sizes, int n_in, void* d_out, int out_size, void* d_ws, size_t ws_size, hipStream_t stream) {
    static int grid = 0;
    if (grid == 0) {
        if (n_in != 21 || out_size != MT * DM || ws_size < WS_END) { fprintf(stderr, "kernel_launch: unexpected shapes (n_in %d out %d ws %zu, need ws >= %zu)\n", n_in, out_size, ws_size, (size_t)WS_END); grid = -1; return; }
        int dev = 0, cus = 0, per_cu = 0;
        (void)hipGetDevice(&dev); (void)hipDeviceGetAttribute(&cus, hipDeviceAttributeMultiprocessorCount, dev);
        (void)hipFuncSetAttribute((const void*)fwd_megakernel, hipFuncAttributeMaxDynamicSharedMemorySize, LDS_BYTES);
        (void)hipOccupancyMaxActiveBlocksPerMultiprocessor(&per_cu, (const void*)fwd_megakernel, NTHREADS, LDS_BYTES);
        if (per_cu < 1) { fprintf(stderr, "kernel_launch: occupancy query says %d blocks per CU\n", per_cu); per_cu = 1; }
        grid = cus * 1;
        (void)hipGetLastError();
    }
    if (grid < 0) return;
    (void)hipMemsetAsync((char*)d_ws + WS_BAR, 0, BAR_ZERO_BYTES, stream);
    Args a{};
    for (int i = 0; i < 21; ++i) a.in[i] = (const float*)d_in[i];
    a.out = (float*)d_out; a.ws = (unsigned char*)d_ws;
    void* args[] = {&a};
    hipError_t e = hipLaunchCooperativeKernel((const void*)fwd_megakernel, dim3(grid), dim3(NTHREADS), args, LDS_BYTES, stream);
    if (e != hipSuccess) fprintf(stderr, "cooperative launch failed: %s (grid %d)\n", hipGetErrorString(e), grid);
}
```
